# Optimizing an MI355X kernel written in HIP

```python
import math
import jax
import jax.numpy as jnp
import numpy as np

D_MODEL = 1024
BATCH = 4
SEQ = 4096
DEPTH = 2

N_A_LAYERS = DEPTH // 2
N_B_LAYERS = DEPTH - N_A_LAYERS
HEAD_DIM = 64
N_FOX_HEADS = 12
FOX_WIDTH = N_FOX_HEADS * HEAD_DIM
N_DIFF_HEADS = 6
DIFF_QK_WIDTH = N_DIFF_HEADS * 2 * HEAD_DIM
DIFF_V_WIDTH = N_DIFF_HEADS * 2 * HEAD_DIM
N_MEM = 256
N_MEM_HEADS = 4
MEM_WIDTH = N_MEM_HEADS * HEAD_DIM
MIX_WIDTH = FOX_WIDTH + MEM_WIDTH
A_IN_WIDTH = 3 * FOX_WIDTH + N_FOX_HEADS + MEM_WIDTH
B_IN_WIDTH = DIFF_QK_WIDTH + MEM_WIDTH
SHARED_KV_WIDTH = DIFF_QK_WIDTH + DIFF_V_WIDTH
D_FF = -(-8 * D_MODEL // (3 * 256)) * 256
BLOCK_Q = 128
ROPE_THETA = 10000.0
NORM_EPS = 1e-6

kernel_name = "yoco_fox_diffattn_hybrid"


def rmsnorm(x, g):
    xf = x.astype(jnp.float32)
    y = xf * jax.lax.rsqrt(jnp.mean(xf * xf, axis=-1, keepdims=True) + NORM_EPS)
    return (y * g.astype(jnp.float32)).astype(x.dtype)


def split_heads(t, n_heads):
    B, S, W = t.shape
    return t.reshape(B, S, n_heads, W // n_heads).transpose(0, 2, 1, 3)


def merge_heads(t):
    B, H, S, Dh = t.shape
    return t.transpose(0, 2, 1, 3).reshape(B, S, H * Dh)


def rope(t):
    S, Dh = t.shape[-2], t.shape[-1]
    half = Dh // 2
    inv_freq = jnp.power(ROPE_THETA, -jnp.arange(half, dtype=jnp.float32) * (2.0 / Dh))
    ang = jnp.arange(S, dtype=jnp.float32)[:, None] * inv_freq[None, :]
    cos, sin = jnp.cos(ang), jnp.sin(ang)
    tf = t.astype(jnp.float32)
    t1, t2 = tf[..., :half], tf[..., half:]
    return jnp.concatenate([t1 * cos - t2 * sin, t1 * sin + t2 * cos], axis=-1).astype(t.dtype)


def causal_mask(q0, k_len):
    qi = q0 + jnp.arange(BLOCK_Q)[:, None]
    ki = jnp.arange(k_len)[None, :]
    return qi >= ki


def fox_attention(q, k, v, log_f):
    S, Dh = q.shape[2], q.shape[3]
    scale = Dh ** -0.5
    c = jnp.cumsum(log_f, axis=-1)
    outs = []
    for blk in range(S // BLOCK_Q):
        q0 = blk * BLOCK_Q
        q_end = q0 + BLOCK_Q
        s = jnp.einsum('bhqd,bhkd->bhqk', q[:, :, q0:q_end], k[:, :, :q_end]).astype(jnp.float32) * scale
        s = s + (c[:, :, q0:q_end, None] - c[:, :, None, :q_end])
        p = jax.nn.softmax(jnp.where(causal_mask(q0, q_end), s, -jnp.inf), axis=-1)
        outs.append(jnp.einsum('bhqk,bhkd->bhqd', p.astype(v.dtype), v[:, :, :q_end]))
    return jnp.concatenate(outs, axis=2)


def diff_attention(q1, q2, k1, k2, v, lam):
    S, Dh = q1.shape[2], q1.shape[3]
    scale = Dh ** -0.5
    outs = []
    for blk in range(S // BLOCK_Q):
        q0 = blk * BLOCK_Q
        q_end = q0 + BLOCK_Q
        mask = causal_mask(q0, q_end)
        s1 = jnp.einsum('bhqd,bhkd->bhqk', q1[:, :, q0:q_end], k1[:, :, :q_end]).astype(jnp.float32) * scale
        s2 = jnp.einsum('bhqd,bhkd->bhqk', q2[:, :, q0:q_end], k2[:, :, :q_end]).astype(jnp.float32) * scale
        p = (jax.nn.softmax(jnp.where(mask, s1, -jnp.inf), axis=-1)
             - lam * jax.nn.softmax(jnp.where(mask, s2, -jnp.inf), axis=-1))
        outs.append(jnp.einsum('bhqk,bhkd->bhqd', p.astype(v.dtype), v[:, :, :q_end]))
    return jnp.concatenate(outs, axis=2)


def memory_kv(mem, g, w_kv):
    kv = rmsnorm(mem, g) @ w_kv
    k, v = jnp.split(kv, 2, axis=-1)
    return split_heads(k, N_MEM_HEADS), split_heads(v, N_MEM_HEADS)


def memory_attention(mq, mem_k, mem_v):
    scale = mq.shape[-1] ** -0.5
    s = jnp.einsum('bhqd,bhmd->bhqm', mq, mem_k).astype(jnp.float32) * scale
    p = jax.nn.softmax(s, axis=-1)
    return jnp.einsum('bhqm,bhmd->bhqd', p.astype(mem_v.dtype), mem_v)


def fox_mixer(h, mem_k, mem_v, w_in, b_f):
    proj = h @ w_in
    q, k, v, f_logit, mq = jnp.split(
        proj, [FOX_WIDTH, 2 * FOX_WIDTH, 3 * FOX_WIDTH, 3 * FOX_WIDTH + N_FOX_HEADS], axis=-1)
    log_f = jax.nn.log_sigmoid(f_logit.astype(jnp.float32) + b_f.astype(jnp.float32)).transpose(0, 2, 1)
    y_fox = fox_attention(split_heads(q, N_FOX_HEADS), split_heads(k, N_FOX_HEADS),
                          split_heads(v, N_FOX_HEADS), log_f)
    y_mem = memory_attention(split_heads(mq, N_MEM_HEADS), mem_k, mem_v)
    return jnp.concatenate([merge_heads(y_fox), merge_heads(y_mem)], axis=-1)


def shared_kv(x, g, w):
    B, S, _ = x.shape
    kv = rmsnorm(x, g) @ w
    k, v = jnp.split(kv, [DIFF_QK_WIDTH], axis=-1)
    k = k.reshape(B, S, N_DIFF_HEADS, 2, HEAD_DIM).transpose(0, 2, 3, 1, 4)
    return rope(k[:, :, 0]), rope(k[:, :, 1]), split_heads(v, N_DIFF_HEADS)


def diff_mixer(h, k1, k2, v, mem_k, mem_v, w_in, lq1, lk1, lq2, lk2, subln_g, lambda_init):
    B, S, _ = h.shape
    proj = h @ w_in
    q, mq = jnp.split(proj, [DIFF_QK_WIDTH], axis=-1)
    q = q.reshape(B, S, N_DIFF_HEADS, 2, HEAD_DIM).transpose(0, 2, 3, 1, 4)
    q1, q2 = rope(q[:, :, 0]), rope(q[:, :, 1])
    lam = (jnp.exp(jnp.sum(lq1.astype(jnp.float32) * lk1.astype(jnp.float32)))
           - jnp.exp(jnp.sum(lq2.astype(jnp.float32) * lk2.astype(jnp.float32))) + lambda_init)
    y = diff_attention(q1, q2, k1, k2, v, lam)
    y = rmsnorm(y, subln_g) * (1.0 - lambda_init)
    y_mem = memory_attention(split_heads(mq, N_MEM_HEADS), mem_k, mem_v)
    return jnp.concatenate([merge_heads(y), merge_heads(y_mem)], axis=-1)


def swiglu(h, w_gate_up, w_down):
    g, u = jnp.split(h @ w_gate_up, 2, axis=-1)
    return (jax.nn.silu(g) * u) @ w_down


def setup_inputs(seed: int = 0) -> dict:
    key = jax.random.key(seed)
    ks = jax.random.split(key, 20)

    def nrm(k, shape, fan_in):
        return jax.random.normal(k, shape, jnp.float32) * (fan_in ** -0.5)

    def gain(k, shape):
        return 1.0 + 0.02 * jax.random.normal(k, shape, jnp.float32)

    return {
        "x": jax.random.normal(ks[0], (BATCH, SEQ, D_MODEL), jnp.float32),
        "mem": jax.random.normal(ks[1], (BATCH, N_MEM, D_MODEL), jnp.float32),
        "attn_norm_g": gain(ks[2], (DEPTH, D_MODEL)),
        "mem_norm_g": gain(ks[3], (DEPTH, D_MODEL)),
        "w_mem_kv": nrm(ks[4], (DEPTH, D_MODEL, 2 * MEM_WIDTH), D_MODEL),
        "w_out": nrm(ks[5], (DEPTH, MIX_WIDTH, D_MODEL), MIX_WIDTH),
        "ffn_norm_g": gain(ks[6], (DEPTH, D_MODEL)),
        "w_gate_up": nrm(ks[7], (DEPTH, D_MODEL, 2 * D_FF), D_MODEL),
        "w_down": nrm(ks[8], (DEPTH, D_FF, D_MODEL), D_FF),
        "a_w_in": nrm(ks[9], (N_A_LAYERS, D_MODEL, A_IN_WIDTH), D_MODEL),
        "a_b_f": jax.random.uniform(ks[10], (N_A_LAYERS, N_FOX_HEADS), jnp.float32, 1.0, 4.0),
        "b_w_in": nrm(ks[11], (N_B_LAYERS, D_MODEL, B_IN_WIDTH), D_MODEL),
        "b_lambda_q1": 0.1 * jax.random.normal(ks[12], (N_B_LAYERS, HEAD_DIM), jnp.float32),
        "b_lambda_k1": 0.1 * jax.random.normal(ks[13], (N_B_LAYERS, HEAD_DIM), jnp.float32),
        "b_lambda_q2": 0.1 * jax.random.normal(ks[14], (N_B_LAYERS, HEAD_DIM), jnp.float32),
        "b_lambda_k2": 0.1 * jax.random.normal(ks[15], (N_B_LAYERS, HEAD_DIM), jnp.float32),
        "b_subln_g": gain(ks[16], (N_B_LAYERS, 2 * HEAD_DIM)),
        "kv_norm_g": gain(ks[17], (D_MODEL,)),
        "w_kv_shared": nrm(ks[18], (D_MODEL, SHARED_KV_WIDTH), D_MODEL),
        "final_norm_g": gain(ks[19], (D_MODEL,)),
    }


def reference(x, mem, attn_norm_g, mem_norm_g, w_mem_kv, w_out, ffn_norm_g, w_gate_up, w_down,
              a_w_in, a_b_f, b_w_in, b_lambda_q1, b_lambda_k1, b_lambda_q2, b_lambda_k2,
              b_subln_g, kv_norm_g, w_kv_shared, final_norm_g):
    k1 = k2 = v_shared = None
    for layer in range(DEPTH):
        mem_k, mem_v = memory_kv(mem, mem_norm_g[layer], w_mem_kv[layer])
        if layer < N_A_LAYERS:
            h = rmsnorm(x, attn_norm_g[layer])
            mix = fox_mixer(h, mem_k, mem_v, a_w_in[layer], a_b_f[layer])
        else:
            if layer == N_A_LAYERS:
                k1, k2, v_shared = shared_kv(x, kv_norm_g, w_kv_shared)
            j = layer - N_A_LAYERS
            lambda_init = 0.8 - 0.6 * math.exp(-0.3 * layer)
            h = rmsnorm(x, attn_norm_g[layer])
            mix = diff_mixer(h, k1, k2, v_shared, mem_k, mem_v, b_w_in[j],
                             b_lambda_q1[j], b_lambda_k1[j], b_lambda_q2[j], b_lambda_k2[j],
                             b_subln_g[j], lambda_init)
        x = x + mix @ w_out[layer]
        x = x + swiglu(rmsnorm(x, ffn_norm_g[layer]), w_gate_up[layer], w_down[layer])
    return rmsnorm(x, final_norm_g)
```

```cpp
#include <hip/hip_runtime.h>
#include <hip/hip_cooperative_groups.h>
#include <cstdio>
#include <cstdint>
__device__ __forceinline__ int hw_lane() { unsigned z = 0u; asm volatile("" : "+v"(z)); return (int)__builtin_amdgcn_mbcnt_hi(~0u, __builtin_amdgcn_mbcnt_lo(~0u, z)); }
namespace pg8 {
#define PG8_LAS __attribute__((address_space(3)))
typedef unsigned short bf16_t;
typedef short bf16x8 __attribute__((ext_vector_type(8)));
typedef float f32x4 __attribute__((ext_vector_type(4)));
typedef unsigned u32x4 __attribute__((ext_vector_type(4)));
constexpr int BM = 256, BK = 64, HALF = 128, HTB = HALF * BK * 2  , STAGE_BYTES = 8 * HTB, NXCD = 8, WGM = 8;

__host__ __device__ __forceinline__ int lds_byte(int r, int c) { const int st = (r >> 4) * 2 + (c >> 5), rr = r & 15, cc = c & 31, ob = rr * 64 + cc * 2; return st * 1024 + (ob ^ (((ob >> 9) & 1) << 5)); }
__host__ __device__ __forceinline__ void stage_rc(int b, int& R, int& C) { const int st = b / 1024, sb = b % 1024, swz = sb ^ (((sb >> 9) & 1) << 5); R = (st >> 1) * 16 + swz / 64; C = (st & 1) * 32 + (swz % 64) / 2; }
__host__ __device__ __forceinline__ int perm32(int rho) { const int n = rho >> 4, i = rho & 15; return 8 * (i >> 2) + 4 * n + (i & 3); }

struct Unit { int pm, pn; };
struct Gemm { const bf16_t* A; const bf16_t* Bt; int M, N, K; };

struct StaticOrder {
    int nM, nN, nwg, G, c;
    __host__ __device__ void init(int M, int N, int G_, int c_) { nM = M / BM; nN = N / BM; nwg = nM * nN; G = G_; c = c_; }
    __host__ __device__ bool next(int i, Unit& u) const {
        const long L = (long)i * G + c; if (L >= nwg) return false;
        int wgid = (int)L; { const int q = nwg / NXCD, r = nwg % NXCD, xcd = wgid % NXCD, off = wgid / NXCD; wgid = (xcd < r ? xcd * (q + 1) : r * (q + 1) + (xcd - r) * q) + off; }
        const int nig = WGM * nN, gid = wgid / nig, fm = gid * WGM, gsz = (nM - fm) < WGM ? (nM - fm) : WGM;
        u.pm = fm + ((wgid % nig) % gsz); u.pn = (wgid % nig) / gsz; return true;
    }
    __device__ __forceinline__ void a_ready(const Unit&) const {}
    __device__ __forceinline__ void done(const Unit&) const {}
};

__device__ __forceinline__ unsigned cvt_pk_bf16(float lo, float hi) { unsigned r; asm volatile("v_cvt_pk_bf16_f32 %0, %1, %2" : "=v"(r) : "v"(lo), "v"(hi)); return r; }
typedef float f32x2 __attribute__((ext_vector_type(2)));
typedef unsigned u32x2 __attribute__((ext_vector_type(2)));
struct Seg { bf16_t* dst; int pn_end; int kind; int pitch; float scale; };
struct EpiProj {
    static constexpr bool PERM = true, AFTER_DRAIN = false;
    const float* ssq; const float* cs; const float* sn; const float* bf; float* lf; int S; Seg s0, s1, s2, s3, s4;
    __device__ __forceinline__ void operator()(const f32x4 (&acc)[2][2][4][2], const Unit& u, int wr, int wc, int fr, int fq) const {
        Seg g = s4; int pn0 = s3.pn_end;
        if (u.pn < s0.pn_end) { g = s0; pn0 = 0; } else if (u.pn < s1.pn_end) { g = s1; pn0 = s0.pn_end; } else if (u.pn < s2.pn_end) { g = s2; pn0 = s1.pn_end; } else if (u.pn < s3.pn_end) { g = s3; pn0 = s2.pn_end; }
        const int ct = (u.pn - pn0) * BM;
        const int lane = fq * 16 + fr;
        float sq8[8];
#pragma unroll
        for (int i = 0; i < 8; ++i) sq8[i] = ssq[u.pm * BM + (i >> 2) * HALF + wr * 64 + (i & 3) * 16 + fr];
#pragma unroll
        for (int am = 0; am < 4; ++am) {
            const int ai = am >> 1;
            f32x4 tc[2][2], tn[2][2];
            if (g.kind == 2) {
#pragma unroll
                for (int mm = 0; mm < 2; ++mm) { const int pos = (u.pm * BM + ai * HALF + wr * 64 + ((am & 1) * 2 + mm) * 16 + fr) % S; const float* cp = cs + pos * 32 + 8 * fq; const float* sp = sn + pos * 32 + 8 * fq;
                    tc[mm][0] = *(const f32x4*)cp; tc[mm][1] = *(const f32x4*)(cp + 4); tn[mm][0] = *(const f32x4*)sp; tn[mm][1] = *(const f32x4*)(sp + 4); }
                asm volatile("" ::: "memory");
            }
#pragma unroll
            for (int mm = 0; mm < 2; ++mm) {
                const int m = (am & 1) * 2 + mm;
                const int row = u.pm * BM + ai * HALF + wr * 64 + m * 16 + fr;
                const float rs = __builtin_amdgcn_rsqf(sq8[ai * 4 + m] * (1.0f / 1024.0f) + 1e-6f) * g.scale;
                if (g.kind == 0) {
#pragma unroll
                    for (int bj = 0; bj < 2; ++bj) { const f32x4 v0 = acc[ai][bj][m][0] * rs, v1 = acc[ai][bj][m][1] * rs;
                        u32x4 w; w.x = cvt_pk_bf16(v0[0], v0[1]); w.y = cvt_pk_bf16(v0[2], v0[3]); w.z = cvt_pk_bf16(v1[0], v1[1]); w.w = cvt_pk_bf16(v1[2], v1[3]);
                        *(u32x4*)(g.dst + (size_t)row * g.pitch + ct + bj * HALF + wc * 32 + 8 * fq) = w; }
                } else if (g.kind == 1) {
                    const int b = row / S, s = row - b * S; const bool odd = (fr & 1) != 0;
#pragma unroll
                    for (int bj = 0; bj < 2; ++bj) { const f32x4 v0 = acc[ai][bj][m][0] * rs, v1 = acc[ai][bj][m][1] * rs;
                        const int cb = ct + bj * HALF + wc * 32 + 8 * fq + (odd ? 4 : 0);
#pragma unroll
                        for (int j = 0; j < 4; ++j) { const float snd = odd ? v0[j] : v1[j]; const float rcv = __shfl_xor(snd, 1);
                            const float lo = odd ? rcv : v0[j], hi = odd ? v1[j] : rcv;
                            *(unsigned*)(g.dst + ((size_t)b * g.pitch + cb + j) * S + (s & ~1)) = cvt_pk_bf16(lo, hi); } }
                } else if (g.kind == 3) {
                    if (wc == 0 && fq < 2) { const int b = row / S, s = row - b * S;
#pragma unroll
                        for (int n = 0; n < 2; ++n)
#pragma unroll
                            for (int e2 = 0; e2 < 4; ++e2) { const int c = 8 * fq + 4 * n + e2;
                                if (c < 12) { const float z = acc[ai][0][m][n][e2] * rs + bf[c]; lf[((size_t)b * 12 + c) * S + s] = fminf(z, 0.f) - log1pf(expf(-fabsf(z))); } } }
                } else {
                    const f32x4 c0 = tc[mm][0], c1 = tc[mm][1], n0 = tn[mm][0], n1 = tn[mm][1];
                    const f32x4 a0 = acc[ai][0][m][0] * rs, a1 = acc[ai][0][m][1] * rs, b0 = acc[ai][1][m][0] * rs, b1 = acc[ai][1][m][1] * rs;
                    const f32x4 x0 = a0 * c0 - b0 * n0, x1 = a1 * c1 - b1 * n1, y0 = a0 * n0 + b0 * c0, y1 = a1 * n1 + b1 * c1;
                    bf16_t* p = g.dst + (size_t)row * g.pitch + ct + wc * 64 + 8 * fq;
                    u32x4 w; w.x = cvt_pk_bf16(x0[0], x0[1]); w.y = cvt_pk_bf16(x0[2], x0[3]); w.z = cvt_pk_bf16(x1[0], x1[1]); w.w = cvt_pk_bf16(x1[2], x1[3]);
                    *(u32x4*)p = w;
                    w.x = cvt_pk_bf16(y0[0], y0[1]); w.y = cvt_pk_bf16(y0[2], y0[3]); w.z = cvt_pk_bf16(y1[0], y1[1]); w.w = cvt_pk_bf16(y1[2], y1[3]);
                    *(u32x4*)(p + 32) = w;
                }
            }
        }
        (void)lane;
    }
};
struct EpiRes {
    static constexpr bool PERM = true, AFTER_DRAIN = false;
    bf16_t* xb; float* ssq_out;
    __device__ __forceinline__ void operator()(const f32x4 (&acc)[2][2][4][2], const Unit& u, int wr, int wc, int fr, int fq) const {
#pragma unroll
        for (int ai = 0; ai < 2; ++ai) {
            u32x4 xr[4][2];
#pragma unroll
            for (int m = 0; m < 4; ++m)
#pragma unroll
                for (int bj = 0; bj < 2; ++bj) xr[m][bj] = *(const u32x4*)(xb + (size_t)(u.pm * BM + ai * HALF + wr * 64 + m * 16 + fr) * 1024 + u.pn * BM + bj * HALF + wc * 32 + 8 * fq);
            asm volatile("" ::: "memory");
#pragma unroll
            for (int m = 0; m < 4; ++m) {
                const int row = u.pm * BM + ai * HALF + wr * 64 + m * 16 + fr; float sq = 0.f;
#pragma unroll
                for (int bj = 0; bj < 2; ++bj) { const size_t off = (size_t)row * 1024 + u.pn * BM + bj * HALF + wc * 32 + 8 * fq; const u32x4 x = xr[m][bj];
                    const f32x4 v0 = (f32x4){__uint_as_float(x.x << 16), __uint_as_float(x.x & 0xffff0000u), __uint_as_float(x.y << 16), __uint_as_float(x.y & 0xffff0000u)} + acc[ai][bj][m][0];
                    const f32x4 v1 = (f32x4){__uint_as_float(x.z << 16), __uint_as_float(x.z & 0xffff0000u), __uint_as_float(x.w << 16), __uint_as_float(x.w & 0xffff0000u)} + acc[ai][bj][m][1];
                    u32x4 w; w.x = cvt_pk_bf16(v0[0], v0[1]); w.y = cvt_pk_bf16(v0[2], v0[3]); w.z = cvt_pk_bf16(v1[0], v1[1]); w.w = cvt_pk_bf16(v1[2], v1[3]);
                    *(u32x4*)(xb + off) = w;
                    sq += (v0[0] * v0[0] + v0[1] * v0[1]) + (v0[2] * v0[2] + v0[3] * v0[3]) + (v1[0] * v1[0] + v1[1] * v1[1]) + (v1[2] * v1[2] + v1[3] * v1[3]); }
                sq += __shfl_xor(sq, 16); sq += __shfl_xor(sq, 32);
                if (fq == 0) atomicAdd(ssq_out + row, sq);
            }
            asm volatile("" ::: "memory");
        }
    }
};
struct EpiResFinal {
    static constexpr bool PERM = true, AFTER_DRAIN = false;
    const bf16_t* xb; float* out; float* ssq; unsigned* cnt; const float* g;
    __device__ __forceinline__ void operator()(f32x4 (&acc)[2][2][4][2], const Unit& u, int wr, int wc, int fr, int fq) const {
        const int col0 = u.pn * BM + wc * 32 + 8 * fq;
#pragma unroll
        for (int ai = 0; ai < 2; ++ai) {
            u32x4 xr[4][2];
#pragma unroll
            for (int m = 0; m < 4; ++m)
#pragma unroll
                for (int bj = 0; bj < 2; ++bj) xr[m][bj] = *(const u32x4*)(xb + (size_t)(u.pm * BM + ai * HALF + wr * 64 + m * 16 + fr) * 1024 + col0 + bj * HALF);
            asm volatile("" ::: "memory");
#pragma unroll
            for (int m = 0; m < 4; ++m) {
                const int row = u.pm * BM + ai * HALF + wr * 64 + m * 16 + fr; float sq = 0.f;
#pragma unroll
                for (int bj = 0; bj < 2; ++bj) { const u32x4 x = xr[m][bj];
                    const f32x4 v0 = (f32x4){__uint_as_float(x.x << 16), __uint_as_float(x.x & 0xffff0000u), __uint_as_float(x.y << 16), __uint_as_float(x.y & 0xffff0000u)} + acc[ai][bj][m][0];
                    const f32x4 v1 = (f32x4){__uint_as_float(x.z << 16), __uint_as_float(x.z & 0xffff0000u), __uint_as_float(x.w << 16), __uint_as_float(x.w & 0xffff0000u)} + acc[ai][bj][m][1];
                    acc[ai][bj][m][0] = v0; acc[ai][bj][m][1] = v1;
                    sq += (v0[0] * v0[0] + v0[1] * v0[1]) + (v0[2] * v0[2] + v0[3] * v0[3]) + (v1[0] * v1[0] + v1[1] * v1[1]) + (v1[2] * v1[2] + v1[3] * v1[3]); }
                sq += __shfl_xor(sq, 16); sq += __shfl_xor(sq, 32);
                if (fq == 0) (void)__hip_atomic_fetch_add(ssq + row, sq, __ATOMIC_RELAXED, __HIP_MEMORY_SCOPE_AGENT);
            }
        }
        asm volatile("s_waitcnt vmcnt(0)" ::: "memory");
        unsigned* pc = cnt + 64 * u.pm;
        if (fr == 0 && fq == 0) (void)__hip_atomic_fetch_add(pc, 1u, __ATOMIC_RELAXED, __HIP_MEMORY_SCOPE_AGENT);
        for (unsigned it = 0; it < (1u << 22); ++it) {
            if ((unsigned)__builtin_amdgcn_readfirstlane((int)__hip_atomic_load(pc, __ATOMIC_RELAXED, __HIP_MEMORY_SCOPE_AGENT)) >= 32u) break;
            __builtin_amdgcn_s_sleep(2);
        }
        __builtin_amdgcn_fence(__ATOMIC_ACQUIRE, "agent");
        f32x4 gv[2][2];
#pragma unroll
        for (int bj = 0; bj < 2; ++bj) { gv[bj][0] = *(const f32x4*)(g + col0 + bj * HALF); gv[bj][1] = *(const f32x4*)(g + col0 + bj * HALF + 4); }
        float rs8[8];
#pragma unroll
        for (int i = 0; i < 8; ++i) { const unsigned sb = __hip_atomic_load((const unsigned*)(ssq + u.pm * BM + (i >> 2) * HALF + wr * 64 + (i & 3) * 16 + fr), __ATOMIC_RELAXED, __HIP_MEMORY_SCOPE_AGENT);
            rs8[i] = __builtin_amdgcn_rsqf(__uint_as_float(sb) * (1.0f / 1024.0f) + 1e-6f); }
#pragma unroll
        for (int ai = 0; ai < 2; ++ai)
#pragma unroll
            for (int m = 0; m < 4; ++m) { const float rs = rs8[ai * 4 + m];
#pragma unroll
                for (int bj = 0; bj < 2; ++bj) { const size_t off = (size_t)(u.pm * BM + ai * HALF + wr * 64 + m * 16 + fr) * 1024 + col0 + bj * HALF;
                    *(f32x4*)(out + off) = acc[ai][bj][m][0] * rs * gv[bj][0]; *(f32x4*)(out + off + 4) = acc[ai][bj][m][1] * rs * gv[bj][1]; } }
    }
};
struct EpiGU {
    static constexpr bool PERM = true, AFTER_DRAIN = false;
    const float* ssq; bf16_t* H;
    __device__ __forceinline__ void operator()(const f32x4 (&acc)[2][2][4][2], const Unit& u, int wr, int wc, int fr, int fq) const {
        float sq8[8];
#pragma unroll
        for (int i = 0; i < 8; ++i) sq8[i] = ssq[u.pm * BM + (i >> 2) * HALF + wr * 64 + (i & 3) * 16 + fr];
#pragma unroll
        for (int ai = 0; ai < 2; ++ai)
#pragma unroll
            for (int m = 0; m < 4; ++m) {
                const int row = u.pm * BM + ai * HALF + wr * 64 + m * 16 + fr;
                const float rs = __builtin_amdgcn_rsqf(sq8[ai * 4 + m] * (1.0f / 1024.0f) + 1e-6f);
                float hv[8];
#pragma unroll
                for (int n = 0; n < 2; ++n)
#pragma unroll
                    for (int e = 0; e < 4; ++e) { const float gg = acc[ai][0][m][n][e] * rs, uu = acc[ai][1][m][n][e] * rs;
                        hv[n * 4 + e] = gg * uu * __builtin_amdgcn_rcpf(1.0f + __builtin_amdgcn_exp2f(-1.4426950408889634f * gg)); }
                u32x4 w; w.x = cvt_pk_bf16(hv[0], hv[1]); w.y = cvt_pk_bf16(hv[2], hv[3]); w.z = cvt_pk_bf16(hv[4], hv[5]); w.w = cvt_pk_bf16(hv[6], hv[7]);
                *(u32x4*)(H + (size_t)row * 2816 + u.pn * HALF + wc * 32 + 8 * fq) = w;
            }
    }
};
template <class Epi, class Sched, bool ALIGN_EPI = false, bool SP2 = false>
__device__ __forceinline__ void gemm_phase(PG8_LAS unsigned char* lds, const Gemm g, const Sched& S, const Epi& E, const int wv) {
    int tid_ = wv * 64 + hw_lane(); asm volatile("" : "+v"(tid_));
    const int tid = tid_, wid = __builtin_amdgcn_readfirstlane(tid >> 6), lane = tid & 63, wr = wid >> 2, wc = wid & 3, fr = lane & 15, fq = lane >> 4;
    const int K = g.K, nt = K / BK;
    unsigned voffA[2], voffB[2];
#pragma unroll
    for (int i = 0; i < 2; ++i) { int R, C; stage_rc(tid * 16 + i * 8192, R, C); const int Rb = Epi::PERM ? ((R & ~31) + perm32(R & 31)) : R;
        voffA[i] = (unsigned)(R * K + C) * 2u; voffB[i] = (unsigned)(Rb * K + C) * 2u; }
    const size_t kstep = (size_t)(BK * 2);
    const size_t hstep = (size_t)HALF * K * 2;
    const size_t tstep = 2 * hstep;
    const unsigned ldsw = (unsigned)wid * 1024u;
    const int aoff = lds_byte(wr * 64 + fr, fq * 8), boff = lds_byte(wc * 32 + fr, fq * 8);
#define PG8_SA(b, h) (((b) * 2 + (h)) * HTB)
#define PG8_SB(b, h) ((4 + (b) * 2 + (h)) * HTB)
#define PG8_STAGE(bufoff, gbase, voff) do { _Pragma("unroll") for (int _i = 0; _i < 2; ++_i) \
        __builtin_amdgcn_global_load_lds((const unsigned*)((const char*)(gbase) + (voff)[_i]), (PG8_LAS unsigned*)(lds + (bufoff) + ldsw + _i * 8192), 16, 0, 0); } while (0)
#define PG8_LDA(dst, b, h) do { _Pragma("unroll") for (int m = 0; m < 4; ++m) _Pragma("unroll") for (int k = 0; k < 2; ++k) dst[m][k] = *(const PG8_LAS bf16x8*)(lds + PG8_SA(b, h) + aoff + m * 2048 + k * 1024); } while (0)
#define PG8_LDB(dst, b, h) do { _Pragma("unroll") for (int n = 0; n < 2; ++n) _Pragma("unroll") for (int k = 0; k < 2; ++k) dst[n][k] = *(const PG8_LAS bf16x8*)(lds + PG8_SB(b, h) + boff + n * 2048 + k * 1024); } while (0)
#define PG8_MMA(ai, bj, At, Bt) do { __builtin_amdgcn_s_setprio(1); _Pragma("unroll") for (int m = 0; m < 4; ++m) _Pragma("unroll") for (int n = 0; n < 2; ++n) _Pragma("unroll") for (int k = 0; k < 2; ++k) \
        acc[ai][bj][m][n] = __builtin_amdgcn_mfma_f32_16x16x32_bf16(Bt[n][k], At[m][k], acc[ai][bj][m][n], 0, 0, 0); __builtin_amdgcn_s_setprio(0); } while (0)
#define PG8_WAIT_V(n) asm volatile("s_waitcnt vmcnt(" #n ")" ::: "memory")
#define PG8_WAIT_L(n) asm volatile("s_waitcnt lgkmcnt(" #n ")" ::: "memory")
#define PG8_BAR __builtin_amdgcn_s_barrier()
#define PG8_SCHED __builtin_amdgcn_sched_barrier(0)
    Unit cur, nxt; int ui = 0;
    if (!S.next(0, cur)) return;
    f32x4 acc[2][2][4][2];
#pragma unroll
    for (int a = 0; a < 2; ++a)
#pragma unroll
        for (int b = 0; b < 2; ++b)
#pragma unroll
            for (int m = 0; m < 4; ++m)
#pragma unroll
                for (int n = 0; n < 2; ++n) acc[a][b][m][n] = (f32x4){0.f, 0.f, 0.f, 0.f};
    bf16x8 At[4][2], B0[2][2], B1[2][2];
    const char* cA = (const char*)g.A + (size_t)cur.pm * tstep; const char* cB = (const char*)g.Bt + (size_t)cur.pn * tstep;
    S.a_ready(cur);
    if constexpr (SP2) {
        PG8_STAGE(PG8_SB(0, 0), cB, voffB); PG8_STAGE(PG8_SB(0, 1), cB + hstep, voffB); PG8_STAGE(PG8_SA(0, 0), cA, voffA); PG8_STAGE(PG8_SA(0, 1), cA + hstep, voffA);
        if (wr == 1) PG8_BAR;
        PG8_WAIT_V(2); PG8_BAR;
        PG8_STAGE(PG8_SB(1, 0), cB + kstep, voffB); PG8_STAGE(PG8_SA(1, 0), cA + kstep, voffA); PG8_STAGE(PG8_SB(1, 1), cB + hstep + kstep, voffB);
        PG8_WAIT_V(6); PG8_BAR;
    } else {
        PG8_STAGE(PG8_SB(0, 0), cB, voffB); PG8_STAGE(PG8_SA(0, 0), cA, voffA); PG8_STAGE(PG8_SB(0, 1), cB + hstep, voffB); PG8_STAGE(PG8_SA(0, 1), cA + hstep, voffA);
        if (wr == 1) PG8_BAR;
        PG8_WAIT_V(4); PG8_BAR;
        PG8_STAGE(PG8_SB(1, 0), cB + kstep, voffB); PG8_STAGE(PG8_SA(1, 0), cA + kstep, voffA); PG8_STAGE(PG8_SB(1, 1), cB + hstep + kstep, voffB);
        PG8_WAIT_V(6); PG8_BAR;
    }
    for (;;) {
        const bool has_next = S.next(ui + 1, nxt);
        const char* nA = has_next ? (const char*)g.A + (size_t)nxt.pm * tstep : cA; const char* nB = has_next ? (const char*)g.Bt + (size_t)nxt.pn * tstep : cB;
        for (int t = 0; t < nt; t += 2) {
            const bool last = (t == nt - 2);
            const char* a1 = cA + (size_t)(t + 1) * kstep;
            const char* a2 = last ? nA : cA + (size_t)(t + 2) * kstep; const char* b2 = last ? nB : cB + (size_t)(t + 2) * kstep;
            const char* a3 = a2 + kstep; const char* b3 = b2 + kstep;
            if (last && has_next) S.a_ready(nxt);
            if constexpr (SP2) {
            PG8_LDB(B0, 0, 0); PG8_LDB(B1, 0, 1); PG8_SCHED; PG8_LDA(At, 0, 0); PG8_STAGE(PG8_SA(1, 1), a1 + hstep, voffA);
            PG8_WAIT_V(8); PG8_WAIT_L(0); PG8_BAR; PG8_MMA(0, 0, At, B0); PG8_MMA(0, 1, At, B1); PG8_BAR; PG8_SCHED;
            PG8_LDA(At, 0, 1); PG8_STAGE(PG8_SB(0, 0), b2, voffB); PG8_STAGE(PG8_SB(0, 1), b2 + hstep, voffB); PG8_STAGE(PG8_SA(0, 0), a2, voffA);
            PG8_WAIT_V(8); PG8_WAIT_L(0); PG8_BAR; PG8_MMA(1, 0, At, B0); PG8_MMA(1, 1, At, B1); PG8_BAR; PG8_SCHED;
            PG8_LDB(B0, 1, 0); PG8_LDB(B1, 1, 1); PG8_SCHED; PG8_LDA(At, 1, 0); PG8_STAGE(PG8_SA(0, 1), a2 + hstep, voffA);
            PG8_WAIT_V(8); PG8_WAIT_L(0); PG8_BAR; PG8_MMA(0, 0, At, B0); PG8_MMA(0, 1, At, B1); PG8_BAR; PG8_SCHED;
            PG8_LDA(At, 1, 1); PG8_STAGE(PG8_SB(1, 0), b3, voffB); PG8_STAGE(PG8_SB(1, 1), b3 + hstep, voffB); PG8_STAGE(PG8_SA(1, 0), a3, voffA);
            PG8_WAIT_V(8); PG8_WAIT_L(0); PG8_BAR; PG8_MMA(1, 0, At, B0); PG8_MMA(1, 1, At, B1); PG8_BAR; PG8_SCHED;
            } else {
            PG8_LDB(B0, 0, 0); PG8_SCHED; PG8_LDA(At, 0, 0); PG8_STAGE(PG8_SA(1, 1), a1 + hstep, voffA);
            PG8_WAIT_L(8); PG8_BAR; PG8_WAIT_L(0); PG8_MMA(0, 0, At, B0); PG8_BAR; PG8_SCHED;
            PG8_LDB(B1, 0, 1); PG8_STAGE(PG8_SB(0, 0), b2, voffB);
            PG8_BAR; PG8_WAIT_L(0); PG8_MMA(0, 1, At, B1); PG8_BAR;
            PG8_LDA(At, 0, 1); PG8_STAGE(PG8_SA(0, 0), a2, voffA);
            PG8_BAR; PG8_WAIT_L(0); PG8_MMA(1, 0, At, B0); PG8_BAR; PG8_SCHED;
            PG8_STAGE(PG8_SB(0, 1), b2 + hstep, voffB);
            PG8_WAIT_V(6); PG8_BAR; PG8_MMA(1, 1, At, B1); PG8_BAR;
            PG8_LDB(B0, 1, 0); PG8_SCHED; PG8_LDA(At, 1, 0); PG8_STAGE(PG8_SA(0, 1), a2 + hstep, voffA);
            PG8_WAIT_L(8); PG8_BAR; PG8_WAIT_L(0); PG8_MMA(0, 0, At, B0); PG8_BAR; PG8_SCHED;
            PG8_LDB(B1, 1, 1); PG8_STAGE(PG8_SB(1, 0), b3, voffB);
            PG8_BAR; PG8_WAIT_L(0); PG8_MMA(0, 1, At, B1); PG8_BAR;
            PG8_LDA(At, 1, 1); PG8_STAGE(PG8_SA(1, 0), a3, voffA);
            PG8_BAR; PG8_WAIT_L(0); PG8_MMA(1, 0, At, B0); PG8_BAR; PG8_SCHED;
            PG8_STAGE(PG8_SB(1, 1), b3 + hstep, voffB);
            PG8_WAIT_V(6); PG8_BAR; PG8_MMA(1, 1, At, B1); PG8_BAR;
            }
        }
        if constexpr (ALIGN_EPI) { if (wr == 0) PG8_BAR; }
        if constexpr (!Epi::AFTER_DRAIN) { E(acc, cur, wr, wc, fr, fq); S.done(cur); }
        if (!has_next) break;
#pragma unroll
        for (int a = 0; a < 2; ++a)
#pragma unroll
            for (int b = 0; b < 2; ++b)
#pragma unroll
                for (int m = 0; m < 4; ++m)
#pragma unroll
                    for (int n = 0; n < 2; ++n) acc[a][b][m][n] = (f32x4){0.f, 0.f, 0.f, 0.f};
        cur = nxt; cA = nA; cB = nB; ++ui;
        if constexpr (ALIGN_EPI) { if (wr == 1) PG8_BAR; }
    }
    PG8_WAIT_V(0);
    if constexpr (!ALIGN_EPI) { if (wr == 0) PG8_BAR; }
    PG8_BAR;
    if constexpr (Epi::AFTER_DRAIN) { E.fused(acc, cur, wr, wc, fr, fq, lds, wid, lane); S.done(cur); }
#undef PG8_SA
#undef PG8_SB
#undef PG8_STAGE
#undef PG8_LDA
#undef PG8_LDB
#undef PG8_MMA
#undef PG8_WAIT_V
#undef PG8_WAIT_L
#undef PG8_BAR
#undef PG8_SCHED
}
}
namespace att {
#define LAS __attribute__((address_space(3)))
typedef unsigned short bf16_t;
typedef short bf16x8 __attribute__((ext_vector_type(8)));
typedef short s16x4 __attribute__((ext_vector_type(4)));
typedef float f32x16 __attribute__((ext_vector_type(16)));
typedef float f32x4 __attribute__((ext_vector_type(4)));
typedef unsigned u32x4 __attribute__((ext_vector_type(4)));
typedef unsigned u32x2 __attribute__((ext_vector_type(2)));
constexpr int KP = 144, VP = 264;
constexpr int KBUF = 128 * KP, VBUF = 128 * VP;
constexpr int OFF_K = 0, OFF_V = 2 * KBUF, OFF_B = OFF_V + 2 * VBUF, ATT_LDS = OFF_B + 1024;
#ifndef PIPE128
#define PIPE128 0
#endif
constexpr float RESC_THR = 60.f;
typedef float f32x2_t __attribute__((ext_vector_type(2))); typedef __bf16 bf16x2_t __attribute__((ext_vector_type(2)));
__device__ __forceinline__ unsigned cvtpk(float lo, float hi) { f32x2_t v = {lo, hi}; bf16x2_t b = __builtin_convertvector(v, bf16x2_t); return __builtin_bit_cast(unsigned, b); }
__device__ __forceinline__ float max3f(float a, float b, float c) { float r; asm("v_max3_f32 %0, %1, %2, %3" : "=v"(r) : "v"(a), "v"(b), "v"(c)); return r; }
__device__ __forceinline__ float xhalf_max(float m) { auto rr = __builtin_amdgcn_permlane32_swap(__float_as_uint(m), __float_as_uint(m), false, false); return fmaxf(__uint_as_float(rr[0]), __uint_as_float(rr[1])); }
__device__ __forceinline__ float xhalf_sum(float m) { auto rr = __builtin_amdgcn_permlane32_swap(__float_as_uint(m), __float_as_uint(m), false, false); return __uint_as_float(rr[0]) + __uint_as_float(rr[1]); }

typedef float f32x2v __attribute__((ext_vector_type(2)));
__device__ __forceinline__ void exp_sum_pk(f32x16& P0, f32x16& P1, float m, float& lrow) {
    const f32x2v mv = {m, m}; f32x2v s0 = {0.f, 0.f}, s1 = {0.f, 0.f};
#pragma unroll
    for (int r = 0; r < 16; r += 2) {
        f32x2v a = (f32x2v){P0[r], P0[r + 1]} - mv, b = (f32x2v){P1[r], P1[r + 1]} - mv;
        a.x = __builtin_amdgcn_exp2f(a.x); a.y = __builtin_amdgcn_exp2f(a.y); b.x = __builtin_amdgcn_exp2f(b.x); b.y = __builtin_amdgcn_exp2f(b.y);
        P0[r] = a.x; P0[r + 1] = a.y; P1[r] = b.x; P1[r + 1] = b.y; s0 += a; s1 += b;
    }
    s0 += s1; lrow += s0.x + s0.y;
}
template <int DV, bool CAUSAL, bool BIAS, int VAR = 0>
__device__ __forceinline__ void attn_stream(LAS unsigned char* lds, const bf16_t* Qg, int qpitch, const bf16_t* Kg, int kpitch, const bf16_t* Vtg, int vpitch,
                                            const float* bias, int q0, int ntiles, f32x16 (&o)[DV / 32], const int wv) {
    int tid_ = wv * 64 + hw_lane(); asm volatile("" : "+v"(tid_));
    const int tid = tid_, lane = tid & 63, r32 = lane & 31, hi = lane >> 5, w = __builtin_amdgcn_readfirstlane(tid >> 6);
    constexpr int NV = DV / 32;
    bf16x8 qf[4];
#pragma unroll
    for (int d0 = 0; d0 < 4; ++d0) qf[d0] = *(const bf16x8*)(Qg + (size_t)(q0 + 32 * w + r32) * qpitch + 16 * d0 + 8 * hi);
    const int krow = tid >> 3, kch = tid & 7, vrow = tid >> 4, vch = tid & 15;
    const bf16_t* ksrc = Kg + (size_t)krow * kpitch + kch * 8;
    const bf16_t* vsrc = Vtg + (size_t)vrow * vpitch + vch * 8;
    const unsigned kdst = OFF_K + krow * KP + kch * 16, vdst = OFF_V + vrow * VP + vch * 16;
    u32x4 kreg[2], vreg[NV]; f32x4 breg = {0.f, 0.f, 0.f, 0.f};
#define ATT_LOAD(t) do { \
        _Pragma("unroll") for (int i = 0; i < 2; ++i) kreg[i] = *(const u32x4*)(ksrc + (size_t)(128 * (t) + 64 * i) * kpitch); \
        _Pragma("unroll") for (int i = 0; i < NV; ++i) vreg[i] = *(const u32x4*)(vsrc + (size_t)(32 * i) * vpitch + 128 * (t)); \
        if (BIAS) { if (tid < 32) breg = *(const f32x4*)(bias + 128 * (t) + 4 * tid); } } while (0)
#define ATT_STORE(buf) do { \
        _Pragma("unroll") for (int i = 0; i < 2; ++i) *(LAS u32x4*)(lds + kdst + (buf) * KBUF + i * 64 * KP) = kreg[i]; \
        _Pragma("unroll") for (int i = 0; i < NV; ++i) { *(LAS u32x2*)(lds + vdst + (buf) * VBUF + i * 32 * VP) = (u32x2){vreg[i].x, vreg[i].y}; *(LAS u32x2*)(lds + vdst + (buf) * VBUF + i * 32 * VP + 8) = (u32x2){vreg[i].z, vreg[i].w}; } \
        if (BIAS) { if (tid < 32) *(LAS f32x4*)(lds + OFF_B + (buf) * 512 + 16 * tid) = breg; } } while (0)
    ATT_LOAD(0);
    ATT_STORE(0);
    __syncthreads();
    float mrow = -1e30f, lrow = 0.f;
#pragma unroll
    for (int d0 = 0; d0 < DV / 32; ++d0)
#pragma unroll
        for (int r = 0; r < 16; ++r) o[d0][r] = 0.f;
    const int qmin = q0 + 32 * w;
#define ATT_KLOAD(P0, P1, buf, sub) do { \
        LAS unsigned char* Ks_ = lds + OFF_K + (buf) * KBUF + (sub) * 64 * KP; \
        _Pragma("unroll") for (int d0 = 0; d0 < 4; ++d0) { kf[2 * d0] = *(LAS bf16x8*)(Ks_ + r32 * KP + (2 * d0 + hi) * 16); kf[2 * d0 + 1] = *(LAS bf16x8*)(Ks_ + (32 + r32) * KP + (2 * d0 + hi) * 16); } \
        if (BIAS) { LAS unsigned char* Bs_ = lds + OFF_B + (buf) * 512 + (sub) * 256; \
            _Pragma("unroll") for (int g = 0; g < 4; ++g) { const f32x4 b0 = *(LAS f32x4*)(Bs_ + (8 * g + 4 * hi) * 4), b1 = *(LAS f32x4*)(Bs_ + (32 + 8 * g + 4 * hi) * 4); \
                _Pragma("unroll") for (int e = 0; e < 4; ++e) { P0[4 * g + e] = b0[e]; P1[4 * g + e] = b1[e]; } } \
        } else { _Pragma("unroll") for (int r = 0; r < 16; ++r) { P0[r] = 0.f; P1[r] = 0.f; } } \
        __builtin_amdgcn_sched_barrier(0); } while (0)
#define ATT_QKM(P0, P1) do { \
        _Pragma("unroll") for (int d0 = 0; d0 < 4; ++d0) { \
            P0 = __builtin_amdgcn_mfma_f32_32x32x16_bf16(kf[2 * d0], qf[d0], P0, 0, 0, 0); \
            P1 = __builtin_amdgcn_mfma_f32_32x32x16_bf16(kf[2 * d0 + 1], qf[d0], P1, 0, 0, 0); } \
        __builtin_amdgcn_sched_barrier(0); } while (0)
#define ATT_VLOAD(buf, sub, KK0, NKK) do { \
        LAS unsigned char* Vs_ = lds + OFF_V + (buf) * VBUF + (sub) * 128; \
        _Pragma("unroll") for (int kk = 0; kk < (NKK); ++kk) _Pragma("unroll") for (int d0 = 0; d0 < DV / 32; ++d0) { \
            const LAS unsigned char* vp = Vs_ + (32 * d0 + r32) * VP + (16 * ((KK0) + kk) + 4 * hi) * 2; \
            const s16x4 lo = *(const LAS s16x4*)vp, hh = *(const LAS s16x4*)(vp + 16); \
            vf[kk * (DV / 32) + d0] = (bf16x8){lo[0], lo[1], lo[2], lo[3], hh[0], hh[1], hh[2], hh[3]}; } \
        __builtin_amdgcn_sched_barrier(0); } while (0)
#define ATT_SM(P0, P1, kv0) do { \
        if (CAUSAL && ((kv0) + 63 > qmin)) { const int qrel = qmin + r32 - (kv0); \
            _Pragma("unroll") for (int r = 0; r < 16; ++r) { const int kv = (r & 3) + 8 * (r >> 2) + 4 * hi; if (kv > qrel) P0[r] = -1e30f; if (kv + 32 > qrel) P1[r] = -1e30f; } } \
        float mt = max3f(P0[0], P1[0], P0[1]), mu = max3f(P1[1], P0[2], P1[2]); \
        _Pragma("unroll") for (int r = 3; r < 15; r += 2) { mt = max3f(mt, P0[r], P1[r]); mu = max3f(mu, P0[r + 1], P1[r + 1]); } \
        mt = max3f(mt, P0[15], P1[15]); mt = max3f(mt, mu, mu); \
        mt = xhalf_max(mt); \
        if (__builtin_amdgcn_ballot_w64(mt > mrow + RESC_THR) != 0ull) { \
            const float mnew = fmaxf(mrow, mt), alpha = __builtin_amdgcn_exp2f(mrow - mnew); mrow = mnew; lrow *= alpha; \
            _Pragma("unroll") for (int d0 = 0; d0 < DV / 32; ++d0) _Pragma("unroll") for (int r = 0; r < 16; ++r) o[d0][r] *= alpha; } \
        exp_sum_pk(P0, P1, mrow, lrow); \
        { u32x4 x; x.x = cvtpk(P0[0], P0[1]); x.y = cvtpk(P0[2], P0[3]); x.z = cvtpk(P0[4], P0[5]); x.w = cvtpk(P0[6], P0[7]); pb[0] = __builtin_bit_cast(bf16x8, x); \
          x.x = cvtpk(P0[8], P0[9]); x.y = cvtpk(P0[10], P0[11]); x.z = cvtpk(P0[12], P0[13]); x.w = cvtpk(P0[14], P0[15]); pb[1] = __builtin_bit_cast(bf16x8, x); \
          x.x = cvtpk(P1[0], P1[1]); x.y = cvtpk(P1[2], P1[3]); x.z = cvtpk(P1[4], P1[5]); x.w = cvtpk(P1[6], P1[7]); pb[2] = __builtin_bit_cast(bf16x8, x); \
          x.x = cvtpk(P1[8], P1[9]); x.y = cvtpk(P1[10], P1[11]); x.z = cvtpk(P1[12], P1[13]); x.w = cvtpk(P1[14], P1[15]); pb[3] = __builtin_bit_cast(bf16x8, x); } \
        __builtin_amdgcn_sched_barrier(0); } while (0)
#define ATT_PVM(KK0, NKK) do { \
        _Pragma("unroll") for (int kk = 0; kk < (NKK); ++kk) _Pragma("unroll") for (int d0 = 0; d0 < DV / 32; ++d0) \
            o[d0] = __builtin_amdgcn_mfma_f32_32x32x16_bf16(vf[kk * (DV / 32) + d0], pb[(KK0) + kk], o[d0], 0, 0, 0); \
        __builtin_amdgcn_sched_barrier(0); } while (0)
    bf16x8 kf[8], vf[8], pb[4];
    if constexpr (DV == 64) {
        f32x16 sa0, sa1, sb0, sb1; bf16x8 pc[4];
        const unsigned kofs = (unsigned)(krow * kpitch + kch * 8) * 2u, vofs = (unsigned)(vrow * vpitch + vch * 8) * 2u, bofs = (unsigned)tid * 16u;
#define ATT_HEAD(P0, P1, kv0, MT) do { \
        if (CAUSAL && ((kv0) + 63 > qmin)) { const int qrel = qmin + r32 - (kv0); \
            _Pragma("unroll") for (int r = 0; r < 16; ++r) { const int kv = (r & 3) + 8 * (r >> 2) + 4 * hi; if (kv > qrel) P0[r] = -1e30f; if (kv + 32 > qrel) P1[r] = -1e30f; } } \
        float mt_ = max3f(P0[0], P1[0], P0[1]), mu_ = max3f(P1[1], P0[2], P1[2]); \
        _Pragma("unroll") for (int r = 3; r < 15; r += 2) { mt_ = max3f(mt_, P0[r], P1[r]); mu_ = max3f(mu_, P0[r + 1], P1[r + 1]); } \
        mt_ = max3f(mt_, P0[15], P1[15]); mt_ = max3f(mt_, mu_, mu_); MT = xhalf_max(mt_); } while (0)
#define ATT_PACK(P0, P1, PB) do { u32x4 x; x.x = cvtpk(P0[0], P0[1]); x.y = cvtpk(P0[2], P0[3]); x.z = cvtpk(P0[4], P0[5]); x.w = cvtpk(P0[6], P0[7]); PB[0] = __builtin_bit_cast(bf16x8, x); \
          x.x = cvtpk(P0[8], P0[9]); x.y = cvtpk(P0[10], P0[11]); x.z = cvtpk(P0[12], P0[13]); x.w = cvtpk(P0[14], P0[15]); PB[1] = __builtin_bit_cast(bf16x8, x); \
          x.x = cvtpk(P1[0], P1[1]); x.y = cvtpk(P1[2], P1[3]); x.z = cvtpk(P1[4], P1[5]); x.w = cvtpk(P1[6], P1[7]); PB[2] = __builtin_bit_cast(bf16x8, x); \
          x.x = cvtpk(P1[8], P1[9]); x.y = cvtpk(P1[10], P1[11]); x.z = cvtpk(P1[12], P1[13]); x.w = cvtpk(P1[14], P1[15]); PB[3] = __builtin_bit_cast(bf16x8, x); } while (0)
#ifndef MIXN
#define MIXN 10
#endif
#define ATT_MIX8() do { if (MIXN > 0) { _Pragma("unroll") for (int i_ = 0; i_ < 8; ++i_) { __builtin_amdgcn_sched_group_barrier(0x008, 1, 0); __builtin_amdgcn_sched_group_barrier(0x402, MIXN, 0); } } } while (0)
        ATT_KLOAD(sa0, sa1, 0, 0); ATT_QKM(sa0, sa1);
        for (int t = 0; t < ntiles; ++t) {
            const int cur = t & 1, nxt = cur ^ 1; const bool more = (t + 1 < ntiles);
            if (more) {
                const char* kt_ = (const char*)(Kg + (size_t)(128 * (t + 1)) * kpitch);
#pragma unroll
                for (int i = 0; i < 2; ++i) kreg[i] = *(const u32x4*)(kt_ + (size_t)(64 * i) * kpitch * 2 + kofs);
                if (BIAS) { if (tid < 32) breg = *(const f32x4*)((const char*)(bias + 128 * (t + 1)) + bofs); } }
            ATT_KLOAD(sb0, sb1, cur, 1);
            { float mt; ATT_HEAD(sa0, sa1, 128 * t, mt);
              if (__builtin_amdgcn_ballot_w64(mt > mrow + RESC_THR) != 0ull) {
                  const float mnew = fmaxf(mrow, mt), alpha = __builtin_amdgcn_exp2f(mrow - mnew); mrow = mnew; lrow *= alpha;
#pragma unroll
                  for (int d0 = 0; d0 < DV / 32; ++d0)
#pragma unroll
                      for (int r = 0; r < 16; ++r) o[d0][r] *= alpha; } }
            __builtin_amdgcn_sched_barrier(0);
#pragma unroll
            for (int d0 = 0; d0 < 4; ++d0) { sb0 = __builtin_amdgcn_mfma_f32_32x32x16_bf16(kf[2 * d0], qf[d0], sb0, 0, 0, 0); sb1 = __builtin_amdgcn_mfma_f32_32x32x16_bf16(kf[2 * d0 + 1], qf[d0], sb1, 0, 0, 0); }
            exp_sum_pk(sa0, sa1, mrow, lrow);
            ATT_PACK(sa0, sa1, pb);
            ATT_MIX8();
            __builtin_amdgcn_sched_barrier(0);
            if (more) {
#pragma unroll
                for (int i = 0; i < 2; ++i) *(LAS u32x4*)(lds + kdst + nxt * KBUF + i * 64 * KP) = kreg[i];
                if (BIAS) { if (tid < 32) *(LAS f32x4*)(lds + OFF_B + nxt * 512 + 16 * tid) = breg; }
                const char* vt_ = (const char*)(Vtg + 128 * (t + 1));
#pragma unroll
                for (int i = 0; i < 2; ++i) kreg[i] = *(const u32x4*)(vt_ + (size_t)(32 * i) * vpitch * 2 + vofs); }
            { LAS unsigned char* Vs_ = lds + OFF_V + cur * VBUF;
#pragma unroll
              for (int kk = 0; kk < 4; ++kk)
#pragma unroll
                  for (int d0 = 0; d0 < 2; ++d0) { const LAS unsigned char* vp = Vs_ + (32 * d0 + r32) * VP + (16 * kk + 4 * hi) * 2;
                      const s16x4 lo = *(const LAS s16x4*)vp, hh = *(const LAS s16x4*)(vp + 16); kf[kk * 2 + d0] = (bf16x8){lo[0], lo[1], lo[2], lo[3], hh[0], hh[1], hh[2], hh[3]}; } }
            float mtb; ATT_HEAD(sb0, sb1, 128 * t + 64, mtb);
            const bool rescb = __builtin_amdgcn_ballot_w64(mtb > mrow + RESC_THR) != 0ull;
            const float mnewb = rescb ? fmaxf(mrow, mtb) : mrow, alphab = __builtin_amdgcn_exp2f(mrow - mnewb);
            float psb = 0.f;
            __builtin_amdgcn_sched_barrier(0);
#pragma unroll
            for (int kk = 0; kk < 4; ++kk)
#pragma unroll
                for (int d0 = 0; d0 < 2; ++d0) o[d0] = __builtin_amdgcn_mfma_f32_32x32x16_bf16(kf[kk * 2 + d0], pb[kk], o[d0], 0, 0, 0);
            exp_sum_pk(sb0, sb1, mnewb, psb);
            ATT_PACK(sb0, sb1, pc);
            ATT_MIX8();
            __builtin_amdgcn_sched_barrier(0);
            { LAS unsigned char* Vs_ = lds + OFF_V + cur * VBUF + 128;
#pragma unroll
              for (int kk = 0; kk < 4; ++kk)
#pragma unroll
                  for (int d0 = 0; d0 < 2; ++d0) { const LAS unsigned char* vp = Vs_ + (32 * d0 + r32) * VP + (16 * kk + 4 * hi) * 2;
                      const s16x4 lo = *(const LAS s16x4*)vp, hh = *(const LAS s16x4*)(vp + 16); kf[kk * 2 + d0] = (bf16x8){lo[0], lo[1], lo[2], lo[3], hh[0], hh[1], hh[2], hh[3]}; } }
            if (rescb) {
#pragma unroll
                for (int d0 = 0; d0 < DV / 32; ++d0)
#pragma unroll
                    for (int r = 0; r < 16; ++r) o[d0][r] *= alphab; }
            lrow = lrow * alphab + psb; mrow = mnewb;
            __builtin_amdgcn_sched_barrier(0);
#pragma unroll
            for (int kk = 0; kk < 4; ++kk)
#pragma unroll
                for (int d0 = 0; d0 < 2; ++d0) o[d0] = __builtin_amdgcn_mfma_f32_32x32x16_bf16(kf[kk * 2 + d0], pc[kk], o[d0], 0, 0, 0);
            __builtin_amdgcn_sched_barrier(0);
            if (more) {
#pragma unroll
                for (int i = 0; i < 2; ++i) { *(LAS u32x2*)(lds + vdst + nxt * VBUF + i * 32 * VP) = (u32x2){kreg[i].x, kreg[i].y}; *(LAS u32x2*)(lds + vdst + nxt * VBUF + i * 32 * VP + 8) = (u32x2){kreg[i].z, kreg[i].w}; } }
            __syncthreads();
            if (more) { ATT_KLOAD(sa0, sa1, nxt, 0); ATT_QKM(sa0, sa1); }
        }
#undef ATT_HEAD
#undef ATT_PACK
#undef ATT_MIX8
    } else if constexpr (DV == 128 && PIPE128) {
#define LOAD_A(t) do { _Pragma("unroll") for (int i = 0; i < 2; ++i) kreg[i] = *(const u32x4*)(ksrc + (size_t)(128 * (t) + 64 * i) * kpitch); \
        _Pragma("unroll") for (int i = 0; i < 2; ++i) vreg[i] = *(const u32x4*)(vsrc + (size_t)(32 * i) * vpitch + 128 * (t)); } while (0)
#define STORE_A(buf) do { _Pragma("unroll") for (int i = 0; i < 2; ++i) *(LAS u32x4*)(lds + kdst + (buf) * KBUF + i * 64 * KP) = kreg[i]; \
        _Pragma("unroll") for (int i = 0; i < 2; ++i) { *(LAS u32x2*)(lds + vdst + (buf) * VBUF + i * 32 * VP) = (u32x2){vreg[i].x, vreg[i].y}; *(LAS u32x2*)(lds + vdst + (buf) * VBUF + i * 32 * VP + 8) = (u32x2){vreg[i].z, vreg[i].w}; } } while (0)
#define LOAD_B(t) do { _Pragma("unroll") for (int i = 0; i < 2; ++i) vreg[i] = *(const u32x4*)(vsrc + (size_t)(32 * (i + 2)) * vpitch + 128 * (t)); } while (0)
#define STORE_B(buf) do { _Pragma("unroll") for (int i = 0; i < 2; ++i) { *(LAS u32x2*)(lds + vdst + (buf) * VBUF + (i + 2) * 32 * VP) = (u32x2){vreg[i].x, vreg[i].y}; *(LAS u32x2*)(lds + vdst + (buf) * VBUF + (i + 2) * 32 * VP + 8) = (u32x2){vreg[i].z, vreg[i].w}; } } while (0)
        f32x16 sa0, sa1, sb0, sb1;
        ATT_KLOAD(sa0, sa1, 0, 0); ATT_QKM(sa0, sa1);
        for (int t = 0; t < ntiles; ++t) {
            const int cur = t & 1, nxt = cur ^ 1; const bool more = (t + 1 < ntiles);
            if (more) LOAD_A(t + 1);
            ATT_KLOAD(sb0, sb1, cur, 1); ATT_QKM(sb0, sb1);
            ATT_VLOAD(cur, 0, 0, 1);
            ATT_SM(sa0, sa1, 128 * t);
            ATT_PVM(0, 1); ATT_VLOAD(cur, 0, 1, 1); ATT_PVM(1, 1); ATT_VLOAD(cur, 0, 2, 1); ATT_PVM(2, 1); ATT_VLOAD(cur, 0, 3, 1); ATT_PVM(3, 1);
            if (more) { STORE_A(nxt); LOAD_B(t + 1); }
            ATT_VLOAD(cur, 1, 0, 1);
            ATT_SM(sb0, sb1, 128 * t + 64);
            ATT_PVM(0, 1); ATT_VLOAD(cur, 1, 1, 1); ATT_PVM(1, 1); ATT_VLOAD(cur, 1, 2, 1); ATT_PVM(2, 1); ATT_VLOAD(cur, 1, 3, 1); ATT_PVM(3, 1);
            if (more) STORE_B(nxt);
            __syncthreads();
            if (more) { ATT_KLOAD(sa0, sa1, nxt, 0); ATT_QKM(sa0, sa1); }
        }
#undef LOAD_A
#undef STORE_A
#undef LOAD_B
#undef STORE_B
    } else {
        f32x16 sa0, sa1;
        for (int t = 0; t < ntiles; ++t) {
            const int cur = t & 1, nxt = cur ^ 1; const bool more = (t + 1 < ntiles);
            if (more) ATT_LOAD(t + 1);
#pragma unroll
            for (int sub = 0; sub < 2; ++sub) {
                if (!(CAUSAL && (128 * t + 64 * sub > qmin + 31))) {
                    ATT_KLOAD(sa0, sa1, cur, sub); ATT_QKM(sa0, sa1);
                    ATT_VLOAD(cur, sub, 0, 1);
                    ATT_SM(sa0, sa1, 128 * t + 64 * sub);
                    ATT_PVM(0, 1);
                    ATT_VLOAD(cur, sub, 1, 1); ATT_PVM(1, 1);
                    ATT_VLOAD(cur, sub, 2, 1); ATT_PVM(2, 1);
                    ATT_VLOAD(cur, sub, 3, 1); ATT_PVM(3, 1);
                }
            }
            if (more) ATT_STORE(nxt);
            __syncthreads();
        }
    }
#undef ATT_KLOAD
#undef ATT_QKM
#undef ATT_VLOAD
#undef ATT_SM
#undef ATT_PVM
#undef ATT_LOAD
#undef ATT_STORE
    const float inv = __builtin_amdgcn_rcpf(xhalf_sum(lrow));
#pragma unroll
    for (int d0 = 0; d0 < DV / 32; ++d0)
#pragma unroll
        for (int r = 0; r < 16; ++r) o[d0][r] *= inv;
}
constexpr int KP2 = 272, KBUF2 = 128 * KP2, OFF_K2 = 0, OFF_V2 = 2 * KBUF2;
template <int SEQ_>
__device__ __forceinline__ void attn_diff_unit(LAS unsigned char* lds, const bf16_t* Qg, const bf16_t* Kg, const bf16_t* Vtg, int q0, int ntiles, float lam, float post,
                                               const float* subln_g, bf16_t* mixbase, const int wv) {
    constexpr int DV = 128;
    int tid_ = wv * 64 + hw_lane(); asm volatile("" : "+v"(tid_));
    const int tid = tid_, lane = tid & 63, r32 = lane & 31, hi = lane >> 5, w = __builtin_amdgcn_readfirstlane(tid >> 6), wr = w & 3, strm = w >> 2;
    bf16x8 qf[4];
#pragma unroll
    for (int d0 = 0; d0 < 4; ++d0) qf[d0] = *(const bf16x8*)(Qg + (size_t)(q0 + 32 * wr + r32) * 768 + 64 * strm + 16 * d0 + 8 * hi);
    const int srow = tid >> 4, sch = tid & 15;
    const bf16_t* ksrc = Kg + (size_t)srow * 768 + sch * 8;
    const bf16_t* vsrc = Vtg + (size_t)srow * SEQ_ + sch * 8;
    const unsigned kdst = OFF_K2 + srow * KP2 + sch * 16, vdst = OFF_V2 + srow * VP + sch * 16;
    u32x4 sreg[4];
#define D_LOADK(t) do { _Pragma("unroll") for (int i = 0; i < 4; ++i) sreg[i] = *(const u32x4*)(ksrc + (size_t)(128 * (t) + 32 * i) * 768); } while (0)
#define D_STOREK(buf) do { _Pragma("unroll") for (int i = 0; i < 4; ++i) *(LAS u32x4*)(lds + kdst + (buf) * KBUF2 + i * 32 * KP2) = sreg[i]; } while (0)
#define D_LOADV(t) do { _Pragma("unroll") for (int i = 0; i < 4; ++i) sreg[i] = *(const u32x4*)(vsrc + (size_t)(32 * i) * SEQ_ + 128 * (t)); } while (0)
#define D_STOREV(buf) do { _Pragma("unroll") for (int i = 0; i < 4; ++i) { *(LAS u32x2*)(lds + vdst + (buf) * VBUF + i * 32 * VP) = (u32x2){sreg[i].x, sreg[i].y}; *(LAS u32x2*)(lds + vdst + (buf) * VBUF + i * 32 * VP + 8) = (u32x2){sreg[i].z, sreg[i].w}; } } while (0)
    D_LOADK(0); D_STOREK(0); D_LOADV(0); D_STOREV(0);
    __syncthreads();
    float mrow = -1e30f, lrow = 0.f;
    f32x16 o[4];
#pragma unroll
    for (int d0 = 0; d0 < 4; ++d0)
#pragma unroll
        for (int r = 0; r < 16; ++r) o[d0][r] = 0.f;
    const int qmin = q0 + 32 * wr;
    bf16x8 kf[8], vf[4], vg[4], pb[4];
    f32x16 p0, p1;
#define D_SUB(buf, sub, kv0) do { if (!((kv0) > qmin + 31)) { \
        LAS unsigned char* Ks_ = lds + OFF_K2 + (buf) * KBUF2 + (sub) * 64 * KP2 + strm * 128; \
        _Pragma("unroll") for (int d0 = 0; d0 < 4; ++d0) { kf[2 * d0] = *(LAS bf16x8*)(Ks_ + r32 * KP2 + (2 * d0 + hi) * 16); kf[2 * d0 + 1] = *(LAS bf16x8*)(Ks_ + (32 + r32) * KP2 + (2 * d0 + hi) * 16); } \
        _Pragma("unroll") for (int r = 0; r < 16; ++r) { p0[r] = 0.f; p1[r] = 0.f; } \
        __builtin_amdgcn_sched_barrier(0); \
        _Pragma("unroll") for (int d0 = 0; d0 < 4; ++d0) { \
            p0 = __builtin_amdgcn_mfma_f32_32x32x16_bf16(kf[2 * d0], qf[d0], p0, 0, 0, 0); \
            p1 = __builtin_amdgcn_mfma_f32_32x32x16_bf16(kf[2 * d0 + 1], qf[d0], p1, 0, 0, 0); } \
        __builtin_amdgcn_sched_barrier(0); \
        LAS unsigned char* Vs_ = lds + OFF_V2 + (buf) * VBUF + (sub) * 128; \
        D_VLOAD(0); \
        if ((kv0) + 63 > qmin) { const int qrel = qmin + r32 - (kv0); \
            _Pragma("unroll") for (int r = 0; r < 16; ++r) { const int kv = (r & 3) + 8 * (r >> 2) + 4 * hi; if (kv > qrel) p0[r] = -1e30f; if (kv + 32 > qrel) p1[r] = -1e30f; } } \
        float mt = max3f(p0[0], p1[0], p0[1]), mu = max3f(p1[1], p0[2], p1[2]); \
        _Pragma("unroll") for (int r = 3; r < 15; r += 2) { mt = max3f(mt, p0[r], p1[r]); mu = max3f(mu, p0[r + 1], p1[r + 1]); } \
        mt = max3f(mt, p0[15], p1[15]); mt = max3f(mt, mu, mu); \
        mt = xhalf_max(mt); \
        if (__builtin_amdgcn_ballot_w64(mt > mrow + RESC_THR) != 0ull) { \
            const float mnew = fmaxf(mrow, mt), alpha = __builtin_amdgcn_exp2f(mrow - mnew); mrow = mnew; lrow *= alpha; \
            _Pragma("unroll") for (int d0 = 0; d0 < 4; ++d0) _Pragma("unroll") for (int r = 0; r < 16; ++r) o[d0][r] *= alpha; } \
        exp_sum_pk(p0, p1, mrow, lrow); \
        { u32x4 x; x.x = cvtpk(p0[0], p0[1]); x.y = cvtpk(p0[2], p0[3]); x.z = cvtpk(p0[4], p0[5]); x.w = cvtpk(p0[6], p0[7]); pb[0] = __builtin_bit_cast(bf16x8, x); \
          x.x = cvtpk(p0[8], p0[9]); x.y = cvtpk(p0[10], p0[11]); x.z = cvtpk(p0[12], p0[13]); x.w = cvtpk(p0[14], p0[15]); pb[1] = __builtin_bit_cast(bf16x8, x); \
          x.x = cvtpk(p1[0], p1[1]); x.y = cvtpk(p1[2], p1[3]); x.z = cvtpk(p1[4], p1[5]); x.w = cvtpk(p1[6], p1[7]); pb[2] = __builtin_bit_cast(bf16x8, x); \
          x.x = cvtpk(p1[8], p1[9]); x.y = cvtpk(p1[10], p1[11]); x.z = cvtpk(p1[12], p1[13]); x.w = cvtpk(p1[14], p1[15]); pb[3] = __builtin_bit_cast(bf16x8, x); } \
        __builtin_amdgcn_sched_barrier(0); \
        D_VLOADB(1); D_PVM(0); D_VLOAD(2); D_PVMB(1); D_VLOADB(3); D_PVM(2); D_PVMB(3); } } while (0)
#define D_VLOAD(KK) do { _Pragma("unroll") for (int d0 = 0; d0 < 4; ++d0) { \
            const LAS unsigned char* vp = Vs_ + (32 * d0 + r32) * VP + (16 * (KK) + 4 * hi) * 2; \
            const s16x4 lo = *(const LAS s16x4*)vp, hh = *(const LAS s16x4*)(vp + 16); \
            vf[d0] = (bf16x8){lo[0], lo[1], lo[2], lo[3], hh[0], hh[1], hh[2], hh[3]}; } \
        __builtin_amdgcn_sched_barrier(0); } while (0)
#define D_VLOADB(KK) do { _Pragma("unroll") for (int d0 = 0; d0 < 4; ++d0) { \
            const LAS unsigned char* vp = Vs_ + (32 * d0 + r32) * VP + (16 * (KK) + 4 * hi) * 2; \
            const s16x4 lo = *(const LAS s16x4*)vp, hh = *(const LAS s16x4*)(vp + 16); \
            vg[d0] = (bf16x8){lo[0], lo[1], lo[2], lo[3], hh[0], hh[1], hh[2], hh[3]}; } \
        __builtin_amdgcn_sched_barrier(0); } while (0)
#define D_PVMB(KK) do { _Pragma("unroll") for (int d0 = 0; d0 < 4; ++d0) o[d0] = __builtin_amdgcn_mfma_f32_32x32x16_bf16(vg[d0], pb[KK], o[d0], 0, 0, 0); \
        __builtin_amdgcn_sched_barrier(0); } while (0)
#define D_PVM(KK) do { _Pragma("unroll") for (int d0 = 0; d0 < 4; ++d0) o[d0] = __builtin_amdgcn_mfma_f32_32x32x16_bf16(vf[d0], pb[KK], o[d0], 0, 0, 0); \
        __builtin_amdgcn_sched_barrier(0); } while (0)
    for (int t = 0; t < ntiles; ++t) {
        const int cur = t & 1, nxt = cur ^ 1; const bool more = (t + 1 < ntiles);
        if (more) D_LOADK(t + 1);
        D_SUB(cur, 0, 128 * t);
        if (more) { D_STOREK(nxt); D_LOADV(t + 1); }
        D_SUB(cur, 1, 128 * t + 64);
        if (more) D_STOREV(nxt);
        __syncthreads();
    }
#undef D_LOADK
#undef D_STOREK
#undef D_LOADV
#undef D_STOREV
#undef D_SUB
#undef D_VLOAD
#undef D_PVM
#undef D_VLOADB
#undef D_PVMB
    const float inv = __builtin_amdgcn_rcpf(xhalf_sum(lrow));
    const int lane_e = hw_lane(), r32e = lane_e & 31, hie = lane_e >> 5;
    if (strm == 1) {
#pragma unroll
        for (int d0 = 0; d0 < 4; ++d0)
#pragma unroll
            for (int g4 = 0; g4 < 4; ++g4) *(LAS f32x4*)(lds + (((d0 * 4 + g4) * 4 + wr) * 64 + lane_e) * 16) = (f32x4){o[d0][4 * g4] * inv, o[d0][4 * g4 + 1] * inv, o[d0][4 * g4 + 2] * inv, o[d0][4 * g4 + 3] * inv};
    }
    __syncthreads();
    if (strm == 0) {
        float sq = 0.f;
#pragma unroll
        for (int d0 = 0; d0 < 4; ++d0)
#pragma unroll
            for (int g4 = 0; g4 < 4; ++g4) { const f32x4 a = *(LAS f32x4*)(lds + (((d0 * 4 + g4) * 4 + wr) * 64 + lane_e) * 16);
#pragma unroll
                for (int e = 0; e < 4; ++e) { const float y = o[d0][4 * g4 + e] * inv - lam * a[e]; o[d0][4 * g4 + e] = y; sq += y * y; } }
        sq = xhalf_sum(sq);
        const float rn = __builtin_amdgcn_rsqf(sq * (1.0f / 128.0f) + 1e-6f) * post;
        bf16_t* dst = mixbase + (size_t)(q0 + 32 * wr + r32e) * 1024;
#pragma unroll
        for (int d0 = 0; d0 < 4; ++d0)
#pragma unroll
            for (int g4 = 0; g4 < 4; ++g4) { const f32x4 gv = *(const f32x4*)(subln_g + 32 * d0 + 8 * g4 + 4 * hie);
                u32x2 x; x.x = cvtpk(o[d0][4 * g4] * rn * gv[0], o[d0][4 * g4 + 1] * rn * gv[1]); x.y = cvtpk(o[d0][4 * g4 + 2] * rn * gv[2], o[d0][4 * g4 + 3] * rn * gv[3]);
                *(u32x2*)(dst + 32 * d0 + 8 * g4 + 4 * hie) = x; }
    }
}
template <int DV> __device__ __forceinline__ void store_o(bf16_t* dstrow, const f32x16 (&o)[DV / 32], int hi) {
#pragma unroll
    for (int d0 = 0; d0 < DV / 32; ++d0)
#pragma unroll
        for (int g = 0; g < 4; ++g) { u32x2 x; x.x = cvtpk(o[d0][4 * g], o[d0][4 * g + 1]); x.y = cvtpk(o[d0][4 * g + 2], o[d0][4 * g + 3]);
            *(u32x2*)(dstrow + 32 * d0 + 8 * g + 4 * hi) = x; }
}
}
__constant__ float INV_FREQ[32] = {1.000000000e+00f, 7.498942614e-01f, 5.623413324e-01f, 4.216965139e-01f, 3.162277639e-01f, 2.371373773e-01f, 1.778279394e-01f, 1.333521307e-01f, 1.000000015e-01f, 7.498941571e-02f, 5.623413250e-02f, 4.216965288e-02f, 3.162277490e-02f, 2.371373773e-02f, 1.778279431e-02f, 1.333521493e-02f, 9.999999776e-03f, 7.498941850e-03f, 5.623413250e-03f, 4.216964822e-03f, 3.162277630e-03f, 2.371373586e-03f, 1.778279431e-03f, 1.333521446e-03f, 1.000000047e-03f, 7.498942432e-04f, 5.623413017e-04f, 4.216965172e-04f, 3.162277571e-04f, 2.371373703e-04f, 1.778279402e-04f, 1.333521504e-04f};
namespace cg = cooperative_groups;
typedef unsigned short bf16;
typedef float f32x4 __attribute__((ext_vector_type(4)));
typedef unsigned v4u __attribute__((ext_vector_type(4)));
typedef unsigned v2u __attribute__((ext_vector_type(2)));
constexpr int NB = 4, SEQ = 4096, DM = 1024, M = NB * SEQ, NMEM = 256, MM = NB * NMEM, DFF = 2816, NPROJ = 2560, NPROJA = 2816;
constexpr float C2 = 0.125f * 1.4426950408889634f;
constexpr float LAMBDA_INIT = 0.35550906759096934f;
constexpr size_t MiB = 1u << 20;
constexpr size_t WS_CTL = 0;
constexpr size_t WS_SSQ = 1 * MiB;
constexpr size_t WS_SSQM = WS_SSQ + 5 * (size_t)M * 4;
constexpr size_t WS_LF = 2 * MiB;
constexpr size_t WS_COS = 3 * MiB, WS_SIN = 3 * MiB + 512 * 1024;
constexpr size_t WS_WA = 4 * MiB, WS_WB = 10 * MiB, WS_WO = 15 * MiB, WS_WM = 19 * MiB, WS_WGU = 21 * MiB, WS_WD = 43 * MiB;
constexpr size_t WS_MEMB = 54 * MiB, WS_MK = 56 * MiB, WS_MVT = 57 * MiB;
constexpr size_t WS_XB = 58 * MiB;
constexpr size_t WS_Q = 90 * MiB, WS_K = 114 * MiB, WS_VT = 138 * MiB, WS_MQ = 162 * MiB, WS_MIX = 170 * MiB, WS_H = 90 * MiB, WS_STASH = 202 * MiB, WS_END = 234 * MiB;
static_assert(WS_H + (size_t)M * DFF * 2 <= WS_END, "h overlay");
constexpr int LDS_BYTES = 147456, LDS_MISC = LDS_BYTES - 1024, LDS_ARGS = LDS_MISC + 256;

constexpr int CW_BAR = 4096;
struct Args {
    const float *x, *mem, *attn_g, *mem_g, *w_mem_kv, *w_out, *ffn_g, *w_gate_up, *w_down, *a_w_in, *a_b_f, *b_w_in, *lq1, *lk1, *lq2, *lk2, *subln_g, *kv_g, *w_kv, *final_g;
    float* out; unsigned char* ws;
};

__device__ __forceinline__ unsigned f2bf(float f) { unsigned u = __builtin_bit_cast(unsigned, f); return (u + 0x7fffu + ((u >> 16) & 1u)) >> 16; }
__device__ __forceinline__ unsigned pk2(float lo, float hi) { return f2bf(lo) | (f2bf(hi) << 16); }
__device__ __forceinline__ float wave_sum(float v) {
#pragma unroll
    for (int o = 1; o < 64; o <<= 1) v += __shfl_xor(v, o);
    return v;
}
__device__ __forceinline__ void wt_item(const float* W, int ldw, int K, const float* g, bf16* WT, int k0, int c0, int nvalid, int drowA, int drowB, LAS float* scr, int lane) {
    const int kq = lane >> 4, n4 = 4 * (lane & 15);
    f32x4 v[16]; float gk[16];
#pragma unroll
    for (int i = 0; i < 16; ++i) gk[i] = g ? g[k0 + 4 * i + kq] : 1.0f;
#pragma unroll
    for (int i = 0; i < 16; ++i) v[i] = *(const f32x4*)(W + (size_t)(k0 + 4 * i + kq) * ldw + c0 + n4);
    if (g) {
#pragma unroll
        for (int i = 0; i < 16; ++i) v[i] = v[i] * gk[i];
    }
    if (nvalid < 64) {
#pragma unroll
        for (int i = 0; i < 16; ++i)
#pragma unroll
            for (int e = 0; e < 4; ++e) if (n4 + e >= nvalid) v[i][e] = 0.f;
    }
#pragma unroll
    for (int i = 0; i < 16; ++i)
#pragma unroll
        for (int e = 0; e < 4; ++e) scr[(4 * i + kq) * 65 + n4 + e] = v[i][e];
    asm volatile("s_waitcnt lgkmcnt(0)" ::: "memory");
#pragma unroll
    for (int j = 0; j < 8; ++j) { const int q = lane + 64 * j, n = q >> 3, kc = q & 7; const LAS float* s = scr + (8 * kc) * 65 + n;
        v4u o; o.x = pk2(s[0 * 65], s[1 * 65]); o.y = pk2(s[2 * 65], s[3 * 65]); o.z = pk2(s[4 * 65], s[5 * 65]); o.w = pk2(s[6 * 65], s[7 * 65]);
        const int drow = (n < 32) ? drowA + n : drowB + n - 32;
        *(v4u*)(WT + (size_t)drow * K + k0 + 8 * kc) = o; }
    asm volatile("s_waitcnt lgkmcnt(0)" ::: "memory");
}
__device__ __forceinline__ int wt_drow(int l, int drow0, int kind) {
    if (kind == 0) return drow0 + l;
    if (kind == 1) return drow0 + (l / 256) * 256 + ((l >> 5) & 1) * 128 + ((l & 255) >> 6) * 32;
    const int up = l >= DFF ? 1 : 0, j = l - up * DFF; return drow0 + (j / 128) * 256 + up * 128 + (j & 127);
}
__device__ __forceinline__ void wt_job(int it, const float* W, int ldw, int K, int c_src, int ncols, int nvalid, const float* g, bf16* WT, int drow0, int kind, LAS float* scr, int lane) {
    const int nblk = ncols / 64, kb = it / nblk, nb = it % nblk; const int l = nb * 64;
    wt_item(W, ldw, K, g, WT, kb * 64, c_src + l, nvalid, wt_drow(l, drow0, kind), wt_drow(l + 32, drow0, kind), scr, lane);
}
#define XB_TMO      128
#define XB_XCNT(j)  (256  + 64 * (j))
#define XB_XSUB(j)  (1280 + 64 * (j))
#define XB_XGEN(j)  (2304 + 64 * (j))
#define XB_TOP      3328
#define XB_TOPGEN   3392
#define XCD_BAR_WORDS 3456
#define XB_SPIN_CAP (1u << 18)

__device__ __forceinline__ unsigned xb_ld(unsigned* p)              { return __hip_atomic_load(p, __ATOMIC_RELAXED, __HIP_MEMORY_SCOPE_AGENT); }
__device__ __forceinline__ unsigned xb_add(unsigned* p, unsigned v) { return __hip_atomic_fetch_add(p, v, __ATOMIC_RELAXED, __HIP_MEMORY_SCOPE_AGENT); }
__device__ __forceinline__ unsigned xb_xcc_id() { return (unsigned)__builtin_amdgcn_s_getreg((3 << 11) | 20) & 0xFu; }
#define XB_SPIN(cond, bar) do { unsigned _sp = 0; while (cond) { __builtin_amdgcn_s_sleep(1); \
    if ((++_sp & 255u) == 0u) { if (xb_ld(&(bar)[XB_TMO])) break; if (_sp > XB_SPIN_CAP) { atomicAdd(&(bar)[XB_TMO], 1u); break; } } } } while (0)

struct XcdBarrier {
    unsigned* bar; unsigned x; int wv;
    volatile LAS unsigned* st;
};

__device__ __forceinline__ XcdBarrier xcd_barrier_post(unsigned* bar, volatile LAS unsigned* st) {
    XcdBarrier b; b.bar = bar; b.x = xb_xcc_id(); b.st = st; b.wv = 0;
    if (threadIdx.x == 0) (void)xb_add(&bar[XB_XCNT(b.x)], 1u);
    return b;
}
__device__ __forceinline__ void xcd_barrier_complete(unsigned* bar, unsigned x, unsigned& nloc, unsigned& nx) {
    const unsigned G = gridDim.x * gridDim.y * gridDim.z;
    unsigned sum, cnt, mine, sp = 0u;
    for (;;) {
        sum = 0u; cnt = 0u; mine = 0u;
#pragma unroll
        for (unsigned j = 0; j < 16; ++j) { const unsigned c = xb_ld(&bar[XB_XCNT(j)]); sum += c; cnt += (c > 0u) ? 1u : 0u; mine = (j == x) ? c : mine; }
        if (sum == G) break;
        __builtin_amdgcn_s_sleep(1);
        if ((++sp & 255u) == 0u) { if (xb_ld(&bar[XB_TMO])) break; if (sp > XB_SPIN_CAP) { atomicAdd(&bar[XB_TMO], 1u); break; } }
    }
    nloc = mine > 0u ? mine : 1u; nx = cnt > 0u ? cnt : 1u;
}

__device__ __forceinline__ void xcd_barrier(const XcdBarrier& b) {
    asm volatile("s_waitcnt vmcnt(0)" ::: "memory");
    __syncthreads();
    if (b.wv * 64 + hw_lane() == 0) {
        unsigned* bar = b.bar;
        __builtin_amdgcn_s_waitcnt(0);
        unsigned nloc = b.st[0], nx = b.st[1];
        if (nloc == 0u) { xcd_barrier_complete(bar, b.x, nloc, nx); b.st[0] = nloc; b.st[1] = nx; }
        const unsigned old = xb_add(&bar[XB_XSUB(b.x)], 1u);
        const unsigned gen = old / nloc;
        if (old + 1u == (gen + 1u) * nloc) {
            __builtin_amdgcn_fence(__ATOMIC_RELEASE, "agent");
            asm volatile("s_waitcnt vmcnt(0)" ::: "memory");
            const unsigned og = xb_add(&bar[XB_TOP], 1u);
            const unsigned tg = og / nx;
            if (og + 1u == (tg + 1u) * nx) xb_add(&bar[XB_TOPGEN], 1u);
            else XB_SPIN(xb_ld(&bar[XB_TOPGEN]) == tg, bar);
            __builtin_amdgcn_fence(__ATOMIC_ACQUIRE, "agent");
            xb_add(&bar[XB_XGEN(b.x)], 1u);
            asm volatile("s_waitcnt vmcnt(0)" ::: "memory");
        } else {
            XB_SPIN(xb_ld(&bar[XB_XGEN(b.x)]) == gen, bar);
            __builtin_amdgcn_fence(__ATOMIC_ACQUIRE, "agent");
            asm volatile("s_waitcnt vmcnt(0)" ::: "memory");
        }
    }
    __syncthreads();
}
#ifndef NREP_SYNC
#define NREP_SYNC 0
#endif
#ifndef NREP2
#define NREP2 1
#endif
#ifndef NREP7
#define NREP7 1
#endif
#ifndef NREP4
#define NREP4 1
#endif
#ifndef NREP1
#define NREP1 1
#endif
#ifndef NREP0
#define NREP0 1
#endif
#ifndef NREP35
#define NREP35 1
#endif
#ifndef PREREAD
#define PREREAD 0
#endif
#ifndef NREPB
#define NREPB 1
#endif
#ifndef USE_XB
#define USE_XB 1
#endif
#ifndef PVAR
#define PVAR 0
#endif
#ifndef PH_MASK
#define PH_MASK 0xFFFF
#endif
__device__ __forceinline__ void scan_bh(float* lf, LAS float* sm, int tid) {
    const f32x4 a = *(const f32x4*)(lf + 8 * tid), b = *(const f32x4*)(lf + 8 * tid + 4);
    float v[8] = {a[0], a[1], a[2], a[3], b[0], b[1], b[2], b[3]};
#pragma unroll
    for (int i = 1; i < 8; ++i) v[i] += v[i - 1];
    float tot = v[7]; const int lane = tid & 63, w = tid >> 6;
    float inc = tot;
#pragma unroll
    for (int o = 1; o < 64; o <<= 1) { const float n = __shfl_up(inc, o); if (lane >= o) inc += n; }
    if (lane == 63) sm[w] = inc;
    __syncthreads();
    float base = inc - tot;
    for (int i = 0; i < w; ++i) base += sm[i];
    const float k = -1.4426950408889634f;
    f32x4 oa, ob;
#pragma unroll
    for (int i = 0; i < 4; ++i) { oa[i] = (v[i] + base) * k; ob[i] = (v[4 + i] + base) * k; }
    *(f32x4*)(lf + 8 * tid) = oa; *(f32x4*)(lf + 8 * tid + 4) = ob;
    __syncthreads();
}

enum { AX = 0, AMEM, AATTN_G, AMEM_G, AW_MEM_KV, AW_OUT, AFFN_G, AW_GATE_UP, AW_DOWN, AA_W_IN, AA_B_F, AB_W_IN, ALQ1, ALK1, ALQ2, ALK2, ASUBLN_G, AKV_G, AW_KV, AFINAL_G, AOUT, AWS };
__device__ __forceinline__ const float* argp(LAS unsigned char* lds, int i) {
    volatile LAS unsigned* p = (volatile LAS unsigned*)(lds + LDS_ARGS + 8 * i);
    const unsigned lo = __builtin_amdgcn_readfirstlane(p[0]), hi = __builtin_amdgcn_readfirstlane(p[1]);
    return (const float*)(__attribute__((address_space(1))) const float*)(((unsigned long long)hi << 32) | (unsigned long long)lo);
}
#define WSPTRS() \
    unsigned char* ws = (unsigned char*)argp(lds, AWS); \
    unsigned* ctl = (unsigned*)(ws + WS_CTL); float* ssq = (float*)(ws + WS_SSQ); float* ssqm = (float*)(ws + WS_SSQM); \
    float* LF = (float*)(ws + WS_LF); float* COS = (float*)(ws + WS_COS); float* SIN = (float*)(ws + WS_SIN); \
    bf16 *WA = (bf16*)(ws + WS_WA), *WB = (bf16*)(ws + WS_WB), *WO = (bf16*)(ws + WS_WO), *WM = (bf16*)(ws + WS_WM), *WGU = (bf16*)(ws + WS_WGU), *WD = (bf16*)(ws + WS_WD); \
    bf16 *MEMB = (bf16*)(ws + WS_MEMB), *MK = (bf16*)(ws + WS_MK), *MVT = (bf16*)(ws + WS_MVT), *XB = (bf16*)(ws + WS_XB); \
    bf16 *Qb = (bf16*)(ws + WS_Q), *Kb = (bf16*)(ws + WS_K), *VT = (bf16*)(ws + WS_VT), *MQ = (bf16*)(ws + WS_MQ), *MIX = (bf16*)(ws + WS_MIX), *H = (bf16*)(ws + WS_H); \
    (void)ctl; (void)ssq; (void)ssqm; (void)LF; (void)COS; (void)SIN; (void)WA; (void)WB; (void)WO; (void)WM; (void)WGU; (void)WD; (void)MEMB; (void)MK; (void)MVT; (void)XB; (void)Qb; (void)Kb; (void)VT; (void)MQ; (void)MIX; (void)H;

constexpr int I1 = 16 * 36, I2 = 16 * 4, IF_ = 16, I3 = 16 * 12, I4 = 16 * 12, I5 = 16 * 12, I6 = 16 * 4, I7 = 16 * 16, I9 = 16 * 8, I11 = 16 * 88, I13 = 44 * 16;
constexpr int WT_A = I11 + I13 + I1 + I2 + IF_ + I7 + 2 * I9, WT_B1 = I3 + I4 + I5 + I6, WT_B2 = I11, WT_B3 = I7 + I13;
#define WT_SRCS() const float *a_w_in = argp(lds, AA_W_IN), *attn_g = argp(lds, AATTN_G), *w_kv = argp(lds, AW_KV), *kv_g = argp(lds, AKV_G), *b_w_in = argp(lds, AB_W_IN), *w_out = argp(lds, AW_OUT); \
    const float *w_mem_kv = argp(lds, AW_MEM_KV), *mem_g = argp(lds, AMEM_G), *w_gate_up = argp(lds, AW_GATE_UP), *ffn_g = argp(lds, AFFN_G), *w_down = argp(lds, AW_DOWN);
#define WT_DISPATCH(it_) do { int r = (it_); \
    if (r < I11) { wt_job(r, w_gate_up, 5632, 1024, 0, 5632, 64, ffn_g, WGU, 0, 2, scr, lane); break; } r -= I11; \
    if (r < I13) { wt_job(r, w_down, 1024, 2816, 0, 1024, 64, nullptr, WD, 0, 0, scr, lane); break; } r -= I13; \
    if (r < I1) { wt_job(r, a_w_in, 2572, 1024, 0, 2304, 64, attn_g, WA, 0, 0, scr, lane); break; } r -= I1; \
    if (r < I2) { wt_job(r, a_w_in, 2572, 1024, 2316, 256, 64, attn_g, WA, 2304, 0, scr, lane); break; } r -= I2; \
    if (r < IF_) { wt_job(r, a_w_in, 2572, 1024, 2304, 64, 12, attn_g, WA, 2560, 0, scr, lane); break; } r -= IF_; \
    if (r < I7) { wt_job(r, w_out, 1024, 1024, 0, 1024, 64, nullptr, WO, 0, 0, scr, lane); break; } r -= I7; \
    if (r < 2 * I9) { const int l = r / I9; wt_job(r % I9, w_mem_kv + (size_t)l * 1024 * 512, 512, 1024, 0, 512, 64, mem_g + 1024 * l, WM, 512 * l, 0, scr, lane); break; } r -= 2 * I9; \
    if (r < I3) { wt_job(r, w_kv, 1536, 1024, 0, 768, 64, kv_g, WB, 0, 1, scr, lane); break; } r -= I3; \
    if (r < I4) { wt_job(r, w_kv, 1536, 1024, 768, 768, 64, kv_g, WB, 768, 0, scr, lane); break; } r -= I4; \
    if (r < I5) { wt_job(r, b_w_in, 1024, 1024, 0, 768, 64, attn_g + 1024, WB, 1536, 1, scr, lane); break; } r -= I5; \
    if (r < I6) { wt_job(r, b_w_in, 1024, 1024, 768, 256, 64, attn_g + 1024, WB, 2304, 0, scr, lane); break; } r -= I6; \
    if (r < I11) { wt_job(r, w_gate_up + (size_t)1024 * 5632, 5632, 1024, 0, 5632, 64, ffn_g + 1024, WGU + (size_t)5632 * 1024, 0, 2, scr, lane); break; } r -= I11; \
    if (r < I7) { wt_job(r, w_out + (size_t)1024 * 1024, 1024, 1024, 0, 1024, 64, nullptr, WO + (size_t)1024 * 1024, 0, 0, scr, lane); break; } r -= I7; \
    wt_job(r, w_down + (size_t)2816 * 1024, 1024, 2816, 0, 1024, 64, nullptr, WD + (size_t)1024 * 2816, 0, 0, scr, lane); } while (0)
#define WT_IDLE(first, lo, hi) do { const int f_ = (first) < G ? (first) : 0;        \
    if (bx >= f_) { WSPTRS(); PHASE_IDS(); WT_SRCS(); LAS float* scr = (LAS float*)(lds + wave * 16640); \
        for (int it = (lo) + (bx - f_) * 8 + wave; it < (hi); it += (G - f_) * 8) WT_DISPATCH(it); __syncthreads(); } } while (0)

__global__ void __launch_bounds__(512, 2) yoco_fwd(Args A) {
    extern __shared__ __attribute__((aligned(16))) unsigned char lds_raw[];
    LAS unsigned char* lds = (LAS unsigned char*)lds_raw;
#if USE_XB
    if (threadIdx.x < 2) ((volatile LAS unsigned*)(lds + LDS_MISC + 128))[threadIdx.x] = 0u;
    __syncthreads();
    XcdBarrier xbar = xcd_barrier_post((unsigned*)(A.ws + WS_CTL) + CW_BAR, (volatile LAS unsigned*)(lds + LDS_MISC + 128));
#define GRID_SYNC() xcd_barrier(xbar)
#else
    cg::grid_group grid = cg::this_grid();
#define GRID_SYNC() grid.sync()
#endif
    const int G = gridDim.x, bx = blockIdx.x;
    const int wave0 = __builtin_amdgcn_readfirstlane((int)threadIdx.x >> 6);
#define HW_TID() (wave0 * 64 + hw_lane())
#if USE_XB
    xbar.wv = wave0;
#endif
    if (threadIdx.x == 0) {
        LAS unsigned long long* P = (LAS unsigned long long*)(lds + LDS_ARGS);
        P[AX] = (unsigned long long)A.x; P[AMEM] = (unsigned long long)A.mem; P[AATTN_G] = (unsigned long long)A.attn_g; P[AMEM_G] = (unsigned long long)A.mem_g;
        P[AW_MEM_KV] = (unsigned long long)A.w_mem_kv; P[AW_OUT] = (unsigned long long)A.w_out; P[AFFN_G] = (unsigned long long)A.ffn_g; P[AW_GATE_UP] = (unsigned long long)A.w_gate_up;
        P[AW_DOWN] = (unsigned long long)A.w_down; P[AA_W_IN] = (unsigned long long)A.a_w_in; P[AA_B_F] = (unsigned long long)A.a_b_f; P[AB_W_IN] = (unsigned long long)A.b_w_in;
        P[ALQ1] = (unsigned long long)A.lq1; P[ALK1] = (unsigned long long)A.lk1; P[ALQ2] = (unsigned long long)A.lq2; P[ALK2] = (unsigned long long)A.lk2;
        P[ASUBLN_G] = (unsigned long long)A.subln_g; P[AKV_G] = (unsigned long long)A.kv_g; P[AW_KV] = (unsigned long long)A.w_kv; P[AFINAL_G] = (unsigned long long)A.final_g;
        P[AOUT] = (unsigned long long)A.out; P[AWS] = (unsigned long long)A.ws;
    }
    __syncthreads();
#define PHASE_IDS() int tid_ = HW_TID(); asm volatile("" : "+v"(tid_)); const int tid = tid_, lane = tid & 63, wave = __builtin_amdgcn_readfirstlane(tid >> 6); \
    const int gw = bx * 8 + wave, NGW = G * 8, gt = bx * 512 + tid, NGT = G * 512; (void)lane; (void)gw; (void)NGW; (void)gt; (void)NGT;

    for (int rep0_ = 0; rep0_ < NREP0; ++rep0_) {
        WSPTRS(); PHASE_IDS();
        const float *a_w_in = argp(lds, AA_W_IN), *attn_g = argp(lds, AATTN_G), *w_kv = argp(lds, AW_KV), *kv_g = argp(lds, AKV_G), *b_w_in = argp(lds, AB_W_IN), *w_out = argp(lds, AW_OUT);
        const float *w_mem_kv = argp(lds, AW_MEM_KV), *mem_g = argp(lds, AMEM_G), *w_gate_up = argp(lds, AW_GATE_UP), *ffn_g = argp(lds, AFFN_G), *w_down = argp(lds, AW_DOWN);
        const float *xin = argp(lds, AX), *memin = argp(lds, AMEM), *a_b_f = argp(lds, AA_B_F);
#if PREREAD
        {
            float acc_ = 0.f;
#define PRE_(ptr, n) for (int i = gt; i < (n) / 4; i += NGT) { const f32x4 v = ((const f32x4*)(ptr))[i]; acc_ += (v[0] + v[1]) + (v[2] + v[3]); }
            PRE_(w_gate_up, 2 * 1024 * 5632) PRE_(w_down, 2 * 2816 * 1024) PRE_(a_w_in, 1024 * 2572) PRE_(w_kv, 1024 * 1536) PRE_(b_w_in, 1024 * 1024) PRE_(w_out, 2 * 1024 * 1024) PRE_(w_mem_kv, 2 * 1024 * 512)
#undef PRE_
            if (acc_ == 1.2345e38f) ctl[63] = 1u;
        }
#endif
        LAS float* scr = (LAS float*)(lds + wave * 16640);
        {
            constexpr int o_WA = I11 + I13, o_WO0 = o_WA + I1 + I2 + IF_, o_WM = o_WO0 + I7, n0 = I11, n1 = o_WO0 - o_WA, n2 = 2 * I9;
            for (int j = gw; j < n0 + n1 + n2; j += NGW) { const int it = j < n0 ? j : (j < n0 + n1 ? o_WA + (j - n0) : o_WM + (j - n0 - n1)); WT_DISPATCH(it); }
        }
        for (int i = gt; i < 192 * 1024 / 8; i += NGT) ((v4u*)(WA + (size_t)2624 * 1024))[i] = (v4u){0u, 0u, 0u, 0u};
        for (int m = 4 * gw; m < M + MM; m += 4 * NGW) {
            const bool ism = m >= M; const float* src = ism ? memin + (size_t)(m - M) * DM : xin + (size_t)m * DM; bf16* dst = ism ? MEMB + (size_t)(m - M) * DM : XB + (size_t)m * DM; float* sdst = ism ? ssqm + (m - M) : ssq + m;
            const f32x4* xr = (const f32x4*)src + lane; f32x4 v[16]; float sr[4];
#pragma unroll
            for (int j = 0; j < 16; ++j) v[j] = xr[64 * j];
#pragma unroll
            for (int r = 0; r < 4; ++r) { float a = 0.f;
#pragma unroll
                for (int j = 0; j < 4; ++j) { const f32x4 q = v[4 * r + j]; a += (q[0] * q[0] + q[1] * q[1]) + (q[2] * q[2] + q[3] * q[3]); }
                sr[r] = wave_sum(a); }
            if (lane == 0) { sdst[0] = sr[0]; sdst[1] = sr[1]; sdst[2] = sr[2]; sdst[3] = sr[3]; }
            unsigned long long* o8 = (unsigned long long*)dst + lane;
#pragma unroll
            for (int j = 0; j < 16; ++j) o8[64 * j] = (unsigned long long)pk2(v[j][0], v[j][1]) | ((unsigned long long)pk2(v[j][2], v[j][3]) << 32);
        }
        for (int i = gt; i < SEQ * 32; i += NGT) { const int pos = i >> 5, f = i & 31; const float ang = (float)pos * INV_FREQ[f];
            double rev = (double)ang * 0.15915494309189535; rev -= __builtin_rint(rev);
            COS[i] = __builtin_amdgcn_cosf((float)rev); SIN[i] = __builtin_amdgcn_sinf((float)rev); }
        for (int i = gt; i < 4 * M; i += NGT) ssq[M + i] = 0.f;
        if (gt < 64) ctl[gt] = 0u;
    }
    GRID_SYNC();

#if PH_MASK & (1 << 1)
    {
        WSPTRS(); PHASE_IDS();
        for (int rep_ = 0; rep_ < NREP1; ++rep_) {
        pg8::Gemm g{XB, WA, M, NPROJA, DM}; pg8::StaticOrder S; S.init(M, NPROJA, G, bx);
        pg8::EpiProj E{ssq, COS, SIN, argp(lds, AA_B_F), LF, SEQ, {Qb, 3, 0, 768, C2}, {Kb, 6, 0, 768, 1.f}, {VT, 9, 1, 768, 1.f}, {MQ, 10, 0, 256, C2}, {nullptr, 11, 3, 0, 1.f}};
        pg8::gemm_phase<pg8::EpiProj, pg8::StaticOrder, true, true>(lds, g, S, E, wave0);
        }
    }
    {
        WSPTRS();
        pg8::Gemm g{MEMB, WM, MM, 1024, DM}; pg8::StaticOrder S; S.init(MM, 1024, G, (bx + 64) & 255);
        pg8::EpiProj E{ssqm, COS, SIN, nullptr, nullptr, NMEM, {MK, 1, 0, 256, 1.f}, {MVT, 2, 1, 256, 1.f}, {MK + (size_t)MM * 256, 3, 0, 256, 1.f}, {MVT + (size_t)MM * 256, 4, 1, 256, 1.f}, {nullptr, 5, 0, 0, 1.f}};
        pg8::gemm_phase<pg8::EpiProj, pg8::StaticOrder, true, true>(lds, g, S, E, wave0);
    }
#endif
    WT_IDLE(208, WT_A, WT_A + WT_B1);
    WT_IDLE(208, I11 + I13 + I1 + I2 + IF_, I11 + I13 + I1 + I2 + IF_ + I7);
    GRID_SYNC();

    if (bx < 48) { WSPTRS(); PHASE_IDS(); scan_bh(LF + (size_t)bx * SEQ, (LAS float*)(lds + LDS_MISC + 64), tid); }
    GRID_SYNC();
#if PH_MASK & (1 << 2)
    for (int rep_ = 0; rep_ < NREP2; ++rep_) { WSPTRS(); PHASE_IDS();
    volatile LAS unsigned* qword = (volatile LAS unsigned*)(lds + LDS_MISC);
    bool first_ = true;
    for (;;) {
        if (HW_TID() == 0) qword[0] = first_ ? (unsigned)bx : (unsigned)G + atomicAdd(ctl + 0 + 2 * rep_, 1u);
        first_ = false;
        __syncthreads();
        const int u = (int)qword[0];
        __syncthreads();
        if (u >= 1024) break;
        att::f32x16 o[2];
        if (u < 768) {
            const int qb = 15 - u / 48, bh = u % 48, b = bh / 12, h = bh % 12;
            if (rep_ + 1 < NREP2) att::attn_stream<64, true, true, PVAR>(lds, Qb + (size_t)b * SEQ * 768 + 64 * h, 768, Kb + (size_t)b * SEQ * 768 + 64 * h, 768, VT + (size_t)(b * 768 + 64 * h) * SEQ, SEQ,
                                             LF + (size_t)bh * SEQ, 256 * qb, 2 * (qb + 1), o, wave0);
            else att::attn_stream<64, true, true>(lds, Qb + (size_t)b * SEQ * 768 + 64 * h, 768, Kb + (size_t)b * SEQ * 768 + 64 * h, 768, VT + (size_t)(b * 768 + 64 * h) * SEQ, SEQ,
                                             LF + (size_t)bh * SEQ, 256 * qb, 2 * (qb + 1), o, wave0);
            { const int l2_ = hw_lane(); att::store_o<64>(MIX + (size_t)(b * SEQ + 256 * qb + 32 * wave + (l2_ & 31)) * DM + 64 * h, o, l2_ >> 5); }
        } else {
            const int j = u - 768, b = j >> 6, hm = (j >> 4) & 3, qb = j & 15;
            att::attn_stream<64, false, false>(lds, MQ + (size_t)b * SEQ * 256 + 64 * hm, 256, MK + (size_t)b * NMEM * 256 + 64 * hm, 256, MVT + (size_t)(b * 256 + 64 * hm) * NMEM, NMEM,
                                               nullptr, 256 * qb, 2, o, wave0);
            { const int l2_ = hw_lane(); att::store_o<64>(MIX + (size_t)(b * SEQ + 256 * qb + 32 * wave + (l2_ & 31)) * DM + 768 + 64 * hm, o, l2_ >> 5); }
        }
    } }
#endif
    GRID_SYNC();

#if PH_MASK & (1 << 3)
    for (int rep_ = 0; rep_ < NREP35; ++rep_) {
        WSPTRS(); const float* xin = argp(lds, AX); float* outp = (float*)argp(lds, AOUT);
        pg8::Gemm g{MIX, WO, M, DM, DM}; pg8::StaticOrder S; S.init(M, DM, G, bx);
        pg8::EpiRes E{XB, ssq + M};
        pg8::gemm_phase<pg8::EpiRes, pg8::StaticOrder, true, true>(lds, g, S, E, wave0);
    }
#endif
    GRID_SYNC();
#if PH_MASK & (1 << 4)
    for (int rep_ = 0; rep_ < NREP4; ++rep_) {
        WSPTRS();
        pg8::Gemm g{XB, WGU, M, 2 * DFF, DM}; pg8::StaticOrder S; S.init(M, 2 * DFF, G, bx);
        pg8::EpiGU E{ssq + M, H};
        pg8::gemm_phase<pg8::EpiGU, pg8::StaticOrder, true, true>(lds, g, S, E, wave0);
    }
#endif
    WT_IDLE(128, WT_A + WT_B1, WT_A + WT_B1 + WT_B2);
    WT_IDLE(128, I11, I11 + I13);
    GRID_SYNC();
#if PH_MASK & (1 << 5)
    for (int rep_ = 0; rep_ < NREP35; ++rep_) {
        WSPTRS(); float* outp = (float*)argp(lds, AOUT);
        pg8::Gemm g{H, WD, M, DM, DFF}; pg8::StaticOrder S; S.init(M, DM, G, bx);
        pg8::EpiRes E{XB, ssq + 2 * M};
        pg8::gemm_phase<pg8::EpiRes, pg8::StaticOrder, true, true>(lds, g, S, E, wave0);
    }
#endif
    GRID_SYNC();
#if PH_MASK & (1 << 6)
    for (int rep_ = 0; rep_ < NREPB; ++rep_) {
        WSPTRS();
        pg8::Gemm g{XB, WB, M, NPROJ, DM}; pg8::StaticOrder S; S.init(M, NPROJ, G, bx);
        pg8::EpiProj E{ssq + 2 * M, COS, SIN, nullptr, nullptr, SEQ, {Kb, 3, 2, 768, 1.f}, {VT, 6, 1, 768, 1.f}, {Qb, 9, 2, 768, C2}, {MQ, 10, 0, 256, C2}, {nullptr, 11, 0, 0, 1.f}};
        pg8::gemm_phase<pg8::EpiProj, pg8::StaticOrder, true, true>(lds, g, S, E, wave0);
    }
#endif
    WT_IDLE(128, WT_A + WT_B1 + WT_B2, WT_A + WT_B1 + WT_B2 + WT_B3);
    GRID_SYNC();
#if PH_MASK & (1 << 7)
    {
        WSPTRS(); PHASE_IDS(); const float* subln_g = argp(lds, ASUBLN_G);
        volatile LAS unsigned* qword = (volatile LAS unsigned*)(lds + LDS_MISC);
        float d1 = argp(lds, ALQ1)[lane] * argp(lds, ALK1)[lane], d2 = argp(lds, ALQ2)[lane] * argp(lds, ALK2)[lane];
        d1 = wave_sum(d1); d2 = wave_sum(d2);
        const float lam = __builtin_bit_cast(float, __builtin_amdgcn_readfirstlane(__builtin_bit_cast(int, expf(d1) - expf(d2) + LAMBDA_INIT)));
        bool first_ = true;
        for (int rep_ = 0; rep_ < NREP7; ++rep_)
        for (;;) {
            if (HW_TID() == 0) qword[0] = first_ ? (unsigned)bx : (unsigned)G + atomicAdd(ctl + 1 + 2 * rep_, 1u);
            first_ = false;
            __syncthreads();
            const int u = (int)qword[0];
            __syncthreads();
            if (u >= 1024) break;
            if (u < 768) {
                const int qb = 31 - u / 24, bh = u % 24, b = bh / 6, hd = bh % 6;
                att::attn_diff_unit<SEQ>(lds, Qb + (size_t)b * SEQ * 768 + 128 * hd, Kb + (size_t)b * SEQ * 768 + 128 * hd, VT + (size_t)(b * 768 + 128 * hd) * SEQ, 128 * qb, qb + 1, lam, 1.0f - LAMBDA_INIT,
                                         subln_g, MIX + (size_t)b * SEQ * DM + 128 * hd, wave0);
            } else {
                att::f32x16 o[2];
                const int j = u - 768, b = j >> 6, hm = (j >> 4) & 3, qb = j & 15;
                att::attn_stream<64, false, false>(lds, MQ + (size_t)b * SEQ * 256 + 64 * hm, 256, MK + (size_t)(MM + b * NMEM) * 256 + 64 * hm, 256, MVT + (size_t)(MM + b * 256 + 64 * hm) * NMEM, NMEM,
                                                   nullptr, 256 * qb, 2, o, wave0);
                { const int l2_ = hw_lane(); att::store_o<64>(MIX + (size_t)(b * SEQ + 256 * qb + 32 * wave + (l2_ & 31)) * DM + 768 + 64 * hm, o, l2_ >> 5); }
            }
        }
    }
#endif
    GRID_SYNC();
#if PH_MASK & (1 << 8)
    for (int rep_ = 0; rep_ < NREPB; ++rep_) {
        WSPTRS(); float* outp = (float*)argp(lds, AOUT);
        pg8::Gemm g{MIX, WO + (size_t)1024 * 1024, M, DM, DM}; pg8::StaticOrder S; S.init(M, DM, G, bx);
        pg8::EpiRes E{XB, ssq + 3 * M};
        pg8::gemm_phase<pg8::EpiRes, pg8::StaticOrder, true, true>(lds, g, S, E, wave0);
    }
#endif
    GRID_SYNC();
#if PH_MASK & (1 << 9)
    for (int rep_ = 0; rep_ < NREPB; ++rep_) {
        WSPTRS();
        pg8::Gemm g{XB, WGU + (size_t)5632 * 1024, M, 2 * DFF, DM}; pg8::StaticOrder S; S.init(M, 2 * DFF, G, bx);
        pg8::EpiGU E{ssq + 3 * M, H};
        pg8::gemm_phase<pg8::EpiGU, pg8::StaticOrder, true, true>(lds, g, S, E, wave0);
    }
#endif
    GRID_SYNC();
#if PH_MASK & (1 << 10)
    {
        WSPTRS(); float* outp = (float*)argp(lds, AOUT);
        pg8::Gemm g{H, WD + (size_t)1024 * 2816, M, DM, DFF}; pg8::StaticOrder S; S.init(M, DM, G, bx);
        pg8::EpiResFinal E{XB, outp, ssq + 4 * M, ctl + 8192, argp(lds, AFINAL_G)};
        pg8::gemm_phase<pg8::EpiResFinal, pg8::StaticOrder, true, true>(lds, g, S, E, wave0);
    }
#endif
}

extern "C" void kernel_launch(void* const* d_in, const int* in_sizes, int n_in, void* d_out, int out_size, void* d_ws, size_t ws_size, hipStream_t stream) {
    static int grid = 0;
    if (grid == 0) {
        if (n_in != 20 || out_size != M * DM || ws_size < WS_END) { fprintf(stderr, "kernel_launch: unexpected sizes n_in %d out %d ws %zu\n", n_in, out_size, ws_size); grid = -1; return; }
        int dev = 0, cus = 0, per_cu = 0;
        (void)hipGetDevice(&dev); (void)hipDeviceGetAttribute(&cus, hipDeviceAttributeMultiprocessorCount, dev);
        (void)hipFuncSetAttribute((const void*)yoco_fwd, hipFuncAttributeMaxDynamicSharedMemorySize, LDS_BYTES);
        (void)hipOccupancyMaxActiveBlocksPerMultiprocessor(&per_cu, (const void*)yoco_fwd, 512, LDS_BYTES);
        if (per_cu < 1) { fprintf(stderr, "kernel_launch: occupancy query says %d blocks per CU; the grid barrier needs every workgroup resident: nothing launched\n", per_cu); grid = -1; return; }
        grid = cus;
        if (grid != 256) fprintf(stderr, "kernel_launch: %d CUs (expected 256)\n", grid);
    }
    if (grid < 0) return;
    Args a{};
    const float** p = (const float**)&a;
    for (int i = 0; i < 20; ++i) p[i] = (const float*)d_in[i];
    a.out = (float*)d_out; a.ws = (unsigned char*)d_ws;
    void* args[] = {&a};
#if USE_XB
    (void)hipMemsetAsync((char*)d_ws + WS_CTL, 0, 65536, stream);
    hipLaunchKernelGGL(yoco_fwd, dim3(grid), dim3(512), LDS_BYTES, stream, a);
    (void)args;
#else
    hipError_t e = hipLaunchCooperativeKernel((const void*)yoco_fwd, dim3(grid), dim3(512), args, LDS_BYTES, stream);
    if (e != hipSuccess) fprintf(stderr, "cooperative launch failed: %s (grid %d)\n", hipGetErrorString(e), grid);
#endif
}
```

```cpp
#include <hip/hip_runtime.h>
#include <hip/hip_cooperative_groups.h>
#include <cstdio>
#include <cstdint>
__device__ __forceinline__ int hw_lane() { unsigned z = 0u; asm volatile("" : "+v"(z)); return (int)__builtin_amdgcn_mbcnt_hi(~0u, __builtin_amdgcn_mbcnt_lo(~0u, z)); }
namespace pg8 {
#define PG8_LAS __attribute__((address_space(3)))
typedef unsigned short bf16_t;
typedef short bf16x8 __attribute__((ext_vector_type(8)));
typedef float f32x4 __attribute__((ext_vector_type(4)));
typedef unsigned u32x4 __attribute__((ext_vector_type(4)));
constexpr int BM = 256, BK = 64, HALF = 128, HTB = HALF * BK * 2  , STAGE_BYTES = 8 * HTB, NXCD = 8, WGM = 8;

__host__ __device__ __forceinline__ int lds_byte(int r, int c) { const int st = (r >> 4) * 2 + (c >> 5), rr = r & 15, cc = c & 31, ob = rr * 64 + cc * 2; return st * 1024 + (ob ^ (((ob >> 9) & 1) << 5)); }
__host__ __device__ __forceinline__ void stage_rc(int b, int& R, int& C) { const int st = b / 1024, sb = b % 1024, swz = sb ^ (((sb >> 9) & 1) << 5); R = (st >> 1) * 16 + swz / 64; C = (st & 1) * 32 + (swz % 64) / 2; }
__host__ __device__ __forceinline__ int perm32(int rho) { const int n = rho >> 4, i = rho & 15; return 8 * (i >> 2) + 4 * n + (i & 3); }

struct Unit { int pm, pn; };
struct Gemm { const bf16_t* A; const bf16_t* Bt; int M, N, K; };

struct StaticOrder {
    int nM, nN, nwg, G, c;
    __host__ __device__ void init(int M, int N, int G_, int c_) { nM = M / BM; nN = N / BM; nwg = nM * nN; G = G_; c = c_; }
    __host__ __device__ bool next(int i, Unit& u) const {
        const long L = (long)i * G + c; if (L >= nwg) return false;
        int wgid = (int)L; { const int q = nwg / NXCD, r = nwg % NXCD, xcd = wgid % NXCD, off = wgid / NXCD; wgid = (xcd < r ? xcd * (q + 1) : r * (q + 1) + (xcd - r) * q) + off; }
        const int nig = WGM * nN, gid = wgid / nig, fm = gid * WGM, gsz = (nM - fm) < WGM ? (nM - fm) : WGM;
        u.pm = fm + ((wgid % nig) % gsz); u.pn = (wgid % nig) / gsz; return true;
    }
    __device__ __forceinline__ void a_ready(const Unit&) const {}
    __device__ __forceinline__ void done(const Unit&) const {}
};

__device__ __forceinline__ unsigned cvt_pk_bf16(float lo, float hi) { unsigned r; asm volatile("v_cvt_pk_bf16_f32 %0, %1, %2" : "=v"(r) : "v"(lo), "v"(hi)); return r; }
typedef float f32x2 __attribute__((ext_vector_type(2)));
typedef unsigned u32x2 __attribute__((ext_vector_type(2)));
struct Seg { bf16_t* dst; int pn_end; int kind; int pitch; float scale; };
struct EpiProj {
    static constexpr bool PERM = true, AFTER_DRAIN = false;
    const float* ssq; const float* cs; const float* sn; const float* bf; float* lf; int S; Seg s0, s1, s2, s3, s4;
    __device__ __forceinline__ void operator()(const f32x4 (&acc)[2][2][4][2], const Unit& u, int wr, int wc, int fr, int fq) const {
        Seg g = s4; int pn0 = s3.pn_end;
        if (u.pn < s0.pn_end) { g = s0; pn0 = 0; } else if (u.pn < s1.pn_end) { g = s1; pn0 = s0.pn_end; } else if (u.pn < s2.pn_end) { g = s2; pn0 = s1.pn_end; } else if (u.pn < s3.pn_end) { g = s3; pn0 = s2.pn_end; }
        const int ct = (u.pn - pn0) * BM;
        const int lane = fq * 16 + fr;
        float sq8[8];
#pragma unroll
        for (int i = 0; i < 8; ++i) sq8[i] = ssq[u.pm * BM + (i >> 2) * HALF + wr * 64 + (i & 3) * 16 + fr];
#pragma unroll
        for (int am = 0; am < 4; ++am) {
            const int ai = am >> 1;
            f32x4 tc[2][2], tn[2][2];
            if (g.kind == 2) {
#pragma unroll
                for (int mm = 0; mm < 2; ++mm) { const int pos = (u.pm * BM + ai * HALF + wr * 64 + ((am & 1) * 2 + mm) * 16 + fr) % S; const float* cp = cs + pos * 32 + 8 * fq; const float* sp = sn + pos * 32 + 8 * fq;
                    tc[mm][0] = *(const f32x4*)cp; tc[mm][1] = *(const f32x4*)(cp + 4); tn[mm][0] = *(const f32x4*)sp; tn[mm][1] = *(const f32x4*)(sp + 4); }
                asm volatile("" ::: "memory");
            }
#pragma unroll
            for (int mm = 0; mm < 2; ++mm) {
                const int m = (am & 1) * 2 + mm;
                const int row = u.pm * BM + ai * HALF + wr * 64 + m * 16 + fr;
                const float rs = __builtin_amdgcn_rsqf(sq8[ai * 4 + m] * (1.0f / 1024.0f) + 1e-6f) * g.scale;
                if (g.kind == 0) {
#pragma unroll
                    for (int bj = 0; bj < 2; ++bj) { const f32x4 v0 = acc[ai][bj][m][0] * rs, v1 = acc[ai][bj][m][1] * rs;
                        u32x4 w; w.x = cvt_pk_bf16(v0[0], v0[1]); w.y = cvt_pk_bf16(v0[2], v0[3]); w.z = cvt_pk_bf16(v1[0], v1[1]); w.w = cvt_pk_bf16(v1[2], v1[3]);
                        *(u32x4*)(g.dst + (size_t)row * g.pitch + ct + bj * HALF + wc * 32 + 8 * fq) = w; }
                } else if (g.kind == 1) {
                    const int b = row / S, s = row - b * S; const bool odd = (fr & 1) != 0;
#pragma unroll
                    for (int bj = 0; bj < 2; ++bj) { const f32x4 v0 = acc[ai][bj][m][0] * rs, v1 = acc[ai][bj][m][1] * rs;
                        const int cb = ct + bj * HALF + wc * 32 + 8 * fq + (odd ? 4 : 0);
#pragma unroll
                        for (int j = 0; j < 4; ++j) { const float snd = odd ? v0[j] : v1[j]; const float rcv = __shfl_xor(snd, 1);
                            const float lo = odd ? rcv : v0[j], hi = odd ? v1[j] : rcv;
                            *(unsigned*)(g.dst + ((size_t)b * g.pitch + cb + j) * S + (s & ~1)) = cvt_pk_bf16(lo, hi); } }
                } else if (g.kind == 3) {
                    if (wc == 0 && fq < 2) { const int b = row / S, s = row - b * S;
#pragma unroll
                        for (int n = 0; n < 2; ++n)
#pragma unroll
                            for (int e2 = 0; e2 < 4; ++e2) { const int c = 8 * fq + 4 * n + e2;
                                if (c < 12) { const float z = acc[ai][0][m][n][e2] * rs + bf[c]; lf[((size_t)b * 12 + c) * S + s] = fminf(z, 0.f) - 0.6931471805599453f * __builtin_amdgcn_logf(1.0f + __builtin_amdgcn_exp2f(-1.4426950408889634f * fabsf(z))); } } }
                } else {
                    const f32x4 c0 = tc[mm][0], c1 = tc[mm][1], n0 = tn[mm][0], n1 = tn[mm][1];
                    const f32x4 a0 = acc[ai][0][m][0] * rs, a1 = acc[ai][0][m][1] * rs, b0 = acc[ai][1][m][0] * rs, b1 = acc[ai][1][m][1] * rs;
                    const f32x4 x0 = a0 * c0 - b0 * n0, x1 = a1 * c1 - b1 * n1, y0 = a0 * n0 + b0 * c0, y1 = a1 * n1 + b1 * c1;
                    bf16_t* p = g.dst + (size_t)row * g.pitch + ct + wc * 64 + 8 * fq;
                    u32x4 w; w.x = cvt_pk_bf16(x0[0], x0[1]); w.y = cvt_pk_bf16(x0[2], x0[3]); w.z = cvt_pk_bf16(x1[0], x1[1]); w.w = cvt_pk_bf16(x1[2], x1[3]);
                    *(u32x4*)p = w;
                    w.x = cvt_pk_bf16(y0[0], y0[1]); w.y = cvt_pk_bf16(y0[2], y0[3]); w.z = cvt_pk_bf16(y1[0], y1[1]); w.w = cvt_pk_bf16(y1[2], y1[3]);
                    *(u32x4*)(p + 32) = w;
                }
            }
        }
        (void)lane;
    }
};
struct EpiRes {
    static constexpr bool PERM = true, AFTER_DRAIN = false;
    bf16_t* xb; float* ssq_out;
    __device__ __forceinline__ void operator()(const f32x4 (&acc)[2][2][4][2], const Unit& u, int wr, int wc, int fr, int fq) const {
#pragma unroll
        for (int ai = 0; ai < 2; ++ai) {
            u32x4 xr[4][2];
#pragma unroll
            for (int m = 0; m < 4; ++m)
#pragma unroll
                for (int bj = 0; bj < 2; ++bj) xr[m][bj] = *(const u32x4*)(xb + (size_t)(u.pm * BM + ai * HALF + wr * 64 + m * 16 + fr) * 1024 + u.pn * BM + bj * HALF + wc * 32 + 8 * fq);
            asm volatile("" ::: "memory");
#pragma unroll
            for (int m = 0; m < 4; ++m) {
                const int row = u.pm * BM + ai * HALF + wr * 64 + m * 16 + fr; float sq = 0.f;
#pragma unroll
                for (int bj = 0; bj < 2; ++bj) { const size_t off = (size_t)row * 1024 + u.pn * BM + bj * HALF + wc * 32 + 8 * fq; const u32x4 x = xr[m][bj];
                    const f32x4 v0 = (f32x4){__uint_as_float(x.x << 16), __uint_as_float(x.x & 0xffff0000u), __uint_as_float(x.y << 16), __uint_as_float(x.y & 0xffff0000u)} + acc[ai][bj][m][0];
                    const f32x4 v1 = (f32x4){__uint_as_float(x.z << 16), __uint_as_float(x.z & 0xffff0000u), __uint_as_float(x.w << 16), __uint_as_float(x.w & 0xffff0000u)} + acc[ai][bj][m][1];
                    u32x4 w; w.x = cvt_pk_bf16(v0[0], v0[1]); w.y = cvt_pk_bf16(v0[2], v0[3]); w.z = cvt_pk_bf16(v1[0], v1[1]); w.w = cvt_pk_bf16(v1[2], v1[3]);
                    *(u32x4*)(xb + off) = w;
                    sq += (v0[0] * v0[0] + v0[1] * v0[1]) + (v0[2] * v0[2] + v0[3] * v0[3]) + (v1[0] * v1[0] + v1[1] * v1[1]) + (v1[2] * v1[2] + v1[3] * v1[3]); }
                sq += __shfl_xor(sq, 16); sq += __shfl_xor(sq, 32);
                if (fq == 0) atomicAdd(ssq_out + row, sq);
            }
            asm volatile("" ::: "memory");
        }
    }
};
struct EpiResFinal {
    static constexpr bool PERM = true, AFTER_DRAIN = false;
    const bf16_t* xb; float* out; float* ssq; unsigned* cnt; const float* g;
    __device__ __forceinline__ void operator()(f32x4 (&acc)[2][2][4][2], const Unit& u, int wr, int wc, int fr, int fq) const {
        const int col0 = u.pn * BM + wc * 32 + 8 * fq;
#pragma unroll
        for (int ai = 0; ai < 2; ++ai) {
            u32x4 xr[4][2];
#pragma unroll
            for (int m = 0; m < 4; ++m)
#pragma unroll
                for (int bj = 0; bj < 2; ++bj) xr[m][bj] = *(const u32x4*)(xb + (size_t)(u.pm * BM + ai * HALF + wr * 64 + m * 16 + fr) * 1024 + col0 + bj * HALF);
            asm volatile("" ::: "memory");
#pragma unroll
            for (int m = 0; m < 4; ++m) {
                const int row = u.pm * BM + ai * HALF + wr * 64 + m * 16 + fr; float sq = 0.f;
#pragma unroll
                for (int bj = 0; bj < 2; ++bj) { const u32x4 x = xr[m][bj];
                    const f32x4 v0 = (f32x4){__uint_as_float(x.x << 16), __uint_as_float(x.x & 0xffff0000u), __uint_as_float(x.y << 16), __uint_as_float(x.y & 0xffff0000u)} + acc[ai][bj][m][0];
                    const f32x4 v1 = (f32x4){__uint_as_float(x.z << 16), __uint_as_float(x.z & 0xffff0000u), __uint_as_float(x.w << 16), __uint_as_float(x.w & 0xffff0000u)} + acc[ai][bj][m][1];
                    acc[ai][bj][m][0] = v0; acc[ai][bj][m][1] = v1;
                    sq += (v0[0] * v0[0] + v0[1] * v0[1]) + (v0[2] * v0[2] + v0[3] * v0[3]) + (v1[0] * v1[0] + v1[1] * v1[1]) + (v1[2] * v1[2] + v1[3] * v1[3]); }
                sq += __shfl_xor(sq, 16); sq += __shfl_xor(sq, 32);
                if (fq == 0) (void)__hip_atomic_fetch_add(ssq + row, sq, __ATOMIC_RELAXED, __HIP_MEMORY_SCOPE_AGENT);
            }
        }
        asm volatile("s_waitcnt vmcnt(0)" ::: "memory");
        unsigned* pc = cnt + 64 * u.pm;
        if (fr == 0 && fq == 0) (void)__hip_atomic_fetch_add(pc, 1u, __ATOMIC_RELAXED, __HIP_MEMORY_SCOPE_AGENT);
        for (unsigned it = 0; it < (1u << 22); ++it) {
            if ((unsigned)__builtin_amdgcn_readfirstlane((int)__hip_atomic_load(pc, __ATOMIC_RELAXED, __HIP_MEMORY_SCOPE_AGENT)) >= 32u) break;
            __builtin_amdgcn_s_sleep(2);
        }
        __builtin_amdgcn_fence(__ATOMIC_ACQUIRE, "agent");
        f32x4 gv[2][2];
#pragma unroll
        for (int bj = 0; bj < 2; ++bj) { gv[bj][0] = *(const f32x4*)(g + col0 + bj * HALF); gv[bj][1] = *(const f32x4*)(g + col0 + bj * HALF + 4); }
        float rs8[8];
#pragma unroll
        for (int i = 0; i < 8; ++i) { const unsigned sb = __hip_atomic_load((const unsigned*)(ssq + u.pm * BM + (i >> 2) * HALF + wr * 64 + (i & 3) * 16 + fr), __ATOMIC_RELAXED, __HIP_MEMORY_SCOPE_AGENT);
            rs8[i] = __builtin_amdgcn_rsqf(__uint_as_float(sb) * (1.0f / 1024.0f) + 1e-6f); }
#pragma unroll
        for (int ai = 0; ai < 2; ++ai)
#pragma unroll
            for (int m = 0; m < 4; ++m) { const float rs = rs8[ai * 4 + m];
#pragma unroll
                for (int bj = 0; bj < 2; ++bj) { const size_t off = (size_t)(u.pm * BM + ai * HALF + wr * 64 + m * 16 + fr) * 1024 + col0 + bj * HALF;
                    *(f32x4*)(out + off) = acc[ai][bj][m][0] * rs * gv[bj][0]; *(f32x4*)(out + off + 4) = acc[ai][bj][m][1] * rs * gv[bj][1]; } }
    }
};
struct EpiGU {
    static constexpr bool PERM = true, AFTER_DRAIN = false;
    const float* ssq; bf16_t* H;
    __device__ __forceinline__ void operator()(const f32x4 (&acc)[2][2][4][2], const Unit& u, int wr, int wc, int fr, int fq) const {
        float sq8[8];
#pragma unroll
        for (int i = 0; i < 8; ++i) sq8[i] = ssq[u.pm * BM + (i >> 2) * HALF + wr * 64 + (i & 3) * 16 + fr];
#pragma unroll
        for (int ai = 0; ai < 2; ++ai)
#pragma unroll
            for (int m = 0; m < 4; ++m) {
                const int row = u.pm * BM + ai * HALF + wr * 64 + m * 16 + fr;
                const float rs = __builtin_amdgcn_rsqf(sq8[ai * 4 + m] * (1.0f / 1024.0f) + 1e-6f);
                float hv[8];
#pragma unroll
                for (int n = 0; n < 2; ++n)
#pragma unroll
                    for (int e = 0; e < 4; ++e) { const float gg = acc[ai][0][m][n][e] * rs, uu = acc[ai][1][m][n][e] * rs;
                        hv[n * 4 + e] = gg * uu * __builtin_amdgcn_rcpf(1.0f + __builtin_amdgcn_exp2f(-1.4426950408889634f * gg)); }
                u32x4 w; w.x = cvt_pk_bf16(hv[0], hv[1]); w.y = cvt_pk_bf16(hv[2], hv[3]); w.z = cvt_pk_bf16(hv[4], hv[5]); w.w = cvt_pk_bf16(hv[6], hv[7]);
                *(u32x4*)(H + (size_t)row * 2816 + u.pn * HALF + wc * 32 + 8 * fq) = w;
            }
    }
};
template <class Epi, class Sched, bool ALIGN_EPI = false, bool SP2 = false>
__device__ __forceinline__ void gemm_phase(PG8_LAS unsigned char* lds, const Gemm g, const Sched& S, const Epi& E, const int wv) {
    int tid_ = wv * 64 + hw_lane(); asm volatile("" : "+v"(tid_));
    const int tid = tid_, wid = __builtin_amdgcn_readfirstlane(tid >> 6), lane = tid & 63, wr = wid >> 2, wc = wid & 3, fr = lane & 15, fq = lane >> 4;
    const int K = g.K, nt = K / BK;
    unsigned voffA[2], voffB[2];
#pragma unroll
    for (int i = 0; i < 2; ++i) { int R, C; stage_rc(tid * 16 + i * 8192, R, C); const int Rb = Epi::PERM ? ((R & ~31) + perm32(R & 31)) : R;
        voffA[i] = (unsigned)(R * K + C) * 2u; voffB[i] = (unsigned)(Rb * K + C) * 2u; }
    const size_t kstep = (size_t)(BK * 2);
    const size_t hstep = (size_t)HALF * K * 2;
    const size_t tstep = 2 * hstep;
    const unsigned ldsw = (unsigned)wid * 1024u;
    const int aoff = lds_byte(wr * 64 + fr, fq * 8), boff = lds_byte(wc * 32 + fr, fq * 8);
#define PG8_SA(b, h) (((b) * 2 + (h)) * HTB)
#define PG8_SB(b, h) ((4 + (b) * 2 + (h)) * HTB)
#define PG8_STAGE(bufoff, gbase, voff) do { _Pragma("unroll") for (int _i = 0; _i < 2; ++_i) \
        __builtin_amdgcn_global_load_lds((const unsigned*)((const char*)(gbase) + (voff)[_i]), (PG8_LAS unsigned*)(lds + (bufoff) + ldsw + _i * 8192), 16, 0, 0); } while (0)
#define PG8_LDA(dst, b, h) do { _Pragma("unroll") for (int m = 0; m < 4; ++m) _Pragma("unroll") for (int k = 0; k < 2; ++k) dst[m][k] = *(const PG8_LAS bf16x8*)(lds + PG8_SA(b, h) + aoff + m * 2048 + k * 1024); } while (0)
#define PG8_LDB(dst, b, h) do { _Pragma("unroll") for (int n = 0; n < 2; ++n) _Pragma("unroll") for (int k = 0; k < 2; ++k) dst[n][k] = *(const PG8_LAS bf16x8*)(lds + PG8_SB(b, h) + boff + n * 2048 + k * 1024); } while (0)
#define PG8_MMA(ai, bj, At, Bt) do { __builtin_amdgcn_s_setprio(1); _Pragma("unroll") for (int m = 0; m < 4; ++m) _Pragma("unroll") for (int n = 0; n < 2; ++n) _Pragma("unroll") for (int k = 0; k < 2; ++k) \
        acc[ai][bj][m][n] = __builtin_amdgcn_mfma_f32_16x16x32_bf16(Bt[n][k], At[m][k], acc[ai][bj][m][n], 0, 0, 0); __builtin_amdgcn_s_setprio(0); } while (0)
#define PG8_WAIT_V(n) asm volatile("s_waitcnt vmcnt(" #n ")" ::: "memory")
#define PG8_WAIT_L(n) asm volatile("s_waitcnt lgkmcnt(" #n ")" ::: "memory")
#define PG8_BAR __builtin_amdgcn_s_barrier()
#define PG8_SCHED __builtin_amdgcn_sched_barrier(0)
    Unit cur, nxt; int ui = 0;
    if (!S.next(0, cur)) return;
    f32x4 acc[2][2][4][2];
#pragma unroll
    for (int a = 0; a < 2; ++a)
#pragma unroll
        for (int b = 0; b < 2; ++b)
#pragma unroll
            for (int m = 0; m < 4; ++m)
#pragma unroll
                for (int n = 0; n < 2; ++n) acc[a][b][m][n] = (f32x4){0.f, 0.f, 0.f, 0.f};
    bf16x8 At[4][2], B0[2][2], B1[2][2];
    const char* cA = (const char*)g.A + (size_t)cur.pm * tstep; const char* cB = (const char*)g.Bt + (size_t)cur.pn * tstep;
    S.a_ready(cur);
    if constexpr (SP2) {
        PG8_STAGE(PG8_SB(0, 0), cB, voffB); PG8_STAGE(PG8_SB(0, 1), cB + hstep, voffB); PG8_STAGE(PG8_SA(0, 0), cA, voffA); PG8_STAGE(PG8_SA(0, 1), cA + hstep, voffA);
        if (wr == 1) PG8_BAR;
        PG8_WAIT_V(2); PG8_BAR;
        PG8_STAGE(PG8_SB(1, 0), cB + kstep, voffB); PG8_STAGE(PG8_SA(1, 0), cA + kstep, voffA); PG8_STAGE(PG8_SB(1, 1), cB + hstep + kstep, voffB);
        PG8_WAIT_V(6); PG8_BAR;
    } else {
        PG8_STAGE(PG8_SB(0, 0), cB, voffB); PG8_STAGE(PG8_SA(0, 0), cA, voffA); PG8_STAGE(PG8_SB(0, 1), cB + hstep, voffB); PG8_STAGE(PG8_SA(0, 1), cA + hstep, voffA);
        if (wr == 1) PG8_BAR;
        PG8_WAIT_V(4); PG8_BAR;
        PG8_STAGE(PG8_SB(1, 0), cB + kstep, voffB); PG8_STAGE(PG8_SA(1, 0), cA + kstep, voffA); PG8_STAGE(PG8_SB(1, 1), cB + hstep + kstep, voffB);
        PG8_WAIT_V(6); PG8_BAR;
    }
    for (;;) {
        const bool has_next = S.next(ui + 1, nxt);
        const char* nA = has_next ? (const char*)g.A + (size_t)nxt.pm * tstep : cA; const char* nB = has_next ? (const char*)g.Bt + (size_t)nxt.pn * tstep : cB;
        for (int t = 0; t < nt; t += 2) {
            const bool last = (t == nt - 2);
            const char* a1 = cA + (size_t)(t + 1) * kstep;
            const char* a2 = last ? nA : cA + (size_t)(t + 2) * kstep; const char* b2 = last ? nB : cB + (size_t)(t + 2) * kstep;
            const char* a3 = a2 + kstep; const char* b3 = b2 + kstep;
            if (last && has_next) S.a_ready(nxt);
            if constexpr (SP2) {
            PG8_LDB(B0, 0, 0); PG8_LDB(B1, 0, 1); PG8_SCHED; PG8_LDA(At, 0, 0); PG8_STAGE(PG8_SA(1, 1), a1 + hstep, voffA);
            PG8_WAIT_V(8); PG8_WAIT_L(0); PG8_BAR; PG8_MMA(0, 0, At, B0); PG8_MMA(0, 1, At, B1); PG8_BAR; PG8_SCHED;
            PG8_LDA(At, 0, 1); PG8_STAGE(PG8_SB(0, 0), b2, voffB); PG8_STAGE(PG8_SB(0, 1), b2 + hstep, voffB); PG8_STAGE(PG8_SA(0, 0), a2, voffA);
            PG8_WAIT_V(8); PG8_WAIT_L(0); PG8_BAR; PG8_MMA(1, 0, At, B0); PG8_MMA(1, 1, At, B1); PG8_BAR; PG8_SCHED;
            PG8_LDB(B0, 1, 0); PG8_LDB(B1, 1, 1); PG8_SCHED; PG8_LDA(At, 1, 0); PG8_STAGE(PG8_SA(0, 1), a2 + hstep, voffA);
            PG8_WAIT_V(8); PG8_WAIT_L(0); PG8_BAR; PG8_MMA(0, 0, At, B0); PG8_MMA(0, 1, At, B1); PG8_BAR; PG8_SCHED;
            PG8_LDA(At, 1, 1); PG8_STAGE(PG8_SB(1, 0), b3, voffB); PG8_STAGE(PG8_SB(1, 1), b3 + hstep, voffB); PG8_STAGE(PG8_SA(1, 0), a3, voffA);
            PG8_WAIT_V(8); PG8_WAIT_L(0); PG8_BAR; PG8_MMA(1, 0, At, B0); PG8_MMA(1, 1, At, B1); PG8_BAR; PG8_SCHED;
            } else {
            PG8_LDB(B0, 0, 0); PG8_SCHED; PG8_LDA(At, 0, 0); PG8_STAGE(PG8_SA(1, 1), a1 + hstep, voffA);
            PG8_WAIT_L(8); PG8_BAR; PG8_WAIT_L(0); PG8_MMA(0, 0, At, B0); PG8_BAR; PG8_SCHED;
            PG8_LDB(B1, 0, 1); PG8_STAGE(PG8_SB(0, 0), b2, voffB);
            PG8_BAR; PG8_WAIT_L(0); PG8_MMA(0, 1, At, B1); PG8_BAR;
            PG8_LDA(At, 0, 1); PG8_STAGE(PG8_SA(0, 0), a2, voffA);
            PG8_BAR; PG8_WAIT_L(0); PG8_MMA(1, 0, At, B0); PG8_BAR; PG8_SCHED;
            PG8_STAGE(PG8_SB(0, 1), b2 + hstep, voffB);
            PG8_WAIT_V(6); PG8_BAR; PG8_MMA(1, 1, At, B1); PG8_BAR;
            PG8_LDB(B0, 1, 0); PG8_SCHED; PG8_LDA(At, 1, 0); PG8_STAGE(PG8_SA(0, 1), a2 + hstep, voffA);
            PG8_WAIT_L(8); PG8_BAR; PG8_WAIT_L(0); PG8_MMA(0, 0, At, B0); PG8_BAR; PG8_SCHED;
            PG8_LDB(B1, 1, 1); PG8_STAGE(PG8_SB(1, 0), b3, voffB);
            PG8_BAR; PG8_WAIT_L(0); PG8_MMA(0, 1, At, B1); PG8_BAR;
            PG8_LDA(At, 1, 1); PG8_STAGE(PG8_SA(1, 0), a3, voffA);
            PG8_BAR; PG8_WAIT_L(0); PG8_MMA(1, 0, At, B0); PG8_BAR; PG8_SCHED;
            PG8_STAGE(PG8_SB(1, 1), b3 + hstep, voffB);
            PG8_WAIT_V(6); PG8_BAR; PG8_MMA(1, 1, At, B1); PG8_BAR;
            }
        }
        if constexpr (ALIGN_EPI) { if (wr == 0) PG8_BAR; }
        if constexpr (!Epi::AFTER_DRAIN) { E(acc, cur, wr, wc, fr, fq); S.done(cur); }
        if (!has_next) break;
#pragma unroll
        for (int a = 0; a < 2; ++a)
#pragma unroll
            for (int b = 0; b < 2; ++b)
#pragma unroll
                for (int m = 0; m < 4; ++m)
#pragma unroll
                    for (int n = 0; n < 2; ++n) acc[a][b][m][n] = (f32x4){0.f, 0.f, 0.f, 0.f};
        cur = nxt; cA = nA; cB = nB; ++ui;
        if constexpr (ALIGN_EPI) { if (wr == 1) PG8_BAR; }
    }
    PG8_WAIT_V(0);
    if constexpr (!ALIGN_EPI) { if (wr == 0) PG8_BAR; }
    PG8_BAR;
    if constexpr (Epi::AFTER_DRAIN) { E.fused(acc, cur, wr, wc, fr, fq, lds, wid, lane); S.done(cur); }
#undef PG8_SA
#undef PG8_SB
#undef PG8_STAGE
#undef PG8_LDA
#undef PG8_LDB
#undef PG8_MMA
#undef PG8_WAIT_V
#undef PG8_WAIT_L
#undef PG8_BAR
#undef PG8_SCHED
}
}
namespace att {
#define LAS __attribute__((address_space(3)))
typedef unsigned short bf16_t;
typedef short bf16x8 __attribute__((ext_vector_type(8)));
typedef short s16x4 __attribute__((ext_vector_type(4)));
typedef float f32x16 __attribute__((ext_vector_type(16)));
typedef float f32x4 __attribute__((ext_vector_type(4)));
typedef unsigned u32x4 __attribute__((ext_vector_type(4)));
typedef unsigned u32x2 __attribute__((ext_vector_type(2)));
constexpr int KP = 144, VP = 264;
constexpr int KBUF = 128 * KP, VBUF = 128 * VP;
constexpr int OFF_K = 0, OFF_V = 2 * KBUF, OFF_B = OFF_V + 2 * VBUF, ATT_LDS = OFF_B + 1024;
#ifndef PIPE128
#define PIPE128 0
#endif
constexpr float RESC_THR = 60.f;
typedef float f32x2_t __attribute__((ext_vector_type(2))); typedef __bf16 bf16x2_t __attribute__((ext_vector_type(2)));
__device__ __forceinline__ unsigned cvtpk(float lo, float hi) { f32x2_t v = {lo, hi}; bf16x2_t b = __builtin_convertvector(v, bf16x2_t); return __builtin_bit_cast(unsigned, b); }
__device__ __forceinline__ float max3f(float a, float b, float c) { float r; asm("v_max3_f32 %0, %1, %2, %3" : "=v"(r) : "v"(a), "v"(b), "v"(c)); return r; }
__device__ __forceinline__ float xhalf_max(float m) { auto rr = __builtin_amdgcn_permlane32_swap(__float_as_uint(m), __float_as_uint(m), false, false); return fmaxf(__uint_as_float(rr[0]), __uint_as_float(rr[1])); }
__device__ __forceinline__ float xhalf_sum(float m) { auto rr = __builtin_amdgcn_permlane32_swap(__float_as_uint(m), __float_as_uint(m), false, false); return __uint_as_float(rr[0]) + __uint_as_float(rr[1]); }

typedef float f32x2v __attribute__((ext_vector_type(2)));
__device__ __forceinline__ void exp_sum_pk(f32x16& P0, f32x16& P1, float m, float& lrow) {
    const f32x2v mv = {m, m}; f32x2v s0 = {0.f, 0.f}, s1 = {0.f, 0.f};
#pragma unroll
    for (int r = 0; r < 16; r += 2) {
        f32x2v a = (f32x2v){P0[r], P0[r + 1]} - mv, b = (f32x2v){P1[r], P1[r + 1]} - mv;
        a.x = __builtin_amdgcn_exp2f(a.x); a.y = __builtin_amdgcn_exp2f(a.y); b.x = __builtin_amdgcn_exp2f(b.x); b.y = __builtin_amdgcn_exp2f(b.y);
        P0[r] = a.x; P0[r + 1] = a.y; P1[r] = b.x; P1[r + 1] = b.y; s0 += a; s1 += b;
    }
    s0 += s1; lrow += s0.x + s0.y;
}
template <int DV, bool CAUSAL, bool BIAS, int VAR = 0>
__device__ __forceinline__ void attn_stream(LAS unsigned char* lds, const bf16_t* Qg, int qpitch, const bf16_t* Kg, int kpitch, const bf16_t* Vtg, int vpitch,
                                            const float* bias, int q0, int ntiles, f32x16 (&o)[DV / 32], const int wv) {
    int tid_ = wv * 64 + hw_lane(); asm volatile("" : "+v"(tid_));
    const int tid = tid_, lane = tid & 63, r32 = lane & 31, hi = lane >> 5, w = __builtin_amdgcn_readfirstlane(tid >> 6);
    constexpr int NV = DV / 32;
    bf16x8 qf[4];
#pragma unroll
    for (int d0 = 0; d0 < 4; ++d0) qf[d0] = *(const bf16x8*)(Qg + (size_t)(q0 + 32 * w + r32) * qpitch + 16 * d0 + 8 * hi);
    const int krow = tid >> 3, kch = tid & 7, vrow = tid >> 4, vch = tid & 15;
    const bf16_t* ksrc = Kg + (size_t)krow * kpitch + kch * 8;
    const bf16_t* vsrc = Vtg + (size_t)vrow * vpitch + vch * 8;
    const unsigned kdst = OFF_K + krow * KP + kch * 16, vdst = OFF_V + vrow * VP + vch * 16;
    u32x4 kreg[2], vreg[NV]; f32x4 breg = {0.f, 0.f, 0.f, 0.f};
#define ATT_LOAD(t) do { \
        _Pragma("unroll") for (int i = 0; i < 2; ++i) kreg[i] = *(const u32x4*)(ksrc + (size_t)(128 * (t) + 64 * i) * kpitch); \
        _Pragma("unroll") for (int i = 0; i < NV; ++i) vreg[i] = *(const u32x4*)(vsrc + (size_t)(32 * i) * vpitch + 128 * (t)); \
        if (BIAS) { if (tid < 32) breg = *(const f32x4*)(bias + 128 * (t) + 4 * tid); } } while (0)
#define ATT_STORE(buf) do { \
        _Pragma("unroll") for (int i = 0; i < 2; ++i) *(LAS u32x4*)(lds + kdst + (buf) * KBUF + i * 64 * KP) = kreg[i]; \
        _Pragma("unroll") for (int i = 0; i < NV; ++i) { *(LAS u32x2*)(lds + vdst + (buf) * VBUF + i * 32 * VP) = (u32x2){vreg[i].x, vreg[i].y}; *(LAS u32x2*)(lds + vdst + (buf) * VBUF + i * 32 * VP + 8) = (u32x2){vreg[i].z, vreg[i].w}; } \
        if (BIAS) { if (tid < 32) *(LAS f32x4*)(lds + OFF_B + (buf) * 512 + 16 * tid) = breg; } } while (0)
    ATT_LOAD(0);
    ATT_STORE(0);
    __syncthreads();
    float mrow = -1e30f, lrow = 0.f;
#pragma unroll
    for (int d0 = 0; d0 < DV / 32; ++d0)
#pragma unroll
        for (int r = 0; r < 16; ++r) o[d0][r] = 0.f;
    const int qmin = q0 + 32 * w;
#define ATT_KLOAD(P0, P1, buf, sub) do { \
        LAS unsigned char* Ks_ = lds + OFF_K + (buf) * KBUF + (sub) * 64 * KP; \
        _Pragma("unroll") for (int d0 = 0; d0 < 4; ++d0) { kf[2 * d0] = *(LAS bf16x8*)(Ks_ + r32 * KP + (2 * d0 + hi) * 16); kf[2 * d0 + 1] = *(LAS bf16x8*)(Ks_ + (32 + r32) * KP + (2 * d0 + hi) * 16); } \
        if (BIAS) { LAS unsigned char* Bs_ = lds + OFF_B + (buf) * 512 + (sub) * 256; \
            _Pragma("unroll") for (int g = 0; g < 4; ++g) { const f32x4 b0 = *(LAS f32x4*)(Bs_ + (8 * g + 4 * hi) * 4), b1 = *(LAS f32x4*)(Bs_ + (32 + 8 * g + 4 * hi) * 4); \
                _Pragma("unroll") for (int e = 0; e < 4; ++e) { P0[4 * g + e] = b0[e]; P1[4 * g + e] = b1[e]; } } \
        } else { _Pragma("unroll") for (int r = 0; r < 16; ++r) { P0[r] = 0.f; P1[r] = 0.f; } } \
        __builtin_amdgcn_sched_barrier(0); } while (0)
#define ATT_QKM(P0, P1) do { \
        _Pragma("unroll") for (int d0 = 0; d0 < 4; ++d0) { \
            P0 = __builtin_amdgcn_mfma_f32_32x32x16_bf16(kf[2 * d0], qf[d0], P0, 0, 0, 0); \
            P1 = __builtin_amdgcn_mfma_f32_32x32x16_bf16(kf[2 * d0 + 1], qf[d0], P1, 0, 0, 0); } \
        __builtin_amdgcn_sched_barrier(0); } while (0)
#define ATT_VLOAD(buf, sub, KK0, NKK) do { \
        LAS unsigned char* Vs_ = lds + OFF_V + (buf) * VBUF + (sub) * 128; \
        _Pragma("unroll") for (int kk = 0; kk < (NKK); ++kk) _Pragma("unroll") for (int d0 = 0; d0 < DV / 32; ++d0) { \
            const LAS unsigned char* vp = Vs_ + (32 * d0 + r32) * VP + (16 * ((KK0) + kk) + 4 * hi) * 2; \
            const s16x4 lo = *(const LAS s16x4*)vp, hh = *(const LAS s16x4*)(vp + 16); \
            vf[kk * (DV / 32) + d0] = (bf16x8){lo[0], lo[1], lo[2], lo[3], hh[0], hh[1], hh[2], hh[3]}; } \
        __builtin_amdgcn_sched_barrier(0); } while (0)
#define ATT_SM(P0, P1, kv0) do { \
        if (CAUSAL && ((kv0) + 63 > qmin)) { const int qrel = qmin + r32 - (kv0); \
            _Pragma("unroll") for (int r = 0; r < 16; ++r) { const int kv = (r & 3) + 8 * (r >> 2) + 4 * hi; if (kv > qrel) P0[r] = -1e30f; if (kv + 32 > qrel) P1[r] = -1e30f; } } \
        float mt = max3f(P0[0], P1[0], P0[1]), mu = max3f(P1[1], P0[2], P1[2]); \
        _Pragma("unroll") for (int r = 3; r < 15; r += 2) { mt = max3f(mt, P0[r], P1[r]); mu = max3f(mu, P0[r + 1], P1[r + 1]); } \
        mt = max3f(mt, P0[15], P1[15]); mt = max3f(mt, mu, mu); \
        mt = xhalf_max(mt); \
        if (__builtin_amdgcn_ballot_w64(mt > mrow + RESC_THR) != 0ull) { \
            const float mnew = fmaxf(mrow, mt), alpha = __builtin_amdgcn_exp2f(mrow - mnew); mrow = mnew; lrow *= alpha; \
            _Pragma("unroll") for (int d0 = 0; d0 < DV / 32; ++d0) _Pragma("unroll") for (int r = 0; r < 16; ++r) o[d0][r] *= alpha; } \
        exp_sum_pk(P0, P1, mrow, lrow); \
        { u32x4 x; x.x = cvtpk(P0[0], P0[1]); x.y = cvtpk(P0[2], P0[3]); x.z = cvtpk(P0[4], P0[5]); x.w = cvtpk(P0[6], P0[7]); pb[0] = __builtin_bit_cast(bf16x8, x); \
          x.x = cvtpk(P0[8], P0[9]); x.y = cvtpk(P0[10], P0[11]); x.z = cvtpk(P0[12], P0[13]); x.w = cvtpk(P0[14], P0[15]); pb[1] = __builtin_bit_cast(bf16x8, x); \
          x.x = cvtpk(P1[0], P1[1]); x.y = cvtpk(P1[2], P1[3]); x.z = cvtpk(P1[4], P1[5]); x.w = cvtpk(P1[6], P1[7]); pb[2] = __builtin_bit_cast(bf16x8, x); \
          x.x = cvtpk(P1[8], P1[9]); x.y = cvtpk(P1[10], P1[11]); x.z = cvtpk(P1[12], P1[13]); x.w = cvtpk(P1[14], P1[15]); pb[3] = __builtin_bit_cast(bf16x8, x); } \
        __builtin_amdgcn_sched_barrier(0); } while (0)
#define ATT_PVM(KK0, NKK) do { \
        _Pragma("unroll") for (int kk = 0; kk < (NKK); ++kk) _Pragma("unroll") for (int d0 = 0; d0 < DV / 32; ++d0) \
            o[d0] = __builtin_amdgcn_mfma_f32_32x32x16_bf16(vf[kk * (DV / 32) + d0], pb[(KK0) + kk], o[d0], 0, 0, 0); \
        __builtin_amdgcn_sched_barrier(0); } while (0)
    bf16x8 kf[8], vf[8], pb[4];
    if constexpr (DV == 64) {
        f32x16 sa0, sa1, sb0, sb1; bf16x8 pc[4];
        const unsigned kofs = (unsigned)(krow * kpitch + kch * 8) * 2u, vofs = (unsigned)(vrow * vpitch + vch * 8) * 2u, bofs = (unsigned)tid * 16u;
#define ATT_HEAD(P0, P1, kv0, MT) do { \
        if (CAUSAL && ((kv0) + 63 > qmin)) { const int qrel = qmin + r32 - (kv0); \
            _Pragma("unroll") for (int r = 0; r < 16; ++r) { const int kv = (r & 3) + 8 * (r >> 2) + 4 * hi; if (kv > qrel) P0[r] = -1e30f; if (kv + 32 > qrel) P1[r] = -1e30f; } } \
        float mt_ = max3f(P0[0], P1[0], P0[1]), mu_ = max3f(P1[1], P0[2], P1[2]); \
        _Pragma("unroll") for (int r = 3; r < 15; r += 2) { mt_ = max3f(mt_, P0[r], P1[r]); mu_ = max3f(mu_, P0[r + 1], P1[r + 1]); } \
        mt_ = max3f(mt_, P0[15], P1[15]); mt_ = max3f(mt_, mu_, mu_); MT = xhalf_max(mt_); } while (0)
#define ATT_PACK(P0, P1, PB) do { u32x4 x; x.x = cvtpk(P0[0], P0[1]); x.y = cvtpk(P0[2], P0[3]); x.z = cvtpk(P0[4], P0[5]); x.w = cvtpk(P0[6], P0[7]); PB[0] = __builtin_bit_cast(bf16x8, x); \
          x.x = cvtpk(P0[8], P0[9]); x.y = cvtpk(P0[10], P0[11]); x.z = cvtpk(P0[12], P0[13]); x.w = cvtpk(P0[14], P0[15]); PB[1] = __builtin_bit_cast(bf16x8, x); \
          x.x = cvtpk(P1[0], P1[1]); x.y = cvtpk(P1[2], P1[3]); x.z = cvtpk(P1[4], P1[5]); x.w = cvtpk(P1[6], P1[7]); PB[2] = __builtin_bit_cast(bf16x8, x); \
          x.x = cvtpk(P1[8], P1[9]); x.y = cvtpk(P1[10], P1[11]); x.z = cvtpk(P1[12], P1[13]); x.w = cvtpk(P1[14], P1[15]); PB[3] = __builtin_bit_cast(bf16x8, x); } while (0)
#ifndef MIXN
#define MIXN 10
#endif
#define ATT_MIX8() do { if (MIXN > 0) { _Pragma("unroll") for (int i_ = 0; i_ < 8; ++i_) { __builtin_amdgcn_sched_group_barrier(0x008, 1, 0); __builtin_amdgcn_sched_group_barrier(0x402, MIXN, 0); } } } while (0)
        ATT_KLOAD(sa0, sa1, 0, 0); ATT_QKM(sa0, sa1);
        for (int t = 0; t < ntiles; ++t) {
            const int cur = t & 1, nxt = cur ^ 1; const bool more = (t + 1 < ntiles);
            if (more) {
                const char* kt_ = (const char*)(Kg + (size_t)(128 * (t + 1)) * kpitch);
#pragma unroll
                for (int i = 0; i < 2; ++i) kreg[i] = *(const u32x4*)(kt_ + (size_t)(64 * i) * kpitch * 2 + kofs);
                if (BIAS) { if (tid < 32) breg = *(const f32x4*)((const char*)(bias + 128 * (t + 1)) + bofs); } }
            ATT_KLOAD(sb0, sb1, cur, 1);
            { float mt; ATT_HEAD(sa0, sa1, 128 * t, mt);
              if (__builtin_amdgcn_ballot_w64(mt > mrow + RESC_THR) != 0ull) {
                  const float mnew = fmaxf(mrow, mt), alpha = __builtin_amdgcn_exp2f(mrow - mnew); mrow = mnew; lrow *= alpha;
#pragma unroll
                  for (int d0 = 0; d0 < DV / 32; ++d0)
#pragma unroll
                      for (int r = 0; r < 16; ++r) o[d0][r] *= alpha; } }
            __builtin_amdgcn_sched_barrier(0);
#pragma unroll
            for (int d0 = 0; d0 < 4; ++d0) { sb0 = __builtin_amdgcn_mfma_f32_32x32x16_bf16(kf[2 * d0], qf[d0], sb0, 0, 0, 0); sb1 = __builtin_amdgcn_mfma_f32_32x32x16_bf16(kf[2 * d0 + 1], qf[d0], sb1, 0, 0, 0); }
            exp_sum_pk(sa0, sa1, mrow, lrow);
            ATT_PACK(sa0, sa1, pb);
            ATT_MIX8();
            __builtin_amdgcn_sched_barrier(0);
            if (more) {
#pragma unroll
                for (int i = 0; i < 2; ++i) *(LAS u32x4*)(lds + kdst + nxt * KBUF + i * 64 * KP) = kreg[i];
                if (BIAS) { if (tid < 32) *(LAS f32x4*)(lds + OFF_B + nxt * 512 + 16 * tid) = breg; }
                const char* vt_ = (const char*)(Vtg + 128 * (t + 1));
#pragma unroll
                for (int i = 0; i < 2; ++i) kreg[i] = *(const u32x4*)(vt_ + (size_t)(32 * i) * vpitch * 2 + vofs); }
            { LAS unsigned char* Vs_ = lds + OFF_V + cur * VBUF;
#pragma unroll
              for (int kk = 0; kk < 4; ++kk)
#pragma unroll
                  for (int d0 = 0; d0 < 2; ++d0) { const LAS unsigned char* vp = Vs_ + (32 * d0 + r32) * VP + (16 * kk + 4 * hi) * 2;
                      const s16x4 lo = *(const LAS s16x4*)vp, hh = *(const LAS s16x4*)(vp + 16); kf[kk * 2 + d0] = (bf16x8){lo[0], lo[1], lo[2], lo[3], hh[0], hh[1], hh[2], hh[3]}; } }
            float mtb; ATT_HEAD(sb0, sb1, 128 * t + 64, mtb);
            const bool rescb = __builtin_amdgcn_ballot_w64(mtb > mrow + RESC_THR) != 0ull;
            const float mnewb = rescb ? fmaxf(mrow, mtb) : mrow, alphab = __builtin_amdgcn_exp2f(mrow - mnewb);
            float psb = 0.f;
            __builtin_amdgcn_sched_barrier(0);
#pragma unroll
            for (int kk = 0; kk < 4; ++kk)
#pragma unroll
                for (int d0 = 0; d0 < 2; ++d0) o[d0] = __builtin_amdgcn_mfma_f32_32x32x16_bf16(kf[kk * 2 + d0], pb[kk], o[d0], 0, 0, 0);
            exp_sum_pk(sb0, sb1, mnewb, psb);
            ATT_PACK(sb0, sb1, pc);
            ATT_MIX8();
            __builtin_amdgcn_sched_barrier(0);
            { LAS unsigned char* Vs_ = lds + OFF_V + cur * VBUF + 128;
#pragma unroll
              for (int kk = 0; kk < 4; ++kk)
#pragma unroll
                  for (int d0 = 0; d0 < 2; ++d0) { const LAS unsigned char* vp = Vs_ + (32 * d0 + r32) * VP + (16 * kk + 4 * hi) * 2;
                      const s16x4 lo = *(const LAS s16x4*)vp, hh = *(const LAS s16x4*)(vp + 16); kf[kk * 2 + d0] = (bf16x8){lo[0], lo[1], lo[2], lo[3], hh[0], hh[1], hh[2], hh[3]}; } }
            if (rescb) {
#pragma unroll
                for (int d0 = 0; d0 < DV / 32; ++d0)
#pragma unroll
                    for (int r = 0; r < 16; ++r) o[d0][r] *= alphab; }
            lrow = lrow * alphab + psb; mrow = mnewb;
            __builtin_amdgcn_sched_barrier(0);
#pragma unroll
            for (int kk = 0; kk < 4; ++kk)
#pragma unroll
                for (int d0 = 0; d0 < 2; ++d0) o[d0] = __builtin_amdgcn_mfma_f32_32x32x16_bf16(kf[kk * 2 + d0], pc[kk], o[d0], 0, 0, 0);
            __builtin_amdgcn_sched_barrier(0);
            if (more) {
#pragma unroll
                for (int i = 0; i < 2; ++i) { *(LAS u32x2*)(lds + vdst + nxt * VBUF + i * 32 * VP) = (u32x2){kreg[i].x, kreg[i].y}; *(LAS u32x2*)(lds + vdst + nxt * VBUF + i * 32 * VP + 8) = (u32x2){kreg[i].z, kreg[i].w}; } }
            __syncthreads();
            if (more) { ATT_KLOAD(sa0, sa1, nxt, 0); ATT_QKM(sa0, sa1); }
        }
#undef ATT_HEAD
#undef ATT_PACK
#undef ATT_MIX8
    } else if constexpr (DV == 128 && PIPE128) {
#define LOAD_A(t) do { _Pragma("unroll") for (int i = 0; i < 2; ++i) kreg[i] = *(const u32x4*)(ksrc + (size_t)(128 * (t) + 64 * i) * kpitch); \
        _Pragma("unroll") for (int i = 0; i < 2; ++i) vreg[i] = *(const u32x4*)(vsrc + (size_t)(32 * i) * vpitch + 128 * (t)); } while (0)
#define STORE_A(buf) do { _Pragma("unroll") for (int i = 0; i < 2; ++i) *(LAS u32x4*)(lds + kdst + (buf) * KBUF + i * 64 * KP) = kreg[i]; \
        _Pragma("unroll") for (int i = 0; i < 2; ++i) { *(LAS u32x2*)(lds + vdst + (buf) * VBUF + i * 32 * VP) = (u32x2){vreg[i].x, vreg[i].y}; *(LAS u32x2*)(lds + vdst + (buf) * VBUF + i * 32 * VP + 8) = (u32x2){vreg[i].z, vreg[i].w}; } } while (0)
#define LOAD_B(t) do { _Pragma("unroll") for (int i = 0; i < 2; ++i) vreg[i] = *(const u32x4*)(vsrc + (size_t)(32 * (i + 2)) * vpitch + 128 * (t)); } while (0)
#define STORE_B(buf) do { _Pragma("unroll") for (int i = 0; i < 2; ++i) { *(LAS u32x2*)(lds + vdst + (buf) * VBUF + (i + 2) * 32 * VP) = (u32x2){vreg[i].x, vreg[i].y}; *(LAS u32x2*)(lds + vdst + (buf) * VBUF + (i + 2) * 32 * VP + 8) = (u32x2){vreg[i].z, vreg[i].w}; } } while (0)
        f32x16 sa0, sa1, sb0, sb1;
        ATT_KLOAD(sa0, sa1, 0, 0); ATT_QKM(sa0, sa1);
        for (int t = 0; t < ntiles; ++t) {
            const int cur = t & 1, nxt = cur ^ 1; const bool more = (t + 1 < ntiles);
            if (more) LOAD_A(t + 1);
            ATT_KLOAD(sb0, sb1, cur, 1); ATT_QKM(sb0, sb1);
            ATT_VLOAD(cur, 0, 0, 1);
            ATT_SM(sa0, sa1, 128 * t);
            ATT_PVM(0, 1); ATT_VLOAD(cur, 0, 1, 1); ATT_PVM(1, 1); ATT_VLOAD(cur, 0, 2, 1); ATT_PVM(2, 1); ATT_VLOAD(cur, 0, 3, 1); ATT_PVM(3, 1);
            if (more) { STORE_A(nxt); LOAD_B(t + 1); }
            ATT_VLOAD(cur, 1, 0, 1);
            ATT_SM(sb0, sb1, 128 * t + 64);
            ATT_PVM(0, 1); ATT_VLOAD(cur, 1, 1, 1); ATT_PVM(1, 1); ATT_VLOAD(cur, 1, 2, 1); ATT_PVM(2, 1); ATT_VLOAD(cur, 1, 3, 1); ATT_PVM(3, 1);
            if (more) STORE_B(nxt);
            __syncthreads();
            if (more) { ATT_KLOAD(sa0, sa1, nxt, 0); ATT_QKM(sa0, sa1); }
        }
#undef LOAD_A
#undef STORE_A
#undef LOAD_B
#undef STORE_B
    } else {
        f32x16 sa0, sa1;
        for (int t = 0; t < ntiles; ++t) {
            const int cur = t & 1, nxt = cur ^ 1; const bool more = (t + 1 < ntiles);
            if (more) ATT_LOAD(t + 1);
#pragma unroll
            for (int sub = 0; sub < 2; ++sub) {
                if (!(CAUSAL && (128 * t + 64 * sub > qmin + 31))) {
                    ATT_KLOAD(sa0, sa1, cur, sub); ATT_QKM(sa0, sa1);
                    ATT_VLOAD(cur, sub, 0, 1);
                    ATT_SM(sa0, sa1, 128 * t + 64 * sub);
                    ATT_PVM(0, 1);
                    ATT_VLOAD(cur, sub, 1, 1); ATT_PVM(1, 1);
                    ATT_VLOAD(cur, sub, 2, 1); ATT_PVM(2, 1);
                    ATT_VLOAD(cur, sub, 3, 1); ATT_PVM(3, 1);
                }
            }
            if (more) ATT_STORE(nxt);
            __syncthreads();
        }
    }
#undef ATT_KLOAD
#undef ATT_QKM
#undef ATT_VLOAD
#undef ATT_SM
#undef ATT_PVM
#undef ATT_LOAD
#undef ATT_STORE
    const float inv = __builtin_amdgcn_rcpf(xhalf_sum(lrow));
#pragma unroll
    for (int d0 = 0; d0 < DV / 32; ++d0)
#pragma unroll
        for (int r = 0; r < 16; ++r) o[d0][r] *= inv;
}
constexpr int KP2 = 272, KBUF2 = 128 * KP2, OFF_K2 = 0, OFF_V2 = 2 * KBUF2;
template <int SEQ_>
__device__ __forceinline__ void attn_diff_unit(LAS unsigned char* lds, const bf16_t* Qg, const bf16_t* Kg, const bf16_t* Vtg, int q0, int ntiles, float lam, float post,
                                               const float* subln_g, bf16_t* mixbase, const int wv) {
    constexpr int DV = 128;
    int tid_ = wv * 64 + hw_lane(); asm volatile("" : "+v"(tid_));
    const int tid = tid_, lane = tid & 63, r32 = lane & 31, hi = lane >> 5, w = __builtin_amdgcn_readfirstlane(tid >> 6), wr = w & 3, strm = w >> 2;
    bf16x8 qf[4];
#pragma unroll
    for (int d0 = 0; d0 < 4; ++d0) qf[d0] = *(const bf16x8*)(Qg + (size_t)(q0 + 32 * wr + r32) * 768 + 64 * strm + 16 * d0 + 8 * hi);
    const int srow = tid >> 4, sch = tid & 15;
    const bf16_t* ksrc = Kg + (size_t)srow * 768 + sch * 8;
    const bf16_t* vsrc = Vtg + (size_t)srow * SEQ_ + sch * 8;
    const unsigned kdst = OFF_K2 + srow * KP2 + sch * 16, vdst = OFF_V2 + srow * VP + sch * 16;
    u32x4 sreg[4];
#define D_LOADK(t) do { _Pragma("unroll") for (int i = 0; i < 4; ++i) sreg[i] = *(const u32x4*)(ksrc + (size_t)(128 * (t) + 32 * i) * 768); } while (0)
#define D_STOREK(buf) do { _Pragma("unroll") for (int i = 0; i < 4; ++i) *(LAS u32x4*)(lds + kdst + (buf) * KBUF2 + i * 32 * KP2) = sreg[i]; } while (0)
#define D_LOADV(t) do { _Pragma("unroll") for (int i = 0; i < 4; ++i) sreg[i] = *(const u32x4*)(vsrc + (size_t)(32 * i) * SEQ_ + 128 * (t)); } while (0)
#define D_STOREV(buf) do { _Pragma("unroll") for (int i = 0; i < 4; ++i) { *(LAS u32x2*)(lds + vdst + (buf) * VBUF + i * 32 * VP) = (u32x2){sreg[i].x, sreg[i].y}; *(LAS u32x2*)(lds + vdst + (buf) * VBUF + i * 32 * VP + 8) = (u32x2){sreg[i].z, sreg[i].w}; } } while (0)
    D_LOADK(0); D_STOREK(0); D_LOADV(0); D_STOREV(0);
    __syncthreads();
    float mrow = -1e30f, lrow = 0.f;
    f32x16 o[4];
#pragma unroll
    for (int d0 = 0; d0 < 4; ++d0)
#pragma unroll
        for (int r = 0; r < 16; ++r) o[d0][r] = 0.f;
    const int qmin = q0 + 32 * wr;
    bf16x8 kf[8], vf[4], vg[4], pb[4];
    f32x16 p0, p1;
#define D_SUB(buf, sub, kv0) do { if (!((kv0) > qmin + 31)) { \
        LAS unsigned char* Ks_ = lds + OFF_K2 + (buf) * KBUF2 + (sub) * 64 * KP2 + strm * 128; \
        _Pragma("unroll") for (int d0 = 0; d0 < 4; ++d0) { kf[2 * d0] = *(LAS bf16x8*)(Ks_ + r32 * KP2 + (2 * d0 + hi) * 16); kf[2 * d0 + 1] = *(LAS bf16x8*)(Ks_ + (32 + r32) * KP2 + (2 * d0 + hi) * 16); } \
        _Pragma("unroll") for (int r = 0; r < 16; ++r) { p0[r] = 0.f; p1[r] = 0.f; } \
        __builtin_amdgcn_sched_barrier(0); \
        _Pragma("unroll") for (int d0 = 0; d0 < 4; ++d0) { \
            p0 = __builtin_amdgcn_mfma_f32_32x32x16_bf16(kf[2 * d0], qf[d0], p0, 0, 0, 0); \
            p1 = __builtin_amdgcn_mfma_f32_32x32x16_bf16(kf[2 * d0 + 1], qf[d0], p1, 0, 0, 0); } \
        __builtin_amdgcn_sched_barrier(0); \
        LAS unsigned char* Vs_ = lds + OFF_V2 + (buf) * VBUF + (sub) * 128; \
        D_VLOAD(0); \
        if ((kv0) + 63 > qmin) { const int qrel = qmin + r32 - (kv0); \
            _Pragma("unroll") for (int r = 0; r < 16; ++r) { const int kv = (r & 3) + 8 * (r >> 2) + 4 * hi; if (kv > qrel) p0[r] = -1e30f; if (kv + 32 > qrel) p1[r] = -1e30f; } } \
        float mt = max3f(p0[0], p1[0], p0[1]), mu = max3f(p1[1], p0[2], p1[2]); \
        _Pragma("unroll") for (int r = 3; r < 15; r += 2) { mt = max3f(mt, p0[r], p1[r]); mu = max3f(mu, p0[r + 1], p1[r + 1]); } \
        mt = max3f(mt, p0[15], p1[15]); mt = max3f(mt, mu, mu); \
        mt = xhalf_max(mt); \
        if (__builtin_amdgcn_ballot_w64(mt > mrow + RESC_THR) != 0ull) { \
            const float mnew = fmaxf(mrow, mt), alpha = __builtin_amdgcn_exp2f(mrow - mnew); mrow = mnew; lrow *= alpha; \
            _Pragma("unroll") for (int d0 = 0; d0 < 4; ++d0) _Pragma("unroll") for (int r = 0; r < 16; ++r) o[d0][r] *= alpha; } \
        exp_sum_pk(p0, p1, mrow, lrow); \
        { u32x4 x; x.x = cvtpk(p0[0], p0[1]); x.y = cvtpk(p0[2], p0[3]); x.z = cvtpk(p0[4], p0[5]); x.w = cvtpk(p0[6], p0[7]); pb[0] = __builtin_bit_cast(bf16x8, x); \
          x.x = cvtpk(p0[8], p0[9]); x.y = cvtpk(p0[10], p0[11]); x.z = cvtpk(p0[12], p0[13]); x.w = cvtpk(p0[14], p0[15]); pb[1] = __builtin_bit_cast(bf16x8, x); \
          x.x = cvtpk(p1[0], p1[1]); x.y = cvtpk(p1[2], p1[3]); x.z = cvtpk(p1[4], p1[5]); x.w = cvtpk(p1[6], p1[7]); pb[2] = __builtin_bit_cast(bf16x8, x); \
          x.x = cvtpk(p1[8], p1[9]); x.y = cvtpk(p1[10], p1[11]); x.z = cvtpk(p1[12], p1[13]); x.w = cvtpk(p1[14], p1[15]); pb[3] = __builtin_bit_cast(bf16x8, x); } \
        __builtin_amdgcn_sched_barrier(0); \
        D_VLOADB(1); D_PVM(0); D_VLOAD(2); D_PVMB(1); D_VLOADB(3); D_PVM(2); D_PVMB(3); } } while (0)
#define D_VLOAD(KK) do { _Pragma("unroll") for (int d0 = 0; d0 < 4; ++d0) { \
            const LAS unsigned char* vp = Vs_ + (32 * d0 + r32) * VP + (16 * (KK) + 4 * hi) * 2; \
            const s16x4 lo = *(const LAS s16x4*)vp, hh = *(const LAS s16x4*)(vp + 16); \
            vf[d0] = (bf16x8){lo[0], lo[1], lo[2], lo[3], hh[0], hh[1], hh[2], hh[3]}; } \
        __builtin_amdgcn_sched_barrier(0); } while (0)
#define D_VLOADB(KK) do { _Pragma("unroll") for (int d0 = 0; d0 < 4; ++d0) { \
            const LAS unsigned char* vp = Vs_ + (32 * d0 + r32) * VP + (16 * (KK) + 4 * hi) * 2; \
            const s16x4 lo = *(const LAS s16x4*)vp, hh = *(const LAS s16x4*)(vp + 16); \
            vg[d0] = (bf16x8){lo[0], lo[1], lo[2], lo[3], hh[0], hh[1], hh[2], hh[3]}; } \
        __builtin_amdgcn_sched_barrier(0); } while (0)
#define D_PVMB(KK) do { _Pragma("unroll") for (int d0 = 0; d0 < 4; ++d0) o[d0] = __builtin_amdgcn_mfma_f32_32x32x16_bf16(vg[d0], pb[KK], o[d0], 0, 0, 0); \
        __builtin_amdgcn_sched_barrier(0); } while (0)
#define D_PVM(KK) do { _Pragma("unroll") for (int d0 = 0; d0 < 4; ++d0) o[d0] = __builtin_amdgcn_mfma_f32_32x32x16_bf16(vf[d0], pb[KK], o[d0], 0, 0, 0); \
        __builtin_amdgcn_sched_barrier(0); } while (0)
    for (int t = 0; t < ntiles; ++t) {
        const int cur = t & 1, nxt = cur ^ 1; const bool more = (t + 1 < ntiles);
        if (more) D_LOADK(t + 1);
        D_SUB(cur, 0, 128 * t);
        if (more) { D_STOREK(nxt); D_LOADV(t + 1); }
        D_SUB(cur, 1, 128 * t + 64);
        if (more) D_STOREV(nxt);
        __syncthreads();
    }
#undef D_LOADK
#undef D_STOREK
#undef D_LOADV
#undef D_STOREV
#undef D_SUB
#undef D_VLOAD
#undef D_PVM
#undef D_VLOADB
#undef D_PVMB
    const float inv = __builtin_amdgcn_rcpf(xhalf_sum(lrow));
    const int lane_e = hw_lane(), r32e = lane_e & 31, hie = lane_e >> 5;
    if (strm == 1) {
#pragma unroll
        for (int d0 = 0; d0 < 4; ++d0)
#pragma unroll
            for (int g4 = 0; g4 < 4; ++g4) *(LAS f32x4*)(lds + (((d0 * 4 + g4) * 4 + wr) * 64 + lane_e) * 16) = (f32x4){o[d0][4 * g4] * inv, o[d0][4 * g4 + 1] * inv, o[d0][4 * g4 + 2] * inv, o[d0][4 * g4 + 3] * inv};
    }
    __syncthreads();
    if (strm == 0) {
        float sq = 0.f;
#pragma unroll
        for (int d0 = 0; d0 < 4; ++d0)
#pragma unroll
            for (int g4 = 0; g4 < 4; ++g4) { const f32x4 a = *(LAS f32x4*)(lds + (((d0 * 4 + g4) * 4 + wr) * 64 + lane_e) * 16);
#pragma unroll
                for (int e = 0; e < 4; ++e) { const float y = o[d0][4 * g4 + e] * inv - lam * a[e]; o[d0][4 * g4 + e] = y; sq += y * y; } }
        sq = xhalf_sum(sq);
        const float rn = __builtin_amdgcn_rsqf(sq * (1.0f / 128.0f) + 1e-6f) * post;
        bf16_t* dst = mixbase + (size_t)(q0 + 32 * wr + r32e) * 1024;
#pragma unroll
        for (int d0 = 0; d0 < 4; ++d0)
#pragma unroll
            for (int g4 = 0; g4 < 4; ++g4) { const f32x4 gv = *(const f32x4*)(subln_g + 32 * d0 + 8 * g4 + 4 * hie);
                u32x2 x; x.x = cvtpk(o[d0][4 * g4] * rn * gv[0], o[d0][4 * g4 + 1] * rn * gv[1]); x.y = cvtpk(o[d0][4 * g4 + 2] * rn * gv[2], o[d0][4 * g4 + 3] * rn * gv[3]);
                *(u32x2*)(dst + 32 * d0 + 8 * g4 + 4 * hie) = x; }
    }
}
template <int DV> __device__ __forceinline__ void store_o(bf16_t* dstrow, const f32x16 (&o)[DV / 32], int hi) {
#pragma unroll
    for (int d0 = 0; d0 < DV / 32; ++d0)
#pragma unroll
        for (int g = 0; g < 4; ++g) { u32x2 x; x.x = cvtpk(o[d0][4 * g], o[d0][4 * g + 1]); x.y = cvtpk(o[d0][4 * g + 2], o[d0][4 * g + 3]);
            *(u32x2*)(dstrow + 32 * d0 + 8 * g + 4 * hi) = x; }
}
}
__constant__ float INV_FREQ[32] = {1.000000000e+00f, 7.498942614e-01f, 5.623413324e-01f, 4.216965139e-01f, 3.162277639e-01f, 2.371373773e-01f, 1.778279394e-01f, 1.333521307e-01f, 1.000000015e-01f, 7.498941571e-02f, 5.623413250e-02f, 4.216965288e-02f, 3.162277490e-02f, 2.371373773e-02f, 1.778279431e-02f, 1.333521493e-02f, 9.999999776e-03f, 7.498941850e-03f, 5.623413250e-03f, 4.216964822e-03f, 3.162277630e-03f, 2.371373586e-03f, 1.778279431e-03f, 1.333521446e-03f, 1.000000047e-03f, 7.498942432e-04f, 5.623413017e-04f, 4.216965172e-04f, 3.162277571e-04f, 2.371373703e-04f, 1.778279402e-04f, 1.333521504e-04f};
namespace cg = cooperative_groups;
typedef unsigned short bf16;
typedef float f32x4 __attribute__((ext_vector_type(4)));
typedef unsigned v4u __attribute__((ext_vector_type(4)));
typedef unsigned v2u __attribute__((ext_vector_type(2)));
constexpr int NB = 4, SEQ = 4096, DM = 1024, M = NB * SEQ, NMEM = 256, MM = NB * NMEM, DFF = 2816, NPROJ = 2560, NPROJA = 2816;
constexpr float C2 = 0.125f * 1.4426950408889634f;
constexpr float LAMBDA_INIT = 0.35550906759096934f;
constexpr size_t MiB = 1u << 20;
constexpr size_t WS_CTL = 0;
constexpr size_t WS_SSQ = 1 * MiB;
constexpr size_t WS_SSQM = WS_SSQ + 5 * (size_t)M * 4;
constexpr size_t WS_LF = 2 * MiB;
constexpr size_t WS_COS = 3 * MiB, WS_SIN = 3 * MiB + 512 * 1024;
constexpr size_t WS_WA = 4 * MiB, WS_WB = 10 * MiB, WS_WO = 15 * MiB, WS_WM = 19 * MiB, WS_WGU = 21 * MiB, WS_WD = 43 * MiB;
constexpr size_t WS_MEMB = 54 * MiB, WS_MK = 56 * MiB, WS_MVT = 57 * MiB;
constexpr size_t WS_XB = 58 * MiB;
constexpr size_t WS_Q = 90 * MiB, WS_K = 114 * MiB, WS_VT = 138 * MiB, WS_MQ = 162 * MiB, WS_MIX = 170 * MiB, WS_H = 90 * MiB, WS_STASH = 202 * MiB, WS_END = 234 * MiB;
static_assert(WS_H + (size_t)M * DFF * 2 <= WS_END, "h overlay");
constexpr int LDS_BYTES = 147456, LDS_MISC = LDS_BYTES - 1024, LDS_ARGS = LDS_MISC + 256;

constexpr int CW_BAR = 4096;
struct Args {
    const float *x, *mem, *attn_g, *mem_g, *w_mem_kv, *w_out, *ffn_g, *w_gate_up, *w_down, *a_w_in, *a_b_f, *b_w_in, *lq1, *lk1, *lq2, *lk2, *subln_g, *kv_g, *w_kv, *final_g;
    float* out; unsigned char* ws;
};

__device__ __forceinline__ unsigned f2bf(float f) { unsigned u = __builtin_bit_cast(unsigned, f); return (u + 0x7fffu + ((u >> 16) & 1u)) >> 16; }
__device__ __forceinline__ unsigned pk2(float lo, float hi) { return f2bf(lo) | (f2bf(hi) << 16); }
__device__ __forceinline__ float wave_sum(float v) {
#pragma unroll
    for (int o = 1; o < 64; o <<= 1) v += __shfl_xor(v, o);
    return v;
}
__device__ __forceinline__ void wt_item(const float* W, int ldw, int K, const float* g, bf16* WT, int k0, int c0, int nvalid, int drowA, int drowB, LAS float* scr, int lane) {
    const int kq = lane >> 4, n4 = 4 * (lane & 15);
    f32x4 v[16]; float gk[16];
#pragma unroll
    for (int i = 0; i < 16; ++i) gk[i] = g ? g[k0 + 4 * i + kq] : 1.0f;
#pragma unroll
    for (int i = 0; i < 16; ++i) v[i] = *(const f32x4*)(W + (size_t)(k0 + 4 * i + kq) * ldw + c0 + n4);
    if (g) {
#pragma unroll
        for (int i = 0; i < 16; ++i) v[i] = v[i] * gk[i];
    }
    if (nvalid < 64) {
#pragma unroll
        for (int i = 0; i < 16; ++i)
#pragma unroll
            for (int e = 0; e < 4; ++e) if (n4 + e >= nvalid) v[i][e] = 0.f;
    }
#pragma unroll
    for (int i = 0; i < 16; ++i)
#pragma unroll
        for (int e = 0; e < 4; ++e) scr[(4 * i + kq) * 65 + n4 + e] = v[i][e];
    asm volatile("s_waitcnt lgkmcnt(0)" ::: "memory");
#pragma unroll
    for (int j = 0; j < 8; ++j) { const int q = lane + 64 * j, n = q >> 3, kc = q & 7; const LAS float* s = scr + (8 * kc) * 65 + n;
        v4u o; o.x = pk2(s[0 * 65], s[1 * 65]); o.y = pk2(s[2 * 65], s[3 * 65]); o.z = pk2(s[4 * 65], s[5 * 65]); o.w = pk2(s[6 * 65], s[7 * 65]);
        const int drow = (n < 32) ? drowA + n : drowB + n - 32;
        *(v4u*)(WT + (size_t)drow * K + k0 + 8 * kc) = o; }
    asm volatile("s_waitcnt lgkmcnt(0)" ::: "memory");
}
__device__ __forceinline__ int wt_drow(int l, int drow0, int kind) {
    if (kind == 0) return drow0 + l;
    if (kind == 1) return drow0 + (l / 256) * 256 + ((l >> 5) & 1) * 128 + ((l & 255) >> 6) * 32;
    const int up = l >= DFF ? 1 : 0, j = l - up * DFF; return drow0 + (j / 128) * 256 + up * 128 + (j & 127);
}
__device__ __forceinline__ void wt_job(int it, const float* W, int ldw, int K, int c_src, int ncols, int nvalid, const float* g, bf16* WT, int drow0, int kind, LAS float* scr, int lane) {
    const int nblk = ncols / 64, kb = it / nblk, nb = it % nblk; const int l = nb * 64;
    wt_item(W, ldw, K, g, WT, kb * 64, c_src + l, nvalid, wt_drow(l, drow0, kind), wt_drow(l + 32, drow0, kind), scr, lane);
}
#define XB_TMO      128
#define XB_XCNT(j)  (256  + 64 * (j))
#define XB_XSUB(j)  (1280 + 64 * (j))
#define XB_XGEN(j)  (2304 + 64 * (j))
#define XB_TOP      3328
#define XB_TOPGEN   3392
#define XCD_BAR_WORDS 3456
#define XB_SPIN_CAP (1u << 18)

__device__ __forceinline__ unsigned xb_ld(unsigned* p)              { return __hip_atomic_load(p, __ATOMIC_RELAXED, __HIP_MEMORY_SCOPE_AGENT); }
__device__ __forceinline__ unsigned xb_add(unsigned* p, unsigned v) { return __hip_atomic_fetch_add(p, v, __ATOMIC_RELAXED, __HIP_MEMORY_SCOPE_AGENT); }
__device__ __forceinline__ unsigned xb_xcc_id() { return (unsigned)__builtin_amdgcn_s_getreg((3 << 11) | 20) & 0xFu; }
#define XB_SPIN(cond, bar) do { unsigned _sp = 0; while (cond) { __builtin_amdgcn_s_sleep(1); \
    if ((++_sp & 255u) == 0u) { if (xb_ld(&(bar)[XB_TMO])) break; if (_sp > XB_SPIN_CAP) { atomicAdd(&(bar)[XB_TMO], 1u); break; } } } } while (0)

struct XcdBarrier {
    unsigned* bar; unsigned x; int wv;
    volatile LAS unsigned* st;
};

__device__ __forceinline__ XcdBarrier xcd_barrier_post(unsigned* bar, volatile LAS unsigned* st) {
    XcdBarrier b; b.bar = bar; b.x = xb_xcc_id(); b.st = st; b.wv = 0;
    if (threadIdx.x == 0) (void)xb_add(&bar[XB_XCNT(b.x)], 1u);
    return b;
}
__device__ __forceinline__ void xcd_barrier_complete(unsigned* bar, unsigned x, unsigned& nloc, unsigned& nx) {
    const unsigned G = gridDim.x * gridDim.y * gridDim.z;
    unsigned sum, cnt, mine, sp = 0u;
    for (;;) {
        sum = 0u; cnt = 0u; mine = 0u;
#pragma unroll
        for (unsigned j = 0; j < 16; ++j) { const unsigned c = xb_ld(&bar[XB_XCNT(j)]); sum += c; cnt += (c > 0u) ? 1u : 0u; mine = (j == x) ? c : mine; }
        if (sum == G) break;
        __builtin_amdgcn_s_sleep(1);
        if ((++sp & 255u) == 0u) { if (xb_ld(&bar[XB_TMO])) break; if (sp > XB_SPIN_CAP) { atomicAdd(&bar[XB_TMO], 1u); break; } }
    }
    nloc = mine > 0u ? mine : 1u; nx = cnt > 0u ? cnt : 1u;
}

__device__ __forceinline__ void xcd_barrier(const XcdBarrier& b) {
    asm volatile("s_waitcnt vmcnt(0)" ::: "memory");
    __syncthreads();
    if (b.wv * 64 + hw_lane() == 0) {
        unsigned* bar = b.bar;
        __builtin_amdgcn_s_waitcnt(0);
        unsigned nloc = b.st[0], nx = b.st[1];
        if (nloc == 0u) { xcd_barrier_complete(bar, b.x, nloc, nx); b.st[0] = nloc; b.st[1] = nx; }
        const unsigned old = xb_add(&bar[XB_XSUB(b.x)], 1u);
        const unsigned gen = old / nloc;
        if (old + 1u == (gen + 1u) * nloc) {
            __builtin_amdgcn_fence(__ATOMIC_RELEASE, "agent");
            asm volatile("s_waitcnt vmcnt(0)" ::: "memory");
            const unsigned og = xb_add(&bar[XB_TOP], 1u);
            const unsigned tg = og / nx;
            if (og + 1u == (tg + 1u) * nx) xb_add(&bar[XB_TOPGEN], 1u);
            else XB_SPIN(xb_ld(&bar[XB_TOPGEN]) == tg, bar);
            __builtin_amdgcn_fence(__ATOMIC_ACQUIRE, "agent");
            xb_add(&bar[XB_XGEN(b.x)], 1u);
            asm volatile("s_waitcnt vmcnt(0)" ::: "memory");
        } else {
            XB_SPIN(xb_ld(&bar[XB_XGEN(b.x)]) == gen, bar);
            __builtin_amdgcn_fence(__ATOMIC_ACQUIRE, "agent");
            asm volatile("s_waitcnt vmcnt(0)" ::: "memory");
        }
    }
    __syncthreads();
}
#ifndef NREP_SYNC
#define NREP_SYNC 0
#endif
#ifndef NREP2
#define NREP2 1
#endif
#ifndef NREP7
#define NREP7 1
#endif
#ifndef NREP4
#define NREP4 1
#endif
#ifndef NREP1
#define NREP1 1
#endif
#ifndef NREP0
#define NREP0 1
#endif
#ifndef NREP35
#define NREP35 1
#endif
#ifndef PREREAD
#define PREREAD 0
#endif
#ifndef NREPB
#define NREPB 1
#endif
#ifndef USE_XB
#define USE_XB 1
#endif
#ifndef PVAR
#define PVAR 0
#endif
#ifndef PH_MASK
#define PH_MASK 0xFFFF
#endif
__device__ __forceinline__ void scan_bh(float* lf, LAS float* sm, int tid) {
    const f32x4 a = *(const f32x4*)(lf + 8 * tid), b = *(const f32x4*)(lf + 8 * tid + 4);
    float v[8] = {a[0], a[1], a[2], a[3], b[0], b[1], b[2], b[3]};
#pragma unroll
    for (int i = 1; i < 8; ++i) v[i] += v[i - 1];
    float tot = v[7]; const int lane = tid & 63, w = tid >> 6;
    float inc = tot;
#pragma unroll
    for (int o = 1; o < 64; o <<= 1) { const float n = __shfl_up(inc, o); if (lane >= o) inc += n; }
    if (lane == 63) sm[w] = inc;
    __syncthreads();
    float base = inc - tot;
    for (int i = 0; i < w; ++i) base += sm[i];
    const float k = -1.4426950408889634f;
    f32x4 oa, ob;
#pragma unroll
    for (int i = 0; i < 4; ++i) { oa[i] = (v[i] + base) * k; ob[i] = (v[4 + i] + base) * k; }
    *(f32x4*)(lf + 8 * tid) = oa; *(f32x4*)(lf + 8 * tid + 4) = ob;
    __syncthreads();
}

enum { AX = 0, AMEM, AATTN_G, AMEM_G, AW_MEM_KV, AW_OUT, AFFN_G, AW_GATE_UP, AW_DOWN, AA_W_IN, AA_B_F, AB_W_IN, ALQ1, ALK1, ALQ2, ALK2, ASUBLN_G, AKV_G, AW_KV, AFINAL_G, AOUT, AWS };
__device__ __forceinline__ const float* argp(LAS unsigned char* lds, int i) {
    volatile LAS unsigned* p = (volatile LAS unsigned*)(lds + LDS_ARGS + 8 * i);
    const unsigned lo = __builtin_amdgcn_readfirstlane(p[0]), hi = __builtin_amdgcn_readfirstlane(p[1]);
    return (const float*)(__attribute__((address_space(1))) const float*)(((unsigned long long)hi << 32) | (unsigned long long)lo);
}
#define WSPTRS() \
    unsigned char* ws = (unsigned char*)argp(lds, AWS); \
    unsigned* ctl = (unsigned*)(ws + WS_CTL); float* ssq = (float*)(ws + WS_SSQ); float* ssqm = (float*)(ws + WS_SSQM); \
    float* LF = (float*)(ws + WS_LF); float* COS = (float*)(ws + WS_COS); float* SIN = (float*)(ws + WS_SIN); \
    bf16 *WA = (bf16*)(ws + WS_WA), *WB = (bf16*)(ws + WS_WB), *WO = (bf16*)(ws + WS_WO), *WM = (bf16*)(ws + WS_WM), *WGU = (bf16*)(ws + WS_WGU), *WD = (bf16*)(ws + WS_WD); \
    bf16 *MEMB = (bf16*)(ws + WS_MEMB), *MK = (bf16*)(ws + WS_MK), *MVT = (bf16*)(ws + WS_MVT), *XB = (bf16*)(ws + WS_XB); \
    bf16 *Qb = (bf16*)(ws + WS_Q), *Kb = (bf16*)(ws + WS_K), *VT = (bf16*)(ws + WS_VT), *MQ = (bf16*)(ws + WS_MQ), *MIX = (bf16*)(ws + WS_MIX), *H = (bf16*)(ws + WS_H); \
    (void)ctl; (void)ssq; (void)ssqm; (void)LF; (void)COS; (void)SIN; (void)WA; (void)WB; (void)WO; (void)WM; (void)WGU; (void)WD; (void)MEMB; (void)MK; (void)MVT; (void)XB; (void)Qb; (void)Kb; (void)VT; (void)MQ; (void)MIX; (void)H;

constexpr int I1 = 16 * 36, I2 = 16 * 4, IF_ = 16, I3 = 16 * 12, I4 = 16 * 12, I5 = 16 * 12, I6 = 16 * 4, I7 = 16 * 16, I9 = 16 * 8, I11 = 16 * 88, I13 = 44 * 16;
constexpr int WT_A = I11 + I13 + I1 + I2 + IF_ + I7 + 2 * I9, WT_B1 = I3 + I4 + I5 + I6, WT_B2 = I11, WT_B3 = I7 + I13;
#define WT_SRCS() const float *a_w_in = argp(lds, AA_W_IN), *attn_g = argp(lds, AATTN_G), *w_kv = argp(lds, AW_KV), *kv_g = argp(lds, AKV_G), *b_w_in = argp(lds, AB_W_IN), *w_out = argp(lds, AW_OUT); \
    const float *w_mem_kv = argp(lds, AW_MEM_KV), *mem_g = argp(lds, AMEM_G), *w_gate_up = argp(lds, AW_GATE_UP), *ffn_g = argp(lds, AFFN_G), *w_down = argp(lds, AW_DOWN);
#define WT_DISPATCH(it_) do { int r = (it_); \
    if (r < I11) { wt_job(r, w_gate_up, 5632, 1024, 0, 5632, 64, ffn_g, WGU, 0, 2, scr, lane); break; } r -= I11; \
    if (r < I13) { wt_job(r, w_down, 1024, 2816, 0, 1024, 64, nullptr, WD, 0, 0, scr, lane); break; } r -= I13; \
    if (r < I1) { wt_job(r, a_w_in, 2572, 1024, 0, 2304, 64, attn_g, WA, 0, 0, scr, lane); break; } r -= I1; \
    if (r < I2) { wt_job(r, a_w_in, 2572, 1024, 2316, 256, 64, attn_g, WA, 2304, 0, scr, lane); break; } r -= I2; \
    if (r < IF_) { wt_job(r, a_w_in, 2572, 1024, 2304, 64, 12, attn_g, WA, 2560, 0, scr, lane); break; } r -= IF_; \
    if (r < I7) { wt_job(r, w_out, 1024, 1024, 0, 1024, 64, nullptr, WO, 0, 0, scr, lane); break; } r -= I7; \
    if (r < 2 * I9) { const int l = r / I9; wt_job(r % I9, w_mem_kv + (size_t)l * 1024 * 512, 512, 1024, 0, 512, 64, mem_g + 1024 * l, WM, 512 * l, 0, scr, lane); break; } r -= 2 * I9; \
    if (r < I3) { wt_job(r, w_kv, 1536, 1024, 0, 768, 64, kv_g, WB, 0, 1, scr, lane); break; } r -= I3; \
    if (r < I4) { wt_job(r, w_kv, 1536, 1024, 768, 768, 64, kv_g, WB, 768, 0, scr, lane); break; } r -= I4; \
    if (r < I5) { wt_job(r, b_w_in, 1024, 1024, 0, 768, 64, attn_g + 1024, WB, 1536, 1, scr, lane); break; } r -= I5; \
    if (r < I6) { wt_job(r, b_w_in, 1024, 1024, 768, 256, 64, attn_g + 1024, WB, 2304, 0, scr, lane); break; } r -= I6; \
    if (r < I11) { wt_job(r, w_gate_up + (size_t)1024 * 5632, 5632, 1024, 0, 5632, 64, ffn_g + 1024, WGU + (size_t)5632 * 1024, 0, 2, scr, lane); break; } r -= I11; \
    if (r < I7) { wt_job(r, w_out + (size_t)1024 * 1024, 1024, 1024, 0, 1024, 64, nullptr, WO + (size_t)1024 * 1024, 0, 0, scr, lane); break; } r -= I7; \
    wt_job(r, w_down + (size_t)2816 * 1024, 1024, 2816, 0, 1024, 64, nullptr, WD + (size_t)1024 * 2816, 0, 0, scr, lane); } while (0)
#define WT_IDLE(first, lo, hi) do { const int f_ = (first) < G ? (first) : 0;        \
    if (bx >= f_) { WSPTRS(); PHASE_IDS(); WT_SRCS(); LAS float* scr = (LAS float*)(lds + wave * 16640); \
        for (int it = (lo) + (bx - f_) * 8 + wave; it < (hi); it += (G - f_) * 8) WT_DISPATCH(it); __syncthreads(); } } while (0)

__global__ void __launch_bounds__(512, 2) yoco_fwd(Args A) {
    extern __shared__ __attribute__((aligned(16))) unsigned char lds_raw[];
    LAS unsigned char* lds = (LAS unsigned char*)lds_raw;
#if USE_XB
    if (threadIdx.x < 2) ((volatile LAS unsigned*)(lds + LDS_MISC + 128))[threadIdx.x] = 0u;
    __syncthreads();
    XcdBarrier xbar = xcd_barrier_post((unsigned*)(A.ws + WS_CTL) + CW_BAR, (volatile LAS unsigned*)(lds + LDS_MISC + 128));
#define GRID_SYNC() xcd_barrier(xbar)
#else
    cg::grid_group grid = cg::this_grid();
#define GRID_SYNC() grid.sync()
#endif
    const int G = gridDim.x, bx = blockIdx.x;
    const int wave0 = __builtin_amdgcn_readfirstlane((int)threadIdx.x >> 6);
#define HW_TID() (wave0 * 64 + hw_lane())
#if USE_XB
    xbar.wv = wave0;
#endif
    if (threadIdx.x == 0) {
        LAS unsigned long long* P = (LAS unsigned long long*)(lds + LDS_ARGS);
        P[AX] = (unsigned long long)A.x; P[AMEM] = (unsigned long long)A.mem; P[AATTN_G] = (unsigned long long)A.attn_g; P[AMEM_G] = (unsigned long long)A.mem_g;
        P[AW_MEM_KV] = (unsigned long long)A.w_mem_kv; P[AW_OUT] = (unsigned long long)A.w_out; P[AFFN_G] = (unsigned long long)A.ffn_g; P[AW_GATE_UP] = (unsigned long long)A.w_gate_up;
        P[AW_DOWN] = (unsigned long long)A.w_down; P[AA_W_IN] = (unsigned long long)A.a_w_in; P[AA_B_F] = (unsigned long long)A.a_b_f; P[AB_W_IN] = (unsigned long long)A.b_w_in;
        P[ALQ1] = (unsigned long long)A.lq1; P[ALK1] = (unsigned long long)A.lk1; P[ALQ2] = (unsigned long long)A.lq2; P[ALK2] = (unsigned long long)A.lk2;
        P[ASUBLN_G] = (unsigned long long)A.subln_g; P[AKV_G] = (unsigned long long)A.kv_g; P[AW_KV] = (unsigned long long)A.w_kv; P[AFINAL_G] = (unsigned long long)A.final_g;
        P[AOUT] = (unsigned long long)A.out; P[AWS] = (unsigned long long)A.ws;
    }
    __syncthreads();
#define PHASE_IDS() int tid_ = HW_TID(); asm volatile("" : "+v"(tid_)); const int tid = tid_, lane = tid & 63, wave = __builtin_amdgcn_readfirstlane(tid >> 6); \
    const int gw = bx * 8 + wave, NGW = G * 8, gt = bx * 512 + tid, NGT = G * 512; (void)lane; (void)gw; (void)NGW; (void)gt; (void)NGT;

    for (int rep0_ = 0; rep0_ < NREP0; ++rep0_) {
        WSPTRS(); PHASE_IDS();
        const float *a_w_in = argp(lds, AA_W_IN), *attn_g = argp(lds, AATTN_G), *w_kv = argp(lds, AW_KV), *kv_g = argp(lds, AKV_G), *b_w_in = argp(lds, AB_W_IN), *w_out = argp(lds, AW_OUT);
        const float *w_mem_kv = argp(lds, AW_MEM_KV), *mem_g = argp(lds, AMEM_G), *w_gate_up = argp(lds, AW_GATE_UP), *ffn_g = argp(lds, AFFN_G), *w_down = argp(lds, AW_DOWN);
        const float *xin = argp(lds, AX), *memin = argp(lds, AMEM), *a_b_f = argp(lds, AA_B_F);
#if PREREAD
        {
            float acc_ = 0.f;
#define PRE_(ptr, n) for (int i = gt; i < (n) / 4; i += NGT) { const f32x4 v = ((const f32x4*)(ptr))[i]; acc_ += (v[0] + v[1]) + (v[2] + v[3]); }
            PRE_(w_gate_up, 2 * 1024 * 5632) PRE_(w_down, 2 * 2816 * 1024) PRE_(a_w_in, 1024 * 2572) PRE_(w_kv, 1024 * 1536) PRE_(b_w_in, 1024 * 1024) PRE_(w_out, 2 * 1024 * 1024) PRE_(w_mem_kv, 2 * 1024 * 512)
#undef PRE_
            if (acc_ == 1.2345e38f) ctl[63] = 1u;
        }
#endif
        LAS float* scr = (LAS float*)(lds + wave * 16640);
        {
            constexpr int o_WA = I11 + I13, o_WO0 = o_WA + I1 + I2 + IF_, o_WM = o_WO0 + I7, n0 = I11, n1 = o_WO0 - o_WA, n2 = 2 * I9;
            for (int j = gw; j < n0 + n1 + n2; j += NGW) { const int it = j < n0 ? j : (j < n0 + n1 ? o_WA + (j - n0) : o_WM + (j - n0 - n1)); WT_DISPATCH(it); }
        }
        for (int i = gt; i < 192 * 1024 / 8; i += NGT) ((v4u*)(WA + (size_t)2624 * 1024))[i] = (v4u){0u, 0u, 0u, 0u};
        for (int m = 2 * gw; m < M + MM; m += 2 * NGW) {
            const bool ism = m >= M; const float* src = ism ? memin + (size_t)(m - M) * DM : xin + (size_t)m * DM; bf16* dst = ism ? MEMB + (size_t)(m - M) * DM : XB + (size_t)m * DM; float* sdst = ism ? ssqm + (m - M) : ssq + m;
            const f32x4* xr = (const f32x4*)src + lane; f32x4 v[8]; float s0 = 0.f, s1 = 0.f;
#pragma unroll
            for (int j = 0; j < 8; ++j) v[j] = xr[64 * j];
#pragma unroll
            for (int j = 0; j < 4; ++j) { s0 += (v[j][0] * v[j][0] + v[j][1] * v[j][1]) + (v[j][2] * v[j][2] + v[j][3] * v[j][3]); s1 += (v[4 + j][0] * v[4 + j][0] + v[4 + j][1] * v[4 + j][1]) + (v[4 + j][2] * v[4 + j][2] + v[4 + j][3] * v[4 + j][3]); }
            s0 = wave_sum(s0); s1 = wave_sum(s1);
            if (lane == 0) { sdst[0] = s0; sdst[1] = s1; }
            unsigned long long* o8 = (unsigned long long*)dst + lane;
#pragma unroll
            for (int j = 0; j < 8; ++j) o8[64 * j] = (unsigned long long)pk2(v[j][0], v[j][1]) | ((unsigned long long)pk2(v[j][2], v[j][3]) << 32);
        }
        for (int i = gt; i < SEQ * 32; i += NGT) { const int pos = i >> 5, f = i & 31; const float ang = (float)pos * INV_FREQ[f];
            double rev = (double)ang * 0.15915494309189535; rev -= __builtin_rint(rev);
            COS[i] = __builtin_amdgcn_cosf((float)rev); SIN[i] = __builtin_amdgcn_sinf((float)rev); }
        for (int i = gt; i < 4 * M; i += NGT) ssq[M + i] = 0.f;
        if (gt < 64) ctl[gt] = 0u;
    }
    GRID_SYNC();

#if PH_MASK & (1 << 1)
    {
        WSPTRS(); PHASE_IDS();
        for (int rep_ = 0; rep_ < NREP1; ++rep_) {
        pg8::Gemm g{XB, WA, M, NPROJA, DM}; pg8::StaticOrder S; S.init(M, NPROJA, G, bx);
        pg8::EpiProj E{ssq, COS, SIN, argp(lds, AA_B_F), LF, SEQ, {Qb, 3, 0, 768, C2}, {Kb, 6, 0, 768, 1.f}, {VT, 9, 1, 768, 1.f}, {MQ, 10, 0, 256, C2}, {nullptr, 11, 3, 0, 1.f}};
        pg8::gemm_phase<pg8::EpiProj, pg8::StaticOrder, true, true>(lds, g, S, E, wave0);
        }
    }
    {
        WSPTRS();
        pg8::Gemm g{MEMB, WM, MM, 1024, DM}; pg8::StaticOrder S; S.init(MM, 1024, G, (bx + 64) & 255);
        pg8::EpiProj E{ssqm, COS, SIN, nullptr, nullptr, NMEM, {MK, 1, 0, 256, 1.f}, {MVT, 2, 1, 256, 1.f}, {MK + (size_t)MM * 256, 3, 0, 256, 1.f}, {MVT + (size_t)MM * 256, 4, 1, 256, 1.f}, {nullptr, 5, 0, 0, 1.f}};
        pg8::gemm_phase<pg8::EpiProj, pg8::StaticOrder, true, true>(lds, g, S, E, wave0);
    }
#endif
    WT_IDLE(208, WT_A, WT_A + WT_B1);
    WT_IDLE(208, I11 + I13 + I1 + I2 + IF_, I11 + I13 + I1 + I2 + IF_ + I7);
    GRID_SYNC();

    if (bx < 48) { WSPTRS(); PHASE_IDS(); scan_bh(LF + (size_t)bx * SEQ, (LAS float*)(lds + LDS_MISC + 64), tid); }
    GRID_SYNC();
#if PH_MASK & (1 << 2)
    for (int rep_ = 0; rep_ < NREP2; ++rep_) { WSPTRS(); PHASE_IDS();
    volatile LAS unsigned* qword = (volatile LAS unsigned*)(lds + LDS_MISC);
    bool first_ = true;
    for (;;) {
        if (HW_TID() == 0) qword[0] = first_ ? (unsigned)bx : (unsigned)G + atomicAdd(ctl + 0 + 2 * rep_, 1u);
        first_ = false;
        __syncthreads();
        const int u = (int)qword[0];
        __syncthreads();
        if (u >= 1024) break;
        att::f32x16 o[2];
        if (u < 768) {
            const int qb = 15 - u / 48, bh = u % 48, b = bh / 12, h = bh % 12;
            if (rep_ + 1 < NREP2) att::attn_stream<64, true, true, PVAR>(lds, Qb + (size_t)b * SEQ * 768 + 64 * h, 768, Kb + (size_t)b * SEQ * 768 + 64 * h, 768, VT + (size_t)(b * 768 + 64 * h) * SEQ, SEQ,
                                             LF + (size_t)bh * SEQ, 256 * qb, 2 * (qb + 1), o, wave0);
            else att::attn_stream<64, true, true>(lds, Qb + (size_t)b * SEQ * 768 + 64 * h, 768, Kb + (size_t)b * SEQ * 768 + 64 * h, 768, VT + (size_t)(b * 768 + 64 * h) * SEQ, SEQ,
                                             LF + (size_t)bh * SEQ, 256 * qb, 2 * (qb + 1), o, wave0);
            { const int l2_ = hw_lane(); att::store_o<64>(MIX + (size_t)(b * SEQ + 256 * qb + 32 * wave + (l2_ & 31)) * DM + 64 * h, o, l2_ >> 5); }
        } else {
            const int j = u - 768, b = j >> 6, hm = (j >> 4) & 3, qb = j & 15;
            att::attn_stream<64, false, false>(lds, MQ + (size_t)b * SEQ * 256 + 64 * hm, 256, MK + (size_t)b * NMEM * 256 + 64 * hm, 256, MVT + (size_t)(b * 256 + 64 * hm) * NMEM, NMEM,
                                               nullptr, 256 * qb, 2, o, wave0);
            { const int l2_ = hw_lane(); att::store_o<64>(MIX + (size_t)(b * SEQ + 256 * qb + 32 * wave + (l2_ & 31)) * DM + 768 + 64 * hm, o, l2_ >> 5); }
        }
    } }
#endif
    GRID_SYNC();

#if PH_MASK & (1 << 3)
    for (int rep_ = 0; rep_ < NREP35; ++rep_) {
        WSPTRS(); const float* xin = argp(lds, AX); float* outp = (float*)argp(lds, AOUT);
        pg8::Gemm g{MIX, WO, M, DM, DM}; pg8::StaticOrder S; S.init(M, DM, G, bx);
        pg8::EpiRes E{XB, ssq + M};
        pg8::gemm_phase<pg8::EpiRes, pg8::StaticOrder, true, true>(lds, g, S, E, wave0);
    }
#endif
    GRID_SYNC();
#if PH_MASK & (1 << 4)
    for (int rep_ = 0; rep_ < NREP4; ++rep_) {
        WSPTRS();
        pg8::Gemm g{XB, WGU, M, 2 * DFF, DM}; pg8::StaticOrder S; S.init(M, 2 * DFF, G, bx);
        pg8::EpiGU E{ssq + M, H};
        pg8::gemm_phase<pg8::EpiGU, pg8::StaticOrder, true, true>(lds, g, S, E, wave0);
    }
#endif
    WT_IDLE(128, WT_A + WT_B1, WT_A + WT_B1 + WT_B2);
    WT_IDLE(128, I11, I11 + I13);
    GRID_SYNC();
#if PH_MASK & (1 << 5)
    for (int rep_ = 0; rep_ < NREP35; ++rep_) {
        WSPTRS(); float* outp = (float*)argp(lds, AOUT);
        pg8::Gemm g{H, WD, M, DM, DFF}; pg8::StaticOrder S; S.init(M, DM, G, bx);
        pg8::EpiRes E{XB, ssq + 2 * M};
        pg8::gemm_phase<pg8::EpiRes, pg8::StaticOrder, true, true>(lds, g, S, E, wave0);
    }
#endif
    GRID_SYNC();
#if PH_MASK & (1 << 6)
    for (int rep_ = 0; rep_ < NREPB; ++rep_) {
        WSPTRS();
        pg8::Gemm g{XB, WB, M, NPROJ, DM}; pg8::StaticOrder S; S.init(M, NPROJ, G, bx);
        pg8::EpiProj E{ssq + 2 * M, COS, SIN, nullptr, nullptr, SEQ, {Kb, 3, 2, 768, 1.f}, {VT, 6, 1, 768, 1.f}, {Qb, 9, 2, 768, C2}, {MQ, 10, 0, 256, C2}, {nullptr, 11, 0, 0, 1.f}};
        pg8::gemm_phase<pg8::EpiProj, pg8::StaticOrder, true, true>(lds, g, S, E, wave0);
    }
#endif
    WT_IDLE(128, WT_A + WT_B1 + WT_B2, WT_A + WT_B1 + WT_B2 + WT_B3);
    GRID_SYNC();
#if PH_MASK & (1 << 7)
    {
        WSPTRS(); PHASE_IDS(); const float* subln_g = argp(lds, ASUBLN_G);
        volatile LAS unsigned* qword = (volatile LAS unsigned*)(lds + LDS_MISC);
        float d1 = argp(lds, ALQ1)[lane] * argp(lds, ALK1)[lane], d2 = argp(lds, ALQ2)[lane] * argp(lds, ALK2)[lane];
        d1 = wave_sum(d1); d2 = wave_sum(d2);
        const float lam = __builtin_bit_cast(float, __builtin_amdgcn_readfirstlane(__builtin_bit_cast(int, expf(d1) - expf(d2) + LAMBDA_INIT)));
        bool first_ = true;
        for (int rep_ = 0; rep_ < NREP7; ++rep_)
        for (;;) {
            if (HW_TID() == 0) qword[0] = first_ ? (unsigned)bx : (unsigned)G + atomicAdd(ctl + 1 + 2 * rep_, 1u);
            first_ = false;
            __syncthreads();
            const int u = (int)qword[0];
            __syncthreads();
            if (u >= 1024) break;
            if (u < 768) {
                const int qb = 31 - u / 24, bh = u % 24, b = bh / 6, hd = bh % 6;
                att::attn_diff_unit<SEQ>(lds, Qb + (size_t)b * SEQ * 768 + 128 * hd, Kb + (size_t)b * SEQ * 768 + 128 * hd, VT + (size_t)(b * 768 + 128 * hd) * SEQ, 128 * qb, qb + 1, lam, 1.0f - LAMBDA_INIT,
                                         subln_g, MIX + (size_t)b * SEQ * DM + 128 * hd, wave0);
            } else {
                att::f32x16 o[2];
                const int j = u - 768, b = j >> 6, hm = (j >> 4) & 3, qb = j & 15;
                att::attn_stream<64, false, false>(lds, MQ + (size_t)b * SEQ * 256 + 64 * hm, 256, MK + (size_t)(MM + b * NMEM) * 256 + 64 * hm, 256, MVT + (size_t)(MM + b * 256 + 64 * hm) * NMEM, NMEM,
                                                   nullptr, 256 * qb, 2, o, wave0);
                { const int l2_ = hw_lane(); att::store_o<64>(MIX + (size_t)(b * SEQ + 256 * qb + 32 * wave + (l2_ & 31)) * DM + 768 + 64 * hm, o, l2_ >> 5); }
            }
        }
    }
#endif
    GRID_SYNC();
#if PH_MASK & (1 << 8)
    for (int rep_ = 0; rep_ < NREPB; ++rep_) {
        WSPTRS(); float* outp = (float*)argp(lds, AOUT);
        pg8::Gemm g{MIX, WO + (size_t)1024 * 1024, M, DM, DM}; pg8::StaticOrder S; S.init(M, DM, G, bx);
        pg8::EpiRes E{XB, ssq + 3 * M};
        pg8::gemm_phase<pg8::EpiRes, pg8::StaticOrder, true, true>(lds, g, S, E, wave0);
    }
#endif
    GRID_SYNC();
#if PH_MASK & (1 << 9)
    for (int rep_ = 0; rep_ < NREPB; ++rep_) {
        WSPTRS();
        pg8::Gemm g{XB, WGU + (size_t)5632 * 1024, M, 2 * DFF, DM}; pg8::StaticOrder S; S.init(M, 2 * DFF, G, bx);
        pg8::EpiGU E{ssq + 3 * M, H};
        pg8::gemm_phase<pg8::EpiGU, pg8::StaticOrder, true, true>(lds, g, S, E, wave0);
    }
#endif
    GRID_SYNC();
#if PH_MASK & (1 << 10)
    {
        WSPTRS(); float* outp = (float*)argp(lds, AOUT);
        pg8::Gemm g{H, WD + (size_t)1024 * 2816, M, DM, DFF}; pg8::StaticOrder S; S.init(M, DM, G, bx);
        pg8::EpiResFinal E{XB, outp, ssq + 4 * M, ctl + 8192, argp(lds, AFINAL_G)};
        pg8::gemm_phase<pg8::EpiResFinal, pg8::StaticOrder, true, true>(lds, g, S, E, wave0);
    }
#endif
}

extern "C" void kernel_launch(void* const* d_in, const int* in_sizes, int n_in, void* d_out, int out_size, void* d_ws, size_t ws_size, hipStream_t stream) {
    static int grid = 0;
    if (grid == 0) {
        if (n_in != 20 || out_size != M * DM || ws_size < WS_END) { fprintf(stderr, "kernel_launch: unexpected sizes n_in %d out %d ws %zu\n", n_in, out_size, ws_size); grid = -1; return; }
        int dev = 0, cus = 0, per_cu = 0;
        (void)hipGetDevice(&dev); (void)hipDeviceGetAttribute(&cus, hipDeviceAttributeMultiprocessorCount, dev);
        (void)hipFuncSetAttribute((const void*)yoco_fwd, hipFuncAttributeMaxDynamicSharedMemorySize, LDS_BYTES);
        (void)hipOccupancyMaxActiveBlocksPerMultiprocessor(&per_cu, (const void*)yoco_fwd, 512, LDS_BYTES);
        if (per_cu < 1) { fprintf(stderr, "kernel_launch: occupancy query says %d blocks per CU; the grid barrier needs every workgroup resident: nothing launched\n", per_cu); grid = -1; return; }
        grid = cus;
        if (grid != 256) fprintf(stderr, "kernel_launch: %d CUs (expected 256)\n", grid);
    }
    if (grid < 0) return;
    Args a{};
    const float** p = (const float**)&a;
    for (int i = 0; i < 20; ++i) p[i] = (const float*)d_in[i];
    a.out = (float*)d_out; a.ws = (unsigned char*)d_ws;
    void* args[] = {&a};
#if USE_XB
    (void)hipMemsetAsync((char*)d_ws + WS_CTL, 0, 65536, stream);
    hipLaunchKernelGGL(yoco_fwd, dim3(grid), dim3(512), LDS_BYTES, stream, a);
    (void)args;
#else
    hipError_t e = hipLaunchCooperativeKernel((const void*)yoco_fwd, dim3(grid), dim3(512), args, LDS_BYTES, stream);
    if (e != hipSuccess) fprintf(stderr, "cooperative launch failed: %s (grid %d)\n", hipGetErrorString(e), grid);
#endif
}
```

```cpp
#include <hip/hip_runtime.h>
#include <hip/hip_cooperative_groups.h>
#include <cstdio>
#include <cstdint>
__device__ __forceinline__ int hw_lane() { unsigned z = 0u; asm volatile("" : "+v"(z)); return (int)__builtin_amdgcn_mbcnt_hi(~0u, __builtin_amdgcn_mbcnt_lo(~0u, z)); }
namespace pg8 {
#define PG8_LAS __attribute__((address_space(3)))
typedef unsigned short bf16_t;
typedef short bf16x8 __attribute__((ext_vector_type(8)));
typedef float f32x4 __attribute__((ext_vector_type(4)));
typedef unsigned u32x4 __attribute__((ext_vector_type(4)));
constexpr int BM = 256, BK = 64, HALF = 128, HTB = HALF * BK * 2  , STAGE_BYTES = 8 * HTB, NXCD = 8, WGM = 8;

__host__ __device__ __forceinline__ int lds_byte(int r, int c) { const int st = (r >> 4) * 2 + (c >> 5), rr = r & 15, cc = c & 31, ob = rr * 64 + cc * 2; return st * 1024 + (ob ^ (((ob >> 9) & 1) << 5)); }
__host__ __device__ __forceinline__ void stage_rc(int b, int& R, int& C) { const int st = b / 1024, sb = b % 1024, swz = sb ^ (((sb >> 9) & 1) << 5); R = (st >> 1) * 16 + swz / 64; C = (st & 1) * 32 + (swz % 64) / 2; }
__host__ __device__ __forceinline__ int perm32(int rho) { const int n = rho >> 4, i = rho & 15; return 8 * (i >> 2) + 4 * n + (i & 3); }

struct Unit { int pm, pn; };
struct Gemm { const bf16_t* A; const bf16_t* Bt; int M, N, K; };

struct StaticOrder {
    int nM, nN, nwg, G, c;
    __host__ __device__ void init(int M, int N, int G_, int c_) { nM = M / BM; nN = N / BM; nwg = nM * nN; G = G_; c = c_; }
    __host__ __device__ bool next(int i, Unit& u) const {
        const long L = (long)i * G + c; if (L >= nwg) return false;
        int wgid = (int)L; { const int q = nwg / NXCD, r = nwg % NXCD, xcd = wgid % NXCD, off = wgid / NXCD; wgid = (xcd < r ? xcd * (q + 1) : r * (q + 1) + (xcd - r) * q) + off; }
        const int nig = WGM * nN, gid = wgid / nig, fm = gid * WGM, gsz = (nM - fm) < WGM ? (nM - fm) : WGM;
        u.pm = fm + ((wgid % nig) % gsz); u.pn = (wgid % nig) / gsz; return true;
    }
    __device__ __forceinline__ void a_ready(const Unit&) const {}
    __device__ __forceinline__ void done(const Unit&) const {}
};

__device__ __forceinline__ unsigned cvt_pk_bf16(float lo, float hi) { unsigned r; asm volatile("v_cvt_pk_bf16_f32 %0, %1, %2" : "=v"(r) : "v"(lo), "v"(hi)); return r; }
typedef float f32x2 __attribute__((ext_vector_type(2)));
typedef unsigned u32x2 __attribute__((ext_vector_type(2)));
struct Seg { bf16_t* dst; int pn_end; int kind; int pitch; float scale; };
struct EpiProj {
    static constexpr bool PERM = true, AFTER_DRAIN = false;
    const float* ssq; const float* cs; const float* sn; const float* bf; float* lf; int S; Seg s0, s1, s2, s3, s4;
    __device__ __forceinline__ void operator()(const f32x4 (&acc)[2][2][4][2], const Unit& u, int wr, int wc, int fr, int fq) const {
        Seg g = s4; int pn0 = s3.pn_end;
        if (u.pn < s0.pn_end) { g = s0; pn0 = 0; } else if (u.pn < s1.pn_end) { g = s1; pn0 = s0.pn_end; } else if (u.pn < s2.pn_end) { g = s2; pn0 = s1.pn_end; } else if (u.pn < s3.pn_end) { g = s3; pn0 = s2.pn_end; }
        const int ct = (u.pn - pn0) * BM;
        const int lane = fq * 16 + fr; const int ssh = 31 - __builtin_clz(S);
        float sq8[8];
#pragma unroll
        for (int i = 0; i < 8; ++i) sq8[i] = ssq[u.pm * BM + (i >> 2) * HALF + wr * 64 + (i & 3) * 16 + fr];
#pragma unroll
        for (int am = 0; am < 4; ++am) {
            const int ai = am >> 1;
            f32x4 tc[2][2], tn[2][2];
            if (g.kind == 2) {
#pragma unroll
                for (int mm = 0; mm < 2; ++mm) { const int pos = (u.pm * BM + ai * HALF + wr * 64 + ((am & 1) * 2 + mm) * 16 + fr) & (S - 1); const float* cp = cs + pos * 32 + 8 * fq; const float* sp = sn + pos * 32 + 8 * fq;
                    tc[mm][0] = *(const f32x4*)cp; tc[mm][1] = *(const f32x4*)(cp + 4); tn[mm][0] = *(const f32x4*)sp; tn[mm][1] = *(const f32x4*)(sp + 4); }
                asm volatile("" ::: "memory");
            }
#pragma unroll
            for (int mm = 0; mm < 2; ++mm) {
                const int m = (am & 1) * 2 + mm;
                const int row = u.pm * BM + ai * HALF + wr * 64 + m * 16 + fr;
                const float rs = __builtin_amdgcn_rsqf(sq8[ai * 4 + m] * (1.0f / 1024.0f) + 1e-6f) * g.scale;
                if (g.kind == 0) {
#pragma unroll
                    for (int bj = 0; bj < 2; ++bj) { const f32x4 v0 = acc[ai][bj][m][0] * rs, v1 = acc[ai][bj][m][1] * rs;
                        u32x4 w; w.x = cvt_pk_bf16(v0[0], v0[1]); w.y = cvt_pk_bf16(v0[2], v0[3]); w.z = cvt_pk_bf16(v1[0], v1[1]); w.w = cvt_pk_bf16(v1[2], v1[3]);
                        *(u32x4*)(g.dst + (size_t)row * g.pitch + ct + bj * HALF + wc * 32 + 8 * fq) = w; }
                } else if (g.kind == 1) {
                    const int b = row >> ssh, s = row & (S - 1); const bool odd = (fr & 1) != 0;
#pragma unroll
                    for (int bj = 0; bj < 2; ++bj) { const f32x4 v0 = acc[ai][bj][m][0] * rs, v1 = acc[ai][bj][m][1] * rs;
                        const int cb = ct + bj * HALF + wc * 32 + 8 * fq + (odd ? 4 : 0);
#pragma unroll
                        for (int j = 0; j < 4; ++j) { const float snd = odd ? v0[j] : v1[j]; const float rcv = __shfl_xor(snd, 1);
                            const float lo = odd ? rcv : v0[j], hi = odd ? v1[j] : rcv;
                            *(unsigned*)(g.dst + ((size_t)b * g.pitch + cb + j) * S + (s & ~1)) = cvt_pk_bf16(lo, hi); } }
                } else if (g.kind == 3) {
                    if (wc == 0 && fq < 2) { const int b = row >> ssh, s = row & (S - 1);
#pragma unroll
                        for (int n = 0; n < 2; ++n)
#pragma unroll
                            for (int e2 = 0; e2 < 4; ++e2) { const int c = 8 * fq + 4 * n + e2;
                                if (c < 12) { const float z = acc[ai][0][m][n][e2] * rs + bf[c]; lf[((size_t)b * 12 + c) * S + s] = fminf(z, 0.f) - 0.6931471805599453f * __builtin_amdgcn_logf(1.0f + __builtin_amdgcn_exp2f(-1.4426950408889634f * fabsf(z))); } } }
                } else {
                    const f32x4 c0 = tc[mm][0], c1 = tc[mm][1], n0 = tn[mm][0], n1 = tn[mm][1];
                    const f32x4 a0 = acc[ai][0][m][0] * rs, a1 = acc[ai][0][m][1] * rs, b0 = acc[ai][1][m][0] * rs, b1 = acc[ai][1][m][1] * rs;
                    const f32x4 x0 = a0 * c0 - b0 * n0, x1 = a1 * c1 - b1 * n1, y0 = a0 * n0 + b0 * c0, y1 = a1 * n1 + b1 * c1;
                    bf16_t* p = g.dst + (size_t)row * g.pitch + ct + wc * 64 + 8 * fq;
                    u32x4 w; w.x = cvt_pk_bf16(x0[0], x0[1]); w.y = cvt_pk_bf16(x0[2], x0[3]); w.z = cvt_pk_bf16(x1[0], x1[1]); w.w = cvt_pk_bf16(x1[2], x1[3]);
                    *(u32x4*)p = w;
                    w.x = cvt_pk_bf16(y0[0], y0[1]); w.y = cvt_pk_bf16(y0[2], y0[3]); w.z = cvt_pk_bf16(y1[0], y1[1]); w.w = cvt_pk_bf16(y1[2], y1[3]);
                    *(u32x4*)(p + 32) = w;
                }
            }
        }
        (void)lane;
    }
};
struct EpiRes {
    static constexpr bool PERM = true, AFTER_DRAIN = false;
    bf16_t* xb; float* ssq_out;
    __device__ __forceinline__ void operator()(const f32x4 (&acc)[2][2][4][2], const Unit& u, int wr, int wc, int fr, int fq) const {
#pragma unroll
        for (int ai = 0; ai < 2; ++ai) {
            u32x4 xr[4][2];
#pragma unroll
            for (int m = 0; m < 4; ++m)
#pragma unroll
                for (int bj = 0; bj < 2; ++bj) xr[m][bj] = *(const u32x4*)(xb + (size_t)(u.pm * BM + ai * HALF + wr * 64 + m * 16 + fr) * 1024 + u.pn * BM + bj * HALF + wc * 32 + 8 * fq);
            asm volatile("" ::: "memory");
#pragma unroll
            for (int m = 0; m < 4; ++m) {
                const int row = u.pm * BM + ai * HALF + wr * 64 + m * 16 + fr; float sq = 0.f;
#pragma unroll
                for (int bj = 0; bj < 2; ++bj) { const size_t off = (size_t)row * 1024 + u.pn * BM + bj * HALF + wc * 32 + 8 * fq; const u32x4 x = xr[m][bj];
                    const f32x4 v0 = (f32x4){__uint_as_float(x.x << 16), __uint_as_float(x.x & 0xffff0000u), __uint_as_float(x.y << 16), __uint_as_float(x.y & 0xffff0000u)} + acc[ai][bj][m][0];
                    const f32x4 v1 = (f32x4){__uint_as_float(x.z << 16), __uint_as_float(x.z & 0xffff0000u), __uint_as_float(x.w << 16), __uint_as_float(x.w & 0xffff0000u)} + acc[ai][bj][m][1];
                    u32x4 w; w.x = cvt_pk_bf16(v0[0], v0[1]); w.y = cvt_pk_bf16(v0[2], v0[3]); w.z = cvt_pk_bf16(v1[0], v1[1]); w.w = cvt_pk_bf16(v1[2], v1[3]);
                    *(u32x4*)(xb + off) = w;
                    sq += (v0[0] * v0[0] + v0[1] * v0[1]) + (v0[2] * v0[2] + v0[3] * v0[3]) + (v1[0] * v1[0] + v1[1] * v1[1]) + (v1[2] * v1[2] + v1[3] * v1[3]); }
                sq += __shfl_xor(sq, 16); sq += __shfl_xor(sq, 32);
                if (fq == 0) atomicAdd(ssq_out + row, sq);
            }
            asm volatile("" ::: "memory");
        }
    }
};
struct EpiResFinal {
    static constexpr bool PERM = true, AFTER_DRAIN = false;
    const bf16_t* xb; float* out; float* ssq; unsigned* cnt; const float* g;
    __device__ __forceinline__ void operator()(f32x4 (&acc)[2][2][4][2], const Unit& u, int wr, int wc, int fr, int fq) const {
        const int col0 = u.pn * BM + wc * 32 + 8 * fq;
#pragma unroll
        for (int ai = 0; ai < 2; ++ai) {
            u32x4 xr[4][2];
#pragma unroll
            for (int m = 0; m < 4; ++m)
#pragma unroll
                for (int bj = 0; bj < 2; ++bj) xr[m][bj] = *(const u32x4*)(xb + (size_t)(u.pm * BM + ai * HALF + wr * 64 + m * 16 + fr) * 1024 + col0 + bj * HALF);
            asm volatile("" ::: "memory");
#pragma unroll
            for (int m = 0; m < 4; ++m) {
                const int row = u.pm * BM + ai * HALF + wr * 64 + m * 16 + fr; float sq = 0.f;
#pragma unroll
                for (int bj = 0; bj < 2; ++bj) { const u32x4 x = xr[m][bj];
                    const f32x4 v0 = (f32x4){__uint_as_float(x.x << 16), __uint_as_float(x.x & 0xffff0000u), __uint_as_float(x.y << 16), __uint_as_float(x.y & 0xffff0000u)} + acc[ai][bj][m][0];
                    const f32x4 v1 = (f32x4){__uint_as_float(x.z << 16), __uint_as_float(x.z & 0xffff0000u), __uint_as_float(x.w << 16), __uint_as_float(x.w & 0xffff0000u)} + acc[ai][bj][m][1];
                    acc[ai][bj][m][0] = v0; acc[ai][bj][m][1] = v1;
                    sq += (v0[0] * v0[0] + v0[1] * v0[1]) + (v0[2] * v0[2] + v0[3] * v0[3]) + (v1[0] * v1[0] + v1[1] * v1[1]) + (v1[2] * v1[2] + v1[3] * v1[3]); }
                sq += __shfl_xor(sq, 16); sq += __shfl_xor(sq, 32);
                if (fq == 0) (void)__hip_atomic_fetch_add(ssq + row, sq, __ATOMIC_RELAXED, __HIP_MEMORY_SCOPE_AGENT);
            }
        }
        asm volatile("s_waitcnt vmcnt(0)" ::: "memory");
        unsigned* pc = cnt + 64 * u.pm;
        if (fr == 0 && fq == 0) (void)__hip_atomic_fetch_add(pc, 1u, __ATOMIC_RELAXED, __HIP_MEMORY_SCOPE_AGENT);
        for (unsigned it = 0; it < (1u << 22); ++it) {
            if ((unsigned)__builtin_amdgcn_readfirstlane((int)__hip_atomic_load(pc, __ATOMIC_RELAXED, __HIP_MEMORY_SCOPE_AGENT)) >= 32u) break;
            __builtin_amdgcn_s_sleep(2);
        }
        __builtin_amdgcn_fence(__ATOMIC_ACQUIRE, "agent");
        f32x4 gv[2][2];
#pragma unroll
        for (int bj = 0; bj < 2; ++bj) { gv[bj][0] = *(const f32x4*)(g + col0 + bj * HALF); gv[bj][1] = *(const f32x4*)(g + col0 + bj * HALF + 4); }
        float rs8[8];
#pragma unroll
        for (int i = 0; i < 8; ++i) { const unsigned sb = __hip_atomic_load((const unsigned*)(ssq + u.pm * BM + (i >> 2) * HALF + wr * 64 + (i & 3) * 16 + fr), __ATOMIC_RELAXED, __HIP_MEMORY_SCOPE_AGENT);
            rs8[i] = __builtin_amdgcn_rsqf(__uint_as_float(sb) * (1.0f / 1024.0f) + 1e-6f); }
#pragma unroll
        for (int ai = 0; ai < 2; ++ai)
#pragma unroll
            for (int m = 0; m < 4; ++m) { const float rs = rs8[ai * 4 + m];
#pragma unroll
                for (int bj = 0; bj < 2; ++bj) { const size_t off = (size_t)(u.pm * BM + ai * HALF + wr * 64 + m * 16 + fr) * 1024 + col0 + bj * HALF;
                    *(f32x4*)(out + off) = acc[ai][bj][m][0] * rs * gv[bj][0]; *(f32x4*)(out + off + 4) = acc[ai][bj][m][1] * rs * gv[bj][1]; } }
    }
};
struct EpiGU {
    static constexpr bool PERM = true, AFTER_DRAIN = false;
    const float* ssq; bf16_t* H;
    __device__ __forceinline__ void operator()(const f32x4 (&acc)[2][2][4][2], const Unit& u, int wr, int wc, int fr, int fq) const {
        float sq8[8];
#pragma unroll
        for (int i = 0; i < 8; ++i) sq8[i] = ssq[u.pm * BM + (i >> 2) * HALF + wr * 64 + (i & 3) * 16 + fr];
#pragma unroll
        for (int ai = 0; ai < 2; ++ai)
#pragma unroll
            for (int m = 0; m < 4; ++m) {
                const int row = u.pm * BM + ai * HALF + wr * 64 + m * 16 + fr;
                const float rs = __builtin_amdgcn_rsqf(sq8[ai * 4 + m] * (1.0f / 1024.0f) + 1e-6f);
                float hv[8];
#pragma unroll
                for (int n = 0; n < 2; ++n)
#pragma unroll
                    for (int e = 0; e < 4; ++e) { const float gg = acc[ai][0][m][n][e] * rs, uu = acc[ai][1][m][n][e] * rs;
                        hv[n * 4 + e] = gg * uu * __builtin_amdgcn_rcpf(1.0f + __builtin_amdgcn_exp2f(-1.4426950408889634f * gg)); }
                u32x4 w; w.x = cvt_pk_bf16(hv[0], hv[1]); w.y = cvt_pk_bf16(hv[2], hv[3]); w.z = cvt_pk_bf16(hv[4], hv[5]); w.w = cvt_pk_bf16(hv[6], hv[7]);
                *(u32x4*)(H + (size_t)row * 2816 + u.pn * HALF + wc * 32 + 8 * fq) = w;
            }
    }
};
template <class Epi, class Sched, bool ALIGN_EPI = false, bool SP2 = false>
__device__ __forceinline__ void gemm_phase(PG8_LAS unsigned char* lds, const Gemm g, const Sched& S, const Epi& E, const int wv) {
    int tid_ = wv * 64 + hw_lane(); asm volatile("" : "+v"(tid_));
    const int tid = tid_, wid = __builtin_amdgcn_readfirstlane(tid >> 6), lane = tid & 63, wr = wid >> 2, wc = wid & 3, fr = lane & 15, fq = lane >> 4;
    const int K = g.K, nt = K / BK;
    unsigned voffA[2], voffB[2];
#pragma unroll
    for (int i = 0; i < 2; ++i) { int R, C; stage_rc(tid * 16 + i * 8192, R, C); const int Rb = Epi::PERM ? ((R & ~31) + perm32(R & 31)) : R;
        voffA[i] = (unsigned)(R * K + C) * 2u; voffB[i] = (unsigned)(Rb * K + C) * 2u; }
    const size_t kstep = (size_t)(BK * 2);
    const size_t hstep = (size_t)HALF * K * 2;
    const size_t tstep = 2 * hstep;
    const unsigned ldsw = (unsigned)wid * 1024u;
    const int aoff = lds_byte(wr * 64 + fr, fq * 8), boff = lds_byte(wc * 32 + fr, fq * 8);
#define PG8_SA(b, h) (((b) * 2 + (h)) * HTB)
#define PG8_SB(b, h) ((4 + (b) * 2 + (h)) * HTB)
#define PG8_STAGE(bufoff, gbase, voff) do { _Pragma("unroll") for (int _i = 0; _i < 2; ++_i) \
        __builtin_amdgcn_global_load_lds((const unsigned*)((const char*)(gbase) + (voff)[_i]), (PG8_LAS unsigned*)(lds + (bufoff) + ldsw + _i * 8192), 16, 0, 0); } while (0)
#define PG8_LDA(dst, b, h) do { _Pragma("unroll") for (int m = 0; m < 4; ++m) _Pragma("unroll") for (int k = 0; k < 2; ++k) dst[m][k] = *(const PG8_LAS bf16x8*)(lds + PG8_SA(b, h) + aoff + m * 2048 + k * 1024); } while (0)
#define PG8_LDB(dst, b, h) do { _Pragma("unroll") for (int n = 0; n < 2; ++n) _Pragma("unroll") for (int k = 0; k < 2; ++k) dst[n][k] = *(const PG8_LAS bf16x8*)(lds + PG8_SB(b, h) + boff + n * 2048 + k * 1024); } while (0)
#define PG8_MMA(ai, bj, At, Bt) do { __builtin_amdgcn_s_setprio(1); _Pragma("unroll") for (int m = 0; m < 4; ++m) _Pragma("unroll") for (int n = 0; n < 2; ++n) _Pragma("unroll") for (int k = 0; k < 2; ++k) \
        acc[ai][bj][m][n] = __builtin_amdgcn_mfma_f32_16x16x32_bf16(Bt[n][k], At[m][k], acc[ai][bj][m][n], 0, 0, 0); __builtin_amdgcn_s_setprio(0); } while (0)
#define PG8_WAIT_V(n) asm volatile("s_waitcnt vmcnt(" #n ")" ::: "memory")
#define PG8_WAIT_L(n) asm volatile("s_waitcnt lgkmcnt(" #n ")" ::: "memory")
#define PG8_BAR __builtin_amdgcn_s_barrier()
#define PG8_SCHED __builtin_amdgcn_sched_barrier(0)
    Unit cur, nxt; int ui = 0;
    if (!S.next(0, cur)) return;
    f32x4 acc[2][2][4][2];
#pragma unroll
    for (int a = 0; a < 2; ++a)
#pragma unroll
        for (int b = 0; b < 2; ++b)
#pragma unroll
            for (int m = 0; m < 4; ++m)
#pragma unroll
                for (int n = 0; n < 2; ++n) acc[a][b][m][n] = (f32x4){0.f, 0.f, 0.f, 0.f};
    bf16x8 At[4][2], B0[2][2], B1[2][2];
    const char* cA = (const char*)g.A + (size_t)cur.pm * tstep; const char* cB = (const char*)g.Bt + (size_t)cur.pn * tstep;
    S.a_ready(cur);
    if constexpr (SP2) {
        PG8_STAGE(PG8_SB(0, 0), cB, voffB); PG8_STAGE(PG8_SB(0, 1), cB + hstep, voffB); PG8_STAGE(PG8_SA(0, 0), cA, voffA); PG8_STAGE(PG8_SA(0, 1), cA + hstep, voffA);
        if (wr == 1) PG8_BAR;
        PG8_WAIT_V(2); PG8_BAR;
        PG8_STAGE(PG8_SB(1, 0), cB + kstep, voffB); PG8_STAGE(PG8_SA(1, 0), cA + kstep, voffA); PG8_STAGE(PG8_SB(1, 1), cB + hstep + kstep, voffB);
        PG8_WAIT_V(6); PG8_BAR;
    } else {
        PG8_STAGE(PG8_SB(0, 0), cB, voffB); PG8_STAGE(PG8_SA(0, 0), cA, voffA); PG8_STAGE(PG8_SB(0, 1), cB + hstep, voffB); PG8_STAGE(PG8_SA(0, 1), cA + hstep, voffA);
        if (wr == 1) PG8_BAR;
        PG8_WAIT_V(4); PG8_BAR;
        PG8_STAGE(PG8_SB(1, 0), cB + kstep, voffB); PG8_STAGE(PG8_SA(1, 0), cA + kstep, voffA); PG8_STAGE(PG8_SB(1, 1), cB + hstep + kstep, voffB);
        PG8_WAIT_V(6); PG8_BAR;
    }
    for (;;) {
        const bool has_next = S.next(ui + 1, nxt);
        const char* nA = has_next ? (const char*)g.A + (size_t)nxt.pm * tstep : cA; const char* nB = has_next ? (const char*)g.Bt + (size_t)nxt.pn * tstep : cB;
        for (int t = 0; t < nt; t += 2) {
            const bool last = (t == nt - 2);
            const char* a1 = cA + (size_t)(t + 1) * kstep;
            const char* a2 = last ? nA : cA + (size_t)(t + 2) * kstep; const char* b2 = last ? nB : cB + (size_t)(t + 2) * kstep;
            const char* a3 = a2 + kstep; const char* b3 = b2 + kstep;
            if (last && has_next) S.a_ready(nxt);
            if constexpr (SP2) {
            PG8_LDB(B0, 0, 0); PG8_LDB(B1, 0, 1); PG8_SCHED; PG8_LDA(At, 0, 0); PG8_STAGE(PG8_SA(1, 1), a1 + hstep, voffA);
            PG8_WAIT_V(8); PG8_WAIT_L(0); PG8_BAR; PG8_MMA(0, 0, At, B0); PG8_MMA(0, 1, At, B1); PG8_BAR; PG8_SCHED;
            PG8_LDA(At, 0, 1); PG8_STAGE(PG8_SB(0, 0), b2, voffB); PG8_STAGE(PG8_SB(0, 1), b2 + hstep, voffB); PG8_STAGE(PG8_SA(0, 0), a2, voffA);
            PG8_WAIT_V(8); PG8_WAIT_L(0); PG8_BAR; PG8_MMA(1, 0, At, B0); PG8_MMA(1, 1, At, B1); PG8_BAR; PG8_SCHED;
            PG8_LDB(B0, 1, 0); PG8_LDB(B1, 1, 1); PG8_SCHED; PG8_LDA(At, 1, 0); PG8_STAGE(PG8_SA(0, 1), a2 + hstep, voffA);
            PG8_WAIT_V(8); PG8_WAIT_L(0); PG8_BAR; PG8_MMA(0, 0, At, B0); PG8_MMA(0, 1, At, B1); PG8_BAR; PG8_SCHED;
            PG8_LDA(At, 1, 1); PG8_STAGE(PG8_SB(1, 0), b3, voffB); PG8_STAGE(PG8_SB(1, 1), b3 + hstep, voffB); PG8_STAGE(PG8_SA(1, 0), a3, voffA);
            PG8_WAIT_V(8); PG8_WAIT_L(0); PG8_BAR; PG8_MMA(1, 0, At, B0); PG8_MMA(1, 1, At, B1); PG8_BAR; PG8_SCHED;
            } else {
            PG8_LDB(B0, 0, 0); PG8_SCHED; PG8_LDA(At, 0, 0); PG8_STAGE(PG8_SA(1, 1), a1 + hstep, voffA);
            PG8_WAIT_L(8); PG8_BAR; PG8_WAIT_L(0); PG8_MMA(0, 0, At, B0); PG8_BAR; PG8_SCHED;
            PG8_LDB(B1, 0, 1); PG8_STAGE(PG8_SB(0, 0), b2, voffB);
            PG8_BAR; PG8_WAIT_L(0); PG8_MMA(0, 1, At, B1); PG8_BAR;
            PG8_LDA(At, 0, 1); PG8_STAGE(PG8_SA(0, 0), a2, voffA);
            PG8_BAR; PG8_WAIT_L(0); PG8_MMA(1, 0, At, B0); PG8_BAR; PG8_SCHED;
            PG8_STAGE(PG8_SB(0, 1), b2 + hstep, voffB);
            PG8_WAIT_V(6); PG8_BAR; PG8_MMA(1, 1, At, B1); PG8_BAR;
            PG8_LDB(B0, 1, 0); PG8_SCHED; PG8_LDA(At, 1, 0); PG8_STAGE(PG8_SA(0, 1), a2 + hstep, voffA);
            PG8_WAIT_L(8); PG8_BAR; PG8_WAIT_L(0); PG8_MMA(0, 0, At, B0); PG8_BAR; PG8_SCHED;
            PG8_LDB(B1, 1, 1); PG8_STAGE(PG8_SB(1, 0), b3, voffB);
            PG8_BAR; PG8_WAIT_L(0); PG8_MMA(0, 1, At, B1); PG8_BAR;
            PG8_LDA(At, 1, 1); PG8_STAGE(PG8_SA(1, 0), a3, voffA);
            PG8_BAR; PG8_WAIT_L(0); PG8_MMA(1, 0, At, B0); PG8_BAR; PG8_SCHED;
            PG8_STAGE(PG8_SB(1, 1), b3 + hstep, voffB);
            PG8_WAIT_V(6); PG8_BAR; PG8_MMA(1, 1, At, B1); PG8_BAR;
            }
        }
        if constexpr (ALIGN_EPI) { if (wr == 0) PG8_BAR; }
        if constexpr (!Epi::AFTER_DRAIN) { E(acc, cur, wr, wc, fr, fq); S.done(cur); }
        if (!has_next) break;
#pragma unroll
        for (int a = 0; a < 2; ++a)
#pragma unroll
            for (int b = 0; b < 2; ++b)
#pragma unroll
                for (int m = 0; m < 4; ++m)
#pragma unroll
                    for (int n = 0; n < 2; ++n) acc[a][b][m][n] = (f32x4){0.f, 0.f, 0.f, 0.f};
        cur = nxt; cA = nA; cB = nB; ++ui;
        if constexpr (ALIGN_EPI) { if (wr == 1) PG8_BAR; }
    }
    PG8_WAIT_V(0);
    if constexpr (!ALIGN_EPI) { if (wr == 0) PG8_BAR; }
    PG8_BAR;
    if constexpr (Epi::AFTER_DRAIN) { E.fused(acc, cur, wr, wc, fr, fq, lds, wid, lane); S.done(cur); }
#undef PG8_SA
#undef PG8_SB
#undef PG8_STAGE
#undef PG8_LDA
#undef PG8_LDB
#undef PG8_MMA
#undef PG8_WAIT_V
#undef PG8_WAIT_L
#undef PG8_BAR
#undef PG8_SCHED
}
}
namespace att {
#define LAS __attribute__((address_space(3)))
typedef unsigned short bf16_t;
typedef short bf16x8 __attribute__((ext_vector_type(8)));
typedef short s16x4 __attribute__((ext_vector_type(4)));
typedef float f32x16 __attribute__((ext_vector_type(16)));
typedef float f32x4 __attribute__((ext_vector_type(4)));
typedef unsigned u32x4 __attribute__((ext_vector_type(4)));
typedef unsigned u32x2 __attribute__((ext_vector_type(2)));
constexpr int KP = 144, VP = 264;
constexpr int KBUF = 128 * KP, VBUF = 128 * VP;
constexpr int OFF_K = 0, OFF_V = 2 * KBUF, OFF_B = OFF_V + 2 * VBUF, ATT_LDS = OFF_B + 1024;
#ifndef PIPE128
#define PIPE128 0
#endif
constexpr float RESC_THR = 60.f;
typedef float f32x2_t __attribute__((ext_vector_type(2))); typedef __bf16 bf16x2_t __attribute__((ext_vector_type(2)));
__device__ __forceinline__ unsigned cvtpk(float lo, float hi) { f32x2_t v = {lo, hi}; bf16x2_t b = __builtin_convertvector(v, bf16x2_t); return __builtin_bit_cast(unsigned, b); }
__device__ __forceinline__ float max3f(float a, float b, float c) { float r; asm("v_max3_f32 %0, %1, %2, %3" : "=v"(r) : "v"(a), "v"(b), "v"(c)); return r; }
__device__ __forceinline__ float xhalf_max(float m) { auto rr = __builtin_amdgcn_permlane32_swap(__float_as_uint(m), __float_as_uint(m), false, false); return fmaxf(__uint_as_float(rr[0]), __uint_as_float(rr[1])); }
__device__ __forceinline__ float xhalf_sum(float m) { auto rr = __builtin_amdgcn_permlane32_swap(__float_as_uint(m), __float_as_uint(m), false, false); return __uint_as_float(rr[0]) + __uint_as_float(rr[1]); }

typedef float f32x2v __attribute__((ext_vector_type(2)));
__device__ __forceinline__ void exp_sum_pk(f32x16& P0, f32x16& P1, float m, float& lrow) {
    const f32x2v mv = {m, m}; f32x2v s0 = {0.f, 0.f}, s1 = {0.f, 0.f};
#pragma unroll
    for (int r = 0; r < 16; r += 2) {
        f32x2v a = (f32x2v){P0[r], P0[r + 1]} - mv, b = (f32x2v){P1[r], P1[r + 1]} - mv;
        a.x = __builtin_amdgcn_exp2f(a.x); a.y = __builtin_amdgcn_exp2f(a.y); b.x = __builtin_amdgcn_exp2f(b.x); b.y = __builtin_amdgcn_exp2f(b.y);
        P0[r] = a.x; P0[r + 1] = a.y; P1[r] = b.x; P1[r + 1] = b.y; s0 += a; s1 += b;
    }
    s0 += s1; lrow += s0.x + s0.y;
}
template <int DV, bool CAUSAL, bool BIAS, int VAR = 0>
__device__ __forceinline__ void attn_stream(LAS unsigned char* lds, const bf16_t* Qg, int qpitch, const bf16_t* Kg, int kpitch, const bf16_t* Vtg, int vpitch,
                                            const float* bias, int q0, int ntiles, f32x16 (&o)[DV / 32], const int wv) {
    int tid_ = wv * 64 + hw_lane(); asm volatile("" : "+v"(tid_));
    const int tid = tid_, lane = tid & 63, r32 = lane & 31, hi = lane >> 5, w = __builtin_amdgcn_readfirstlane(tid >> 6);
    constexpr int NV = DV / 32;
    bf16x8 qf[4];
#pragma unroll
    for (int d0 = 0; d0 < 4; ++d0) qf[d0] = *(const bf16x8*)(Qg + (size_t)(q0 + 32 * w + r32) * qpitch + 16 * d0 + 8 * hi);
    const int krow = tid >> 3, kch = tid & 7, vrow = tid >> 4, vch = tid & 15;
    const bf16_t* ksrc = Kg + (size_t)krow * kpitch + kch * 8;
    const bf16_t* vsrc = Vtg + (size_t)vrow * vpitch + vch * 8;
    const unsigned kdst = OFF_K + krow * KP + kch * 16, vdst = OFF_V + vrow * VP + vch * 16;
    u32x4 kreg[2], vreg[NV]; f32x4 breg = {0.f, 0.f, 0.f, 0.f};
#define ATT_LOAD(t) do { \
        _Pragma("unroll") for (int i = 0; i < 2; ++i) kreg[i] = *(const u32x4*)(ksrc + (size_t)(128 * (t) + 64 * i) * kpitch); \
        _Pragma("unroll") for (int i = 0; i < NV; ++i) vreg[i] = *(const u32x4*)(vsrc + (size_t)(32 * i) * vpitch + 128 * (t)); \
        if (BIAS) { if (tid < 32) breg = *(const f32x4*)(bias + 128 * (t) + 4 * tid); } } while (0)
#define ATT_STORE(buf) do { \
        _Pragma("unroll") for (int i = 0; i < 2; ++i) *(LAS u32x4*)(lds + kdst + (buf) * KBUF + i * 64 * KP) = kreg[i]; \
        _Pragma("unroll") for (int i = 0; i < NV; ++i) { *(LAS u32x2*)(lds + vdst + (buf) * VBUF + i * 32 * VP) = (u32x2){vreg[i].x, vreg[i].y}; *(LAS u32x2*)(lds + vdst + (buf) * VBUF + i * 32 * VP + 8) = (u32x2){vreg[i].z, vreg[i].w}; } \
        if (BIAS) { if (tid < 32) *(LAS f32x4*)(lds + OFF_B + (buf) * 512 + 16 * tid) = breg; } } while (0)
    ATT_LOAD(0);
    ATT_STORE(0);
    __syncthreads();
    float mrow = -1e30f, lrow = 0.f;
#pragma unroll
    for (int d0 = 0; d0 < DV / 32; ++d0)
#pragma unroll
        for (int r = 0; r < 16; ++r) o[d0][r] = 0.f;
    const int qmin = q0 + 32 * w;
#define ATT_KLOAD(P0, P1, buf, sub) do { \
        LAS unsigned char* Ks_ = lds + OFF_K + (buf) * KBUF + (sub) * 64 * KP; \
        _Pragma("unroll") for (int d0 = 0; d0 < 4; ++d0) { kf[2 * d0] = *(LAS bf16x8*)(Ks_ + r32 * KP + (2 * d0 + hi) * 16); kf[2 * d0 + 1] = *(LAS bf16x8*)(Ks_ + (32 + r32) * KP + (2 * d0 + hi) * 16); } \
        if (BIAS) { LAS unsigned char* Bs_ = lds + OFF_B + (buf) * 512 + (sub) * 256; \
            _Pragma("unroll") for (int g = 0; g < 4; ++g) { const f32x4 b0 = *(LAS f32x4*)(Bs_ + (8 * g + 4 * hi) * 4), b1 = *(LAS f32x4*)(Bs_ + (32 + 8 * g + 4 * hi) * 4); \
                _Pragma("unroll") for (int e = 0; e < 4; ++e) { P0[4 * g + e] = b0[e]; P1[4 * g + e] = b1[e]; } } \
        } else { _Pragma("unroll") for (int r = 0; r < 16; ++r) { P0[r] = 0.f; P1[r] = 0.f; } } \
        __builtin_amdgcn_sched_barrier(0); } while (0)
#define ATT_QKM(P0, P1) do { \
        _Pragma("unroll") for (int d0 = 0; d0 < 4; ++d0) { \
            P0 = __builtin_amdgcn_mfma_f32_32x32x16_bf16(kf[2 * d0], qf[d0], P0, 0, 0, 0); \
            P1 = __builtin_amdgcn_mfma_f32_32x32x16_bf16(kf[2 * d0 + 1], qf[d0], P1, 0, 0, 0); } \
        __builtin_amdgcn_sched_barrier(0); } while (0)
#define ATT_VLOAD(buf, sub, KK0, NKK) do { \
        LAS unsigned char* Vs_ = lds + OFF_V + (buf) * VBUF + (sub) * 128; \
        _Pragma("unroll") for (int kk = 0; kk < (NKK); ++kk) _Pragma("unroll") for (int d0 = 0; d0 < DV / 32; ++d0) { \
            const LAS unsigned char* vp = Vs_ + (32 * d0 + r32) * VP + (16 * ((KK0) + kk) + 4 * hi) * 2; \
            const s16x4 lo = *(const LAS s16x4*)vp, hh = *(const LAS s16x4*)(vp + 16); \
            vf[kk * (DV / 32) + d0] = (bf16x8){lo[0], lo[1], lo[2], lo[3], hh[0], hh[1], hh[2], hh[3]}; } \
        __builtin_amdgcn_sched_barrier(0); } while (0)
#define ATT_SM(P0, P1, kv0) do { \
        if (CAUSAL && ((kv0) + 63 > qmin)) { const int qrel = qmin + r32 - (kv0); \
            _Pragma("unroll") for (int r = 0; r < 16; ++r) { const int kv = (r & 3) + 8 * (r >> 2) + 4 * hi; if (kv > qrel) P0[r] = -1e30f; if (kv + 32 > qrel) P1[r] = -1e30f; } } \
        float mt = max3f(P0[0], P1[0], P0[1]), mu = max3f(P1[1], P0[2], P1[2]); \
        _Pragma("unroll") for (int r = 3; r < 15; r += 2) { mt = max3f(mt, P0[r], P1[r]); mu = max3f(mu, P0[r + 1], P1[r + 1]); } \
        mt = max3f(mt, P0[15], P1[15]); mt = max3f(mt, mu, mu); \
        mt = xhalf_max(mt); \
        if (__builtin_amdgcn_ballot_w64(mt > mrow + RESC_THR) != 0ull) { \
            const float mnew = fmaxf(mrow, mt), alpha = __builtin_amdgcn_exp2f(mrow - mnew); mrow = mnew; lrow *= alpha; \
            _Pragma("unroll") for (int d0 = 0; d0 < DV / 32; ++d0) _Pragma("unroll") for (int r = 0; r < 16; ++r) o[d0][r] *= alpha; } \
        exp_sum_pk(P0, P1, mrow, lrow); \
        { u32x4 x; x.x = cvtpk(P0[0], P0[1]); x.y = cvtpk(P0[2], P0[3]); x.z = cvtpk(P0[4], P0[5]); x.w = cvtpk(P0[6], P0[7]); pb[0] = __builtin_bit_cast(bf16x8, x); \
          x.x = cvtpk(P0[8], P0[9]); x.y = cvtpk(P0[10], P0[11]); x.z = cvtpk(P0[12], P0[13]); x.w = cvtpk(P0[14], P0[15]); pb[1] = __builtin_bit_cast(bf16x8, x); \
          x.x = cvtpk(P1[0], P1[1]); x.y = cvtpk(P1[2], P1[3]); x.z = cvtpk(P1[4], P1[5]); x.w = cvtpk(P1[6], P1[7]); pb[2] = __builtin_bit_cast(bf16x8, x); \
          x.x = cvtpk(P1[8], P1[9]); x.y = cvtpk(P1[10], P1[11]); x.z = cvtpk(P1[12], P1[13]); x.w = cvtpk(P1[14], P1[15]); pb[3] = __builtin_bit_cast(bf16x8, x); } \
        __builtin_amdgcn_sched_barrier(0); } while (0)
#define ATT_PVM(KK0, NKK) do { \
        _Pragma("unroll") for (int kk = 0; kk < (NKK); ++kk) _Pragma("unroll") for (int d0 = 0; d0 < DV / 32; ++d0) \
            o[d0] = __builtin_amdgcn_mfma_f32_32x32x16_bf16(vf[kk * (DV / 32) + d0], pb[(KK0) + kk], o[d0], 0, 0, 0); \
        __builtin_amdgcn_sched_barrier(0); } while (0)
    bf16x8 kf[8], vf[8], pb[4];
    if constexpr (DV == 64) {
        f32x16 sa0, sa1, sb0, sb1; bf16x8 pc[4];
        const unsigned kofs = (unsigned)(krow * kpitch + kch * 8) * 2u, vofs = (unsigned)(vrow * vpitch + vch * 8) * 2u, bofs = (unsigned)tid * 16u;
#define ATT_HEAD(P0, P1, kv0, MT) do { \
        if (CAUSAL && ((kv0) + 63 > qmin)) { const int qrel = qmin + r32 - (kv0); \
            _Pragma("unroll") for (int r = 0; r < 16; ++r) { const int kv = (r & 3) + 8 * (r >> 2) + 4 * hi; if (kv > qrel) P0[r] = -1e30f; if (kv + 32 > qrel) P1[r] = -1e30f; } } \
        float mt_ = max3f(P0[0], P1[0], P0[1]), mu_ = max3f(P1[1], P0[2], P1[2]); \
        _Pragma("unroll") for (int r = 3; r < 15; r += 2) { mt_ = max3f(mt_, P0[r], P1[r]); mu_ = max3f(mu_, P0[r + 1], P1[r + 1]); } \
        mt_ = max3f(mt_, P0[15], P1[15]); mt_ = max3f(mt_, mu_, mu_); MT = xhalf_max(mt_); } while (0)
#define ATT_PACK(P0, P1, PB) do { u32x4 x; x.x = cvtpk(P0[0], P0[1]); x.y = cvtpk(P0[2], P0[3]); x.z = cvtpk(P0[4], P0[5]); x.w = cvtpk(P0[6], P0[7]); PB[0] = __builtin_bit_cast(bf16x8, x); \
          x.x = cvtpk(P0[8], P0[9]); x.y = cvtpk(P0[10], P0[11]); x.z = cvtpk(P0[12], P0[13]); x.w = cvtpk(P0[14], P0[15]); PB[1] = __builtin_bit_cast(bf16x8, x); \
          x.x = cvtpk(P1[0], P1[1]); x.y = cvtpk(P1[2], P1[3]); x.z = cvtpk(P1[4], P1[5]); x.w = cvtpk(P1[6], P1[7]); PB[2] = __builtin_bit_cast(bf16x8, x); \
          x.x = cvtpk(P1[8], P1[9]); x.y = cvtpk(P1[10], P1[11]); x.z = cvtpk(P1[12], P1[13]); x.w = cvtpk(P1[14], P1[15]); PB[3] = __builtin_bit_cast(bf16x8, x); } while (0)
#ifndef MIXN
#define MIXN 10
#endif
#define ATT_MIX8() do { if (MIXN > 0) { _Pragma("unroll") for (int i_ = 0; i_ < 8; ++i_) { __builtin_amdgcn_sched_group_barrier(0x008, 1, 0); __builtin_amdgcn_sched_group_barrier(0x402, MIXN, 0); } } } while (0)
        ATT_KLOAD(sa0, sa1, 0, 0); ATT_QKM(sa0, sa1);
        for (int t = 0; t < ntiles; ++t) {
            const int cur = t & 1, nxt = cur ^ 1; const bool more = (t + 1 < ntiles);
            if (more) {
                const char* kt_ = (const char*)(Kg + (size_t)(128 * (t + 1)) * kpitch);
#pragma unroll
                for (int i = 0; i < 2; ++i) kreg[i] = *(const u32x4*)(kt_ + (size_t)(64 * i) * kpitch * 2 + kofs);
                if (BIAS) { if (tid < 32) breg = *(const f32x4*)((const char*)(bias + 128 * (t + 1)) + bofs); } }
            ATT_KLOAD(sb0, sb1, cur, 1);
            { float mt; ATT_HEAD(sa0, sa1, 128 * t, mt);
              if (__builtin_amdgcn_ballot_w64(mt > mrow + RESC_THR) != 0ull) {
                  const float mnew = fmaxf(mrow, mt), alpha = __builtin_amdgcn_exp2f(mrow - mnew); mrow = mnew; lrow *= alpha;
#pragma unroll
                  for (int d0 = 0; d0 < DV / 32; ++d0)
#pragma unroll
                      for (int r = 0; r < 16; ++r) o[d0][r] *= alpha; } }
            __builtin_amdgcn_sched_barrier(0);
#pragma unroll
            for (int d0 = 0; d0 < 4; ++d0) { sb0 = __builtin_amdgcn_mfma_f32_32x32x16_bf16(kf[2 * d0], qf[d0], sb0, 0, 0, 0); sb1 = __builtin_amdgcn_mfma_f32_32x32x16_bf16(kf[2 * d0 + 1], qf[d0], sb1, 0, 0, 0); }
            exp_sum_pk(sa0, sa1, mrow, lrow);
            ATT_PACK(sa0, sa1, pb);
            ATT_MIX8();
            __builtin_amdgcn_sched_barrier(0);
            if (more) {
#pragma unroll
                for (int i = 0; i < 2; ++i) *(LAS u32x4*)(lds + kdst + nxt * KBUF + i * 64 * KP) = kreg[i];
                if (BIAS) { if (tid < 32) *(LAS f32x4*)(lds + OFF_B + nxt * 512 + 16 * tid) = breg; }
                const char* vt_ = (const char*)(Vtg + 128 * (t + 1));
#pragma unroll
                for (int i = 0; i < 2; ++i) kreg[i] = *(const u32x4*)(vt_ + (size_t)(32 * i) * vpitch * 2 + vofs); }
            { LAS unsigned char* Vs_ = lds + OFF_V + cur * VBUF;
#pragma unroll
              for (int kk = 0; kk < 4; ++kk)
#pragma unroll
                  for (int d0 = 0; d0 < 2; ++d0) { const LAS unsigned char* vp = Vs_ + (32 * d0 + r32) * VP + (16 * kk + 4 * hi) * 2;
                      const s16x4 lo = *(const LAS s16x4*)vp, hh = *(const LAS s16x4*)(vp + 16); kf[kk * 2 + d0] = (bf16x8){lo[0], lo[1], lo[2], lo[3], hh[0], hh[1], hh[2], hh[3]}; } }
            float mtb; ATT_HEAD(sb0, sb1, 128 * t + 64, mtb);
            const bool rescb = __builtin_amdgcn_ballot_w64(mtb > mrow + RESC_THR) != 0ull;
            const float mnewb = rescb ? fmaxf(mrow, mtb) : mrow, alphab = __builtin_amdgcn_exp2f(mrow - mnewb);
            float psb = 0.f;
            __builtin_amdgcn_sched_barrier(0);
#pragma unroll
            for (int kk = 0; kk < 4; ++kk)
#pragma unroll
                for (int d0 = 0; d0 < 2; ++d0) o[d0] = __builtin_amdgcn_mfma_f32_32x32x16_bf16(kf[kk * 2 + d0], pb[kk], o[d0], 0, 0, 0);
            exp_sum_pk(sb0, sb1, mnewb, psb);
            ATT_PACK(sb0, sb1, pc);
            ATT_MIX8();
            __builtin_amdgcn_sched_barrier(0);
            { LAS unsigned char* Vs_ = lds + OFF_V + cur * VBUF + 128;
#pragma unroll
              for (int kk = 0; kk < 4; ++kk)
#pragma unroll
                  for (int d0 = 0; d0 < 2; ++d0) { const LAS unsigned char* vp = Vs_ + (32 * d0 + r32) * VP + (16 * kk + 4 * hi) * 2;
                      const s16x4 lo = *(const LAS s16x4*)vp, hh = *(const LAS s16x4*)(vp + 16); kf[kk * 2 + d0] = (bf16x8){lo[0], lo[1], lo[2], lo[3], hh[0], hh[1], hh[2], hh[3]}; } }
            if (rescb) {
#pragma unroll
                for (int d0 = 0; d0 < DV / 32; ++d0)
#pragma unroll
                    for (int r = 0; r < 16; ++r) o[d0][r] *= alphab; }
            lrow = lrow * alphab + psb; mrow = mnewb;
            __builtin_amdgcn_sched_barrier(0);
#pragma unroll
            for (int kk = 0; kk < 4; ++kk)
#pragma unroll
                for (int d0 = 0; d0 < 2; ++d0) o[d0] = __builtin_amdgcn_mfma_f32_32x32x16_bf16(kf[kk * 2 + d0], pc[kk], o[d0], 0, 0, 0);
            __builtin_amdgcn_sched_barrier(0);
            if (more) {
#pragma unroll
                for (int i = 0; i < 2; ++i) { *(LAS u32x2*)(lds + vdst + nxt * VBUF + i * 32 * VP) = (u32x2){kreg[i].x, kreg[i].y}; *(LAS u32x2*)(lds + vdst + nxt * VBUF + i * 32 * VP + 8) = (u32x2){kreg[i].z, kreg[i].w}; } }
            __syncthreads();
            if (more) { ATT_KLOAD(sa0, sa1, nxt, 0); ATT_QKM(sa0, sa1); }
        }
#undef ATT_HEAD
#undef ATT_PACK
#undef ATT_MIX8
    } else if constexpr (DV == 128 && PIPE128) {
#define LOAD_A(t) do { _Pragma("unroll") for (int i = 0; i < 2; ++i) kreg[i] = *(const u32x4*)(ksrc + (size_t)(128 * (t) + 64 * i) * kpitch); \
        _Pragma("unroll") for (int i = 0; i < 2; ++i) vreg[i] = *(const u32x4*)(vsrc + (size_t)(32 * i) * vpitch + 128 * (t)); } while (0)
#define STORE_A(buf) do { _Pragma("unroll") for (int i = 0; i < 2; ++i) *(LAS u32x4*)(lds + kdst + (buf) * KBUF + i * 64 * KP) = kreg[i]; \
        _Pragma("unroll") for (int i = 0; i < 2; ++i) { *(LAS u32x2*)(lds + vdst + (buf) * VBUF + i * 32 * VP) = (u32x2){vreg[i].x, vreg[i].y}; *(LAS u32x2*)(lds + vdst + (buf) * VBUF + i * 32 * VP + 8) = (u32x2){vreg[i].z, vreg[i].w}; } } while (0)
#define LOAD_B(t) do { _Pragma("unroll") for (int i = 0; i < 2; ++i) vreg[i] = *(const u32x4*)(vsrc + (size_t)(32 * (i + 2)) * vpitch + 128 * (t)); } while (0)
#define STORE_B(buf) do { _Pragma("unroll") for (int i = 0; i < 2; ++i) { *(LAS u32x2*)(lds + vdst + (buf) * VBUF + (i + 2) * 32 * VP) = (u32x2){vreg[i].x, vreg[i].y}; *(LAS u32x2*)(lds + vdst + (buf) * VBUF + (i + 2) * 32 * VP + 8) = (u32x2){vreg[i].z, vreg[i].w}; } } while (0)
        f32x16 sa0, sa1, sb0, sb1;
        ATT_KLOAD(sa0, sa1, 0, 0); ATT_QKM(sa0, sa1);
        for (int t = 0; t < ntiles; ++t) {
            const int cur = t & 1, nxt = cur ^ 1; const bool more = (t + 1 < ntiles);
            if (more) LOAD_A(t + 1);
            ATT_KLOAD(sb0, sb1, cur, 1); ATT_QKM(sb0, sb1);
            ATT_VLOAD(cur, 0, 0, 1);
            ATT_SM(sa0, sa1, 128 * t);
            ATT_PVM(0, 1); ATT_VLOAD(cur, 0, 1, 1); ATT_PVM(1, 1); ATT_VLOAD(cur, 0, 2, 1); ATT_PVM(2, 1); ATT_VLOAD(cur, 0, 3, 1); ATT_PVM(3, 1);
            if (more) { STORE_A(nxt); LOAD_B(t + 1); }
            ATT_VLOAD(cur, 1, 0, 1);
            ATT_SM(sb0, sb1, 128 * t + 64);
            ATT_PVM(0, 1); ATT_VLOAD(cur, 1, 1, 1); ATT_PVM(1, 1); ATT_VLOAD(cur, 1, 2, 1); ATT_PVM(2, 1); ATT_VLOAD(cur, 1, 3, 1); ATT_PVM(3, 1);
            if (more) STORE_B(nxt);
            __syncthreads();
            if (more) { ATT_KLOAD(sa0, sa1, nxt, 0); ATT_QKM(sa0, sa1); }
        }
#undef LOAD_A
#undef STORE_A
#undef LOAD_B
#undef STORE_B
    } else {
        f32x16 sa0, sa1;
        for (int t = 0; t < ntiles; ++t) {
            const int cur = t & 1, nxt = cur ^ 1; const bool more = (t + 1 < ntiles);
            if (more) ATT_LOAD(t + 1);
#pragma unroll
            for (int sub = 0; sub < 2; ++sub) {
                if (!(CAUSAL && (128 * t + 64 * sub > qmin + 31))) {
                    ATT_KLOAD(sa0, sa1, cur, sub); ATT_QKM(sa0, sa1);
                    ATT_VLOAD(cur, sub, 0, 1);
                    ATT_SM(sa0, sa1, 128 * t + 64 * sub);
                    ATT_PVM(0, 1);
                    ATT_VLOAD(cur, sub, 1, 1); ATT_PVM(1, 1);
                    ATT_VLOAD(cur, sub, 2, 1); ATT_PVM(2, 1);
                    ATT_VLOAD(cur, sub, 3, 1); ATT_PVM(3, 1);
                }
            }
            if (more) ATT_STORE(nxt);
            __syncthreads();
        }
    }
#undef ATT_KLOAD
#undef ATT_QKM
#undef ATT_VLOAD
#undef ATT_SM
#undef ATT_PVM
#undef ATT_LOAD
#undef ATT_STORE
    const float inv = __builtin_amdgcn_rcpf(xhalf_sum(lrow));
#pragma unroll
    for (int d0 = 0; d0 < DV / 32; ++d0)
#pragma unroll
        for (int r = 0; r < 16; ++r) o[d0][r] *= inv;
}
constexpr int KP2 = 272, KBUF2 = 128 * KP2, OFF_K2 = 0, OFF_V2 = 2 * KBUF2;
template <int SEQ_>
__device__ __forceinline__ void attn_diff_unit(LAS unsigned char* lds, const bf16_t* Qg, const bf16_t* Kg, const bf16_t* Vtg, int q0, int ntiles, float lam, float post,
                                               const float* subln_g, bf16_t* mixbase, const int wv) {
    constexpr int DV = 128;
    int tid_ = wv * 64 + hw_lane(); asm volatile("" : "+v"(tid_));
    const int tid = tid_, lane = tid & 63, r32 = lane & 31, hi = lane >> 5, w = __builtin_amdgcn_readfirstlane(tid >> 6), wr = w & 3, strm = w >> 2;
    bf16x8 qf[4];
#pragma unroll
    for (int d0 = 0; d0 < 4; ++d0) qf[d0] = *(const bf16x8*)(Qg + (size_t)(q0 + 32 * wr + r32) * 768 + 64 * strm + 16 * d0 + 8 * hi);
    const int srow = tid >> 4, sch = tid & 15;
    const bf16_t* ksrc = Kg + (size_t)srow * 768 + sch * 8;
    const bf16_t* vsrc = Vtg + (size_t)srow * SEQ_ + sch * 8;
    const unsigned kdst = OFF_K2 + srow * KP2 + sch * 16, vdst = OFF_V2 + srow * VP + sch * 16;
    u32x4 sreg[4];
#define D_LOADK(t) do { _Pragma("unroll") for (int i = 0; i < 4; ++i) sreg[i] = *(const u32x4*)(ksrc + (size_t)(128 * (t) + 32 * i) * 768); } while (0)
#define D_STOREK(buf) do { _Pragma("unroll") for (int i = 0; i < 4; ++i) *(LAS u32x4*)(lds + kdst + (buf) * KBUF2 + i * 32 * KP2) = sreg[i]; } while (0)
#define D_LOADV(t) do { _Pragma("unroll") for (int i = 0; i < 4; ++i) sreg[i] = *(const u32x4*)(vsrc + (size_t)(32 * i) * SEQ_ + 128 * (t)); } while (0)
#define D_STOREV(buf) do { _Pragma("unroll") for (int i = 0; i < 4; ++i) { *(LAS u32x2*)(lds + vdst + (buf) * VBUF + i * 32 * VP) = (u32x2){sreg[i].x, sreg[i].y}; *(LAS u32x2*)(lds + vdst + (buf) * VBUF + i * 32 * VP + 8) = (u32x2){sreg[i].z, sreg[i].w}; } } while (0)
    D_LOADK(0); D_STOREK(0); D_LOADV(0); D_STOREV(0);
    __syncthreads();
    float mrow = -1e30f, lrow = 0.f;
    f32x16 o[4];
#pragma unroll
    for (int d0 = 0; d0 < 4; ++d0)
#pragma unroll
        for (int r = 0; r < 16; ++r) o[d0][r] = 0.f;
    const int qmin = q0 + 32 * wr;
    bf16x8 kf[8], vf[4], vg[4], pb[4];
    f32x16 p0, p1;
#define D_SUB(buf, sub, kv0) do { if (!((kv0) > qmin + 31)) { \
        LAS unsigned char* Ks_ = lds + OFF_K2 + (buf) * KBUF2 + (sub) * 64 * KP2 + strm * 128; \
        _Pragma("unroll") for (int d0 = 0; d0 < 4; ++d0) { kf[2 * d0] = *(LAS bf16x8*)(Ks_ + r32 * KP2 + (2 * d0 + hi) * 16); kf[2 * d0 + 1] = *(LAS bf16x8*)(Ks_ + (32 + r32) * KP2 + (2 * d0 + hi) * 16); } \
        _Pragma("unroll") for (int r = 0; r < 16; ++r) { p0[r] = 0.f; p1[r] = 0.f; } \
        __builtin_amdgcn_sched_barrier(0); \
        _Pragma("unroll") for (int d0 = 0; d0 < 4; ++d0) { \
            p0 = __builtin_amdgcn_mfma_f32_32x32x16_bf16(kf[2 * d0], qf[d0], p0, 0, 0, 0); \
            p1 = __builtin_amdgcn_mfma_f32_32x32x16_bf16(kf[2 * d0 + 1], qf[d0], p1, 0, 0, 0); } \
        __builtin_amdgcn_sched_barrier(0); \
        LAS unsigned char* Vs_ = lds + OFF_V2 + (buf) * VBUF + (sub) * 128; \
        D_VLOAD(0); \
        if ((kv0) + 63 > qmin) { const int qrel = qmin + r32 - (kv0); \
            _Pragma("unroll") for (int r = 0; r < 16; ++r) { const int kv = (r & 3) + 8 * (r >> 2) + 4 * hi; if (kv > qrel) p0[r] = -1e30f; if (kv + 32 > qrel) p1[r] = -1e30f; } } \
        float mt = max3f(p0[0], p1[0], p0[1]), mu = max3f(p1[1], p0[2], p1[2]); \
        _Pragma("unroll") for (int r = 3; r < 15; r += 2) { mt = max3f(mt, p0[r], p1[r]); mu = max3f(mu, p0[r + 1], p1[r + 1]); } \
        mt = max3f(mt, p0[15], p1[15]); mt = max3f(mt, mu, mu); \
        mt = xhalf_max(mt); \
        if (__builtin_amdgcn_ballot_w64(mt > mrow + RESC_THR) != 0ull) { \
            const float mnew = fmaxf(mrow, mt), alpha = __builtin_amdgcn_exp2f(mrow - mnew); mrow = mnew; lrow *= alpha; \
            _Pragma("unroll") for (int d0 = 0; d0 < 4; ++d0) _Pragma("unroll") for (int r = 0; r < 16; ++r) o[d0][r] *= alpha; } \
        exp_sum_pk(p0, p1, mrow, lrow); \
        { u32x4 x; x.x = cvtpk(p0[0], p0[1]); x.y = cvtpk(p0[2], p0[3]); x.z = cvtpk(p0[4], p0[5]); x.w = cvtpk(p0[6], p0[7]); pb[0] = __builtin_bit_cast(bf16x8, x); \
          x.x = cvtpk(p0[8], p0[9]); x.y = cvtpk(p0[10], p0[11]); x.z = cvtpk(p0[12], p0[13]); x.w = cvtpk(p0[14], p0[15]); pb[1] = __builtin_bit_cast(bf16x8, x); \
          x.x = cvtpk(p1[0], p1[1]); x.y = cvtpk(p1[2], p1[3]); x.z = cvtpk(p1[4], p1[5]); x.w = cvtpk(p1[6], p1[7]); pb[2] = __builtin_bit_cast(bf16x8, x); \
          x.x = cvtpk(p1[8], p1[9]); x.y = cvtpk(p1[10], p1[11]); x.z = cvtpk(p1[12], p1[13]); x.w = cvtpk(p1[14], p1[15]); pb[3] = __builtin_bit_cast(bf16x8, x); } \
        __builtin_amdgcn_sched_barrier(0); \
        D_VLOADB(1); D_PVM(0); D_VLOAD(2); D_PVMB(1); D_VLOADB(3); D_PVM(2); D_PVMB(3); } } while (0)
#define D_VLOAD(KK) do { _Pragma("unroll") for (int d0 = 0; d0 < 4; ++d0) { \
            const LAS unsigned char* vp = Vs_ + (32 * d0 + r32) * VP + (16 * (KK) + 4 * hi) * 2; \
            const s16x4 lo = *(const LAS s16x4*)vp, hh = *(const LAS s16x4*)(vp + 16); \
            vf[d0] = (bf16x8){lo[0], lo[1], lo[2], lo[3], hh[0], hh[1], hh[2], hh[3]}; } \
        __builtin_amdgcn_sched_barrier(0); } while (0)
#define D_VLOADB(KK) do { _Pragma("unroll") for (int d0 = 0; d0 < 4; ++d0) { \
            const LAS unsigned char* vp = Vs_ + (32 * d0 + r32) * VP + (16 * (KK) + 4 * hi) * 2; \
            const s16x4 lo = *(const LAS s16x4*)vp, hh = *(const LAS s16x4*)(vp + 16); \
            vg[d0] = (bf16x8){lo[0], lo[1], lo[2], lo[3], hh[0], hh[1], hh[2], hh[3]}; } \
        __builtin_amdgcn_sched_barrier(0); } while (0)
#define D_PVMB(KK) do { _Pragma("unroll") for (int d0 = 0; d0 < 4; ++d0) o[d0] = __builtin_amdgcn_mfma_f32_32x32x16_bf16(vg[d0], pb[KK], o[d0], 0, 0, 0); \
        __builtin_amdgcn_sched_barrier(0); } while (0)
#define D_PVM(KK) do { _Pragma("unroll") for (int d0 = 0; d0 < 4; ++d0) o[d0] = __builtin_amdgcn_mfma_f32_32x32x16_bf16(vf[d0], pb[KK], o[d0], 0, 0, 0); \
        __builtin_amdgcn_sched_barrier(0); } while (0)
    for (int t = 0; t < ntiles; ++t) {
        const int cur = t & 1, nxt = cur ^ 1; const bool more = (t + 1 < ntiles);
        if (more) D_LOADK(t + 1);
        D_SUB(cur, 0, 128 * t);
        if (more) { D_STOREK(nxt); D_LOADV(t + 1); }
        D_SUB(cur, 1, 128 * t + 64);
        if (more) D_STOREV(nxt);
        __syncthreads();
    }
#undef D_LOADK
#undef D_STOREK
#undef D_LOADV
#undef D_STOREV
#undef D_SUB
#undef D_VLOAD
#undef D_PVM
#undef D_VLOADB
#undef D_PVMB
    const float inv = __builtin_amdgcn_rcpf(xhalf_sum(lrow));
    const int lane_e = hw_lane(), r32e = lane_e & 31, hie = lane_e >> 5;
    if (strm == 1) {
#pragma unroll
        for (int d0 = 0; d0 < 4; ++d0)
#pragma unroll
            for (int g4 = 0; g4 < 4; ++g4) *(LAS f32x4*)(lds + (((d0 * 4 + g4) * 4 + wr) * 64 + lane_e) * 16) = (f32x4){o[d0][4 * g4] * inv, o[d0][4 * g4 + 1] * inv, o[d0][4 * g4 + 2] * inv, o[d0][4 * g4 + 3] * inv};
    }
    __syncthreads();
    if (strm == 0) {
        float sq = 0.f;
#pragma unroll
        for (int d0 = 0; d0 < 4; ++d0)
#pragma unroll
            for (int g4 = 0; g4 < 4; ++g4) { const f32x4 a = *(LAS f32x4*)(lds + (((d0 * 4 + g4) * 4 + wr) * 64 + lane_e) * 16);
#pragma unroll
                for (int e = 0; e < 4; ++e) { const float y = o[d0][4 * g4 + e] * inv - lam * a[e]; o[d0][4 * g4 + e] = y; sq += y * y; } }
        sq = xhalf_sum(sq);
        const float rn = __builtin_amdgcn_rsqf(sq * (1.0f / 128.0f) + 1e-6f) * post;
        bf16_t* dst = mixbase + (size_t)(q0 + 32 * wr + r32e) * 1024;
#pragma unroll
        for (int d0 = 0; d0 < 4; ++d0)
#pragma unroll
            for (int g4 = 0; g4 < 4; ++g4) { const f32x4 gv = *(const f32x4*)(subln_g + 32 * d0 + 8 * g4 + 4 * hie);
                u32x2 x; x.x = cvtpk(o[d0][4 * g4] * rn * gv[0], o[d0][4 * g4 + 1] * rn * gv[1]); x.y = cvtpk(o[d0][4 * g4 + 2] * rn * gv[2], o[d0][4 * g4 + 3] * rn * gv[3]);
                *(u32x2*)(dst + 32 * d0 + 8 * g4 + 4 * hie) = x; }
    }
}
template <int DV> __device__ __forceinline__ void store_o(bf16_t* dstrow, const f32x16 (&o)[DV / 32], int hi) {
#pragma unroll
    for (int d0 = 0; d0 < DV / 32; ++d0)
#pragma unroll
        for (int g = 0; g < 4; ++g) { u32x2 x; x.x = cvtpk(o[d0][4 * g], o[d0][4 * g + 1]); x.y = cvtpk(o[d0][4 * g + 2], o[d0][4 * g + 3]);
            *(u32x2*)(dstrow + 32 * d0 + 8 * g + 4 * hi) = x; }
}
}
__constant__ float INV_FREQ[32] = {1.000000000e+00f, 7.498942614e-01f, 5.623413324e-01f, 4.216965139e-01f, 3.162277639e-01f, 2.371373773e-01f, 1.778279394e-01f, 1.333521307e-01f, 1.000000015e-01f, 7.498941571e-02f, 5.623413250e-02f, 4.216965288e-02f, 3.162277490e-02f, 2.371373773e-02f, 1.778279431e-02f, 1.333521493e-02f, 9.999999776e-03f, 7.498941850e-03f, 5.623413250e-03f, 4.216964822e-03f, 3.162277630e-03f, 2.371373586e-03f, 1.778279431e-03f, 1.333521446e-03f, 1.000000047e-03f, 7.498942432e-04f, 5.623413017e-04f, 4.216965172e-04f, 3.162277571e-04f, 2.371373703e-04f, 1.778279402e-04f, 1.333521504e-04f};
namespace cg = cooperative_groups;
typedef unsigned short bf16;
typedef float f32x4 __attribute__((ext_vector_type(4)));
typedef unsigned v4u __attribute__((ext_vector_type(4)));
typedef unsigned v2u __attribute__((ext_vector_type(2)));
constexpr int NB = 4, SEQ = 4096, DM = 1024, M = NB * SEQ, NMEM = 256, MM = NB * NMEM, DFF = 2816, NPROJ = 2560, NPROJA = 2816;
constexpr float C2 = 0.125f * 1.4426950408889634f;
constexpr float LAMBDA_INIT = 0.35550906759096934f;
constexpr size_t MiB = 1u << 20;
constexpr size_t WS_CTL = 0;
constexpr size_t WS_SSQ = 1 * MiB;
constexpr size_t WS_SSQM = WS_SSQ + 5 * (size_t)M * 4;
constexpr size_t WS_LF = 2 * MiB;
constexpr size_t WS_COS = 3 * MiB, WS_SIN = 3 * MiB + 512 * 1024;
constexpr size_t WS_WA = 4 * MiB, WS_WB = 10 * MiB, WS_WO = 15 * MiB, WS_WM = 19 * MiB, WS_WGU = 21 * MiB, WS_WD = 43 * MiB;
constexpr size_t WS_MEMB = 54 * MiB, WS_MK = 56 * MiB, WS_MVT = 57 * MiB;
constexpr size_t WS_XB = 58 * MiB;
constexpr size_t WS_Q = 90 * MiB, WS_K = 114 * MiB, WS_VT = 138 * MiB, WS_MQ = 162 * MiB, WS_MIX = 170 * MiB, WS_H = 90 * MiB, WS_STASH = 202 * MiB, WS_END = 234 * MiB;
static_assert(WS_H + (size_t)M * DFF * 2 <= WS_END, "h overlay");
constexpr int LDS_BYTES = 147456, LDS_MISC = LDS_BYTES - 1024, LDS_ARGS = LDS_MISC + 256;

constexpr int CW_BAR = 4096;
struct Args {
    const float *x, *mem, *attn_g, *mem_g, *w_mem_kv, *w_out, *ffn_g, *w_gate_up, *w_down, *a_w_in, *a_b_f, *b_w_in, *lq1, *lk1, *lq2, *lk2, *subln_g, *kv_g, *w_kv, *final_g;
    float* out; unsigned char* ws;
};

__device__ __forceinline__ unsigned f2bf(float f) { unsigned u = __builtin_bit_cast(unsigned, f); return (u + 0x7fffu + ((u >> 16) & 1u)) >> 16; }
__device__ __forceinline__ unsigned pk2(float lo, float hi) { return att::cvtpk(lo, hi); }
__device__ __forceinline__ float wave_sum(float v) {
#pragma unroll
    for (int o = 1; o < 64; o <<= 1) v += __shfl_xor(v, o);
    return v;
}
__device__ __forceinline__ void wt_item(const float* W, int ldw, int K, const float* g, bf16* WT, int k0, int c0, int nvalid, int drowA, int drowB, LAS float* scr, int lane) {
    const int kq = lane >> 4, n4 = 4 * (lane & 15);
    f32x4 v[16]; float gk[16];
#pragma unroll
    for (int i = 0; i < 16; ++i) gk[i] = g ? g[k0 + 4 * i + kq] : 1.0f;
#pragma unroll
    for (int i = 0; i < 16; ++i) v[i] = *(const f32x4*)(W + (size_t)(k0 + 4 * i + kq) * ldw + c0 + n4);
    if (g) {
#pragma unroll
        for (int i = 0; i < 16; ++i) v[i] = v[i] * gk[i];
    }
    if (nvalid < 64) {
#pragma unroll
        for (int i = 0; i < 16; ++i)
#pragma unroll
            for (int e = 0; e < 4; ++e) if (n4 + e >= nvalid) v[i][e] = 0.f;
    }
#pragma unroll
    for (int i = 0; i < 16; ++i)
#pragma unroll
        for (int e = 0; e < 4; ++e) scr[(4 * i + kq) * 65 + n4 + e] = v[i][e];
    asm volatile("s_waitcnt lgkmcnt(0)" ::: "memory");
#pragma unroll
    for (int j = 0; j < 8; ++j) { const int q = lane + 64 * j, n = q >> 3, kc = q & 7; const LAS float* s = scr + (8 * kc) * 65 + n;
        v4u o; o.x = pk2(s[0 * 65], s[1 * 65]); o.y = pk2(s[2 * 65], s[3 * 65]); o.z = pk2(s[4 * 65], s[5 * 65]); o.w = pk2(s[6 * 65], s[7 * 65]);
        const int drow = (n < 32) ? drowA + n : drowB + n - 32;
        *(v4u*)(WT + (size_t)drow * K + k0 + 8 * kc) = o; }
    asm volatile("s_waitcnt lgkmcnt(0)" ::: "memory");
}
__device__ __forceinline__ int wt_drow(int l, int drow0, int kind) {
    if (kind == 0) return drow0 + l;
    if (kind == 1) return drow0 + (l / 256) * 256 + ((l >> 5) & 1) * 128 + ((l & 255) >> 6) * 32;
    const int up = l >= DFF ? 1 : 0, j = l - up * DFF; return drow0 + (j / 128) * 256 + up * 128 + (j & 127);
}
__device__ __forceinline__ void wt_job(int it, const float* W, int ldw, int K, int c_src, int ncols, int nvalid, const float* g, bf16* WT, int drow0, int kind, LAS float* scr, int lane) {
    const int nblk = ncols / 64, kb = it / nblk, nb = it % nblk; const int l = nb * 64;
    wt_item(W, ldw, K, g, WT, kb * 64, c_src + l, nvalid, wt_drow(l, drow0, kind), wt_drow(l + 32, drow0, kind), scr, lane);
}
#define XB_TMO      128
#define XB_XCNT(j)  (256  + 64 * (j))
#define XB_XSUB(j)  (1280 + 64 * (j))
#define XB_XGEN(j)  (2304 + 64 * (j))
#define XB_TOP      3328
#define XB_TOPGEN   3392
#define XCD_BAR_WORDS 3456
#define XB_SPIN_CAP (1u << 18)

__device__ __forceinline__ unsigned xb_ld(unsigned* p)              { return __hip_atomic_load(p, __ATOMIC_RELAXED, __HIP_MEMORY_SCOPE_AGENT); }
__device__ __forceinline__ unsigned xb_add(unsigned* p, unsigned v) { return __hip_atomic_fetch_add(p, v, __ATOMIC_RELAXED, __HIP_MEMORY_SCOPE_AGENT); }
__device__ __forceinline__ unsigned xb_xcc_id() { return (unsigned)__builtin_amdgcn_s_getreg((3 << 11) | 20) & 0xFu; }
#define XB_SPIN(cond, bar) do { unsigned _sp = 0; while (cond) { __builtin_amdgcn_s_sleep(1); \
    if ((++_sp & 255u) == 0u) { if (xb_ld(&(bar)[XB_TMO])) break; if (_sp > XB_SPIN_CAP) { atomicAdd(&(bar)[XB_TMO], 1u); break; } } } } while (0)

struct XcdBarrier {
    unsigned* bar; unsigned x; int wv;
    volatile LAS unsigned* st;
};

__device__ __forceinline__ XcdBarrier xcd_barrier_post(unsigned* bar, volatile LAS unsigned* st) {
    XcdBarrier b; b.bar = bar; b.x = xb_xcc_id(); b.st = st; b.wv = 0;
    if (threadIdx.x == 0) (void)xb_add(&bar[XB_XCNT(b.x)], 1u);
    return b;
}
__device__ __forceinline__ void xcd_barrier_complete(unsigned* bar, unsigned x, unsigned& nloc, unsigned& nx) {
    const unsigned G = gridDim.x * gridDim.y * gridDim.z;
    unsigned sum, cnt, mine, sp = 0u;
    for (;;) {
        sum = 0u; cnt = 0u; mine = 0u;
#pragma unroll
        for (unsigned j = 0; j < 16; ++j) { const unsigned c = xb_ld(&bar[XB_XCNT(j)]); sum += c; cnt += (c > 0u) ? 1u : 0u; mine = (j == x) ? c : mine; }
        if (sum == G) break;
        __builtin_amdgcn_s_sleep(1);
        if ((++sp & 255u) == 0u) { if (xb_ld(&bar[XB_TMO])) break; if (sp > XB_SPIN_CAP) { atomicAdd(&bar[XB_TMO], 1u); break; } }
    }
    nloc = mine > 0u ? mine : 1u; nx = cnt > 0u ? cnt : 1u;
}

__device__ __forceinline__ void xcd_barrier(const XcdBarrier& b) {
    asm volatile("s_waitcnt vmcnt(0)" ::: "memory");
    __syncthreads();
    if (b.wv * 64 + hw_lane() == 0) {
        unsigned* bar = b.bar;
        __builtin_amdgcn_s_waitcnt(0);
        unsigned nloc = b.st[0], nx = b.st[1];
        if (nloc == 0u) { xcd_barrier_complete(bar, b.x, nloc, nx); b.st[0] = nloc; b.st[1] = nx; }
        const unsigned old = xb_add(&bar[XB_XSUB(b.x)], 1u);
        const unsigned gen = old / nloc;
        if (old + 1u == (gen + 1u) * nloc) {
            __builtin_amdgcn_fence(__ATOMIC_RELEASE, "agent");
            asm volatile("s_waitcnt vmcnt(0)" ::: "memory");
            const unsigned og = xb_add(&bar[XB_TOP], 1u);
            const unsigned tg = og / nx;
            if (og + 1u == (tg + 1u) * nx) xb_add(&bar[XB_TOPGEN], 1u);
            else XB_SPIN(xb_ld(&bar[XB_TOPGEN]) == tg, bar);
            __builtin_amdgcn_fence(__ATOMIC_ACQUIRE, "agent");
            xb_add(&bar[XB_XGEN(b.x)], 1u);
            asm volatile("s_waitcnt vmcnt(0)" ::: "memory");
        } else {
            XB_SPIN(xb_ld(&bar[XB_XGEN(b.x)]) == gen, bar);
            __builtin_amdgcn_fence(__ATOMIC_ACQUIRE, "agent");
            asm volatile("s_waitcnt vmcnt(0)" ::: "memory");
        }
    }
    __syncthreads();
}
#ifndef NREP_SYNC
#define NREP_SYNC 0
#endif
#ifndef NREP2
#define NREP2 1
#endif
#ifndef NREP7
#define NREP7 1
#endif
#ifndef NREP4
#define NREP4 1
#endif
#ifndef NREP1
#define NREP1 1
#endif
#ifndef NREP0
#define NREP0 1
#endif
#ifndef NREP35
#define NREP35 1
#endif
#ifndef PREREAD
#define PREREAD 0
#endif
#ifndef NREPB
#define NREPB 1
#endif
#ifndef USE_XB
#define USE_XB 1
#endif
#ifndef PVAR
#define PVAR 0
#endif
#ifndef PH_MASK
#define PH_MASK 0xFFFF
#endif
__device__ __forceinline__ void scan_bh(float* lf, LAS float* sm, int tid) {
    const f32x4 a = *(const f32x4*)(lf + 8 * tid), b = *(const f32x4*)(lf + 8 * tid + 4);
    float v[8] = {a[0], a[1], a[2], a[3], b[0], b[1], b[2], b[3]};
#pragma unroll
    for (int i = 1; i < 8; ++i) v[i] += v[i - 1];
    float tot = v[7]; const int lane = tid & 63, w = tid >> 6;
    float inc = tot;
#pragma unroll
    for (int o = 1; o < 64; o <<= 1) { const float n = __shfl_up(inc, o); if (lane >= o) inc += n; }
    if (lane == 63) sm[w] = inc;
    __syncthreads();
    float base = inc - tot;
    for (int i = 0; i < w; ++i) base += sm[i];
    const float k = -1.4426950408889634f;
    f32x4 oa, ob;
#pragma unroll
    for (int i = 0; i < 4; ++i) { oa[i] = (v[i] + base) * k; ob[i] = (v[4 + i] + base) * k; }
    *(f32x4*)(lf + 8 * tid) = oa; *(f32x4*)(lf + 8 * tid + 4) = ob;
    __syncthreads();
}

enum { AX = 0, AMEM, AATTN_G, AMEM_G, AW_MEM_KV, AW_OUT, AFFN_G, AW_GATE_UP, AW_DOWN, AA_W_IN, AA_B_F, AB_W_IN, ALQ1, ALK1, ALQ2, ALK2, ASUBLN_G, AKV_G, AW_KV, AFINAL_G, AOUT, AWS };
__device__ __forceinline__ const float* argp(LAS unsigned char* lds, int i) {
    volatile LAS unsigned* p = (volatile LAS unsigned*)(lds + LDS_ARGS + 8 * i);
    const unsigned lo = __builtin_amdgcn_readfirstlane(p[0]), hi = __builtin_amdgcn_readfirstlane(p[1]);
    return (const float*)(__attribute__((address_space(1))) const float*)(((unsigned long long)hi << 32) | (unsigned long long)lo);
}
#define WSPTRS() \
    unsigned char* ws = (unsigned char*)argp(lds, AWS); \
    unsigned* ctl = (unsigned*)(ws + WS_CTL); float* ssq = (float*)(ws + WS_SSQ); float* ssqm = (float*)(ws + WS_SSQM); \
    float* LF = (float*)(ws + WS_LF); float* COS = (float*)(ws + WS_COS); float* SIN = (float*)(ws + WS_SIN); \
    bf16 *WA = (bf16*)(ws + WS_WA), *WB = (bf16*)(ws + WS_WB), *WO = (bf16*)(ws + WS_WO), *WM = (bf16*)(ws + WS_WM), *WGU = (bf16*)(ws + WS_WGU), *WD = (bf16*)(ws + WS_WD); \
    bf16 *MEMB = (bf16*)(ws + WS_MEMB), *MK = (bf16*)(ws + WS_MK), *MVT = (bf16*)(ws + WS_MVT), *XB = (bf16*)(ws + WS_XB); \
    bf16 *Qb = (bf16*)(ws + WS_Q), *Kb = (bf16*)(ws + WS_K), *VT = (bf16*)(ws + WS_VT), *MQ = (bf16*)(ws + WS_MQ), *MIX = (bf16*)(ws + WS_MIX), *H = (bf16*)(ws + WS_H); \
    (void)ctl; (void)ssq; (void)ssqm; (void)LF; (void)COS; (void)SIN; (void)WA; (void)WB; (void)WO; (void)WM; (void)WGU; (void)WD; (void)MEMB; (void)MK; (void)MVT; (void)XB; (void)Qb; (void)Kb; (void)VT; (void)MQ; (void)MIX; (void)H;

constexpr int I1 = 16 * 36, I2 = 16 * 4, IF_ = 16, I3 = 16 * 12, I4 = 16 * 12, I5 = 16 * 12, I6 = 16 * 4, I7 = 16 * 16, I9 = 16 * 8, I11 = 16 * 88, I13 = 44 * 16;
constexpr int WT_A = I11 + I13 + I1 + I2 + IF_ + I7 + 2 * I9, WT_B1 = I3 + I4 + I5 + I6, WT_B2 = I11, WT_B3 = I7 + I13;
#define WT_SRCS() const float *a_w_in = argp(lds, AA_W_IN), *attn_g = argp(lds, AATTN_G), *w_kv = argp(lds, AW_KV), *kv_g = argp(lds, AKV_G), *b_w_in = argp(lds, AB_W_IN), *w_out = argp(lds, AW_OUT); \
    const float *w_mem_kv = argp(lds, AW_MEM_KV), *mem_g = argp(lds, AMEM_G), *w_gate_up = argp(lds, AW_GATE_UP), *ffn_g = argp(lds, AFFN_G), *w_down = argp(lds, AW_DOWN);
#define WT_DISPATCH(it_) do { int r = (it_); \
    if (r < I11) { wt_job(r, w_gate_up, 5632, 1024, 0, 5632, 64, ffn_g, WGU, 0, 2, scr, lane); break; } r -= I11; \
    if (r < I13) { wt_job(r, w_down, 1024, 2816, 0, 1024, 64, nullptr, WD, 0, 0, scr, lane); break; } r -= I13; \
    if (r < I1) { wt_job(r, a_w_in, 2572, 1024, 0, 2304, 64, attn_g, WA, 0, 0, scr, lane); break; } r -= I1; \
    if (r < I2) { wt_job(r, a_w_in, 2572, 1024, 2316, 256, 64, attn_g, WA, 2304, 0, scr, lane); break; } r -= I2; \
    if (r < IF_) { wt_job(r, a_w_in, 2572, 1024, 2304, 64, 12, attn_g, WA, 2560, 0, scr, lane); break; } r -= IF_; \
    if (r < I7) { wt_job(r, w_out, 1024, 1024, 0, 1024, 64, nullptr, WO, 0, 0, scr, lane); break; } r -= I7; \
    if (r < 2 * I9) { const int l = r / I9; wt_job(r % I9, w_mem_kv + (size_t)l * 1024 * 512, 512, 1024, 0, 512, 64, mem_g + 1024 * l, WM, 512 * l, 0, scr, lane); break; } r -= 2 * I9; \
    if (r < I3) { wt_job(r, w_kv, 1536, 1024, 0, 768, 64, kv_g, WB, 0, 1, scr, lane); break; } r -= I3; \
    if (r < I4) { wt_job(r, w_kv, 1536, 1024, 768, 768, 64, kv_g, WB, 768, 0, scr, lane); break; } r -= I4; \
    if (r < I5) { wt_job(r, b_w_in, 1024, 1024, 0, 768, 64, attn_g + 1024, WB, 1536, 1, scr, lane); break; } r -= I5; \
    if (r < I6) { wt_job(r, b_w_in, 1024, 1024, 768, 256, 64, attn_g + 1024, WB, 2304, 0, scr, lane); break; } r -= I6; \
    if (r < I11) { wt_job(r, w_gate_up + (size_t)1024 * 5632, 5632, 1024, 0, 5632, 64, ffn_g + 1024, WGU + (size_t)5632 * 1024, 0, 2, scr, lane); break; } r -= I11; \
    if (r < I7) { wt_job(r, w_out + (size_t)1024 * 1024, 1024, 1024, 0, 1024, 64, nullptr, WO + (size_t)1024 * 1024, 0, 0, scr, lane); break; } r -= I7; \
    wt_job(r, w_down + (size_t)2816 * 1024, 1024, 2816, 0, 1024, 64, nullptr, WD + (size_t)1024 * 2816, 0, 0, scr, lane); } while (0)
#define WT_IDLE(first, lo, hi) do { const int f_ = (first) < G ? (first) : 0;        \
    if (bx >= f_) { WSPTRS(); PHASE_IDS(); WT_SRCS(); LAS float* scr = (LAS float*)(lds + wave * 16640); \
        for (int it = (lo) + (bx - f_) * 8 + wave; it < (hi); it += (G - f_) * 8) WT_DISPATCH(it); __syncthreads(); } } while (0)

__global__ void __launch_bounds__(512, 2) yoco_fwd(Args A) {
    extern __shared__ __attribute__((aligned(16))) unsigned char lds_raw[];
    LAS unsigned char* lds = (LAS unsigned char*)lds_raw;
#if USE_XB
    if (threadIdx.x < 2) ((volatile LAS unsigned*)(lds + LDS_MISC + 128))[threadIdx.x] = 0u;
    __syncthreads();
    XcdBarrier xbar = xcd_barrier_post((unsigned*)(A.ws + WS_CTL) + CW_BAR, (volatile LAS unsigned*)(lds + LDS_MISC + 128));
#define GRID_SYNC() xcd_barrier(xbar)
#else
    cg::grid_group grid = cg::this_grid();
#define GRID_SYNC() grid.sync()
#endif
    const int G = gridDim.x, bx = blockIdx.x;
    const int wave0 = __builtin_amdgcn_readfirstlane((int)threadIdx.x >> 6);
#define HW_TID() (wave0 * 64 + hw_lane())
#if USE_XB
    xbar.wv = wave0;
#endif
    if (threadIdx.x == 0) {
        LAS unsigned long long* P = (LAS unsigned long long*)(lds + LDS_ARGS);
        P[AX] = (unsigned long long)A.x; P[AMEM] = (unsigned long long)A.mem; P[AATTN_G] = (unsigned long long)A.attn_g; P[AMEM_G] = (unsigned long long)A.mem_g;
        P[AW_MEM_KV] = (unsigned long long)A.w_mem_kv; P[AW_OUT] = (unsigned long long)A.w_out; P[AFFN_G] = (unsigned long long)A.ffn_g; P[AW_GATE_UP] = (unsigned long long)A.w_gate_up;
        P[AW_DOWN] = (unsigned long long)A.w_down; P[AA_W_IN] = (unsigned long long)A.a_w_in; P[AA_B_F] = (unsigned long long)A.a_b_f; P[AB_W_IN] = (unsigned long long)A.b_w_in;
        P[ALQ1] = (unsigned long long)A.lq1; P[ALK1] = (unsigned long long)A.lk1; P[ALQ2] = (unsigned long long)A.lq2; P[ALK2] = (unsigned long long)A.lk2;
        P[ASUBLN_G] = (unsigned long long)A.subln_g; P[AKV_G] = (unsigned long long)A.kv_g; P[AW_KV] = (unsigned long long)A.w_kv; P[AFINAL_G] = (unsigned long long)A.final_g;
        P[AOUT] = (unsigned long long)A.out; P[AWS] = (unsigned long long)A.ws;
    }
    __syncthreads();
#define PHASE_IDS() int tid_ = HW_TID(); asm volatile("" : "+v"(tid_)); const int tid = tid_, lane = tid & 63, wave = __builtin_amdgcn_readfirstlane(tid >> 6); \
    const int gw = bx * 8 + wave, NGW = G * 8, gt = bx * 512 + tid, NGT = G * 512; (void)lane; (void)gw; (void)NGW; (void)gt; (void)NGT;

    for (int rep0_ = 0; rep0_ < NREP0; ++rep0_) {
        WSPTRS(); PHASE_IDS();
        const float *a_w_in = argp(lds, AA_W_IN), *attn_g = argp(lds, AATTN_G), *w_kv = argp(lds, AW_KV), *kv_g = argp(lds, AKV_G), *b_w_in = argp(lds, AB_W_IN), *w_out = argp(lds, AW_OUT);
        const float *w_mem_kv = argp(lds, AW_MEM_KV), *mem_g = argp(lds, AMEM_G), *w_gate_up = argp(lds, AW_GATE_UP), *ffn_g = argp(lds, AFFN_G), *w_down = argp(lds, AW_DOWN);
        const float *xin = argp(lds, AX), *memin = argp(lds, AMEM), *a_b_f = argp(lds, AA_B_F);
#if PREREAD
        {
            float acc_ = 0.f;
#define PRE_(ptr, n) for (int i = gt; i < (n) / 4; i += NGT) { const f32x4 v = ((const f32x4*)(ptr))[i]; acc_ += (v[0] + v[1]) + (v[2] + v[3]); }
            PRE_(w_gate_up, 2 * 1024 * 5632) PRE_(w_down, 2 * 2816 * 1024) PRE_(a_w_in, 1024 * 2572) PRE_(w_kv, 1024 * 1536) PRE_(b_w_in, 1024 * 1024) PRE_(w_out, 2 * 1024 * 1024) PRE_(w_mem_kv, 2 * 1024 * 512)
#undef PRE_
            if (acc_ == 1.2345e38f) ctl[63] = 1u;
        }
#endif
        LAS float* scr = (LAS float*)(lds + wave * 16640);
        {
            constexpr int o_WA = I11 + I13, o_WO0 = o_WA + I1 + I2 + IF_, o_WM = o_WO0 + I7, n0 = I11, n1 = o_WO0 - o_WA, n2 = 2 * I9;
            for (int j = gw; j < n0 + n1 + n2; j += NGW) { const int it = j < n0 ? j : (j < n0 + n1 ? o_WA + (j - n0) : o_WM + (j - n0 - n1)); WT_DISPATCH(it); }
        }
        for (int i = gt; i < 192 * 1024 / 8; i += NGT) ((v4u*)(WA + (size_t)2624 * 1024))[i] = (v4u){0u, 0u, 0u, 0u};
        for (int m = 2 * gw; m < M + MM; m += 2 * NGW) {
            const bool ism = m >= M; const float* src = ism ? memin + (size_t)(m - M) * DM : xin + (size_t)m * DM; bf16* dst = ism ? MEMB + (size_t)(m - M) * DM : XB + (size_t)m * DM; float* sdst = ism ? ssqm + (m - M) : ssq + m;
            const f32x4* xr = (const f32x4*)src + lane; f32x4 v[8]; float s0 = 0.f, s1 = 0.f;
#pragma unroll
            for (int j = 0; j < 8; ++j) v[j] = xr[64 * j];
#pragma unroll
            for (int j = 0; j < 4; ++j) { s0 += (v[j][0] * v[j][0] + v[j][1] * v[j][1]) + (v[j][2] * v[j][2] + v[j][3] * v[j][3]); s1 += (v[4 + j][0] * v[4 + j][0] + v[4 + j][1] * v[4 + j][1]) + (v[4 + j][2] * v[4 + j][2] + v[4 + j][3] * v[4 + j][3]); }
            s0 = wave_sum(s0); s1 = wave_sum(s1);
            if (lane == 0) { sdst[0] = s0; sdst[1] = s1; }
            unsigned long long* o8 = (unsigned long long*)dst + lane;
#pragma unroll
            for (int j = 0; j < 8; ++j) o8[64 * j] = (unsigned long long)pk2(v[j][0], v[j][1]) | ((unsigned long long)pk2(v[j][2], v[j][3]) << 32);
        }
        for (int i = gt; i < SEQ * 32; i += NGT) { const int pos = i >> 5, f = i & 31; const float ang = (float)pos * INV_FREQ[f];
            double rev = (double)ang * 0.15915494309189535; rev -= __builtin_rint(rev);
            COS[i] = __builtin_amdgcn_cosf((float)rev); SIN[i] = __builtin_amdgcn_sinf((float)rev); }
        for (int i = gt; i < 4 * M; i += NGT) ssq[M + i] = 0.f;
        if (gt < 64) ctl[gt] = 0u;
    }
    GRID_SYNC();

#if PH_MASK & (1 << 1)
    {
        WSPTRS(); PHASE_IDS();
        for (int rep_ = 0; rep_ < NREP1; ++rep_) {
        pg8::Gemm g{XB, WA, M, NPROJA, DM}; pg8::StaticOrder S; S.init(M, NPROJA, G, bx);
        pg8::EpiProj E{ssq, COS, SIN, argp(lds, AA_B_F), LF, SEQ, {Qb, 3, 0, 768, C2}, {Kb, 6, 0, 768, 1.f}, {VT, 9, 1, 768, 1.f}, {MQ, 10, 0, 256, C2}, {nullptr, 11, 3, 0, 1.f}};
        pg8::gemm_phase<pg8::EpiProj, pg8::StaticOrder, true, true>(lds, g, S, E, wave0);
        }
    }
    {
        WSPTRS();
        pg8::Gemm g{MEMB, WM, MM, 1024, DM}; pg8::StaticOrder S; S.init(MM, 1024, G, (bx + 64) & 255);
        pg8::EpiProj E{ssqm, COS, SIN, nullptr, nullptr, NMEM, {MK, 1, 0, 256, 1.f}, {MVT, 2, 1, 256, 1.f}, {MK + (size_t)MM * 256, 3, 0, 256, 1.f}, {MVT + (size_t)MM * 256, 4, 1, 256, 1.f}, {nullptr, 5, 0, 0, 1.f}};
        pg8::gemm_phase<pg8::EpiProj, pg8::StaticOrder, true, true>(lds, g, S, E, wave0);
    }
#endif
    WT_IDLE(208, WT_A, WT_A + WT_B1);
    WT_IDLE(208, I11 + I13 + I1 + I2 + IF_, I11 + I13 + I1 + I2 + IF_ + I7);
    GRID_SYNC();

    if (bx < 48) { WSPTRS(); PHASE_IDS(); scan_bh(LF + (size_t)bx * SEQ, (LAS float*)(lds + LDS_MISC + 64), tid); }
    GRID_SYNC();
#if PH_MASK & (1 << 2)
    for (int rep_ = 0; rep_ < NREP2; ++rep_) { WSPTRS(); PHASE_IDS();
    volatile LAS unsigned* qword = (volatile LAS unsigned*)(lds + LDS_MISC);
    bool first_ = true;
    for (;;) {
        if (HW_TID() == 0) qword[0] = first_ ? (unsigned)bx : (unsigned)G + atomicAdd(ctl + 0 + 2 * rep_, 1u);
        first_ = false;
        __syncthreads();
        const int u = (int)qword[0];
        __syncthreads();
        if (u >= 1024) break;
        att::f32x16 o[2];
        if (u < 768) {
            const int qb = 15 - u / 48, bh = u % 48, b = bh / 12, h = bh % 12;
            if (rep_ + 1 < NREP2) att::attn_stream<64, true, true, PVAR>(lds, Qb + (size_t)b * SEQ * 768 + 64 * h, 768, Kb + (size_t)b * SEQ * 768 + 64 * h, 768, VT + (size_t)(b * 768 + 64 * h) * SEQ, SEQ,
                                             LF + (size_t)bh * SEQ, 256 * qb, 2 * (qb + 1), o, wave0);
            else att::attn_stream<64, true, true>(lds, Qb + (size_t)b * SEQ * 768 + 64 * h, 768, Kb + (size_t)b * SEQ * 768 + 64 * h, 768, VT + (size_t)(b * 768 + 64 * h) * SEQ, SEQ,
                                             LF + (size_t)bh * SEQ, 256 * qb, 2 * (qb + 1), o, wave0);
            { const int l2_ = hw_lane(); att::store_o<64>(MIX + (size_t)(b * SEQ + 256 * qb + 32 * wave + (l2_ & 31)) * DM + 64 * h, o, l2_ >> 5); }
        } else {
            const int j = u - 768, b = j >> 6, hm = (j >> 4) & 3, qb = j & 15;
            att::attn_stream<64, false, false>(lds, MQ + (size_t)b * SEQ * 256 + 64 * hm, 256, MK + (size_t)b * NMEM * 256 + 64 * hm, 256, MVT + (size_t)(b * 256 + 64 * hm) * NMEM, NMEM,
                                               nullptr, 256 * qb, 2, o, wave0);
            { const int l2_ = hw_lane(); att::store_o<64>(MIX + (size_t)(b * SEQ + 256 * qb + 32 * wave + (l2_ & 31)) * DM + 768 + 64 * hm, o, l2_ >> 5); }
        }
    } }
#endif
    GRID_SYNC();

#if PH_MASK & (1 << 3)
    for (int rep_ = 0; rep_ < NREP35; ++rep_) {
        WSPTRS(); const float* xin = argp(lds, AX); float* outp = (float*)argp(lds, AOUT);
        pg8::Gemm g{MIX, WO, M, DM, DM}; pg8::StaticOrder S; S.init(M, DM, G, bx);
        pg8::EpiRes E{XB, ssq + M};
        pg8::gemm_phase<pg8::EpiRes, pg8::StaticOrder, true, true>(lds, g, S, E, wave0);
    }
#endif
    GRID_SYNC();
#if PH_MASK & (1 << 4)
    for (int rep_ = 0; rep_ < NREP4; ++rep_) {
        WSPTRS();
        pg8::Gemm g{XB, WGU, M, 2 * DFF, DM}; pg8::StaticOrder S; S.init(M, 2 * DFF, G, bx);
        pg8::EpiGU E{ssq + M, H};
        pg8::gemm_phase<pg8::EpiGU, pg8::StaticOrder, true, true>(lds, g, S, E, wave0);
    }
#endif
    WT_IDLE(128, WT_A + WT_B1, WT_A + WT_B1 + WT_B2);
    WT_IDLE(128, I11, I11 + I13);
    GRID_SYNC();
#if PH_MASK & (1 << 5)
    for (int rep_ = 0; rep_ < NREP35; ++rep_) {
        WSPTRS(); float* outp = (float*)argp(lds, AOUT);
        pg8::Gemm g{H, WD, M, DM, DFF}; pg8::StaticOrder S; S.init(M, DM, G, bx);
        pg8::EpiRes E{XB, ssq + 2 * M};
        pg8::gemm_phase<pg8::EpiRes, pg8::StaticOrder, true, true>(lds, g, S, E, wave0);
    }
#endif
    GRID_SYNC();
#if PH_MASK & (1 << 6)
    for (int rep_ = 0; rep_ < NREPB; ++rep_) {
        WSPTRS();
        pg8::Gemm g{XB, WB, M, NPROJ, DM}; pg8::StaticOrder S; S.init(M, NPROJ, G, bx);
        pg8::EpiProj E{ssq + 2 * M, COS, SIN, nullptr, nullptr, SEQ, {Kb, 3, 2, 768, 1.f}, {VT, 6, 1, 768, 1.f}, {Qb, 9, 2, 768, C2}, {MQ, 10, 0, 256, C2}, {nullptr, 11, 0, 0, 1.f}};
        pg8::gemm_phase<pg8::EpiProj, pg8::StaticOrder, true, true>(lds, g, S, E, wave0);
    }
#endif
    WT_IDLE(128, WT_A + WT_B1 + WT_B2, WT_A + WT_B1 + WT_B2 + WT_B3);
    GRID_SYNC();
#if PH_MASK & (1 << 7)
    {
        WSPTRS(); PHASE_IDS(); const float* subln_g = argp(lds, ASUBLN_G);
        volatile LAS unsigned* qword = (volatile LAS unsigned*)(lds + LDS_MISC);
        float d1 = argp(lds, ALQ1)[lane] * argp(lds, ALK1)[lane], d2 = argp(lds, ALQ2)[lane] * argp(lds, ALK2)[lane];
        d1 = wave_sum(d1); d2 = wave_sum(d2);
        const float lam = __builtin_bit_cast(float, __builtin_amdgcn_readfirstlane(__builtin_bit_cast(int, expf(d1) - expf(d2) + LAMBDA_INIT)));
        bool first_ = true;
        for (int rep_ = 0; rep_ < NREP7; ++rep_)
        for (;;) {
            if (HW_TID() == 0) qword[0] = first_ ? (unsigned)bx : (unsigned)G + atomicAdd(ctl + 1 + 2 * rep_, 1u);
            first_ = false;
            __syncthreads();
            const int u = (int)qword[0];
            __syncthreads();
            if (u >= 1024) break;
            if (u < 768) {
                const int qb = 31 - u / 24, bh = u % 24, b = bh / 6, hd = bh % 6;
                att::attn_diff_unit<SEQ>(lds, Qb + (size_t)b * SEQ * 768 + 128 * hd, Kb + (size_t)b * SEQ * 768 + 128 * hd, VT + (size_t)(b * 768 + 128 * hd) * SEQ, 128 * qb, qb + 1, lam, 1.0f - LAMBDA_INIT,
                                         subln_g, MIX + (size_t)b * SEQ * DM + 128 * hd, wave0);
            } else {
                att::f32x16 o[2];
                const int j = u - 768, b = j >> 6, hm = (j >> 4) & 3, qb = j & 15;
                att::attn_stream<64, false, false>(lds, MQ + (size_t)b * SEQ * 256 + 64 * hm, 256, MK + (size_t)(MM + b * NMEM) * 256 + 64 * hm, 256, MVT + (size_t)(MM + b * 256 + 64 * hm) * NMEM, NMEM,
                                                   nullptr, 256 * qb, 2, o, wave0);
                { const int l2_ = hw_lane(); att::store_o<64>(MIX + (size_t)(b * SEQ + 256 * qb + 32 * wave + (l2_ & 31)) * DM + 768 + 64 * hm, o, l2_ >> 5); }
            }
        }
    }
#endif
    GRID_SYNC();
#if PH_MASK & (1 << 8)
    for (int rep_ = 0; rep_ < NREPB; ++rep_) {
        WSPTRS(); float* outp = (float*)argp(lds, AOUT);
        pg8::Gemm g{MIX, WO + (size_t)1024 * 1024, M, DM, DM}; pg8::StaticOrder S; S.init(M, DM, G, bx);
        pg8::EpiRes E{XB, ssq + 3 * M};
        pg8::gemm_phase<pg8::EpiRes, pg8::StaticOrder, true, true>(lds, g, S, E, wave0);
    }
#endif
    GRID_SYNC();
#if PH_MASK & (1 << 9)
    for (int rep_ = 0; rep_ < NREPB; ++rep_) {
        WSPTRS();
        pg8::Gemm g{XB, WGU + (size_t)5632 * 1024, M, 2 * DFF, DM}; pg8::StaticOrder S; S.init(M, 2 * DFF, G, bx);
        pg8::EpiGU E{ssq + 3 * M, H};
        pg8::gemm_phase<pg8::EpiGU, pg8::StaticOrder, true, true>(lds, g, S, E, wave0);
    }
#endif
    GRID_SYNC();
#if PH_MASK & (1 << 10)
    {
        WSPTRS(); float* outp = (float*)argp(lds, AOUT);
        pg8::Gemm g{H, WD + (size_t)1024 * 2816, M, DM, DFF}; pg8::StaticOrder S; S.init(M, DM, G, bx);
        pg8::EpiResFinal E{XB, outp, ssq + 4 * M, ctl + 8192, argp(lds, AFINAL_G)};
        pg8::gemm_phase<pg8::EpiResFinal, pg8::StaticOrder, true, true>(lds, g, S, E, wave0);
    }
#endif
}

extern "C" void kernel_launch(void* const* d_in, const int* in_sizes, int n_in, void* d_out, int out_size, void* d_ws, size_t ws_size, hipStream_t stream) {
    static int grid = 0;
    if (grid == 0) {
        if (n_in != 20 || out_size != M * DM || ws_size < WS_END) { fprintf(stderr, "kernel_launch: unexpected sizes n_in %d out %d ws %zu\n", n_in, out_size, ws_size); grid = -1; return; }
        int dev = 0, cus = 0, per_cu = 0;
        (void)hipGetDevice(&dev); (void)hipDeviceGetAttribute(&cus, hipDeviceAttributeMultiprocessorCount, dev);
        (void)hipFuncSetAttribute((const void*)yoco_fwd, hipFuncAttributeMaxDynamicSharedMemorySize, LDS_BYTES);
        (void)hipOccupancyMaxActiveBlocksPerMultiprocessor(&per_cu, (const void*)yoco_fwd, 512, LDS_BYTES);
        if (per_cu < 1) { fprintf(stderr, "kernel_launch: occupancy query says %d blocks per CU; the grid barrier needs every workgroup resident: nothing launched\n", per_cu); grid = -1; return; }
        grid = cus;
        if (grid != 256) fprintf(stderr, "kernel_launch: %d CUs (expected 256)\n", grid);
    }
    if (grid < 0) return;
    Args a{};
    const float** p = (const float**)&a;
    for (int i = 0; i < 20; ++i) p[i] = (const float*)d_in[i];
    a.out = (float*)d_out; a.ws = (unsigned char*)d_ws;
    void* args[] = {&a};
#if USE_XB
    (void)hipMemsetAsync((char*)d_ws + WS_CTL, 0, 65536, stream);
    hipLaunchKernelGGL(yoco_fwd, dim3(grid), dim3(512), LDS_BYTES, stream, a);
    (void)args;
#else
    hipError_t e = hipLaunchCooperativeKernel((const void*)yoco_fwd, dim3(grid), dim3(512), args, LDS_BYTES, stream);
    if (e != hipSuccess) fprintf(stderr, "cooperative launch failed: %s (grid %d)\n", hipGetErrorString(e), grid);
#endif
}
```

```cpp
#include <hip/hip_runtime.h>
#include <hip/hip_cooperative_groups.h>
#include <cstdio>
#include <cstdint>
__device__ __forceinline__ int hw_lane() { unsigned z = 0u; asm volatile("" : "+v"(z)); return (int)__builtin_amdgcn_mbcnt_hi(~0u, __builtin_amdgcn_mbcnt_lo(~0u, z)); }
namespace pg8 {
#define PG8_LAS __attribute__((address_space(3)))
typedef unsigned short bf16_t;
typedef short bf16x8 __attribute__((ext_vector_type(8)));
typedef float f32x4 __attribute__((ext_vector_type(4)));
typedef unsigned u32x4 __attribute__((ext_vector_type(4)));
constexpr int BM = 256, BK = 64, HALF = 128, HTB = HALF * BK * 2  , STAGE_BYTES = 8 * HTB, NXCD = 8, WGM = 8;

__host__ __device__ __forceinline__ int lds_byte(int r, int c) { const int st = (r >> 4) * 2 + (c >> 5), rr = r & 15, cc = c & 31, ob = rr * 64 + cc * 2; return st * 1024 + (ob ^ (((ob >> 9) & 1) << 5)); }
__host__ __device__ __forceinline__ void stage_rc(int b, int& R, int& C) { const int st = b / 1024, sb = b % 1024, swz = sb ^ (((sb >> 9) & 1) << 5); R = (st >> 1) * 16 + swz / 64; C = (st & 1) * 32 + (swz % 64) / 2; }
__host__ __device__ __forceinline__ int perm32(int rho) { const int n = rho >> 4, i = rho & 15; return 8 * (i >> 2) + 4 * n + (i & 3); }

struct Unit { int pm, pn; };
struct Gemm { const bf16_t* A; const bf16_t* Bt; int M, N, K; };

struct StaticOrder {
    int nM, nN, nwg, G, c;
    __host__ __device__ void init(int M, int N, int G_, int c_) { nM = M / BM; nN = N / BM; nwg = nM * nN; G = G_; c = c_; }
    __host__ __device__ bool next(int i, Unit& u) const {
        const long L = (long)i * G + c; if (L >= nwg) return false;
        int wgid = (int)L; { const int q = nwg / NXCD, r = nwg % NXCD, xcd = wgid % NXCD, off = wgid / NXCD; wgid = (xcd < r ? xcd * (q + 1) : r * (q + 1) + (xcd - r) * q) + off; }
        const int nig = WGM * nN, gid = wgid / nig, fm = gid * WGM, gsz = (nM - fm) < WGM ? (nM - fm) : WGM;
        u.pm = fm + ((wgid % nig) % gsz); u.pn = (wgid % nig) / gsz; return true;
    }
    __device__ __forceinline__ void a_ready(const Unit&) const {}
    __device__ __forceinline__ void done(const Unit&) const {}
};

__device__ __forceinline__ unsigned cvt_pk_bf16(float lo, float hi) { unsigned r; asm volatile("v_cvt_pk_bf16_f32 %0, %1, %2" : "=v"(r) : "v"(lo), "v"(hi)); return r; }
typedef float f32x2 __attribute__((ext_vector_type(2)));
typedef unsigned u32x2 __attribute__((ext_vector_type(2)));
struct Seg { bf16_t* dst; int pn_end; int kind; int pitch; float scale; };
struct EpiProj {
    static constexpr bool PERM = true, AFTER_DRAIN = false;
    const float* ssq; const float* cs; const float* sn; const float* bf; float* lf; int S; Seg s0, s1, s2, s3, s4;
    __device__ __forceinline__ void operator()(const f32x4 (&acc)[2][2][4][2], const Unit& u, int wr, int wc, int fr, int fq) const {
        Seg g = s4; int pn0 = s3.pn_end;
        if (u.pn < s0.pn_end) { g = s0; pn0 = 0; } else if (u.pn < s1.pn_end) { g = s1; pn0 = s0.pn_end; } else if (u.pn < s2.pn_end) { g = s2; pn0 = s1.pn_end; } else if (u.pn < s3.pn_end) { g = s3; pn0 = s2.pn_end; }
        const int ct = (u.pn - pn0) * BM;
        const int lane = fq * 16 + fr; const int ssh = 31 - __builtin_clz(S);
        float sq8[8];
#pragma unroll
        for (int i = 0; i < 8; ++i) sq8[i] = ssq[u.pm * BM + (i >> 2) * HALF + wr * 64 + (i & 3) * 16 + fr];
        f32x4 w0 = {0.f, 0.f, 0.f, 0.f}, w1 = {0.f, 0.f, 0.f, 0.f};
        if (g.kind == 2) { w0 = *(const f32x4*)(cs + 8 * fq); w1 = *(const f32x4*)(cs + 8 * fq + 4); }
#pragma unroll
        for (int am = 0; am < 4; ++am) {
            const int ai = am >> 1;
#pragma unroll
            for (int mm = 0; mm < 2; ++mm) {
                const int m = (am & 1) * 2 + mm;
                const int row = u.pm * BM + ai * HALF + wr * 64 + m * 16 + fr;
                const float rs = __builtin_amdgcn_rsqf(sq8[ai * 4 + m] * (1.0f / 1024.0f) + 1e-6f) * g.scale;
                if (g.kind == 0) {
#pragma unroll
                    for (int bj = 0; bj < 2; ++bj) { const f32x4 v0 = acc[ai][bj][m][0] * rs, v1 = acc[ai][bj][m][1] * rs;
                        u32x4 w; w.x = cvt_pk_bf16(v0[0], v0[1]); w.y = cvt_pk_bf16(v0[2], v0[3]); w.z = cvt_pk_bf16(v1[0], v1[1]); w.w = cvt_pk_bf16(v1[2], v1[3]);
                        *(u32x4*)(g.dst + (size_t)row * g.pitch + ct + bj * HALF + wc * 32 + 8 * fq) = w; }
                } else if (g.kind == 1) {
                    const int b = row >> ssh, s = row & (S - 1); const bool odd = (fr & 1) != 0;
#pragma unroll
                    for (int bj = 0; bj < 2; ++bj) { const f32x4 v0 = acc[ai][bj][m][0] * rs, v1 = acc[ai][bj][m][1] * rs;
                        const int cb = ct + bj * HALF + wc * 32 + 8 * fq + (odd ? 4 : 0);
#pragma unroll
                        for (int j = 0; j < 4; ++j) { const float snd = odd ? v0[j] : v1[j]; const float rcv = __shfl_xor(snd, 1);
                            const float lo = odd ? rcv : v0[j], hi = odd ? v1[j] : rcv;
                            *(unsigned*)(g.dst + ((size_t)b * g.pitch + cb + j) * S + (s & ~1)) = cvt_pk_bf16(lo, hi); } }
                } else if (g.kind == 3) {
                    if (wc == 0 && fq < 2) { const int b = row >> ssh, s = row & (S - 1);
#pragma unroll
                        for (int n = 0; n < 2; ++n)
#pragma unroll
                            for (int e2 = 0; e2 < 4; ++e2) { const int c = 8 * fq + 4 * n + e2;
                                if (c < 12) { const float z = acc[ai][0][m][n][e2] * rs + bf[c]; lf[((size_t)b * 12 + c) * S + s] = fminf(z, 0.f) - 0.6931471805599453f * __builtin_amdgcn_logf(1.0f + __builtin_amdgcn_exp2f(-1.4426950408889634f * fabsf(z))); } } }
                } else {
                    const float pf = (float)(row & (S - 1)); f32x4 c0, c1, n0, n1;
#pragma unroll
                    for (int e = 0; e < 4; ++e) { const float r0 = __builtin_amdgcn_fractf(pf * w0[e]), r1 = __builtin_amdgcn_fractf(pf * w1[e]);
                        c0[e] = __builtin_amdgcn_cosf(r0); n0[e] = __builtin_amdgcn_sinf(r0); c1[e] = __builtin_amdgcn_cosf(r1); n1[e] = __builtin_amdgcn_sinf(r1); }
                    const f32x4 a0 = acc[ai][0][m][0] * rs, a1 = acc[ai][0][m][1] * rs, b0 = acc[ai][1][m][0] * rs, b1 = acc[ai][1][m][1] * rs;
                    const f32x4 x0 = a0 * c0 - b0 * n0, x1 = a1 * c1 - b1 * n1, y0 = a0 * n0 + b0 * c0, y1 = a1 * n1 + b1 * c1;
                    bf16_t* p = g.dst + (size_t)row * g.pitch + ct + wc * 64 + 8 * fq;
                    u32x4 w; w.x = cvt_pk_bf16(x0[0], x0[1]); w.y = cvt_pk_bf16(x0[2], x0[3]); w.z = cvt_pk_bf16(x1[0], x1[1]); w.w = cvt_pk_bf16(x1[2], x1[3]);
                    *(u32x4*)p = w;
                    w.x = cvt_pk_bf16(y0[0], y0[1]); w.y = cvt_pk_bf16(y0[2], y0[3]); w.z = cvt_pk_bf16(y1[0], y1[1]); w.w = cvt_pk_bf16(y1[2], y1[3]);
                    *(u32x4*)(p + 32) = w;
                }
            }
        }
        (void)lane;
    }
};
struct EpiRes {
    static constexpr bool PERM = true, AFTER_DRAIN = false;
    bf16_t* xb; float* ssq_out;
    __device__ __forceinline__ void operator()(const f32x4 (&acc)[2][2][4][2], const Unit& u, int wr, int wc, int fr, int fq) const {
#pragma unroll
        for (int ai = 0; ai < 2; ++ai) {
            u32x4 xr[4][2];
#pragma unroll
            for (int m = 0; m < 4; ++m)
#pragma unroll
                for (int bj = 0; bj < 2; ++bj) xr[m][bj] = *(const u32x4*)(xb + (size_t)(u.pm * BM + ai * HALF + wr * 64 + m * 16 + fr) * 1024 + u.pn * BM + bj * HALF + wc * 32 + 8 * fq);
            asm volatile("" ::: "memory");
#pragma unroll
            for (int m = 0; m < 4; ++m) {
                const int row = u.pm * BM + ai * HALF + wr * 64 + m * 16 + fr; float sq = 0.f;
#pragma unroll
                for (int bj = 0; bj < 2; ++bj) { const size_t off = (size_t)row * 1024 + u.pn * BM + bj * HALF + wc * 32 + 8 * fq; const u32x4 x = xr[m][bj];
                    const f32x4 v0 = (f32x4){__uint_as_float(x.x << 16), __uint_as_float(x.x & 0xffff0000u), __uint_as_float(x.y << 16), __uint_as_float(x.y & 0xffff0000u)} + acc[ai][bj][m][0];
                    const f32x4 v1 = (f32x4){__uint_as_float(x.z << 16), __uint_as_float(x.z & 0xffff0000u), __uint_as_float(x.w << 16), __uint_as_float(x.w & 0xffff0000u)} + acc[ai][bj][m][1];
                    u32x4 w; w.x = cvt_pk_bf16(v0[0], v0[1]); w.y = cvt_pk_bf16(v0[2], v0[3]); w.z = cvt_pk_bf16(v1[0], v1[1]); w.w = cvt_pk_bf16(v1[2], v1[3]);
                    *(u32x4*)(xb + off) = w;
                    sq += (v0[0] * v0[0] + v0[1] * v0[1]) + (v0[2] * v0[2] + v0[3] * v0[3]) + (v1[0] * v1[0] + v1[1] * v1[1]) + (v1[2] * v1[2] + v1[3] * v1[3]); }
                sq += __shfl_xor(sq, 16); sq += __shfl_xor(sq, 32);
                if (fq == 0) atomicAdd(ssq_out + row, sq);
            }
            asm volatile("" ::: "memory");
        }
    }
};
struct EpiResFinal {
    static constexpr bool PERM = true, AFTER_DRAIN = false;
    const bf16_t* xb; float* out; float* ssq; unsigned* cnt; const float* g;
    __device__ __forceinline__ void operator()(f32x4 (&acc)[2][2][4][2], const Unit& u, int wr, int wc, int fr, int fq) const {
        const int col0 = u.pn * BM + wc * 32 + 8 * fq;
#pragma unroll
        for (int ai = 0; ai < 2; ++ai) {
            u32x4 xr[4][2];
#pragma unroll
            for (int m = 0; m < 4; ++m)
#pragma unroll
                for (int bj = 0; bj < 2; ++bj) xr[m][bj] = *(const u32x4*)(xb + (size_t)(u.pm * BM + ai * HALF + wr * 64 + m * 16 + fr) * 1024 + col0 + bj * HALF);
            asm volatile("" ::: "memory");
#pragma unroll
            for (int m = 0; m < 4; ++m) {
                const int row = u.pm * BM + ai * HALF + wr * 64 + m * 16 + fr; float sq = 0.f;
#pragma unroll
                for (int bj = 0; bj < 2; ++bj) { const u32x4 x = xr[m][bj];
                    const f32x4 v0 = (f32x4){__uint_as_float(x.x << 16), __uint_as_float(x.x & 0xffff0000u), __uint_as_float(x.y << 16), __uint_as_float(x.y & 0xffff0000u)} + acc[ai][bj][m][0];
                    const f32x4 v1 = (f32x4){__uint_as_float(x.z << 16), __uint_as_float(x.z & 0xffff0000u), __uint_as_float(x.w << 16), __uint_as_float(x.w & 0xffff0000u)} + acc[ai][bj][m][1];
                    acc[ai][bj][m][0] = v0; acc[ai][bj][m][1] = v1;
                    sq += (v0[0] * v0[0] + v0[1] * v0[1]) + (v0[2] * v0[2] + v0[3] * v0[3]) + (v1[0] * v1[0] + v1[1] * v1[1]) + (v1[2] * v1[2] + v1[3] * v1[3]); }
                sq += __shfl_xor(sq, 16); sq += __shfl_xor(sq, 32);
                if (fq == 0) (void)__hip_atomic_fetch_add(ssq + row, sq, __ATOMIC_RELAXED, __HIP_MEMORY_SCOPE_AGENT);
            }
        }
        asm volatile("s_waitcnt vmcnt(0)" ::: "memory");
        unsigned* pc = cnt + 64 * u.pm;
        if (fr == 0 && fq == 0) (void)__hip_atomic_fetch_add(pc, 1u, __ATOMIC_RELAXED, __HIP_MEMORY_SCOPE_AGENT);
        for (unsigned it = 0; it < (1u << 22); ++it) {
            if ((unsigned)__builtin_amdgcn_readfirstlane((int)__hip_atomic_load(pc, __ATOMIC_RELAXED, __HIP_MEMORY_SCOPE_AGENT)) >= 32u) break;
            __builtin_amdgcn_s_sleep(2);
        }
        __builtin_amdgcn_fence(__ATOMIC_ACQUIRE, "agent");
        f32x4 gv[2][2];
#pragma unroll
        for (int bj = 0; bj < 2; ++bj) { gv[bj][0] = *(const f32x4*)(g + col0 + bj * HALF); gv[bj][1] = *(const f32x4*)(g + col0 + bj * HALF + 4); }
        float rs8[8];
#pragma unroll
        for (int i = 0; i < 8; ++i) { const unsigned sb = __hip_atomic_load((const unsigned*)(ssq + u.pm * BM + (i >> 2) * HALF + wr * 64 + (i & 3) * 16 + fr), __ATOMIC_RELAXED, __HIP_MEMORY_SCOPE_AGENT);
            rs8[i] = __builtin_amdgcn_rsqf(__uint_as_float(sb) * (1.0f / 1024.0f) + 1e-6f); }
#pragma unroll
        for (int ai = 0; ai < 2; ++ai)
#pragma unroll
            for (int m = 0; m < 4; ++m) { const float rs = rs8[ai * 4 + m];
#pragma unroll
                for (int bj = 0; bj < 2; ++bj) { const size_t off = (size_t)(u.pm * BM + ai * HALF + wr * 64 + m * 16 + fr) * 1024 + col0 + bj * HALF;
                    *(f32x4*)(out + off) = acc[ai][bj][m][0] * rs * gv[bj][0]; *(f32x4*)(out + off + 4) = acc[ai][bj][m][1] * rs * gv[bj][1]; } }
    }
};
struct EpiGU {
    static constexpr bool PERM = true, AFTER_DRAIN = false;
    const float* ssq; bf16_t* H;
    __device__ __forceinline__ void operator()(const f32x4 (&acc)[2][2][4][2], const Unit& u, int wr, int wc, int fr, int fq) const {
        float sq8[8];
#pragma unroll
        for (int i = 0; i < 8; ++i) sq8[i] = ssq[u.pm * BM + (i >> 2) * HALF + wr * 64 + (i & 3) * 16 + fr];
#pragma unroll
        for (int ai = 0; ai < 2; ++ai)
#pragma unroll
            for (int m = 0; m < 4; ++m) {
                const int row = u.pm * BM + ai * HALF + wr * 64 + m * 16 + fr;
                const float rs = __builtin_amdgcn_rsqf(sq8[ai * 4 + m] * (1.0f / 1024.0f) + 1e-6f);
                float hv[8];
#pragma unroll
                for (int n = 0; n < 2; ++n)
#pragma unroll
                    for (int e = 0; e < 4; ++e) { const float gg = acc[ai][0][m][n][e] * rs, uu = acc[ai][1][m][n][e] * rs;
                        hv[n * 4 + e] = gg * uu * __builtin_amdgcn_rcpf(1.0f + __builtin_amdgcn_exp2f(-1.4426950408889634f * gg)); }
                u32x4 w; w.x = cvt_pk_bf16(hv[0], hv[1]); w.y = cvt_pk_bf16(hv[2], hv[3]); w.z = cvt_pk_bf16(hv[4], hv[5]); w.w = cvt_pk_bf16(hv[6], hv[7]);
                *(u32x4*)(H + (size_t)row * 2816 + u.pn * HALF + wc * 32 + 8 * fq) = w;
            }
    }
};
template <class Epi, class Sched, bool ALIGN_EPI = false, bool SP2 = false>
__device__ __forceinline__ void gemm_phase(PG8_LAS unsigned char* lds, const Gemm g, const Sched& S, const Epi& E, const int wv) {
    int tid_ = wv * 64 + hw_lane(); asm volatile("" : "+v"(tid_));
    const int tid = tid_, wid = __builtin_amdgcn_readfirstlane(tid >> 6), lane = tid & 63, wr = wid >> 2, wc = wid & 3, fr = lane & 15, fq = lane >> 4;
    const int K = g.K, nt = K / BK;
    unsigned voffA[2], voffB[2];
#pragma unroll
    for (int i = 0; i < 2; ++i) { int R, C; stage_rc(tid * 16 + i * 8192, R, C); const int Rb = Epi::PERM ? ((R & ~31) + perm32(R & 31)) : R;
        voffA[i] = (unsigned)(R * K + C) * 2u; voffB[i] = (unsigned)(Rb * K + C) * 2u; }
    const size_t kstep = (size_t)(BK * 2);
    const size_t hstep = (size_t)HALF * K * 2;
    const size_t tstep = 2 * hstep;
    const unsigned ldsw = (unsigned)wid * 1024u;
    const int aoff = lds_byte(wr * 64 + fr, fq * 8), boff = lds_byte(wc * 32 + fr, fq * 8);
#define PG8_SA(b, h) (((b) * 2 + (h)) * HTB)
#define PG8_SB(b, h) ((4 + (b) * 2 + (h)) * HTB)
#define PG8_STAGE(bufoff, gbase, voff) do { _Pragma("unroll") for (int _i = 0; _i < 2; ++_i) \
        __builtin_amdgcn_global_load_lds((const unsigned*)((const char*)(gbase) + (voff)[_i]), (PG8_LAS unsigned*)(lds + (bufoff) + ldsw + _i * 8192), 16, 0, 0); } while (0)
#define PG8_LDA(dst, b, h) do { _Pragma("unroll") for (int m = 0; m < 4; ++m) _Pragma("unroll") for (int k = 0; k < 2; ++k) dst[m][k] = *(const PG8_LAS bf16x8*)(lds + PG8_SA(b, h) + aoff + m * 2048 + k * 1024); } while (0)
#define PG8_LDB(dst, b, h) do { _Pragma("unroll") for (int n = 0; n < 2; ++n) _Pragma("unroll") for (int k = 0; k < 2; ++k) dst[n][k] = *(const PG8_LAS bf16x8*)(lds + PG8_SB(b, h) + boff + n * 2048 + k * 1024); } while (0)
#define PG8_MMA(ai, bj, At, Bt) do { __builtin_amdgcn_s_setprio(1); _Pragma("unroll") for (int m = 0; m < 4; ++m) _Pragma("unroll") for (int n = 0; n < 2; ++n) _Pragma("unroll") for (int k = 0; k < 2; ++k) \
        acc[ai][bj][m][n] = __builtin_amdgcn_mfma_f32_16x16x32_bf16(Bt[n][k], At[m][k], acc[ai][bj][m][n], 0, 0, 0); __builtin_amdgcn_s_setprio(0); } while (0)
#define PG8_WAIT_V(n) asm volatile("s_waitcnt vmcnt(" #n ")" ::: "memory")
#define PG8_WAIT_L(n) asm volatile("s_waitcnt lgkmcnt(" #n ")" ::: "memory")
#define PG8_BAR __builtin_amdgcn_s_barrier()
#define PG8_SCHED __builtin_amdgcn_sched_barrier(0)
    Unit cur, nxt; int ui = 0;
    if (!S.next(0, cur)) return;
    f32x4 acc[2][2][4][2];
#pragma unroll
    for (int a = 0; a < 2; ++a)
#pragma unroll
        for (int b = 0; b < 2; ++b)
#pragma unroll
            for (int m = 0; m < 4; ++m)
#pragma unroll
                for (int n = 0; n < 2; ++n) acc[a][b][m][n] = (f32x4){0.f, 0.f, 0.f, 0.f};
    bf16x8 At[4][2], B0[2][2], B1[2][2];
    const char* cA = (const char*)g.A + (size_t)cur.pm * tstep; const char* cB = (const char*)g.Bt + (size_t)cur.pn * tstep;
    S.a_ready(cur);
    if constexpr (SP2) {
        PG8_STAGE(PG8_SB(0, 0), cB, voffB); PG8_STAGE(PG8_SB(0, 1), cB + hstep, voffB); PG8_STAGE(PG8_SA(0, 0), cA, voffA); PG8_STAGE(PG8_SA(0, 1), cA + hstep, voffA);
        if (wr == 1) PG8_BAR;
        PG8_WAIT_V(2); PG8_BAR;
        PG8_STAGE(PG8_SB(1, 0), cB + kstep, voffB); PG8_STAGE(PG8_SA(1, 0), cA + kstep, voffA); PG8_STAGE(PG8_SB(1, 1), cB + hstep + kstep, voffB);
        PG8_WAIT_V(6); PG8_BAR;
    } else {
        PG8_STAGE(PG8_SB(0, 0), cB, voffB); PG8_STAGE(PG8_SA(0, 0), cA, voffA); PG8_STAGE(PG8_SB(0, 1), cB + hstep, voffB); PG8_STAGE(PG8_SA(0, 1), cA + hstep, voffA);
        if (wr == 1) PG8_BAR;
        PG8_WAIT_V(4); PG8_BAR;
        PG8_STAGE(PG8_SB(1, 0), cB + kstep, voffB); PG8_STAGE(PG8_SA(1, 0), cA + kstep, voffA); PG8_STAGE(PG8_SB(1, 1), cB + hstep + kstep, voffB);
        PG8_WAIT_V(6); PG8_BAR;
    }
    for (;;) {
        const bool has_next = S.next(ui + 1, nxt);
        const char* nA = has_next ? (const char*)g.A + (size_t)nxt.pm * tstep : cA; const char* nB = has_next ? (const char*)g.Bt + (size_t)nxt.pn * tstep : cB;
        for (int t = 0; t < nt; t += 2) {
            const bool last = (t == nt - 2);
            const char* a1 = cA + (size_t)(t + 1) * kstep;
            const char* a2 = last ? nA : cA + (size_t)(t + 2) * kstep; const char* b2 = last ? nB : cB + (size_t)(t + 2) * kstep;
            const char* a3 = a2 + kstep; const char* b3 = b2 + kstep;
            if (last && has_next) S.a_ready(nxt);
            if constexpr (SP2) {
            PG8_LDB(B0, 0, 0); PG8_LDB(B1, 0, 1); PG8_SCHED; PG8_LDA(At, 0, 0); PG8_STAGE(PG8_SA(1, 1), a1 + hstep, voffA);
            PG8_WAIT_V(8); PG8_WAIT_L(0); PG8_BAR; PG8_MMA(0, 0, At, B0); PG8_MMA(0, 1, At, B1); PG8_BAR; PG8_SCHED;
            PG8_LDA(At, 0, 1); PG8_STAGE(PG8_SB(0, 0), b2, voffB); PG8_STAGE(PG8_SB(0, 1), b2 + hstep, voffB); PG8_STAGE(PG8_SA(0, 0), a2, voffA);
            PG8_WAIT_V(8); PG8_WAIT_L(0); PG8_BAR; PG8_MMA(1, 0, At, B0); PG8_MMA(1, 1, At, B1); PG8_BAR; PG8_SCHED;
            PG8_LDB(B0, 1, 0); PG8_LDB(B1, 1, 1); PG8_SCHED; PG8_LDA(At, 1, 0); PG8_STAGE(PG8_SA(0, 1), a2 + hstep, voffA);
            PG8_WAIT_V(8); PG8_WAIT_L(0); PG8_BAR; PG8_MMA(0, 0, At, B0); PG8_MMA(0, 1, At, B1); PG8_BAR; PG8_SCHED;
            PG8_LDA(At, 1, 1); PG8_STAGE(PG8_SB(1, 0), b3, voffB); PG8_STAGE(PG8_SB(1, 1), b3 + hstep, voffB); PG8_STAGE(PG8_SA(1, 0), a3, voffA);
            PG8_WAIT_V(8); PG8_WAIT_L(0); PG8_BAR; PG8_MMA(1, 0, At, B0); PG8_MMA(1, 1, At, B1); PG8_BAR; PG8_SCHED;
            } else {
            PG8_LDB(B0, 0, 0); PG8_SCHED; PG8_LDA(At, 0, 0); PG8_STAGE(PG8_SA(1, 1), a1 + hstep, voffA);
            PG8_WAIT_L(8); PG8_BAR; PG8_WAIT_L(0); PG8_MMA(0, 0, At, B0); PG8_BAR; PG8_SCHED;
            PG8_LDB(B1, 0, 1); PG8_STAGE(PG8_SB(0, 0), b2, voffB);
            PG8_BAR; PG8_WAIT_L(0); PG8_MMA(0, 1, At, B1); PG8_BAR;
            PG8_LDA(At, 0, 1); PG8_STAGE(PG8_SA(0, 0), a2, voffA);
            PG8_BAR; PG8_WAIT_L(0); PG8_MMA(1, 0, At, B0); PG8_BAR; PG8_SCHED;
            PG8_STAGE(PG8_SB(0, 1), b2 + hstep, voffB);
            PG8_WAIT_V(6); PG8_BAR; PG8_MMA(1, 1, At, B1); PG8_BAR;
            PG8_LDB(B0, 1, 0); PG8_SCHED; PG8_LDA(At, 1, 0); PG8_STAGE(PG8_SA(0, 1), a2 + hstep, voffA);
            PG8_WAIT_L(8); PG8_BAR; PG8_WAIT_L(0); PG8_MMA(0, 0, At, B0); PG8_BAR; PG8_SCHED;
            PG8_LDB(B1, 1, 1); PG8_STAGE(PG8_SB(1, 0), b3, voffB);
            PG8_BAR; PG8_WAIT_L(0); PG8_MMA(0, 1, At, B1); PG8_BAR;
            PG8_LDA(At, 1, 1); PG8_STAGE(PG8_SA(1, 0), a3, voffA);
            PG8_BAR; PG8_WAIT_L(0); PG8_MMA(1, 0, At, B0); PG8_BAR; PG8_SCHED;
            PG8_STAGE(PG8_SB(1, 1), b3 + hstep, voffB);
            PG8_WAIT_V(6); PG8_BAR; PG8_MMA(1, 1, At, B1); PG8_BAR;
            }
        }
        if constexpr (ALIGN_EPI) { if (wr == 0) PG8_BAR; }
        if constexpr (!Epi::AFTER_DRAIN) { E(acc, cur, wr, wc, fr, fq); S.done(cur); }
        if (!has_next) break;
#pragma unroll
        for (int a = 0; a < 2; ++a)
#pragma unroll
            for (int b = 0; b < 2; ++b)
#pragma unroll
                for (int m = 0; m < 4; ++m)
#pragma unroll
                    for (int n = 0; n < 2; ++n) acc[a][b][m][n] = (f32x4){0.f, 0.f, 0.f, 0.f};
        cur = nxt; cA = nA; cB = nB; ++ui;
        if constexpr (ALIGN_EPI) { if (wr == 1) PG8_BAR; }
    }
    PG8_WAIT_V(0);
    if constexpr (!ALIGN_EPI) { if (wr == 0) PG8_BAR; }
    PG8_BAR;
    if constexpr (Epi::AFTER_DRAIN) { E.fused(acc, cur, wr, wc, fr, fq, lds, wid, lane); S.done(cur); }
#undef PG8_SA
#undef PG8_SB
#undef PG8_STAGE
#undef PG8_LDA
#undef PG8_LDB
#undef PG8_MMA
#undef PG8_WAIT_V
#undef PG8_WAIT_L
#undef PG8_BAR
#undef PG8_SCHED
}
}
namespace att {
#define LAS __attribute__((address_space(3)))
typedef unsigned short bf16_t;
typedef short bf16x8 __attribute__((ext_vector_type(8)));
typedef short s16x4 __attribute__((ext_vector_type(4)));
typedef float f32x16 __attribute__((ext_vector_type(16)));
typedef float f32x4 __attribute__((ext_vector_type(4)));
typedef unsigned u32x4 __attribute__((ext_vector_type(4)));
typedef unsigned u32x2 __attribute__((ext_vector_type(2)));
constexpr int KP = 144, VP = 264;
constexpr int KBUF = 128 * KP, VBUF = 128 * VP;
constexpr int OFF_K = 0, OFF_V = 2 * KBUF, OFF_B = OFF_V + 2 * VBUF, ATT_LDS = OFF_B + 1024;
#ifndef PIPE128
#define PIPE128 0
#endif
constexpr float RESC_THR = 60.f;
typedef float f32x2_t __attribute__((ext_vector_type(2))); typedef __bf16 bf16x2_t __attribute__((ext_vector_type(2)));
__device__ __forceinline__ unsigned cvtpk(float lo, float hi) { f32x2_t v = {lo, hi}; bf16x2_t b = __builtin_convertvector(v, bf16x2_t); return __builtin_bit_cast(unsigned, b); }
__device__ __forceinline__ float max3f(float a, float b, float c) { float r; asm("v_max3_f32 %0, %1, %2, %3" : "=v"(r) : "v"(a), "v"(b), "v"(c)); return r; }
__device__ __forceinline__ float xhalf_max(float m) { auto rr = __builtin_amdgcn_permlane32_swap(__float_as_uint(m), __float_as_uint(m), false, false); return fmaxf(__uint_as_float(rr[0]), __uint_as_float(rr[1])); }
__device__ __forceinline__ float xhalf_sum(float m) { auto rr = __builtin_amdgcn_permlane32_swap(__float_as_uint(m), __float_as_uint(m), false, false); return __uint_as_float(rr[0]) + __uint_as_float(rr[1]); }

typedef float f32x2v __attribute__((ext_vector_type(2)));
__device__ __forceinline__ void exp_sum_pk(f32x16& P0, f32x16& P1, float m, float& lrow) {
    const f32x2v mv = {m, m}; f32x2v s0 = {0.f, 0.f}, s1 = {0.f, 0.f};
#pragma unroll
    for (int r = 0; r < 16; r += 2) {
        f32x2v a = (f32x2v){P0[r], P0[r + 1]} - mv, b = (f32x2v){P1[r], P1[r + 1]} - mv;
        a.x = __builtin_amdgcn_exp2f(a.x); a.y = __builtin_amdgcn_exp2f(a.y); b.x = __builtin_amdgcn_exp2f(b.x); b.y = __builtin_amdgcn_exp2f(b.y);
        P0[r] = a.x; P0[r + 1] = a.y; P1[r] = b.x; P1[r + 1] = b.y; s0 += a; s1 += b;
    }
    s0 += s1; lrow += s0.x + s0.y;
}
template <int DV, bool CAUSAL, bool BIAS, int VAR = 0>
__device__ __forceinline__ void attn_stream(LAS unsigned char* lds, const bf16_t* Qg, int qpitch, const bf16_t* Kg, int kpitch, const bf16_t* Vtg, int vpitch,
                                            const float* bias, int q0, int ntiles, f32x16 (&o)[DV / 32], const int wv) {
    int tid_ = wv * 64 + hw_lane(); asm volatile("" : "+v"(tid_));
    const int tid = tid_, lane = tid & 63, r32 = lane & 31, hi = lane >> 5, w = __builtin_amdgcn_readfirstlane(tid >> 6);
    constexpr int NV = DV / 32;
    bf16x8 qf[4];
#pragma unroll
    for (int d0 = 0; d0 < 4; ++d0) qf[d0] = *(const bf16x8*)(Qg + (size_t)(q0 + 32 * w + r32) * qpitch + 16 * d0 + 8 * hi);
    const int krow = tid >> 3, kch = tid & 7, vrow = tid >> 4, vch = tid & 15;
    const bf16_t* ksrc = Kg + (size_t)krow * kpitch + kch * 8;
    const bf16_t* vsrc = Vtg + (size_t)vrow * vpitch + vch * 8;
    const unsigned kdst = OFF_K + krow * KP + kch * 16, vdst = OFF_V + vrow * VP + vch * 16;
    u32x4 kreg[2], vreg[NV]; f32x4 breg = {0.f, 0.f, 0.f, 0.f};
#define ATT_LOAD(t) do { \
        _Pragma("unroll") for (int i = 0; i < 2; ++i) kreg[i] = *(const u32x4*)(ksrc + (size_t)(128 * (t) + 64 * i) * kpitch); \
        _Pragma("unroll") for (int i = 0; i < NV; ++i) vreg[i] = *(const u32x4*)(vsrc + (size_t)(32 * i) * vpitch + 128 * (t)); \
        if (BIAS) { if (tid < 32) breg = *(const f32x4*)(bias + 128 * (t) + 4 * tid); } } while (0)
#define ATT_STORE(buf) do { \
        _Pragma("unroll") for (int i = 0; i < 2; ++i) *(LAS u32x4*)(lds + kdst + (buf) * KBUF + i * 64 * KP) = kreg[i]; \
        _Pragma("unroll") for (int i = 0; i < NV; ++i) { *(LAS u32x2*)(lds + vdst + (buf) * VBUF + i * 32 * VP) = (u32x2){vreg[i].x, vreg[i].y}; *(LAS u32x2*)(lds + vdst + (buf) * VBUF + i * 32 * VP + 8) = (u32x2){vreg[i].z, vreg[i].w}; } \
        if (BIAS) { if (tid < 32) *(LAS f32x4*)(lds + OFF_B + (buf) * 512 + 16 * tid) = breg; } } while (0)
    ATT_LOAD(0);
    ATT_STORE(0);
    __syncthreads();
    float mrow = -1e30f, lrow = 0.f;
#pragma unroll
    for (int d0 = 0; d0 < DV / 32; ++d0)
#pragma unroll
        for (int r = 0; r < 16; ++r) o[d0][r] = 0.f;
    const int qmin = q0 + 32 * w;
#define ATT_KLOAD(P0, P1, buf, sub) do { \
        LAS unsigned char* Ks_ = lds + OFF_K + (buf) * KBUF + (sub) * 64 * KP; \
        _Pragma("unroll") for (int d0 = 0; d0 < 4; ++d0) { kf[2 * d0] = *(LAS bf16x8*)(Ks_ + r32 * KP + (2 * d0 + hi) * 16); kf[2 * d0 + 1] = *(LAS bf16x8*)(Ks_ + (32 + r32) * KP + (2 * d0 + hi) * 16); } \
        if (BIAS) { LAS unsigned char* Bs_ = lds + OFF_B + (buf) * 512 + (sub) * 256; \
            _Pragma("unroll") for (int g = 0; g < 4; ++g) { const f32x4 b0 = *(LAS f32x4*)(Bs_ + (8 * g + 4 * hi) * 4), b1 = *(LAS f32x4*)(Bs_ + (32 + 8 * g + 4 * hi) * 4); \
                _Pragma("unroll") for (int e = 0; e < 4; ++e) { P0[4 * g + e] = b0[e]; P1[4 * g + e] = b1[e]; } } \
        } else { _Pragma("unroll") for (int r = 0; r < 16; ++r) { P0[r] = 0.f; P1[r] = 0.f; } } \
        __builtin_amdgcn_sched_barrier(0); } while (0)
#define ATT_QKM(P0, P1) do { \
        _Pragma("unroll") for (int d0 = 0; d0 < 4; ++d0) { \
            P0 = __builtin_amdgcn_mfma_f32_32x32x16_bf16(kf[2 * d0], qf[d0], P0, 0, 0, 0); \
            P1 = __builtin_amdgcn_mfma_f32_32x32x16_bf16(kf[2 * d0 + 1], qf[d0], P1, 0, 0, 0); } \
        __builtin_amdgcn_sched_barrier(0); } while (0)
#define ATT_VLOAD(buf, sub, KK0, NKK) do { \
        LAS unsigned char* Vs_ = lds + OFF_V + (buf) * VBUF + (sub) * 128; \
        _Pragma("unroll") for (int kk = 0; kk < (NKK); ++kk) _Pragma("unroll") for (int d0 = 0; d0 < DV / 32; ++d0) { \
            const LAS unsigned char* vp = Vs_ + (32 * d0 + r32) * VP + (16 * ((KK0) + kk) + 4 * hi) * 2; \
            const s16x4 lo = *(const LAS s16x4*)vp, hh = *(const LAS s16x4*)(vp + 16); \
            vf[kk * (DV / 32) + d0] = (bf16x8){lo[0], lo[1], lo[2], lo[3], hh[0], hh[1], hh[2], hh[3]}; } \
        __builtin_amdgcn_sched_barrier(0); } while (0)
#define ATT_SM(P0, P1, kv0) do { \
        if (CAUSAL && ((kv0) + 63 > qmin)) { const int qrel = qmin + r32 - (kv0); \
            _Pragma("unroll") for (int r = 0; r < 16; ++r) { const int kv = (r & 3) + 8 * (r >> 2) + 4 * hi; if (kv > qrel) P0[r] = -1e30f; if (kv + 32 > qrel) P1[r] = -1e30f; } } \
        float mt = max3f(P0[0], P1[0], P0[1]), mu = max3f(P1[1], P0[2], P1[2]); \
        _Pragma("unroll") for (int r = 3; r < 15; r += 2) { mt = max3f(mt, P0[r], P1[r]); mu = max3f(mu, P0[r + 1], P1[r + 1]); } \
        mt = max3f(mt, P0[15], P1[15]); mt = max3f(mt, mu, mu); \
        mt = xhalf_max(mt); \
        if (__builtin_amdgcn_ballot_w64(mt > mrow + RESC_THR) != 0ull) { \
            const float mnew = fmaxf(mrow, mt), alpha = __builtin_amdgcn_exp2f(mrow - mnew); mrow = mnew; lrow *= alpha; \
            _Pragma("unroll") for (int d0 = 0; d0 < DV / 32; ++d0) _Pragma("unroll") for (int r = 0; r < 16; ++r) o[d0][r] *= alpha; } \
        exp_sum_pk(P0, P1, mrow, lrow); \
        { u32x4 x; x.x = cvtpk(P0[0], P0[1]); x.y = cvtpk(P0[2], P0[3]); x.z = cvtpk(P0[4], P0[5]); x.w = cvtpk(P0[6], P0[7]); pb[0] = __builtin_bit_cast(bf16x8, x); \
          x.x = cvtpk(P0[8], P0[9]); x.y = cvtpk(P0[10], P0[11]); x.z = cvtpk(P0[12], P0[13]); x.w = cvtpk(P0[14], P0[15]); pb[1] = __builtin_bit_cast(bf16x8, x); \
          x.x = cvtpk(P1[0], P1[1]); x.y = cvtpk(P1[2], P1[3]); x.z = cvtpk(P1[4], P1[5]); x.w = cvtpk(P1[6], P1[7]); pb[2] = __builtin_bit_cast(bf16x8, x); \
          x.x = cvtpk(P1[8], P1[9]); x.y = cvtpk(P1[10], P1[11]); x.z = cvtpk(P1[12], P1[13]); x.w = cvtpk(P1[14], P1[15]); pb[3] = __builtin_bit_cast(bf16x8, x); } \
        __builtin_amdgcn_sched_barrier(0); } while (0)
#define ATT_PVM(KK0, NKK) do { \
        _Pragma("unroll") for (int kk = 0; kk < (NKK); ++kk) _Pragma("unroll") for (int d0 = 0; d0 < DV / 32; ++d0) \
            o[d0] = __builtin_amdgcn_mfma_f32_32x32x16_bf16(vf[kk * (DV / 32) + d0], pb[(KK0) + kk], o[d0], 0, 0, 0); \
        __builtin_amdgcn_sched_barrier(0); } while (0)
    bf16x8 kf[8], vf[8], pb[4];
    if constexpr (DV == 64) {
        f32x16 sa0, sa1, sb0, sb1; bf16x8 pc[4];
        const unsigned kofs = (unsigned)(krow * kpitch + kch * 8) * 2u, vofs = (unsigned)(vrow * vpitch + vch * 8) * 2u, bofs = (unsigned)tid * 16u;
#define ATT_HEAD(P0, P1, kv0, MT) do { \
        if (CAUSAL && ((kv0) + 63 > qmin)) { const int qrel = qmin + r32 - (kv0); \
            _Pragma("unroll") for (int r = 0; r < 16; ++r) { const int kv = (r & 3) + 8 * (r >> 2) + 4 * hi; if (kv > qrel) P0[r] = -1e30f; if (kv + 32 > qrel) P1[r] = -1e30f; } } \
        float mt_ = max3f(P0[0], P1[0], P0[1]), mu_ = max3f(P1[1], P0[2], P1[2]); \
        _Pragma("unroll") for (int r = 3; r < 15; r += 2) { mt_ = max3f(mt_, P0[r], P1[r]); mu_ = max3f(mu_, P0[r + 1], P1[r + 1]); } \
        mt_ = max3f(mt_, P0[15], P1[15]); mt_ = max3f(mt_, mu_, mu_); MT = xhalf_max(mt_); } while (0)
#define ATT_PACK(P0, P1, PB) do { u32x4 x; x.x = cvtpk(P0[0], P0[1]); x.y = cvtpk(P0[2], P0[3]); x.z = cvtpk(P0[4], P0[5]); x.w = cvtpk(P0[6], P0[7]); PB[0] = __builtin_bit_cast(bf16x8, x); \
          x.x = cvtpk(P0[8], P0[9]); x.y = cvtpk(P0[10], P0[11]); x.z = cvtpk(P0[12], P0[13]); x.w = cvtpk(P0[14], P0[15]); PB[1] = __builtin_bit_cast(bf16x8, x); \
          x.x = cvtpk(P1[0], P1[1]); x.y = cvtpk(P1[2], P1[3]); x.z = cvtpk(P1[4], P1[5]); x.w = cvtpk(P1[6], P1[7]); PB[2] = __builtin_bit_cast(bf16x8, x); \
          x.x = cvtpk(P1[8], P1[9]); x.y = cvtpk(P1[10], P1[11]); x.z = cvtpk(P1[12], P1[13]); x.w = cvtpk(P1[14], P1[15]); PB[3] = __builtin_bit_cast(bf16x8, x); } while (0)
#ifndef MIXN
#define MIXN 10
#endif
#define ATT_MIX8() do { if (MIXN > 0) { _Pragma("unroll") for (int i_ = 0; i_ < 8; ++i_) { __builtin_amdgcn_sched_group_barrier(0x008, 1, 0); __builtin_amdgcn_sched_group_barrier(0x402, MIXN, 0); } } } while (0)
        ATT_KLOAD(sa0, sa1, 0, 0); ATT_QKM(sa0, sa1);
        for (int t = 0; t < ntiles; ++t) {
            const int cur = t & 1, nxt = cur ^ 1; const bool more = (t + 1 < ntiles);
            if (more) {
                const char* kt_ = (const char*)(Kg + (size_t)(128 * (t + 1)) * kpitch);
#pragma unroll
                for (int i = 0; i < 2; ++i) kreg[i] = *(const u32x4*)(kt_ + (size_t)(64 * i) * kpitch * 2 + kofs);
                if (BIAS) { if (tid < 32) breg = *(const f32x4*)((const char*)(bias + 128 * (t + 1)) + bofs); } }
            ATT_KLOAD(sb0, sb1, cur, 1);
            { float mt; ATT_HEAD(sa0, sa1, 128 * t, mt);
              if (__builtin_amdgcn_ballot_w64(mt > mrow + RESC_THR) != 0ull) {
                  const float mnew = fmaxf(mrow, mt), alpha = __builtin_amdgcn_exp2f(mrow - mnew); mrow = mnew; lrow *= alpha;
#pragma unroll
                  for (int d0 = 0; d0 < DV / 32; ++d0)
#pragma unroll
                      for (int r = 0; r < 16; ++r) o[d0][r] *= alpha; } }
            __builtin_amdgcn_sched_barrier(0);
#pragma unroll
            for (int d0 = 0; d0 < 4; ++d0) { sb0 = __builtin_amdgcn_mfma_f32_32x32x16_bf16(kf[2 * d0], qf[d0], sb0, 0, 0, 0); sb1 = __builtin_amdgcn_mfma_f32_32x32x16_bf16(kf[2 * d0 + 1], qf[d0], sb1, 0, 0, 0); }
            exp_sum_pk(sa0, sa1, mrow, lrow);
            ATT_PACK(sa0, sa1, pb);
            ATT_MIX8();
            __builtin_amdgcn_sched_barrier(0);
            if (more) {
#pragma unroll
                for (int i = 0; i < 2; ++i) *(LAS u32x4*)(lds + kdst + nxt * KBUF + i * 64 * KP) = kreg[i];
                if (BIAS) { if (tid < 32) *(LAS f32x4*)(lds + OFF_B + nxt * 512 + 16 * tid) = breg; }
                const char* vt_ = (const char*)(Vtg + 128 * (t + 1));
#pragma unroll
                for (int i = 0; i < 2; ++i) kreg[i] = *(const u32x4*)(vt_ + (size_t)(32 * i) * vpitch * 2 + vofs); }
            { LAS unsigned char* Vs_ = lds + OFF_V + cur * VBUF;
#pragma unroll
              for (int kk = 0; kk < 4; ++kk)
#pragma unroll
                  for (int d0 = 0; d0 < 2; ++d0) { const LAS unsigned char* vp = Vs_ + (32 * d0 + r32) * VP + (16 * kk + 4 * hi) * 2;
                      const s16x4 lo = *(const LAS s16x4*)vp, hh = *(const LAS s16x4*)(vp + 16); kf[kk * 2 + d0] = (bf16x8){lo[0], lo[1], lo[2], lo[3], hh[0], hh[1], hh[2], hh[3]}; } }
            float mtb; ATT_HEAD(sb0, sb1, 128 * t + 64, mtb);
            const bool rescb = __builtin_amdgcn_ballot_w64(mtb > mrow + RESC_THR) != 0ull;
            const float mnewb = rescb ? fmaxf(mrow, mtb) : mrow, alphab = __builtin_amdgcn_exp2f(mrow - mnewb);
            float psb = 0.f;
            __builtin_amdgcn_sched_barrier(0);
#pragma unroll
            for (int kk = 0; kk < 4; ++kk)
#pragma unroll
                for (int d0 = 0; d0 < 2; ++d0) o[d0] = __builtin_amdgcn_mfma_f32_32x32x16_bf16(kf[kk * 2 + d0], pb[kk], o[d0], 0, 0, 0);
            exp_sum_pk(sb0, sb1, mnewb, psb);
            ATT_PACK(sb0, sb1, pc);
            ATT_MIX8();
            __builtin_amdgcn_sched_barrier(0);
            { LAS unsigned char* Vs_ = lds + OFF_V + cur * VBUF + 128;
#pragma unroll
              for (int kk = 0; kk < 4; ++kk)
#pragma unroll
                  for (int d0 = 0; d0 < 2; ++d0) { const LAS unsigned char* vp = Vs_ + (32 * d0 + r32) * VP + (16 * kk + 4 * hi) * 2;
                      const s16x4 lo = *(const LAS s16x4*)vp, hh = *(const LAS s16x4*)(vp + 16); kf[kk * 2 + d0] = (bf16x8){lo[0], lo[1], lo[2], lo[3], hh[0], hh[1], hh[2], hh[3]}; } }
            if (rescb) {
#pragma unroll
                for (int d0 = 0; d0 < DV / 32; ++d0)
#pragma unroll
                    for (int r = 0; r < 16; ++r) o[d0][r] *= alphab; }
            lrow = lrow * alphab + psb; mrow = mnewb;
            __builtin_amdgcn_sched_barrier(0);
#pragma unroll
            for (int kk = 0; kk < 4; ++kk)
#pragma unroll
                for (int d0 = 0; d0 < 2; ++d0) o[d0] = __builtin_amdgcn_mfma_f32_32x32x16_bf16(kf[kk * 2 + d0], pc[kk], o[d0], 0, 0, 0);
            __builtin_amdgcn_sched_barrier(0);
            if (more) {
#pragma unroll
                for (int i = 0; i < 2; ++i) { *(LAS u32x2*)(lds + vdst + nxt * VBUF + i * 32 * VP) = (u32x2){kreg[i].x, kreg[i].y}; *(LAS u32x2*)(lds + vdst + nxt * VBUF + i * 32 * VP + 8) = (u32x2){kreg[i].z, kreg[i].w}; } }
            __syncthreads();
            if (more) { ATT_KLOAD(sa0, sa1, nxt, 0); ATT_QKM(sa0, sa1); }
        }
#undef ATT_HEAD
#undef ATT_PACK
#undef ATT_MIX8
    } else if constexpr (DV == 128 && PIPE128) {
#define LOAD_A(t) do { _Pragma("unroll") for (int i = 0; i < 2; ++i) kreg[i] = *(const u32x4*)(ksrc + (size_t)(128 * (t) + 64 * i) * kpitch); \
        _Pragma("unroll") for (int i = 0; i < 2; ++i) vreg[i] = *(const u32x4*)(vsrc + (size_t)(32 * i) * vpitch + 128 * (t)); } while (0)
#define STORE_A(buf) do { _Pragma("unroll") for (int i = 0; i < 2; ++i) *(LAS u32x4*)(lds + kdst + (buf) * KBUF + i * 64 * KP) = kreg[i]; \
        _Pragma("unroll") for (int i = 0; i < 2; ++i) { *(LAS u32x2*)(lds + vdst + (buf) * VBUF + i * 32 * VP) = (u32x2){vreg[i].x, vreg[i].y}; *(LAS u32x2*)(lds + vdst + (buf) * VBUF + i * 32 * VP + 8) = (u32x2){vreg[i].z, vreg[i].w}; } } while (0)
#define LOAD_B(t) do { _Pragma("unroll") for (int i = 0; i < 2; ++i) vreg[i] = *(const u32x4*)(vsrc + (size_t)(32 * (i + 2)) * vpitch + 128 * (t)); } while (0)
#define STORE_B(buf) do { _Pragma("unroll") for (int i = 0; i < 2; ++i) { *(LAS u32x2*)(lds + vdst + (buf) * VBUF + (i + 2) * 32 * VP) = (u32x2){vreg[i].x, vreg[i].y}; *(LAS u32x2*)(lds + vdst + (buf) * VBUF + (i + 2) * 32 * VP + 8) = (u32x2){vreg[i].z, vreg[i].w}; } } while (0)
        f32x16 sa0, sa1, sb0, sb1;
        ATT_KLOAD(sa0, sa1, 0, 0); ATT_QKM(sa0, sa1);
        for (int t = 0; t < ntiles; ++t) {
            const int cur = t & 1, nxt = cur ^ 1; const bool more = (t + 1 < ntiles);
            if (more) LOAD_A(t + 1);
            ATT_KLOAD(sb0, sb1, cur, 1); ATT_QKM(sb0, sb1);
            ATT_VLOAD(cur, 0, 0, 1);
            ATT_SM(sa0, sa1, 128 * t);
            ATT_PVM(0, 1); ATT_VLOAD(cur, 0, 1, 1); ATT_PVM(1, 1); ATT_VLOAD(cur, 0, 2, 1); ATT_PVM(2, 1); ATT_VLOAD(cur, 0, 3, 1); ATT_PVM(3, 1);
            if (more) { STORE_A(nxt); LOAD_B(t + 1); }
            ATT_VLOAD(cur, 1, 0, 1);
            ATT_SM(sb0, sb1, 128 * t + 64);
            ATT_PVM(0, 1); ATT_VLOAD(cur, 1, 1, 1); ATT_PVM(1, 1); ATT_VLOAD(cur, 1, 2, 1); ATT_PVM(2, 1); ATT_VLOAD(cur, 1, 3, 1); ATT_PVM(3, 1);
            if (more) STORE_B(nxt);
            __syncthreads();
            if (more) { ATT_KLOAD(sa0, sa1, nxt, 0); ATT_QKM(sa0, sa1); }
        }
#undef LOAD_A
#undef STORE_A
#undef LOAD_B
#undef STORE_B
    } else {
        f32x16 sa0, sa1;
        for (int t = 0; t < ntiles; ++t) {
            const int cur = t & 1, nxt = cur ^ 1; const bool more = (t + 1 < ntiles);
            if (more) ATT_LOAD(t + 1);
#pragma unroll
            for (int sub = 0; sub < 2; ++sub) {
                if (!(CAUSAL && (128 * t + 64 * sub > qmin + 31))) {
                    ATT_KLOAD(sa0, sa1, cur, sub); ATT_QKM(sa0, sa1);
                    ATT_VLOAD(cur, sub, 0, 1);
                    ATT_SM(sa0, sa1, 128 * t + 64 * sub);
                    ATT_PVM(0, 1);
                    ATT_VLOAD(cur, sub, 1, 1); ATT_PVM(1, 1);
                    ATT_VLOAD(cur, sub, 2, 1); ATT_PVM(2, 1);
                    ATT_VLOAD(cur, sub, 3, 1); ATT_PVM(3, 1);
                }
            }
            if (more) ATT_STORE(nxt);
            __syncthreads();
        }
    }
#undef ATT_KLOAD
#undef ATT_QKM
#undef ATT_VLOAD
#undef ATT_SM
#undef ATT_PVM
#undef ATT_LOAD
#undef ATT_STORE
    const float inv = __builtin_amdgcn_rcpf(xhalf_sum(lrow));
#pragma unroll
    for (int d0 = 0; d0 < DV / 32; ++d0)
#pragma unroll
        for (int r = 0; r < 16; ++r) o[d0][r] *= inv;
}
constexpr int KP2 = 272, KBUF2 = 128 * KP2, OFF_K2 = 0, OFF_V2 = 2 * KBUF2;
template <int SEQ_>
__device__ __forceinline__ void attn_diff_unit(LAS unsigned char* lds, const bf16_t* Qg, const bf16_t* Kg, const bf16_t* Vtg, int q0, int ntiles, float lam, float post,
                                               const float* subln_g, bf16_t* mixbase, const int wv) {
    constexpr int DV = 128;
    int tid_ = wv * 64 + hw_lane(); asm volatile("" : "+v"(tid_));
    const int tid = tid_, lane = tid & 63, r32 = lane & 31, hi = lane >> 5, w = __builtin_amdgcn_readfirstlane(tid >> 6), wr = w & 3, strm = w >> 2;
    bf16x8 qf[4];
#pragma unroll
    for (int d0 = 0; d0 < 4; ++d0) qf[d0] = *(const bf16x8*)(Qg + (size_t)(q0 + 32 * wr + r32) * 768 + 64 * strm + 16 * d0 + 8 * hi);
    const int srow = tid >> 4, sch = tid & 15;
    const bf16_t* ksrc = Kg + (size_t)srow * 768 + sch * 8;
    const bf16_t* vsrc = Vtg + (size_t)srow * SEQ_ + sch * 8;
    const unsigned kdst = OFF_K2 + srow * KP2 + sch * 16, vdst = OFF_V2 + srow * VP + sch * 16;
    u32x4 sreg[4];
#define D_LOADK(t) do { _Pragma("unroll") for (int i = 0; i < 4; ++i) sreg[i] = *(const u32x4*)(ksrc + (size_t)(128 * (t) + 32 * i) * 768); } while (0)
#define D_STOREK(buf) do { _Pragma("unroll") for (int i = 0; i < 4; ++i) *(LAS u32x4*)(lds + kdst + (buf) * KBUF2 + i * 32 * KP2) = sreg[i]; } while (0)
#define D_LOADV(t) do { _Pragma("unroll") for (int i = 0; i < 4; ++i) sreg[i] = *(const u32x4*)(vsrc + (size_t)(32 * i) * SEQ_ + 128 * (t)); } while (0)
#define D_STOREV(buf) do { _Pragma("unroll") for (int i = 0; i < 4; ++i) { *(LAS u32x2*)(lds + vdst + (buf) * VBUF + i * 32 * VP) = (u32x2){sreg[i].x, sreg[i].y}; *(LAS u32x2*)(lds + vdst + (buf) * VBUF + i * 32 * VP + 8) = (u32x2){sreg[i].z, sreg[i].w}; } } while (0)
    D_LOADK(0); D_STOREK(0); D_LOADV(0); D_STOREV(0);
    __syncthreads();
    float mrow = -1e30f, lrow = 0.f;
    f32x16 o[4];
#pragma unroll
    for (int d0 = 0; d0 < 4; ++d0)
#pragma unroll
        for (int r = 0; r < 16; ++r) o[d0][r] = 0.f;
    const int qmin = q0 + 32 * wr;
    bf16x8 kf[8], vf[4], vg[4], pb[4];
    f32x16 p0, p1;
#define D_SUB(buf, sub, kv0) do { if (!((kv0) > qmin + 31)) { \
        LAS unsigned char* Ks_ = lds + OFF_K2 + (buf) * KBUF2 + (sub) * 64 * KP2 + strm * 128; \
        _Pragma("unroll") for (int d0 = 0; d0 < 4; ++d0) { kf[2 * d0] = *(LAS bf16x8*)(Ks_ + r32 * KP2 + (2 * d0 + hi) * 16); kf[2 * d0 + 1] = *(LAS bf16x8*)(Ks_ + (32 + r32) * KP2 + (2 * d0 + hi) * 16); } \
        _Pragma("unroll") for (int r = 0; r < 16; ++r) { p0[r] = 0.f; p1[r] = 0.f; } \
        __builtin_amdgcn_sched_barrier(0); \
        _Pragma("unroll") for (int d0 = 0; d0 < 4; ++d0) { \
            p0 = __builtin_amdgcn_mfma_f32_32x32x16_bf16(kf[2 * d0], qf[d0], p0, 0, 0, 0); \
            p1 = __builtin_amdgcn_mfma_f32_32x32x16_bf16(kf[2 * d0 + 1], qf[d0], p1, 0, 0, 0); } \
        __builtin_amdgcn_sched_barrier(0); \
        LAS unsigned char* Vs_ = lds + OFF_V2 + (buf) * VBUF + (sub) * 128; \
        D_VLOAD(0); \
        if ((kv0) + 63 > qmin) { const int qrel = qmin + r32 - (kv0); \
            _Pragma("unroll") for (int r = 0; r < 16; ++r) { const int kv = (r & 3) + 8 * (r >> 2) + 4 * hi; if (kv > qrel) p0[r] = -1e30f; if (kv + 32 > qrel) p1[r] = -1e30f; } } \
        float mt = max3f(p0[0], p1[0], p0[1]), mu = max3f(p1[1], p0[2], p1[2]); \
        _Pragma("unroll") for (int r = 3; r < 15; r += 2) { mt = max3f(mt, p0[r], p1[r]); mu = max3f(mu, p0[r + 1], p1[r + 1]); } \
        mt = max3f(mt, p0[15], p1[15]); mt = max3f(mt, mu, mu); \
        mt = xhalf_max(mt); \
        if (__builtin_amdgcn_ballot_w64(mt > mrow + RESC_THR) != 0ull) { \
            const float mnew = fmaxf(mrow, mt), alpha = __builtin_amdgcn_exp2f(mrow - mnew); mrow = mnew; lrow *= alpha; \
            _Pragma("unroll") for (int d0 = 0; d0 < 4; ++d0) _Pragma("unroll") for (int r = 0; r < 16; ++r) o[d0][r] *= alpha; } \
        exp_sum_pk(p0, p1, mrow, lrow); \
        { u32x4 x; x.x = cvtpk(p0[0], p0[1]); x.y = cvtpk(p0[2], p0[3]); x.z = cvtpk(p0[4], p0[5]); x.w = cvtpk(p0[6], p0[7]); pb[0] = __builtin_bit_cast(bf16x8, x); \
          x.x = cvtpk(p0[8], p0[9]); x.y = cvtpk(p0[10], p0[11]); x.z = cvtpk(p0[12], p0[13]); x.w = cvtpk(p0[14], p0[15]); pb[1] = __builtin_bit_cast(bf16x8, x); \
          x.x = cvtpk(p1[0], p1[1]); x.y = cvtpk(p1[2], p1[3]); x.z = cvtpk(p1[4], p1[5]); x.w = cvtpk(p1[6], p1[7]); pb[2] = __builtin_bit_cast(bf16x8, x); \
          x.x = cvtpk(p1[8], p1[9]); x.y = cvtpk(p1[10], p1[11]); x.z = cvtpk(p1[12], p1[13]); x.w = cvtpk(p1[14], p1[15]); pb[3] = __builtin_bit_cast(bf16x8, x); } \
        __builtin_amdgcn_sched_barrier(0); \
        D_VLOADB(1); D_PVM(0); D_VLOAD(2); D_PVMB(1); D_VLOADB(3); D_PVM(2); D_PVMB(3); } } while (0)
#define D_VLOAD(KK) do { _Pragma("unroll") for (int d0 = 0; d0 < 4; ++d0) { \
            const LAS unsigned char* vp = Vs_ + (32 * d0 + r32) * VP + (16 * (KK) + 4 * hi) * 2; \
            const s16x4 lo = *(const LAS s16x4*)vp, hh = *(const LAS s16x4*)(vp + 16); \
            vf[d0] = (bf16x8){lo[0], lo[1], lo[2], lo[3], hh[0], hh[1], hh[2], hh[3]}; } \
        __builtin_amdgcn_sched_barrier(0); } while (0)
#define D_VLOADB(KK) do { _Pragma("unroll") for (int d0 = 0; d0 < 4; ++d0) { \
            const LAS unsigned char* vp = Vs_ + (32 * d0 + r32) * VP + (16 * (KK) + 4 * hi) * 2; \
            const s16x4 lo = *(const LAS s16x4*)vp, hh = *(const LAS s16x4*)(vp + 16); \
            vg[d0] = (bf16x8){lo[0], lo[1], lo[2], lo[3], hh[0], hh[1], hh[2], hh[3]}; } \
        __builtin_amdgcn_sched_barrier(0); } while (0)
#define D_PVMB(KK) do { _Pragma("unroll") for (int d0 = 0; d0 < 4; ++d0) o[d0] = __builtin_amdgcn_mfma_f32_32x32x16_bf16(vg[d0], pb[KK], o[d0], 0, 0, 0); \
        __builtin_amdgcn_sched_barrier(0); } while (0)
#define D_PVM(KK) do { _Pragma("unroll") for (int d0 = 0; d0 < 4; ++d0) o[d0] = __builtin_amdgcn_mfma_f32_32x32x16_bf16(vf[d0], pb[KK], o[d0], 0, 0, 0); \
        __builtin_amdgcn_sched_barrier(0); } while (0)
    for (int t = 0; t < ntiles; ++t) {
        const int cur = t & 1, nxt = cur ^ 1; const bool more = (t + 1 < ntiles);
        if (more) D_LOADK(t + 1);
        D_SUB(cur, 0, 128 * t);
        if (more) { D_STOREK(nxt); D_LOADV(t + 1); }
        D_SUB(cur, 1, 128 * t + 64);
        if (more) D_STOREV(nxt);
        __syncthreads();
    }
#undef D_LOADK
#undef D_STOREK
#undef D_LOADV
#undef D_STOREV
#undef D_SUB
#undef D_VLOAD
#undef D_PVM
#undef D_VLOADB
#undef D_PVMB
    const float inv = __builtin_amdgcn_rcpf(xhalf_sum(lrow));
    const int lane_e = hw_lane(), r32e = lane_e & 31, hie = lane_e >> 5;
    if (strm == 1) {
#pragma unroll
        for (int d0 = 0; d0 < 4; ++d0)
#pragma unroll
            for (int g4 = 0; g4 < 4; ++g4) *(LAS f32x4*)(lds + (((d0 * 4 + g4) * 4 + wr) * 64 + lane_e) * 16) = (f32x4){o[d0][4 * g4] * inv, o[d0][4 * g4 + 1] * inv, o[d0][4 * g4 + 2] * inv, o[d0][4 * g4 + 3] * inv};
    }
    __syncthreads();
    if (strm == 0) {
        float sq = 0.f;
#pragma unroll
        for (int d0 = 0; d0 < 4; ++d0)
#pragma unroll
            for (int g4 = 0; g4 < 4; ++g4) { const f32x4 a = *(LAS f32x4*)(lds + (((d0 * 4 + g4) * 4 + wr) * 64 + lane_e) * 16);
#pragma unroll
                for (int e = 0; e < 4; ++e) { const float y = o[d0][4 * g4 + e] * inv - lam * a[e]; o[d0][4 * g4 + e] = y; sq += y * y; } }
        sq = xhalf_sum(sq);
        const float rn = __builtin_amdgcn_rsqf(sq * (1.0f / 128.0f) + 1e-6f) * post;
        bf16_t* dst = mixbase + (size_t)(q0 + 32 * wr + r32e) * 1024;
#pragma unroll
        for (int d0 = 0; d0 < 4; ++d0)
#pragma unroll
            for (int g4 = 0; g4 < 4; ++g4) { const f32x4 gv = *(const f32x4*)(subln_g + 32 * d0 + 8 * g4 + 4 * hie);
                u32x2 x; x.x = cvtpk(o[d0][4 * g4] * rn * gv[0], o[d0][4 * g4 + 1] * rn * gv[1]); x.y = cvtpk(o[d0][4 * g4 + 2] * rn * gv[2], o[d0][4 * g4 + 3] * rn * gv[3]);
                *(u32x2*)(dst + 32 * d0 + 8 * g4 + 4 * hie) = x; }
    }
}
template <int DV> __device__ __forceinline__ void store_o(bf16_t* dstrow, const f32x16 (&o)[DV / 32], int hi) {
#pragma unroll
    for (int d0 = 0; d0 < DV / 32; ++d0)
#pragma unroll
        for (int g = 0; g < 4; ++g) { u32x2 x; x.x = cvtpk(o[d0][4 * g], o[d0][4 * g + 1]); x.y = cvtpk(o[d0][4 * g + 2], o[d0][4 * g + 3]);
            *(u32x2*)(dstrow + 32 * d0 + 8 * g + 4 * hi) = x; }
}
}
__constant__ float INV_FREQ[32] = {1.000000000e+00f, 7.498942614e-01f, 5.623413324e-01f, 4.216965139e-01f, 3.162277639e-01f, 2.371373773e-01f, 1.778279394e-01f, 1.333521307e-01f, 1.000000015e-01f, 7.498941571e-02f, 5.623413250e-02f, 4.216965288e-02f, 3.162277490e-02f, 2.371373773e-02f, 1.778279431e-02f, 1.333521493e-02f, 9.999999776e-03f, 7.498941850e-03f, 5.623413250e-03f, 4.216964822e-03f, 3.162277630e-03f, 2.371373586e-03f, 1.778279431e-03f, 1.333521446e-03f, 1.000000047e-03f, 7.498942432e-04f, 5.623413017e-04f, 4.216965172e-04f, 3.162277571e-04f, 2.371373703e-04f, 1.778279402e-04f, 1.333521504e-04f};
namespace cg = cooperative_groups;
typedef unsigned short bf16;
typedef float f32x4 __attribute__((ext_vector_type(4)));
typedef unsigned v4u __attribute__((ext_vector_type(4)));
typedef unsigned v2u __attribute__((ext_vector_type(2)));
constexpr int NB = 4, SEQ = 4096, DM = 1024, M = NB * SEQ, NMEM = 256, MM = NB * NMEM, DFF = 2816, NPROJ = 2560, NPROJA = 2816;
constexpr float C2 = 0.125f * 1.4426950408889634f;
constexpr float LAMBDA_INIT = 0.35550906759096934f;
constexpr size_t MiB = 1u << 20;
constexpr size_t WS_CTL = 0;
constexpr size_t WS_SSQ = 1 * MiB;
constexpr size_t WS_SSQM = WS_SSQ + 5 * (size_t)M * 4;
constexpr size_t WS_LF = 2 * MiB;
constexpr size_t WS_COS = 3 * MiB, WS_SIN = 3 * MiB + 512 * 1024;
constexpr size_t WS_INVREV = 2 * MiB + 800 * 1024;
constexpr size_t WS_WA = 4 * MiB, WS_WB = 10 * MiB, WS_WO = 15 * MiB, WS_WM = 19 * MiB, WS_WGU = 21 * MiB, WS_WD = 43 * MiB;
constexpr size_t WS_MEMB = 54 * MiB, WS_MK = 56 * MiB, WS_MVT = 57 * MiB;
constexpr size_t WS_XB = 58 * MiB;
constexpr size_t WS_Q = 90 * MiB, WS_K = 114 * MiB, WS_VT = 138 * MiB, WS_MQ = 162 * MiB, WS_MIX = 170 * MiB, WS_H = 90 * MiB, WS_STASH = 202 * MiB, WS_END = 234 * MiB;
static_assert(WS_H + (size_t)M * DFF * 2 <= WS_END, "h overlay");
constexpr int LDS_BYTES = 147456, LDS_MISC = LDS_BYTES - 1024, LDS_ARGS = LDS_MISC + 256;

constexpr int CW_BAR = 4096;
struct Args {
    const float *x, *mem, *attn_g, *mem_g, *w_mem_kv, *w_out, *ffn_g, *w_gate_up, *w_down, *a_w_in, *a_b_f, *b_w_in, *lq1, *lk1, *lq2, *lk2, *subln_g, *kv_g, *w_kv, *final_g;
    float* out; unsigned char* ws;
};

__device__ __forceinline__ unsigned f2bf(float f) { unsigned u = __builtin_bit_cast(unsigned, f); return (u + 0x7fffu + ((u >> 16) & 1u)) >> 16; }
__device__ __forceinline__ unsigned pk2(float lo, float hi) { return att::cvtpk(lo, hi); }
__device__ __forceinline__ float wave_sum(float v) {
#pragma unroll
    for (int o = 1; o < 64; o <<= 1) v += __shfl_xor(v, o);
    return v;
}
__device__ __forceinline__ void wt_item(const float* W, int ldw, int K, const float* g, bf16* WT, int k0, int c0, int nvalid, int drowA, int drowB, LAS float* scr, int lane) {
    const int kq = lane >> 4, n4 = 4 * (lane & 15);
    f32x4 v[16]; float gk[16];
#pragma unroll
    for (int i = 0; i < 16; ++i) gk[i] = g ? g[k0 + 4 * i + kq] : 1.0f;
#pragma unroll
    for (int i = 0; i < 16; ++i) v[i] = *(const f32x4*)(W + (size_t)(k0 + 4 * i + kq) * ldw + c0 + n4);
    if (g) {
#pragma unroll
        for (int i = 0; i < 16; ++i) v[i] = v[i] * gk[i];
    }
    if (nvalid < 64) {
#pragma unroll
        for (int i = 0; i < 16; ++i)
#pragma unroll
            for (int e = 0; e < 4; ++e) if (n4 + e >= nvalid) v[i][e] = 0.f;
    }
#pragma unroll
    for (int i = 0; i < 16; ++i)
#pragma unroll
        for (int e = 0; e < 4; ++e) scr[(4 * i + kq) * 65 + n4 + e] = v[i][e];
    asm volatile("s_waitcnt lgkmcnt(0)" ::: "memory");
#pragma unroll
    for (int j = 0; j < 8; ++j) { const int q = lane + 64 * j, n = q >> 3, kc = q & 7; const LAS float* s = scr + (8 * kc) * 65 + n;
        v4u o; o.x = pk2(s[0 * 65], s[1 * 65]); o.y = pk2(s[2 * 65], s[3 * 65]); o.z = pk2(s[4 * 65], s[5 * 65]); o.w = pk2(s[6 * 65], s[7 * 65]);
        const int drow = (n < 32) ? drowA + n : drowB + n - 32;
        *(v4u*)(WT + (size_t)drow * K + k0 + 8 * kc) = o; }
    asm volatile("s_waitcnt lgkmcnt(0)" ::: "memory");
}
__device__ __forceinline__ int wt_drow(int l, int drow0, int kind) {
    if (kind == 0) return drow0 + l;
    if (kind == 1) return drow0 + (l / 256) * 256 + ((l >> 5) & 1) * 128 + ((l & 255) >> 6) * 32;
    const int up = l >= DFF ? 1 : 0, j = l - up * DFF; return drow0 + (j / 128) * 256 + up * 128 + (j & 127);
}
__device__ __forceinline__ void wt_job(int it, const float* W, int ldw, int K, int c_src, int ncols, int nvalid, const float* g, bf16* WT, int drow0, int kind, LAS float* scr, int lane) {
    const int nblk = ncols / 64, kb = it / nblk, nb = it % nblk; const int l = nb * 64;
    wt_item(W, ldw, K, g, WT, kb * 64, c_src + l, nvalid, wt_drow(l, drow0, kind), wt_drow(l + 32, drow0, kind), scr, lane);
}
#define XB_TMO      128
#define XB_XCNT(j)  (256  + 64 * (j))
#define XB_XSUB(j)  (1280 + 64 * (j))
#define XB_XGEN(j)  (2304 + 64 * (j))
#define XB_TOP      3328
#define XB_TOPGEN   3392
#define XCD_BAR_WORDS 3456
#define XB_SPIN_CAP (1u << 18)

__device__ __forceinline__ unsigned xb_ld(unsigned* p)              { return __hip_atomic_load(p, __ATOMIC_RELAXED, __HIP_MEMORY_SCOPE_AGENT); }
__device__ __forceinline__ unsigned xb_add(unsigned* p, unsigned v) { return __hip_atomic_fetch_add(p, v, __ATOMIC_RELAXED, __HIP_MEMORY_SCOPE_AGENT); }
__device__ __forceinline__ unsigned xb_xcc_id() { return (unsigned)__builtin_amdgcn_s_getreg((3 << 11) | 20) & 0xFu; }
#define XB_SPIN(cond, bar) do { unsigned _sp = 0; while (cond) { __builtin_amdgcn_s_sleep(1); \
    if ((++_sp & 255u) == 0u) { if (xb_ld(&(bar)[XB_TMO])) break; if (_sp > XB_SPIN_CAP) { atomicAdd(&(bar)[XB_TMO], 1u); break; } } } } while (0)

struct XcdBarrier {
    unsigned* bar; unsigned x; int wv;
    volatile LAS unsigned* st;
};

__device__ __forceinline__ XcdBarrier xcd_barrier_post(unsigned* bar, volatile LAS unsigned* st) {
    XcdBarrier b; b.bar = bar; b.x = xb_xcc_id(); b.st = st; b.wv = 0;
    if (threadIdx.x == 0) (void)xb_add(&bar[XB_XCNT(b.x)], 1u);
    return b;
}
__device__ __forceinline__ void xcd_barrier_complete(unsigned* bar, unsigned x, unsigned& nloc, unsigned& nx) {
    const unsigned G = gridDim.x * gridDim.y * gridDim.z;
    unsigned sum, cnt, mine, sp = 0u;
    for (;;) {
        sum = 0u; cnt = 0u; mine = 0u;
#pragma unroll
        for (unsigned j = 0; j < 16; ++j) { const unsigned c = xb_ld(&bar[XB_XCNT(j)]); sum += c; cnt += (c > 0u) ? 1u : 0u; mine = (j == x) ? c : mine; }
        if (sum == G) break;
        __builtin_amdgcn_s_sleep(1);
        if ((++sp & 255u) == 0u) { if (xb_ld(&bar[XB_TMO])) break; if (sp > XB_SPIN_CAP) { atomicAdd(&bar[XB_TMO], 1u); break; } }
    }
    nloc = mine > 0u ? mine : 1u; nx = cnt > 0u ? cnt : 1u;
}

__device__ __forceinline__ void xcd_barrier(const XcdBarrier& b) {
    asm volatile("s_waitcnt vmcnt(0)" ::: "memory");
    __syncthreads();
    if (b.wv * 64 + hw_lane() == 0) {
        unsigned* bar = b.bar;
        __builtin_amdgcn_s_waitcnt(0);
        unsigned nloc = b.st[0], nx = b.st[1];
        if (nloc == 0u) { xcd_barrier_complete(bar, b.x, nloc, nx); b.st[0] = nloc; b.st[1] = nx; }
        const unsigned old = xb_add(&bar[XB_XSUB(b.x)], 1u);
        const unsigned gen = old / nloc;
        if (old + 1u == (gen + 1u) * nloc) {
            __builtin_amdgcn_fence(__ATOMIC_RELEASE, "agent");
            asm volatile("s_waitcnt vmcnt(0)" ::: "memory");
            const unsigned og = xb_add(&bar[XB_TOP], 1u);
            const unsigned tg = og / nx;
            if (og + 1u == (tg + 1u) * nx) xb_add(&bar[XB_TOPGEN], 1u);
            else XB_SPIN(xb_ld(&bar[XB_TOPGEN]) == tg, bar);
            __builtin_amdgcn_fence(__ATOMIC_ACQUIRE, "agent");
            xb_add(&bar[XB_XGEN(b.x)], 1u);
            asm volatile("s_waitcnt vmcnt(0)" ::: "memory");
        } else {
            XB_SPIN(xb_ld(&bar[XB_XGEN(b.x)]) == gen, bar);
            __builtin_amdgcn_fence(__ATOMIC_ACQUIRE, "agent");
            asm volatile("s_waitcnt vmcnt(0)" ::: "memory");
        }
    }
    __syncthreads();
}
#ifndef NREP_SYNC
#define NREP_SYNC 0
#endif
#ifndef NREP2
#define NREP2 1
#endif
#ifndef NREP7
#define NREP7 1
#endif
#ifndef NREP4
#define NREP4 1
#endif
#ifndef NREP1
#define NREP1 1
#endif
#ifndef NREP0
#define NREP0 1
#endif
#ifndef NREP35
#define NREP35 1
#endif
#ifndef PREREAD
#define PREREAD 0
#endif
#ifndef NREPB
#define NREPB 1
#endif
#ifndef USE_XB
#define USE_XB 1
#endif
#ifndef PVAR
#define PVAR 0
#endif
#ifndef PH_MASK
#define PH_MASK 0xFFFF
#endif
__device__ __forceinline__ void scan_bh(float* lf, LAS float* sm, int tid) {
    const f32x4 a = *(const f32x4*)(lf + 8 * tid), b = *(const f32x4*)(lf + 8 * tid + 4);
    float v[8] = {a[0], a[1], a[2], a[3], b[0], b[1], b[2], b[3]};
#pragma unroll
    for (int i = 1; i < 8; ++i) v[i] += v[i - 1];
    float tot = v[7]; const int lane = tid & 63, w = tid >> 6;
    float inc = tot;
#pragma unroll
    for (int o = 1; o < 64; o <<= 1) { const float n = __shfl_up(inc, o); if (lane >= o) inc += n; }
    if (lane == 63) sm[w] = inc;
    __syncthreads();
    float base = inc - tot;
    for (int i = 0; i < w; ++i) base += sm[i];
    const float k = -1.4426950408889634f;
    f32x4 oa, ob;
#pragma unroll
    for (int i = 0; i < 4; ++i) { oa[i] = (v[i] + base) * k; ob[i] = (v[4 + i] + base) * k; }
    *(f32x4*)(lf + 8 * tid) = oa; *(f32x4*)(lf + 8 * tid + 4) = ob;
    __syncthreads();
}

enum { AX = 0, AMEM, AATTN_G, AMEM_G, AW_MEM_KV, AW_OUT, AFFN_G, AW_GATE_UP, AW_DOWN, AA_W_IN, AA_B_F, AB_W_IN, ALQ1, ALK1, ALQ2, ALK2, ASUBLN_G, AKV_G, AW_KV, AFINAL_G, AOUT, AWS };
__device__ __forceinline__ const float* argp(LAS unsigned char* lds, int i) {
    volatile LAS unsigned* p = (volatile LAS unsigned*)(lds + LDS_ARGS + 8 * i);
    const unsigned lo = __builtin_amdgcn_readfirstlane(p[0]), hi = __builtin_amdgcn_readfirstlane(p[1]);
    return (const float*)(__attribute__((address_space(1))) const float*)(((unsigned long long)hi << 32) | (unsigned long long)lo);
}
#define WSPTRS() \
    unsigned char* ws = (unsigned char*)argp(lds, AWS); \
    unsigned* ctl = (unsigned*)(ws + WS_CTL); float* ssq = (float*)(ws + WS_SSQ); float* ssqm = (float*)(ws + WS_SSQM); \
    float* LF = (float*)(ws + WS_LF); float* COS = (float*)(ws + WS_COS); float* SIN = (float*)(ws + WS_SIN); \
    bf16 *WA = (bf16*)(ws + WS_WA), *WB = (bf16*)(ws + WS_WB), *WO = (bf16*)(ws + WS_WO), *WM = (bf16*)(ws + WS_WM), *WGU = (bf16*)(ws + WS_WGU), *WD = (bf16*)(ws + WS_WD); \
    bf16 *MEMB = (bf16*)(ws + WS_MEMB), *MK = (bf16*)(ws + WS_MK), *MVT = (bf16*)(ws + WS_MVT), *XB = (bf16*)(ws + WS_XB); \
    bf16 *Qb = (bf16*)(ws + WS_Q), *Kb = (bf16*)(ws + WS_K), *VT = (bf16*)(ws + WS_VT), *MQ = (bf16*)(ws + WS_MQ), *MIX = (bf16*)(ws + WS_MIX), *H = (bf16*)(ws + WS_H); \
    (void)ctl; (void)ssq; (void)ssqm; (void)LF; (void)COS; (void)SIN; (void)WA; (void)WB; (void)WO; (void)WM; (void)WGU; (void)WD; (void)MEMB; (void)MK; (void)MVT; (void)XB; (void)Qb; (void)Kb; (void)VT; (void)MQ; (void)MIX; (void)H;

constexpr int I1 = 16 * 36, I2 = 16 * 4, IF_ = 16, I3 = 16 * 12, I4 = 16 * 12, I5 = 16 * 12, I6 = 16 * 4, I7 = 16 * 16, I9 = 16 * 8, I11 = 16 * 88, I13 = 44 * 16;
constexpr int WT_A = I11 + I13 + I1 + I2 + IF_ + I7 + 2 * I9, WT_B1 = I3 + I4 + I5 + I6, WT_B2 = I11, WT_B3 = I7 + I13;
#define WT_SRCS() const float *a_w_in = argp(lds, AA_W_IN), *attn_g = argp(lds, AATTN_G), *w_kv = argp(lds, AW_KV), *kv_g = argp(lds, AKV_G), *b_w_in = argp(lds, AB_W_IN), *w_out = argp(lds, AW_OUT); \
    const float *w_mem_kv = argp(lds, AW_MEM_KV), *mem_g = argp(lds, AMEM_G), *w_gate_up = argp(lds, AW_GATE_UP), *ffn_g = argp(lds, AFFN_G), *w_down = argp(lds, AW_DOWN);
#define WT_DISPATCH(it_) do { int r = (it_); \
    if (r < I11) { wt_job(r, w_gate_up, 5632, 1024, 0, 5632, 64, ffn_g, WGU, 0, 2, scr, lane); break; } r -= I11; \
    if (r < I13) { wt_job(r, w_down, 1024, 2816, 0, 1024, 64, nullptr, WD, 0, 0, scr, lane); break; } r -= I13; \
    if (r < I1) { wt_job(r, a_w_in, 2572, 1024, 0, 2304, 64, attn_g, WA, 0, 0, scr, lane); break; } r -= I1; \
    if (r < I2) { wt_job(r, a_w_in, 2572, 1024, 2316, 256, 64, attn_g, WA, 2304, 0, scr, lane); break; } r -= I2; \
    if (r < IF_) { wt_job(r, a_w_in, 2572, 1024, 2304, 64, 12, attn_g, WA, 2560, 0, scr, lane); break; } r -= IF_; \
    if (r < I7) { wt_job(r, w_out, 1024, 1024, 0, 1024, 64, nullptr, WO, 0, 0, scr, lane); break; } r -= I7; \
    if (r < 2 * I9) { const int l = r / I9; wt_job(r % I9, w_mem_kv + (size_t)l * 1024 * 512, 512, 1024, 0, 512, 64, mem_g + 1024 * l, WM, 512 * l, 0, scr, lane); break; } r -= 2 * I9; \
    if (r < I3) { wt_job(r, w_kv, 1536, 1024, 0, 768, 64, kv_g, WB, 0, 1, scr, lane); break; } r -= I3; \
    if (r < I4) { wt_job(r, w_kv, 1536, 1024, 768, 768, 64, kv_g, WB, 768, 0, scr, lane); break; } r -= I4; \
    if (r < I5) { wt_job(r, b_w_in, 1024, 1024, 0, 768, 64, attn_g + 1024, WB, 1536, 1, scr, lane); break; } r -= I5; \
    if (r < I6) { wt_job(r, b_w_in, 1024, 1024, 768, 256, 64, attn_g + 1024, WB, 2304, 0, scr, lane); break; } r -= I6; \
    if (r < I11) { wt_job(r, w_gate_up + (size_t)1024 * 5632, 5632, 1024, 0, 5632, 64, ffn_g + 1024, WGU + (size_t)5632 * 1024, 0, 2, scr, lane); break; } r -= I11; \
    if (r < I7) { wt_job(r, w_out + (size_t)1024 * 1024, 1024, 1024, 0, 1024, 64, nullptr, WO + (size_t)1024 * 1024, 0, 0, scr, lane); break; } r -= I7; \
    wt_job(r, w_down + (size_t)2816 * 1024, 1024, 2816, 0, 1024, 64, nullptr, WD + (size_t)1024 * 2816, 0, 0, scr, lane); } while (0)
#define WT_IDLE(first, lo, hi) do { const int f_ = (first) < G ? (first) : 0;        \
    if (bx >= f_) { WSPTRS(); PHASE_IDS(); WT_SRCS(); LAS float* scr = (LAS float*)(lds + wave * 16640); \
        for (int it = (lo) + (bx - f_) * 8 + wave; it < (hi); it += (G - f_) * 8) WT_DISPATCH(it); __syncthreads(); } } while (0)

__global__ void __launch_bounds__(512, 2) yoco_fwd(Args A) {
    extern __shared__ __attribute__((aligned(16))) unsigned char lds_raw[];
    LAS unsigned char* lds = (LAS unsigned char*)lds_raw;
#if USE_XB
    if (threadIdx.x < 2) ((volatile LAS unsigned*)(lds + LDS_MISC + 128))[threadIdx.x] = 0u;
    __syncthreads();
    XcdBarrier xbar = xcd_barrier_post((unsigned*)(A.ws + WS_CTL) + CW_BAR, (volatile LAS unsigned*)(lds + LDS_MISC + 128));
#define GRID_SYNC() xcd_barrier(xbar)
#else
    cg::grid_group grid = cg::this_grid();
#define GRID_SYNC() grid.sync()
#endif
    const int G = gridDim.x, bx = blockIdx.x;
    const int wave0 = __builtin_amdgcn_readfirstlane((int)threadIdx.x >> 6);
#define HW_TID() (wave0 * 64 + hw_lane())
#if USE_XB
    xbar.wv = wave0;
#endif
    if (threadIdx.x == 0) {
        LAS unsigned long long* P = (LAS unsigned long long*)(lds + LDS_ARGS);
        P[AX] = (unsigned long long)A.x; P[AMEM] = (unsigned long long)A.mem; P[AATTN_G] = (unsigned long long)A.attn_g; P[AMEM_G] = (unsigned long long)A.mem_g;
        P[AW_MEM_KV] = (unsigned long long)A.w_mem_kv; P[AW_OUT] = (unsigned long long)A.w_out; P[AFFN_G] = (unsigned long long)A.ffn_g; P[AW_GATE_UP] = (unsigned long long)A.w_gate_up;
        P[AW_DOWN] = (unsigned long long)A.w_down; P[AA_W_IN] = (unsigned long long)A.a_w_in; P[AA_B_F] = (unsigned long long)A.a_b_f; P[AB_W_IN] = (unsigned long long)A.b_w_in;
        P[ALQ1] = (unsigned long long)A.lq1; P[ALK1] = (unsigned long long)A.lk1; P[ALQ2] = (unsigned long long)A.lq2; P[ALK2] = (unsigned long long)A.lk2;
        P[ASUBLN_G] = (unsigned long long)A.subln_g; P[AKV_G] = (unsigned long long)A.kv_g; P[AW_KV] = (unsigned long long)A.w_kv; P[AFINAL_G] = (unsigned long long)A.final_g;
        P[AOUT] = (unsigned long long)A.out; P[AWS] = (unsigned long long)A.ws;
    }
    __syncthreads();
#define PHASE_IDS() int tid_ = HW_TID(); asm volatile("" : "+v"(tid_)); const int tid = tid_, lane = tid & 63, wave = __builtin_amdgcn_readfirstlane(tid >> 6); \
    const int gw = bx * 8 + wave, NGW = G * 8, gt = bx * 512 + tid, NGT = G * 512; (void)lane; (void)gw; (void)NGW; (void)gt; (void)NGT;

    for (int rep0_ = 0; rep0_ < NREP0; ++rep0_) {
        WSPTRS(); PHASE_IDS();
        const float *a_w_in = argp(lds, AA_W_IN), *attn_g = argp(lds, AATTN_G), *w_kv = argp(lds, AW_KV), *kv_g = argp(lds, AKV_G), *b_w_in = argp(lds, AB_W_IN), *w_out = argp(lds, AW_OUT);
        const float *w_mem_kv = argp(lds, AW_MEM_KV), *mem_g = argp(lds, AMEM_G), *w_gate_up = argp(lds, AW_GATE_UP), *ffn_g = argp(lds, AFFN_G), *w_down = argp(lds, AW_DOWN);
        const float *xin = argp(lds, AX), *memin = argp(lds, AMEM), *a_b_f = argp(lds, AA_B_F);
#if PREREAD
        {
            float acc_ = 0.f;
#define PRE_(ptr, n) for (int i = gt; i < (n) / 4; i += NGT) { const f32x4 v = ((const f32x4*)(ptr))[i]; acc_ += (v[0] + v[1]) + (v[2] + v[3]); }
            PRE_(w_gate_up, 2 * 1024 * 5632) PRE_(w_down, 2 * 2816 * 1024) PRE_(a_w_in, 1024 * 2572) PRE_(w_kv, 1024 * 1536) PRE_(b_w_in, 1024 * 1024) PRE_(w_out, 2 * 1024 * 1024) PRE_(w_mem_kv, 2 * 1024 * 512)
#undef PRE_
            if (acc_ == 1.2345e38f) ctl[63] = 1u;
        }
#endif
        LAS float* scr = (LAS float*)(lds + wave * 16640);
        {
            constexpr int o_WA = I11 + I13, o_WO0 = o_WA + I1 + I2 + IF_, o_WM = o_WO0 + I7, n0 = I11, n1 = o_WO0 - o_WA, n2 = 2 * I9;
            for (int j = gw; j < n0 + n1 + n2; j += NGW) { const int it = j < n0 ? j : (j < n0 + n1 ? o_WA + (j - n0) : o_WM + (j - n0 - n1)); WT_DISPATCH(it); }
        }
        for (int i = gt; i < 192 * 1024 / 8; i += NGT) ((v4u*)(WA + (size_t)2624 * 1024))[i] = (v4u){0u, 0u, 0u, 0u};
        for (int m = 2 * gw; m < M + MM; m += 2 * NGW) {
            const bool ism = m >= M; const float* src = ism ? memin + (size_t)(m - M) * DM : xin + (size_t)m * DM; bf16* dst = ism ? MEMB + (size_t)(m - M) * DM : XB + (size_t)m * DM; float* sdst = ism ? ssqm + (m - M) : ssq + m;
            const f32x4* xr = (const f32x4*)src + lane; f32x4 v[8]; float s0 = 0.f, s1 = 0.f;
#pragma unroll
            for (int j = 0; j < 8; ++j) v[j] = xr[64 * j];
#pragma unroll
            for (int j = 0; j < 4; ++j) { s0 += (v[j][0] * v[j][0] + v[j][1] * v[j][1]) + (v[j][2] * v[j][2] + v[j][3] * v[j][3]); s1 += (v[4 + j][0] * v[4 + j][0] + v[4 + j][1] * v[4 + j][1]) + (v[4 + j][2] * v[4 + j][2] + v[4 + j][3] * v[4 + j][3]); }
            s0 = wave_sum(s0); s1 = wave_sum(s1);
            if (lane == 0) { sdst[0] = s0; sdst[1] = s1; }
            unsigned long long* o8 = (unsigned long long*)dst + lane;
#pragma unroll
            for (int j = 0; j < 8; ++j) o8[64 * j] = (unsigned long long)pk2(v[j][0], v[j][1]) | ((unsigned long long)pk2(v[j][2], v[j][3]) << 32);
        }
        if (gt < 32) ((float*)(ws + WS_INVREV))[gt] = INV_FREQ[gt] * 0.15915494309189535f;
        for (int i = gt; i < SEQ * 32; i += NGT) { const int pos = i >> 5, f = i & 31; const float ang = (float)pos * INV_FREQ[f];
            double rev = (double)ang * 0.15915494309189535; rev -= __builtin_rint(rev);
            COS[i] = __builtin_amdgcn_cosf((float)rev); SIN[i] = __builtin_amdgcn_sinf((float)rev); }
        for (int i = gt; i < 4 * M; i += NGT) ssq[M + i] = 0.f;
        if (gt < 64) ctl[gt] = 0u;
    }
    GRID_SYNC();

#if PH_MASK & (1 << 1)
    {
        WSPTRS(); PHASE_IDS();
        for (int rep_ = 0; rep_ < NREP1; ++rep_) {
        pg8::Gemm g{XB, WA, M, NPROJA, DM}; pg8::StaticOrder S; S.init(M, NPROJA, G, bx);
        pg8::EpiProj E{ssq, COS, SIN, argp(lds, AA_B_F), LF, SEQ, {Qb, 3, 0, 768, C2}, {Kb, 6, 0, 768, 1.f}, {VT, 9, 1, 768, 1.f}, {MQ, 10, 0, 256, C2}, {nullptr, 11, 3, 0, 1.f}};
        pg8::gemm_phase<pg8::EpiProj, pg8::StaticOrder, true, true>(lds, g, S, E, wave0);
        }
    }
    {
        WSPTRS();
        pg8::Gemm g{MEMB, WM, MM, 1024, DM}; pg8::StaticOrder S; S.init(MM, 1024, G, (bx + 64) & 255);
        pg8::EpiProj E{ssqm, COS, SIN, nullptr, nullptr, NMEM, {MK, 1, 0, 256, 1.f}, {MVT, 2, 1, 256, 1.f}, {MK + (size_t)MM * 256, 3, 0, 256, 1.f}, {MVT + (size_t)MM * 256, 4, 1, 256, 1.f}, {nullptr, 5, 0, 0, 1.f}};
        pg8::gemm_phase<pg8::EpiProj, pg8::StaticOrder, true, true>(lds, g, S, E, wave0);
    }
#endif
    WT_IDLE(208, WT_A, WT_A + WT_B1);
    WT_IDLE(208, I11 + I13 + I1 + I2 + IF_, I11 + I13 + I1 + I2 + IF_ + I7);
    GRID_SYNC();

    if (bx < 48) { WSPTRS(); PHASE_IDS(); scan_bh(LF + (size_t)bx * SEQ, (LAS float*)(lds + LDS_MISC + 64), tid); }
    GRID_SYNC();
#if PH_MASK & (1 << 2)
    for (int rep_ = 0; rep_ < NREP2; ++rep_) { WSPTRS(); PHASE_IDS();
    volatile LAS unsigned* qword = (volatile LAS unsigned*)(lds + LDS_MISC);
    bool first_ = true;
    for (;;) {
        if (HW_TID() == 0) qword[0] = first_ ? (unsigned)bx : (unsigned)G + atomicAdd(ctl + 0 + 2 * rep_, 1u);
        first_ = false;
        __syncthreads();
        const int u = (int)qword[0];
        __syncthreads();
        if (u >= 1024) break;
        att::f32x16 o[2];
        if (u < 768) {
            const int qb = 15 - u / 48, bh = u % 48, b = bh / 12, h = bh % 12;
            if (rep_ + 1 < NREP2) att::attn_stream<64, true, true, PVAR>(lds, Qb + (size_t)b * SEQ * 768 + 64 * h, 768, Kb + (size_t)b * SEQ * 768 + 64 * h, 768, VT + (size_t)(b * 768 + 64 * h) * SEQ, SEQ,
                                             LF + (size_t)bh * SEQ, 256 * qb, 2 * (qb + 1), o, wave0);
            else att::attn_stream<64, true, true>(lds, Qb + (size_t)b * SEQ * 768 + 64 * h, 768, Kb + (size_t)b * SEQ * 768 + 64 * h, 768, VT + (size_t)(b * 768 + 64 * h) * SEQ, SEQ,
                                             LF + (size_t)bh * SEQ, 256 * qb, 2 * (qb + 1), o, wave0);
            { const int l2_ = hw_lane(); att::store_o<64>(MIX + (size_t)(b * SEQ + 256 * qb + 32 * wave + (l2_ & 31)) * DM + 64 * h, o, l2_ >> 5); }
        } else {
            const int j = u - 768, b = j >> 6, hm = (j >> 4) & 3, qb = j & 15;
            att::attn_stream<64, false, false>(lds, MQ + (size_t)b * SEQ * 256 + 64 * hm, 256, MK + (size_t)b * NMEM * 256 + 64 * hm, 256, MVT + (size_t)(b * 256 + 64 * hm) * NMEM, NMEM,
                                               nullptr, 256 * qb, 2, o, wave0);
            { const int l2_ = hw_lane(); att::store_o<64>(MIX + (size_t)(b * SEQ + 256 * qb + 32 * wave + (l2_ & 31)) * DM + 768 + 64 * hm, o, l2_ >> 5); }
        }
    } }
#endif
    GRID_SYNC();

#if PH_MASK & (1 << 3)
    for (int rep_ = 0; rep_ < NREP35; ++rep_) {
        WSPTRS(); const float* xin = argp(lds, AX); float* outp = (float*)argp(lds, AOUT);
        pg8::Gemm g{MIX, WO, M, DM, DM}; pg8::StaticOrder S; S.init(M, DM, G, bx);
        pg8::EpiRes E{XB, ssq + M};
        pg8::gemm_phase<pg8::EpiRes, pg8::StaticOrder, true, true>(lds, g, S, E, wave0);
    }
#endif
    GRID_SYNC();
#if PH_MASK & (1 << 4)
    for (int rep_ = 0; rep_ < NREP4; ++rep_) {
        WSPTRS();
        pg8::Gemm g{XB, WGU, M, 2 * DFF, DM}; pg8::StaticOrder S; S.init(M, 2 * DFF, G, bx);
        pg8::EpiGU E{ssq + M, H};
        pg8::gemm_phase<pg8::EpiGU, pg8::StaticOrder, true, true>(lds, g, S, E, wave0);
    }
#endif
    WT_IDLE(128, WT_A + WT_B1, WT_A + WT_B1 + WT_B2);
    WT_IDLE(128, I11, I11 + I13);
    GRID_SYNC();
#if PH_MASK & (1 << 5)
    for (int rep_ = 0; rep_ < NREP35; ++rep_) {
        WSPTRS(); float* outp = (float*)argp(lds, AOUT);
        pg8::Gemm g{H, WD, M, DM, DFF}; pg8::StaticOrder S; S.init(M, DM, G, bx);
        pg8::EpiRes E{XB, ssq + 2 * M};
        pg8::gemm_phase<pg8::EpiRes, pg8::StaticOrder, true, true>(lds, g, S, E, wave0);
    }
#endif
    GRID_SYNC();
#if PH_MASK & (1 << 6)
    for (int rep_ = 0; rep_ < NREPB; ++rep_) {
        WSPTRS();
        pg8::Gemm g{XB, WB, M, NPROJ, DM}; pg8::StaticOrder S; S.init(M, NPROJ, G, bx);
        pg8::EpiProj E{ssq + 2 * M, (const float*)(ws + WS_INVREV), SIN, nullptr, nullptr, SEQ, {Kb, 3, 2, 768, 1.f}, {VT, 6, 1, 768, 1.f}, {Qb, 9, 2, 768, C2}, {MQ, 10, 0, 256, C2}, {nullptr, 11, 0, 0, 1.f}};
        pg8::gemm_phase<pg8::EpiProj, pg8::StaticOrder, true, true>(lds, g, S, E, wave0);
    }
#endif
    WT_IDLE(128, WT_A + WT_B1 + WT_B2, WT_A + WT_B1 + WT_B2 + WT_B3);
    GRID_SYNC();
#if PH_MASK & (1 << 7)
    {
        WSPTRS(); PHASE_IDS(); const float* subln_g = argp(lds, ASUBLN_G);
        volatile LAS unsigned* qword = (volatile LAS unsigned*)(lds + LDS_MISC);
        float d1 = argp(lds, ALQ1)[lane] * argp(lds, ALK1)[lane], d2 = argp(lds, ALQ2)[lane] * argp(lds, ALK2)[lane];
        d1 = wave_sum(d1); d2 = wave_sum(d2);
        const float lam = __builtin_bit_cast(float, __builtin_amdgcn_readfirstlane(__builtin_bit_cast(int, expf(d1) - expf(d2) + LAMBDA_INIT)));
        bool first_ = true;
        for (int rep_ = 0; rep_ < NREP7; ++rep_)
        for (;;) {
            if (HW_TID() == 0) qword[0] = first_ ? (unsigned)bx : (unsigned)G + atomicAdd(ctl + 1 + 2 * rep_, 1u);
            first_ = false;
            __syncthreads();
            const int u = (int)qword[0];
            __syncthreads();
            if (u >= 1024) break;
            if (u < 768) {
                const int qb = 31 - u / 24, bh = u % 24, b = bh / 6, hd = bh % 6;
                att::attn_diff_unit<SEQ>(lds, Qb + (size_t)b * SEQ * 768 + 128 * hd, Kb + (size_t)b * SEQ * 768 + 128 * hd, VT + (size_t)(b * 768 + 128 * hd) * SEQ, 128 * qb, qb + 1, lam, 1.0f - LAMBDA_INIT,
                                         subln_g, MIX + (size_t)b * SEQ * DM + 128 * hd, wave0);
            } else {
                att::f32x16 o[2];
                const int j = u - 768, b = j >> 6, hm = (j >> 4) & 3, qb = j & 15;
                att::attn_stream<64, false, false>(lds, MQ + (size_t)b * SEQ * 256 + 64 * hm, 256, MK + (size_t)(MM + b * NMEM) * 256 + 64 * hm, 256, MVT + (size_t)(MM + b * 256 + 64 * hm) * NMEM, NMEM,
                                                   nullptr, 256 * qb, 2, o, wave0);
                { const int l2_ = hw_lane(); att::store_o<64>(MIX + (size_t)(b * SEQ + 256 * qb + 32 * wave + (l2_ & 31)) * DM + 768 + 64 * hm, o, l2_ >> 5); }
            }
        }
    }
#endif
    GRID_SYNC();
#if PH_MASK & (1 << 8)
    for (int rep_ = 0; rep_ < NREPB; ++rep_) {
        WSPTRS(); float* outp = (float*)argp(lds, AOUT);
        pg8::Gemm g{MIX, WO + (size_t)1024 * 1024, M, DM, DM}; pg8::StaticOrder S; S.init(M, DM, G, bx);
        pg8::EpiRes E{XB, ssq + 3 * M};
        pg8::gemm_phase<pg8::EpiRes, pg8::StaticOrder, true, true>(lds, g, S, E, wave0);
    }
#endif
    GRID_SYNC();
#if PH_MASK & (1 << 9)
    for (int rep_ = 0; rep_ < NREPB; ++rep_) {
        WSPTRS();
        pg8::Gemm g{XB, WGU + (size_t)5632 * 1024, M, 2 * DFF, DM}; pg8::StaticOrder S; S.init(M, 2 * DFF, G, bx);
        pg8::EpiGU E{ssq + 3 * M, H};
        pg8::gemm_phase<pg8::EpiGU, pg8::StaticOrder, true, true>(lds, g, S, E, wave0);
    }
#endif
    GRID_SYNC();
#if PH_MASK & (1 << 10)
    {
        WSPTRS(); float* outp = (float*)argp(lds, AOUT);
        pg8::Gemm g{H, WD + (size_t)1024 * 2816, M, DM, DFF}; pg8::StaticOrder S; S.init(M, DM, G, bx);
        pg8::EpiResFinal E{XB, outp, ssq + 4 * M, ctl + 8192, argp(lds, AFINAL_G)};
        pg8::gemm_phase<pg8::EpiResFinal, pg8::StaticOrder, true, true>(lds, g, S, E, wave0);
    }
#endif
}

extern "C" void kernel_launch(void* const* d_in, const int* in_sizes, int n_in, void* d_out, int out_size, void* d_ws, size_t ws_size, hipStream_t stream) {
    static int grid = 0;
    if (grid == 0) {
        if (n_in != 20 || out_size != M * DM || ws_size < WS_END) { fprintf(stderr, "kernel_launch: unexpected sizes n_in %d out %d ws %zu\n", n_in, out_size, ws_size); grid = -1; return; }
        int dev = 0, cus = 0, per_cu = 0;
        (void)hipGetDevice(&dev); (void)hipDeviceGetAttribute(&cus, hipDeviceAttributeMultiprocessorCount, dev);
        (void)hipFuncSetAttribute((const void*)yoco_fwd, hipFuncAttributeMaxDynamicSharedMemorySize, LDS_BYTES);
        (void)hipOccupancyMaxActiveBlocksPerMultiprocessor(&per_cu, (const void*)yoco_fwd, 512, LDS_BYTES);
        if (per_cu < 1) { fprintf(stderr, "kernel_launch: occupancy query says %d blocks per CU; the grid barrier needs every workgroup resident: nothing launched\n", per_cu); grid = -1; return; }
        grid = cus;
        if (grid != 256) fprintf(stderr, "kernel_launch: %d CUs (expected 256)\n", grid);
    }
    if (grid < 0) return;
    Args a{};
    const float** p = (const float**)&a;
    for (int i = 0; i < 20; ++i) p[i] = (const float*)d_in[i];
    a.out = (float*)d_out; a.ws = (unsigned char*)d_ws;
    void* args[] = {&a};
#if USE_XB
    (void)hipMemsetAsync((char*)d_ws + WS_CTL, 0, 65536, stream);
    hipLaunchKernelGGL(yoco_fwd, dim3(grid), dim3(512), LDS_BYTES, stream, a);
    (void)args;
#else
    hipError_t e = hipLaunchCooperativeKernel((const void*)yoco_fwd, dim3(grid), dim3(512), args, LDS_BYTES, stream);
    if (e != hipSuccess) fprintf(stderr, "cooperative launch failed: %s (grid %d)\n", hipGetErrorString(e), grid);
#endif
}
```

```cpp
#include <hip/hip_runtime.h>
#include <hip/hip_cooperative_groups.h>
#include <cstdio>
#include <cstdint>
__device__ __forceinline__ int hw_lane() { unsigned z = 0u; asm volatile("" : "+v"(z)); return (int)__builtin_amdgcn_mbcnt_hi(~0u, __builtin_amdgcn_mbcnt_lo(~0u, z)); }
namespace pg8 {
#define PG8_LAS __attribute__((address_space(3)))
typedef unsigned short bf16_t;
typedef short bf16x8 __attribute__((ext_vector_type(8)));
typedef float f32x4 __attribute__((ext_vector_type(4)));
typedef unsigned u32x4 __attribute__((ext_vector_type(4)));
constexpr int BM = 256, BK = 64, HALF = 128, HTB = HALF * BK * 2  , STAGE_BYTES = 8 * HTB, NXCD = 8, WGM = 8;

__host__ __device__ __forceinline__ int lds_byte(int r, int c) { const int st = (r >> 4) * 2 + (c >> 5), rr = r & 15, cc = c & 31, ob = rr * 64 + cc * 2; return st * 1024 + (ob ^ (((ob >> 9) & 1) << 5)); }
__host__ __device__ __forceinline__ void stage_rc(int b, int& R, int& C) { const int st = b / 1024, sb = b % 1024, swz = sb ^ (((sb >> 9) & 1) << 5); R = (st >> 1) * 16 + swz / 64; C = (st & 1) * 32 + (swz % 64) / 2; }
__host__ __device__ __forceinline__ int perm32(int rho) { const int n = rho >> 4, i = rho & 15; return 8 * (i >> 2) + 4 * n + (i & 3); }

struct Unit { int pm, pn; };
struct Gemm { const bf16_t* A; const bf16_t* Bt; int M, N, K; };

struct StaticOrder {
    int nM, nN, nwg, G, c;
    __host__ __device__ void init(int M, int N, int G_, int c_) { nM = M / BM; nN = N / BM; nwg = nM * nN; G = G_; c = c_; }
    __host__ __device__ bool next(int i, Unit& u) const {
        const long L = (long)i * G + c; if (L >= nwg) return false;
        int wgid = (int)L; { const int q = nwg / NXCD, r = nwg % NXCD, xcd = wgid % NXCD, off = wgid / NXCD; wgid = (xcd < r ? xcd * (q + 1) : r * (q + 1) + (xcd - r) * q) + off; }
        const int nig = WGM * nN, gid = wgid / nig, fm = gid * WGM, gsz = (nM - fm) < WGM ? (nM - fm) : WGM;
        u.pm = fm + ((wgid % nig) % gsz); u.pn = (wgid % nig) / gsz; return true;
    }
    __device__ __forceinline__ void a_ready(const Unit&) const {}
    __device__ __forceinline__ void done(const Unit&) const {}
};

__device__ __forceinline__ unsigned cvt_pk_bf16(float lo, float hi) { unsigned r; asm volatile("v_cvt_pk_bf16_f32 %0, %1, %2" : "=v"(r) : "v"(lo), "v"(hi)); return r; }
typedef float f32x2 __attribute__((ext_vector_type(2)));
typedef unsigned u32x2 __attribute__((ext_vector_type(2)));
struct Seg { bf16_t* dst; int pn_end; int kind; int pitch; float scale; };
struct EpiProj {
    static constexpr bool PERM = true, AFTER_DRAIN = false;
    const float* ssq; const float* cs; const float* sn; const float* bf; float* lf; int S; Seg s0, s1, s2, s3, s4;
    __device__ __forceinline__ void operator()(const f32x4 (&acc)[2][2][4][2], const Unit& u, int wr, int wc, int fr, int fq) const {
        Seg g = s4; int pn0 = s3.pn_end;
        if (u.pn < s0.pn_end) { g = s0; pn0 = 0; } else if (u.pn < s1.pn_end) { g = s1; pn0 = s0.pn_end; } else if (u.pn < s2.pn_end) { g = s2; pn0 = s1.pn_end; } else if (u.pn < s3.pn_end) { g = s3; pn0 = s2.pn_end; }
        const int ct = (u.pn - pn0) * BM;
        const int lane = fq * 16 + fr; const int ssh = 31 - __builtin_clz(S);
        float sq8[8];
#pragma unroll
        for (int i = 0; i < 8; ++i) sq8[i] = ssq[u.pm * BM + (i >> 2) * HALF + wr * 64 + (i & 3) * 16 + fr];
        f32x4 w0 = {0.f, 0.f, 0.f, 0.f}, w1 = {0.f, 0.f, 0.f, 0.f};
        if (g.kind == 2) { w0 = *(const f32x4*)(cs + 8 * fq); w1 = *(const f32x4*)(cs + 8 * fq + 4); }
#pragma unroll
        for (int am = 0; am < 4; ++am) {
            const int ai = am >> 1;
#pragma unroll
            for (int mm = 0; mm < 2; ++mm) {
                const int m = (am & 1) * 2 + mm;
                const int row = u.pm * BM + ai * HALF + wr * 64 + m * 16 + fr;
                const float rs = __builtin_amdgcn_rsqf(sq8[ai * 4 + m] * (1.0f / 1024.0f) + 1e-6f) * g.scale;
                if (g.kind == 0) {
#pragma unroll
                    for (int bj = 0; bj < 2; ++bj) { const f32x4 v0 = acc[ai][bj][m][0] * rs, v1 = acc[ai][bj][m][1] * rs;
                        u32x4 w; w.x = cvt_pk_bf16(v0[0], v0[1]); w.y = cvt_pk_bf16(v0[2], v0[3]); w.z = cvt_pk_bf16(v1[0], v1[1]); w.w = cvt_pk_bf16(v1[2], v1[3]);
                        *(u32x4*)(g.dst + (size_t)row * g.pitch + ct + bj * HALF + wc * 32 + 8 * fq) = w; }
                } else if (g.kind == 1) {
                    const int b = row >> ssh, s = row & (S - 1); const bool odd = (fr & 1) != 0;
#pragma unroll
                    for (int bj = 0; bj < 2; ++bj) { const f32x4 v0 = acc[ai][bj][m][0] * rs, v1 = acc[ai][bj][m][1] * rs;
                        const int cb = ct + bj * HALF + wc * 32 + 8 * fq + (odd ? 4 : 0);
#pragma unroll
                        for (int j = 0; j < 4; ++j) { const float snd = odd ? v0[j] : v1[j]; const float rcv = __builtin_bit_cast(float, __builtin_amdgcn_update_dpp(0, __builtin_bit_cast(int, snd), 0xB1  , 0xF, 0xF, true));
                            const float lo = odd ? rcv : v0[j], hi = odd ? v1[j] : rcv;
                            *(unsigned*)(g.dst + ((size_t)b * g.pitch + cb + j) * S + (s & ~1)) = cvt_pk_bf16(lo, hi); } }
                } else if (g.kind == 3) {
                    if (wc == 0 && fq < 2) { const int b = row >> ssh, s = row & (S - 1);
#pragma unroll
                        for (int n = 0; n < 2; ++n)
#pragma unroll
                            for (int e2 = 0; e2 < 4; ++e2) { const int c = 8 * fq + 4 * n + e2;
                                if (c < 12) { const float z = acc[ai][0][m][n][e2] * rs + bf[c]; lf[((size_t)b * 12 + c) * S + s] = fminf(z, 0.f) - 0.6931471805599453f * __builtin_amdgcn_logf(1.0f + __builtin_amdgcn_exp2f(-1.4426950408889634f * fabsf(z))); } } }
                } else {
                    const float pf = (float)(row & (S - 1)); f32x4 c0, c1, n0, n1;
#pragma unroll
                    for (int e = 0; e < 4; ++e) { const float r0 = __builtin_amdgcn_fractf(pf * w0[e]), r1 = __builtin_amdgcn_fractf(pf * w1[e]);
                        c0[e] = __builtin_amdgcn_cosf(r0); n0[e] = __builtin_amdgcn_sinf(r0); c1[e] = __builtin_amdgcn_cosf(r1); n1[e] = __builtin_amdgcn_sinf(r1); }
                    const f32x4 a0 = acc[ai][0][m][0] * rs, a1 = acc[ai][0][m][1] * rs, b0 = acc[ai][1][m][0] * rs, b1 = acc[ai][1][m][1] * rs;
                    const f32x4 x0 = a0 * c0 - b0 * n0, x1 = a1 * c1 - b1 * n1, y0 = a0 * n0 + b0 * c0, y1 = a1 * n1 + b1 * c1;
                    bf16_t* p = g.dst + (size_t)row * g.pitch + ct + wc * 64 + 8 * fq;
                    u32x4 w; w.x = cvt_pk_bf16(x0[0], x0[1]); w.y = cvt_pk_bf16(x0[2], x0[3]); w.z = cvt_pk_bf16(x1[0], x1[1]); w.w = cvt_pk_bf16(x1[2], x1[3]);
                    *(u32x4*)p = w;
                    w.x = cvt_pk_bf16(y0[0], y0[1]); w.y = cvt_pk_bf16(y0[2], y0[3]); w.z = cvt_pk_bf16(y1[0], y1[1]); w.w = cvt_pk_bf16(y1[2], y1[3]);
                    *(u32x4*)(p + 32) = w;
                }
            }
        }
        (void)lane;
    }
};
struct EpiRes {
    static constexpr bool PERM = true, AFTER_DRAIN = false;
    bf16_t* xb; float* ssq_out;
    __device__ __forceinline__ void operator()(const f32x4 (&acc)[2][2][4][2], const Unit& u, int wr, int wc, int fr, int fq) const {
#pragma unroll
        for (int ai = 0; ai < 2; ++ai) {
            u32x4 xr[4][2];
#pragma unroll
            for (int m = 0; m < 4; ++m)
#pragma unroll
                for (int bj = 0; bj < 2; ++bj) xr[m][bj] = *(const u32x4*)(xb + (size_t)(u.pm * BM + ai * HALF + wr * 64 + m * 16 + fr) * 1024 + u.pn * BM + bj * HALF + wc * 32 + 8 * fq);
            asm volatile("" ::: "memory");
#pragma unroll
            for (int m = 0; m < 4; ++m) {
                const int row = u.pm * BM + ai * HALF + wr * 64 + m * 16 + fr; float sq = 0.f;
#pragma unroll
                for (int bj = 0; bj < 2; ++bj) { const size_t off = (size_t)row * 1024 + u.pn * BM + bj * HALF + wc * 32 + 8 * fq; const u32x4 x = xr[m][bj];
                    const f32x4 v0 = (f32x4){__uint_as_float(x.x << 16), __uint_as_float(x.x & 0xffff0000u), __uint_as_float(x.y << 16), __uint_as_float(x.y & 0xffff0000u)} + acc[ai][bj][m][0];
                    const f32x4 v1 = (f32x4){__uint_as_float(x.z << 16), __uint_as_float(x.z & 0xffff0000u), __uint_as_float(x.w << 16), __uint_as_float(x.w & 0xffff0000u)} + acc[ai][bj][m][1];
                    u32x4 w; w.x = cvt_pk_bf16(v0[0], v0[1]); w.y = cvt_pk_bf16(v0[2], v0[3]); w.z = cvt_pk_bf16(v1[0], v1[1]); w.w = cvt_pk_bf16(v1[2], v1[3]);
                    *(u32x4*)(xb + off) = w;
                    sq += (v0[0] * v0[0] + v0[1] * v0[1]) + (v0[2] * v0[2] + v0[3] * v0[3]) + (v1[0] * v1[0] + v1[1] * v1[1]) + (v1[2] * v1[2] + v1[3] * v1[3]); }
                sq += __shfl_xor(sq, 16); sq += __shfl_xor(sq, 32);
                if (fq == 0) atomicAdd(ssq_out + row, sq);
            }
            asm volatile("" ::: "memory");
        }
    }
};
struct EpiResFinal {
    static constexpr bool PERM = true, AFTER_DRAIN = false;
    const bf16_t* xb; float* out; float* ssq; unsigned* cnt; const float* g;
    __device__ __forceinline__ void operator()(f32x4 (&acc)[2][2][4][2], const Unit& u, int wr, int wc, int fr, int fq) const {
        const int col0 = u.pn * BM + wc * 32 + 8 * fq;
#pragma unroll
        for (int ai = 0; ai < 2; ++ai) {
            u32x4 xr[4][2];
#pragma unroll
            for (int m = 0; m < 4; ++m)
#pragma unroll
                for (int bj = 0; bj < 2; ++bj) xr[m][bj] = *(const u32x4*)(xb + (size_t)(u.pm * BM + ai * HALF + wr * 64 + m * 16 + fr) * 1024 + col0 + bj * HALF);
            asm volatile("" ::: "memory");
#pragma unroll
            for (int m = 0; m < 4; ++m) {
                const int row = u.pm * BM + ai * HALF + wr * 64 + m * 16 + fr; float sq = 0.f;
#pragma unroll
                for (int bj = 0; bj < 2; ++bj) { const u32x4 x = xr[m][bj];
                    const f32x4 v0 = (f32x4){__uint_as_float(x.x << 16), __uint_as_float(x.x & 0xffff0000u), __uint_as_float(x.y << 16), __uint_as_float(x.y & 0xffff0000u)} + acc[ai][bj][m][0];
                    const f32x4 v1 = (f32x4){__uint_as_float(x.z << 16), __uint_as_float(x.z & 0xffff0000u), __uint_as_float(x.w << 16), __uint_as_float(x.w & 0xffff0000u)} + acc[ai][bj][m][1];
                    acc[ai][bj][m][0] = v0; acc[ai][bj][m][1] = v1;
                    sq += (v0[0] * v0[0] + v0[1] * v0[1]) + (v0[2] * v0[2] + v0[3] * v0[3]) + (v1[0] * v1[0] + v1[1] * v1[1]) + (v1[2] * v1[2] + v1[3] * v1[3]); }
                sq += __shfl_xor(sq, 16); sq += __shfl_xor(sq, 32);
                if (fq == 0) (void)__hip_atomic_fetch_add(ssq + row, sq, __ATOMIC_RELAXED, __HIP_MEMORY_SCOPE_AGENT);
            }
        }
        asm volatile("s_waitcnt vmcnt(0)" ::: "memory");
        unsigned* pc = cnt + 64 * u.pm;
        if (fr == 0 && fq == 0) (void)__hip_atomic_fetch_add(pc, 1u, __ATOMIC_RELAXED, __HIP_MEMORY_SCOPE_AGENT);
        for (unsigned it = 0; it < (1u << 22); ++it) {
            if ((unsigned)__builtin_amdgcn_readfirstlane((int)__hip_atomic_load(pc, __ATOMIC_RELAXED, __HIP_MEMORY_SCOPE_AGENT)) >= 32u) break;
            __builtin_amdgcn_s_sleep(2);
        }
        __builtin_amdgcn_fence(__ATOMIC_ACQUIRE, "agent");
        f32x4 gv[2][2];
#pragma unroll
        for (int bj = 0; bj < 2; ++bj) { gv[bj][0] = *(const f32x4*)(g + col0 + bj * HALF); gv[bj][1] = *(const f32x4*)(g + col0 + bj * HALF + 4); }
        float rs8[8];
#pragma unroll
        for (int i = 0; i < 8; ++i) { const unsigned sb = __hip_atomic_load((const unsigned*)(ssq + u.pm * BM + (i >> 2) * HALF + wr * 64 + (i & 3) * 16 + fr), __ATOMIC_RELAXED, __HIP_MEMORY_SCOPE_AGENT);
            rs8[i] = __builtin_amdgcn_rsqf(__uint_as_float(sb) * (1.0f / 1024.0f) + 1e-6f); }
#pragma unroll
        for (int ai = 0; ai < 2; ++ai)
#pragma unroll
            for (int m = 0; m < 4; ++m) { const float rs = rs8[ai * 4 + m];
#pragma unroll
                for (int bj = 0; bj < 2; ++bj) { const size_t off = (size_t)(u.pm * BM + ai * HALF + wr * 64 + m * 16 + fr) * 1024 + col0 + bj * HALF;
                    *(f32x4*)(out + off) = acc[ai][bj][m][0] * rs * gv[bj][0]; *(f32x4*)(out + off + 4) = acc[ai][bj][m][1] * rs * gv[bj][1]; } }
    }
};
struct EpiGU {
    static constexpr bool PERM = true, AFTER_DRAIN = false;
    const float* ssq; bf16_t* H;
    __device__ __forceinline__ void operator()(const f32x4 (&acc)[2][2][4][2], const Unit& u, int wr, int wc, int fr, int fq) const {
        float sq8[8];
#pragma unroll
        for (int i = 0; i < 8; ++i) sq8[i] = ssq[u.pm * BM + (i >> 2) * HALF + wr * 64 + (i & 3) * 16 + fr];
#pragma unroll
        for (int ai = 0; ai < 2; ++ai)
#pragma unroll
            for (int m = 0; m < 4; ++m) {
                const int row = u.pm * BM + ai * HALF + wr * 64 + m * 16 + fr;
                const float rs = __builtin_amdgcn_rsqf(sq8[ai * 4 + m] * (1.0f / 1024.0f) + 1e-6f);
                float hv[8];
#pragma unroll
                for (int n = 0; n < 2; ++n)
#pragma unroll
                    for (int e = 0; e < 4; ++e) { const float gg = acc[ai][0][m][n][e] * rs, uu = acc[ai][1][m][n][e] * rs;
                        hv[n * 4 + e] = gg * uu * __builtin_amdgcn_rcpf(1.0f + __builtin_amdgcn_exp2f(-1.4426950408889634f * gg)); }
                u32x4 w; w.x = cvt_pk_bf16(hv[0], hv[1]); w.y = cvt_pk_bf16(hv[2], hv[3]); w.z = cvt_pk_bf16(hv[4], hv[5]); w.w = cvt_pk_bf16(hv[6], hv[7]);
                *(u32x4*)(H + (size_t)row * 2816 + u.pn * HALF + wc * 32 + 8 * fq) = w;
            }
    }
};
template <class Epi, class Sched, bool ALIGN_EPI = false, bool SP2 = false>
__device__ __forceinline__ void gemm_phase(PG8_LAS unsigned char* lds, const Gemm g, const Sched& S, const Epi& E, const int wv) {
    int tid_ = wv * 64 + hw_lane(); asm volatile("" : "+v"(tid_));
    const int tid = tid_, wid = __builtin_amdgcn_readfirstlane(tid >> 6), lane = tid & 63, wr = wid >> 2, wc = wid & 3, fr = lane & 15, fq = lane >> 4;
    const int K = g.K, nt = K / BK;
    unsigned voffA[2], voffB[2];
#pragma unroll
    for (int i = 0; i < 2; ++i) { int R, C; stage_rc(tid * 16 + i * 8192, R, C); const int Rb = Epi::PERM ? ((R & ~31) + perm32(R & 31)) : R;
        voffA[i] = (unsigned)(R * K + C) * 2u; voffB[i] = (unsigned)(Rb * K + C) * 2u; }
    const size_t kstep = (size_t)(BK * 2);
    const size_t hstep = (size_t)HALF * K * 2;
    const size_t tstep = 2 * hstep;
    const unsigned ldsw = (unsigned)wid * 1024u;
    const int aoff = lds_byte(wr * 64 + fr, fq * 8), boff = lds_byte(wc * 32 + fr, fq * 8);
#define PG8_SA(b, h) (((b) * 2 + (h)) * HTB)
#define PG8_SB(b, h) ((4 + (b) * 2 + (h)) * HTB)
#define PG8_STAGE(bufoff, gbase, voff) do { _Pragma("unroll") for (int _i = 0; _i < 2; ++_i) \
        __builtin_amdgcn_global_load_lds((const unsigned*)((const char*)(gbase) + (voff)[_i]), (PG8_LAS unsigned*)(lds + (bufoff) + ldsw + _i * 8192), 16, 0, 0); } while (0)
#define PG8_LDA(dst, b, h) do { _Pragma("unroll") for (int m = 0; m < 4; ++m) _Pragma("unroll") for (int k = 0; k < 2; ++k) dst[m][k] = *(const PG8_LAS bf16x8*)(lds + PG8_SA(b, h) + aoff + m * 2048 + k * 1024); } while (0)
#define PG8_LDB(dst, b, h) do { _Pragma("unroll") for (int n = 0; n < 2; ++n) _Pragma("unroll") for (int k = 0; k < 2; ++k) dst[n][k] = *(const PG8_LAS bf16x8*)(lds + PG8_SB(b, h) + boff + n * 2048 + k * 1024); } while (0)
#define PG8_MMA(ai, bj, At, Bt) do { __builtin_amdgcn_s_setprio(1); _Pragma("unroll") for (int m = 0; m < 4; ++m) _Pragma("unroll") for (int n = 0; n < 2; ++n) _Pragma("unroll") for (int k = 0; k < 2; ++k) \
        acc[ai][bj][m][n] = __builtin_amdgcn_mfma_f32_16x16x32_bf16(Bt[n][k], At[m][k], acc[ai][bj][m][n], 0, 0, 0); __builtin_amdgcn_s_setprio(0); } while (0)
#define PG8_WAIT_V(n) asm volatile("s_waitcnt vmcnt(" #n ")" ::: "memory")
#define PG8_WAIT_L(n) asm volatile("s_waitcnt lgkmcnt(" #n ")" ::: "memory")
#define PG8_BAR __builtin_amdgcn_s_barrier()
#define PG8_SCHED __builtin_amdgcn_sched_barrier(0)
    Unit cur, nxt; int ui = 0;
    if (!S.next(0, cur)) return;
    f32x4 acc[2][2][4][2];
#pragma unroll
    for (int a = 0; a < 2; ++a)
#pragma unroll
        for (int b = 0; b < 2; ++b)
#pragma unroll
            for (int m = 0; m < 4; ++m)
#pragma unroll
                for (int n = 0; n < 2; ++n) acc[a][b][m][n] = (f32x4){0.f, 0.f, 0.f, 0.f};
    bf16x8 At[4][2], B0[2][2], B1[2][2];
    const char* cA = (const char*)g.A + (size_t)cur.pm * tstep; const char* cB = (const char*)g.Bt + (size_t)cur.pn * tstep;
    S.a_ready(cur);
    if constexpr (SP2) {
        PG8_STAGE(PG8_SB(0, 0), cB, voffB); PG8_STAGE(PG8_SB(0, 1), cB + hstep, voffB); PG8_STAGE(PG8_SA(0, 0), cA, voffA); PG8_STAGE(PG8_SA(0, 1), cA + hstep, voffA);
        if (wr == 1) PG8_BAR;
        PG8_WAIT_V(2); PG8_BAR;
        PG8_STAGE(PG8_SB(1, 0), cB + kstep, voffB); PG8_STAGE(PG8_SA(1, 0), cA + kstep, voffA); PG8_STAGE(PG8_SB(1, 1), cB + hstep + kstep, voffB);
        PG8_WAIT_V(6); PG8_BAR;
    } else {
        PG8_STAGE(PG8_SB(0, 0), cB, voffB); PG8_STAGE(PG8_SA(0, 0), cA, voffA); PG8_STAGE(PG8_SB(0, 1), cB + hstep, voffB); PG8_STAGE(PG8_SA(0, 1), cA + hstep, voffA);
        if (wr == 1) PG8_BAR;
        PG8_WAIT_V(4); PG8_BAR;
        PG8_STAGE(PG8_SB(1, 0), cB + kstep, voffB); PG8_STAGE(PG8_SA(1, 0), cA + kstep, voffA); PG8_STAGE(PG8_SB(1, 1), cB + hstep + kstep, voffB);
        PG8_WAIT_V(6); PG8_BAR;
    }
    for (;;) {
        const bool has_next = S.next(ui + 1, nxt);
        const char* nA = has_next ? (const char*)g.A + (size_t)nxt.pm * tstep : cA; const char* nB = has_next ? (const char*)g.Bt + (size_t)nxt.pn * tstep : cB;
        for (int t = 0; t < nt; t += 2) {
            const bool last = (t == nt - 2);
            const char* a1 = cA + (size_t)(t + 1) * kstep;
            const char* a2 = last ? nA : cA + (size_t)(t + 2) * kstep; const char* b2 = last ? nB : cB + (size_t)(t + 2) * kstep;
            const char* a3 = a2 + kstep; const char* b3 = b2 + kstep;
            if (last && has_next) S.a_ready(nxt);
            if constexpr (SP2) {
            PG8_LDB(B0, 0, 0); PG8_LDB(B1, 0, 1); PG8_SCHED; PG8_LDA(At, 0, 0); PG8_STAGE(PG8_SA(1, 1), a1 + hstep, voffA);
            PG8_WAIT_V(8); PG8_WAIT_L(0); PG8_BAR; PG8_MMA(0, 0, At, B0); PG8_MMA(0, 1, At, B1); PG8_BAR; PG8_SCHED;
            PG8_LDA(At, 0, 1); PG8_STAGE(PG8_SB(0, 0), b2, voffB); PG8_STAGE(PG8_SB(0, 1), b2 + hstep, voffB); PG8_STAGE(PG8_SA(0, 0), a2, voffA);
            PG8_WAIT_V(8); PG8_WAIT_L(0); PG8_BAR; PG8_MMA(1, 0, At, B0); PG8_MMA(1, 1, At, B1); PG8_BAR; PG8_SCHED;
            PG8_LDB(B0, 1, 0); PG8_LDB(B1, 1, 1); PG8_SCHED; PG8_LDA(At, 1, 0); PG8_STAGE(PG8_SA(0, 1), a2 + hstep, voffA);
            PG8_WAIT_V(8); PG8_WAIT_L(0); PG8_BAR; PG8_MMA(0, 0, At, B0); PG8_MMA(0, 1, At, B1); PG8_BAR; PG8_SCHED;
            PG8_LDA(At, 1, 1); PG8_STAGE(PG8_SB(1, 0), b3, voffB); PG8_STAGE(PG8_SB(1, 1), b3 + hstep, voffB); PG8_STAGE(PG8_SA(1, 0), a3, voffA);
            PG8_WAIT_V(8); PG8_WAIT_L(0); PG8_BAR; PG8_MMA(1, 0, At, B0); PG8_MMA(1, 1, At, B1); PG8_BAR; PG8_SCHED;
            } else {
            PG8_LDB(B0, 0, 0); PG8_SCHED; PG8_LDA(At, 0, 0); PG8_STAGE(PG8_SA(1, 1), a1 + hstep, voffA);
            PG8_WAIT_L(8); PG8_BAR; PG8_WAIT_L(0); PG8_MMA(0, 0, At, B0); PG8_BAR; PG8_SCHED;
            PG8_LDB(B1, 0, 1); PG8_STAGE(PG8_SB(0, 0), b2, voffB);
            PG8_BAR; PG8_WAIT_L(0); PG8_MMA(0, 1, At, B1); PG8_BAR;
            PG8_LDA(At, 0, 1); PG8_STAGE(PG8_SA(0, 0), a2, voffA);
            PG8_BAR; PG8_WAIT_L(0); PG8_MMA(1, 0, At, B0); PG8_BAR; PG8_SCHED;
            PG8_STAGE(PG8_SB(0, 1), b2 + hstep, voffB);
            PG8_WAIT_V(6); PG8_BAR; PG8_MMA(1, 1, At, B1); PG8_BAR;
            PG8_LDB(B0, 1, 0); PG8_SCHED; PG8_LDA(At, 1, 0); PG8_STAGE(PG8_SA(0, 1), a2 + hstep, voffA);
            PG8_WAIT_L(8); PG8_BAR; PG8_WAIT_L(0); PG8_MMA(0, 0, At, B0); PG8_BAR; PG8_SCHED;
            PG8_LDB(B1, 1, 1); PG8_STAGE(PG8_SB(1, 0), b3, voffB);
            PG8_BAR; PG8_WAIT_L(0); PG8_MMA(0, 1, At, B1); PG8_BAR;
            PG8_LDA(At, 1, 1); PG8_STAGE(PG8_SA(1, 0), a3, voffA);
            PG8_BAR; PG8_WAIT_L(0); PG8_MMA(1, 0, At, B0); PG8_BAR; PG8_SCHED;
            PG8_STAGE(PG8_SB(1, 1), b3 + hstep, voffB);
            PG8_WAIT_V(6); PG8_BAR; PG8_MMA(1, 1, At, B1); PG8_BAR;
            }
        }
        if constexpr (ALIGN_EPI) { if (wr == 0) PG8_BAR; }
        if constexpr (!Epi::AFTER_DRAIN) { E(acc, cur, wr, wc, fr, fq); S.done(cur); }
        if (!has_next) break;
#pragma unroll
        for (int a = 0; a < 2; ++a)
#pragma unroll
            for (int b = 0; b < 2; ++b)
#pragma unroll
                for (int m = 0; m < 4; ++m)
#pragma unroll
                    for (int n = 0; n < 2; ++n) acc[a][b][m][n] = (f32x4){0.f, 0.f, 0.f, 0.f};
        cur = nxt; cA = nA; cB = nB; ++ui;
        if constexpr (ALIGN_EPI) { if (wr == 1) PG8_BAR; }
    }
    PG8_WAIT_V(0);
    if constexpr (!ALIGN_EPI) { if (wr == 0) PG8_BAR; }
    PG8_BAR;
    if constexpr (Epi::AFTER_DRAIN) { E.fused(acc, cur, wr, wc, fr, fq, lds, wid, lane); S.done(cur); }
#undef PG8_SA
#undef PG8_SB
#undef PG8_STAGE
#undef PG8_LDA
#undef PG8_LDB
#undef PG8_MMA
#undef PG8_WAIT_V
#undef PG8_WAIT_L
#undef PG8_BAR
#undef PG8_SCHED
}
}
namespace att {
#define LAS __attribute__((address_space(3)))
typedef unsigned short bf16_t;
typedef short bf16x8 __attribute__((ext_vector_type(8)));
typedef short s16x4 __attribute__((ext_vector_type(4)));
typedef float f32x16 __attribute__((ext_vector_type(16)));
typedef float f32x4 __attribute__((ext_vector_type(4)));
typedef unsigned u32x4 __attribute__((ext_vector_type(4)));
typedef unsigned u32x2 __attribute__((ext_vector_type(2)));
constexpr int KP = 144, VP = 264;
constexpr int KBUF = 128 * KP, VBUF = 128 * VP;
constexpr int OFF_K = 0, OFF_V = 2 * KBUF, OFF_B = OFF_V + 2 * VBUF, ATT_LDS = OFF_B + 1024;
#ifndef PIPE128
#define PIPE128 0
#endif
constexpr float RESC_THR = 60.f;
typedef float f32x2_t __attribute__((ext_vector_type(2))); typedef __bf16 bf16x2_t __attribute__((ext_vector_type(2)));
__device__ __forceinline__ unsigned cvtpk(float lo, float hi) { f32x2_t v = {lo, hi}; bf16x2_t b = __builtin_convertvector(v, bf16x2_t); return __builtin_bit_cast(unsigned, b); }
__device__ __forceinline__ float max3f(float a, float b, float c) { float r; asm("v_max3_f32 %0, %1, %2, %3" : "=v"(r) : "v"(a), "v"(b), "v"(c)); return r; }
__device__ __forceinline__ float xhalf_max(float m) { auto rr = __builtin_amdgcn_permlane32_swap(__float_as_uint(m), __float_as_uint(m), false, false); return fmaxf(__uint_as_float(rr[0]), __uint_as_float(rr[1])); }
__device__ __forceinline__ float xhalf_sum(float m) { auto rr = __builtin_amdgcn_permlane32_swap(__float_as_uint(m), __float_as_uint(m), false, false); return __uint_as_float(rr[0]) + __uint_as_float(rr[1]); }

typedef float f32x2v __attribute__((ext_vector_type(2)));
__device__ __forceinline__ void exp_sum_pk(f32x16& P0, f32x16& P1, float m, float& lrow) {
    const f32x2v mv = {m, m}; f32x2v s0 = {0.f, 0.f}, s1 = {0.f, 0.f};
#pragma unroll
    for (int r = 0; r < 16; r += 2) {
        f32x2v a = (f32x2v){P0[r], P0[r + 1]} - mv, b = (f32x2v){P1[r], P1[r + 1]} - mv;
        a.x = __builtin_amdgcn_exp2f(a.x); a.y = __builtin_amdgcn_exp2f(a.y); b.x = __builtin_amdgcn_exp2f(b.x); b.y = __builtin_amdgcn_exp2f(b.y);
        P0[r] = a.x; P0[r + 1] = a.y; P1[r] = b.x; P1[r + 1] = b.y; s0 += a; s1 += b;
    }
    s0 += s1; lrow += s0.x + s0.y;
}
template <int DV, bool CAUSAL, bool BIAS, int VAR = 0>
__device__ __forceinline__ void attn_stream(LAS unsigned char* lds, const bf16_t* Qg, int qpitch, const bf16_t* Kg, int kpitch, const bf16_t* Vtg, int vpitch,
                                            const float* bias, int q0, int ntiles, f32x16 (&o)[DV / 32], const int wv) {
    int tid_ = wv * 64 + hw_lane(); asm volatile("" : "+v"(tid_));
    const int tid = tid_, lane = tid & 63, r32 = lane & 31, hi = lane >> 5, w = __builtin_amdgcn_readfirstlane(tid >> 6);
    constexpr int NV = DV / 32;
    bf16x8 qf[4];
#pragma unroll
    for (int d0 = 0; d0 < 4; ++d0) qf[d0] = *(const bf16x8*)(Qg + (size_t)(q0 + 32 * w + r32) * qpitch + 16 * d0 + 8 * hi);
    const int krow = tid >> 3, kch = tid & 7, vrow = tid >> 4, vch = tid & 15;
    const bf16_t* ksrc = Kg + (size_t)krow * kpitch + kch * 8;
    const bf16_t* vsrc = Vtg + (size_t)vrow * vpitch + vch * 8;
    const unsigned kdst = OFF_K + krow * KP + kch * 16, vdst = OFF_V + vrow * VP + vch * 16;
    u32x4 kreg[2], vreg[NV]; f32x4 breg = {0.f, 0.f, 0.f, 0.f};
#define ATT_LOAD(t) do { \
        _Pragma("unroll") for (int i = 0; i < 2; ++i) kreg[i] = *(const u32x4*)(ksrc + (size_t)(128 * (t) + 64 * i) * kpitch); \
        _Pragma("unroll") for (int i = 0; i < NV; ++i) vreg[i] = *(const u32x4*)(vsrc + (size_t)(32 * i) * vpitch + 128 * (t)); \
        if (BIAS) { if (tid < 32) breg = *(const f32x4*)(bias + 128 * (t) + 4 * tid); } } while (0)
#define ATT_STORE(buf) do { \
        _Pragma("unroll") for (int i = 0; i < 2; ++i) *(LAS u32x4*)(lds + kdst + (buf) * KBUF + i * 64 * KP) = kreg[i]; \
        _Pragma("unroll") for (int i = 0; i < NV; ++i) { *(LAS u32x2*)(lds + vdst + (buf) * VBUF + i * 32 * VP) = (u32x2){vreg[i].x, vreg[i].y}; *(LAS u32x2*)(lds + vdst + (buf) * VBUF + i * 32 * VP + 8) = (u32x2){vreg[i].z, vreg[i].w}; } \
        if (BIAS) { if (tid < 32) *(LAS f32x4*)(lds + OFF_B + (buf) * 512 + 16 * tid) = breg; } } while (0)
    ATT_LOAD(0);
    ATT_STORE(0);
    __syncthreads();
    float mrow = -1e30f, lrow = 0.f;
#pragma unroll
    for (int d0 = 0; d0 < DV / 32; ++d0)
#pragma unroll
        for (int r = 0; r < 16; ++r) o[d0][r] = 0.f;
    const int qmin = q0 + 32 * w;
#define ATT_KLOAD(P0, P1, buf, sub) do { \
        LAS unsigned char* Ks_ = lds + OFF_K + (buf) * KBUF + (sub) * 64 * KP; \
        _Pragma("unroll") for (int d0 = 0; d0 < 4; ++d0) { kf[2 * d0] = *(LAS bf16x8*)(Ks_ + r32 * KP + (2 * d0 + hi) * 16); kf[2 * d0 + 1] = *(LAS bf16x8*)(Ks_ + (32 + r32) * KP + (2 * d0 + hi) * 16); } \
        if (BIAS) { LAS unsigned char* Bs_ = lds + OFF_B + (buf) * 512 + (sub) * 256; \
            _Pragma("unroll") for (int g = 0; g < 4; ++g) { const f32x4 b0 = *(LAS f32x4*)(Bs_ + (8 * g + 4 * hi) * 4), b1 = *(LAS f32x4*)(Bs_ + (32 + 8 * g + 4 * hi) * 4); \
                _Pragma("unroll") for (int e = 0; e < 4; ++e) { P0[4 * g + e] = b0[e]; P1[4 * g + e] = b1[e]; } } \
        } else { _Pragma("unroll") for (int r = 0; r < 16; ++r) { P0[r] = 0.f; P1[r] = 0.f; } } \
        __builtin_amdgcn_sched_barrier(0); } while (0)
#define ATT_QKM(P0, P1) do { \
        _Pragma("unroll") for (int d0 = 0; d0 < 4; ++d0) { \
            P0 = __builtin_amdgcn_mfma_f32_32x32x16_bf16(kf[2 * d0], qf[d0], P0, 0, 0, 0); \
            P1 = __builtin_amdgcn_mfma_f32_32x32x16_bf16(kf[2 * d0 + 1], qf[d0], P1, 0, 0, 0); } \
        __builtin_amdgcn_sched_barrier(0); } while (0)
#define ATT_VLOAD(buf, sub, KK0, NKK) do { \
        LAS unsigned char* Vs_ = lds + OFF_V + (buf) * VBUF + (sub) * 128; \
        _Pragma("unroll") for (int kk = 0; kk < (NKK); ++kk) _Pragma("unroll") for (int d0 = 0; d0 < DV / 32; ++d0) { \
            const LAS unsigned char* vp = Vs_ + (32 * d0 + r32) * VP + (16 * ((KK0) + kk) + 4 * hi) * 2; \
            const s16x4 lo = *(const LAS s16x4*)vp, hh = *(const LAS s16x4*)(vp + 16); \
            vf[kk * (DV / 32) + d0] = (bf16x8){lo[0], lo[1], lo[2], lo[3], hh[0], hh[1], hh[2], hh[3]}; } \
        __builtin_amdgcn_sched_barrier(0); } while (0)
#define ATT_SM(P0, P1, kv0) do { \
        if (CAUSAL && ((kv0) + 63 > qmin)) { const int qrel = qmin + r32 - (kv0); \
            _Pragma("unroll") for (int r = 0; r < 16; ++r) { const int kv = (r & 3) + 8 * (r >> 2) + 4 * hi; if (kv > qrel) P0[r] = -1e30f; if (kv + 32 > qrel) P1[r] = -1e30f; } } \
        float mt = max3f(P0[0], P1[0], P0[1]), mu = max3f(P1[1], P0[2], P1[2]); \
        _Pragma("unroll") for (int r = 3; r < 15; r += 2) { mt = max3f(mt, P0[r], P1[r]); mu = max3f(mu, P0[r + 1], P1[r + 1]); } \
        mt = max3f(mt, P0[15], P1[15]); mt = max3f(mt, mu, mu); \
        mt = xhalf_max(mt); \
        if (__builtin_amdgcn_ballot_w64(mt > mrow + RESC_THR) != 0ull) { \
            const float mnew = fmaxf(mrow, mt), alpha = __builtin_amdgcn_exp2f(mrow - mnew); mrow = mnew; lrow *= alpha; \
            _Pragma("unroll") for (int d0 = 0; d0 < DV / 32; ++d0) _Pragma("unroll") for (int r = 0; r < 16; ++r) o[d0][r] *= alpha; } \
        exp_sum_pk(P0, P1, mrow, lrow); \
        { u32x4 x; x.x = cvtpk(P0[0], P0[1]); x.y = cvtpk(P0[2], P0[3]); x.z = cvtpk(P0[4], P0[5]); x.w = cvtpk(P0[6], P0[7]); pb[0] = __builtin_bit_cast(bf16x8, x); \
          x.x = cvtpk(P0[8], P0[9]); x.y = cvtpk(P0[10], P0[11]); x.z = cvtpk(P0[12], P0[13]); x.w = cvtpk(P0[14], P0[15]); pb[1] = __builtin_bit_cast(bf16x8, x); \
          x.x = cvtpk(P1[0], P1[1]); x.y = cvtpk(P1[2], P1[3]); x.z = cvtpk(P1[4], P1[5]); x.w = cvtpk(P1[6], P1[7]); pb[2] = __builtin_bit_cast(bf16x8, x); \
          x.x = cvtpk(P1[8], P1[9]); x.y = cvtpk(P1[10], P1[11]); x.z = cvtpk(P1[12], P1[13]); x.w = cvtpk(P1[14], P1[15]); pb[3] = __builtin_bit_cast(bf16x8, x); } \
        __builtin_amdgcn_sched_barrier(0); } while (0)
#define ATT_PVM(KK0, NKK) do { \
        _Pragma("unroll") for (int kk = 0; kk < (NKK); ++kk) _Pragma("unroll") for (int d0 = 0; d0 < DV / 32; ++d0) \
            o[d0] = __builtin_amdgcn_mfma_f32_32x32x16_bf16(vf[kk * (DV / 32) + d0], pb[(KK0) + kk], o[d0], 0, 0, 0); \
        __builtin_amdgcn_sched_barrier(0); } while (0)
    bf16x8 kf[8], vf[8], pb[4];
    if constexpr (DV == 64) {
        f32x16 sa0, sa1, sb0, sb1; bf16x8 pc[4];
        const unsigned kofs = (unsigned)(krow * kpitch + kch * 8) * 2u, vofs = (unsigned)(vrow * vpitch + vch * 8) * 2u, bofs = (unsigned)tid * 16u;
#define ATT_HEAD(P0, P1, kv0, MT) do { \
        if (CAUSAL && ((kv0) + 63 > qmin)) { const int qrel = qmin + r32 - (kv0); \
            _Pragma("unroll") for (int r = 0; r < 16; ++r) { const int kv = (r & 3) + 8 * (r >> 2) + 4 * hi; if (kv > qrel) P0[r] = -1e30f; if (kv + 32 > qrel) P1[r] = -1e30f; } } \
        float mt_ = max3f(P0[0], P1[0], P0[1]), mu_ = max3f(P1[1], P0[2], P1[2]); \
        _Pragma("unroll") for (int r = 3; r < 15; r += 2) { mt_ = max3f(mt_, P0[r], P1[r]); mu_ = max3f(mu_, P0[r + 1], P1[r + 1]); } \
        mt_ = max3f(mt_, P0[15], P1[15]); mt_ = max3f(mt_, mu_, mu_); MT = xhalf_max(mt_); } while (0)
#define ATT_PACK(P0, P1, PB) do { u32x4 x; x.x = cvtpk(P0[0], P0[1]); x.y = cvtpk(P0[2], P0[3]); x.z = cvtpk(P0[4], P0[5]); x.w = cvtpk(P0[6], P0[7]); PB[0] = __builtin_bit_cast(bf16x8, x); \
          x.x = cvtpk(P0[8], P0[9]); x.y = cvtpk(P0[10], P0[11]); x.z = cvtpk(P0[12], P0[13]); x.w = cvtpk(P0[14], P0[15]); PB[1] = __builtin_bit_cast(bf16x8, x); \
          x.x = cvtpk(P1[0], P1[1]); x.y = cvtpk(P1[2], P1[3]); x.z = cvtpk(P1[4], P1[5]); x.w = cvtpk(P1[6], P1[7]); PB[2] = __builtin_bit_cast(bf16x8, x); \
          x.x = cvtpk(P1[8], P1[9]); x.y = cvtpk(P1[10], P1[11]); x.z = cvtpk(P1[12], P1[13]); x.w = cvtpk(P1[14], P1[15]); PB[3] = __builtin_bit_cast(bf16x8, x); } while (0)
#ifndef MIXN
#define MIXN 10
#endif
#define ATT_MIX8() do { if (MIXN > 0) { _Pragma("unroll") for (int i_ = 0; i_ < 8; ++i_) { __builtin_amdgcn_sched_group_barrier(0x008, 1, 0); __builtin_amdgcn_sched_group_barrier(0x402, MIXN, 0); } } } while (0)
        ATT_KLOAD(sa0, sa1, 0, 0); ATT_QKM(sa0, sa1);
        for (int t = 0; t < ntiles; ++t) {
            const int cur = t & 1, nxt = cur ^ 1; const bool more = (t + 1 < ntiles);
            if (more) {
                const char* kt_ = (const char*)(Kg + (size_t)(128 * (t + 1)) * kpitch);
#pragma unroll
                for (int i = 0; i < 2; ++i) kreg[i] = *(const u32x4*)(kt_ + (size_t)(64 * i) * kpitch * 2 + kofs);
                if (BIAS) { if (tid < 32) breg = *(const f32x4*)((const char*)(bias + 128 * (t + 1)) + bofs); } }
            ATT_KLOAD(sb0, sb1, cur, 1);
            { float mt; ATT_HEAD(sa0, sa1, 128 * t, mt);
              if (__builtin_amdgcn_ballot_w64(mt > mrow + RESC_THR) != 0ull) {
                  const float mnew = fmaxf(mrow, mt), alpha = __builtin_amdgcn_exp2f(mrow - mnew); mrow = mnew; lrow *= alpha;
#pragma unroll
                  for (int d0 = 0; d0 < DV / 32; ++d0)
#pragma unroll
                      for (int r = 0; r < 16; ++r) o[d0][r] *= alpha; } }
            __builtin_amdgcn_sched_barrier(0);
#pragma unroll
            for (int d0 = 0; d0 < 4; ++d0) { sb0 = __builtin_amdgcn_mfma_f32_32x32x16_bf16(kf[2 * d0], qf[d0], sb0, 0, 0, 0); sb1 = __builtin_amdgcn_mfma_f32_32x32x16_bf16(kf[2 * d0 + 1], qf[d0], sb1, 0, 0, 0); }
            exp_sum_pk(sa0, sa1, mrow, lrow);
            ATT_PACK(sa0, sa1, pb);
            ATT_MIX8();
            __builtin_amdgcn_sched_barrier(0);
            if (more) {
#pragma unroll
                for (int i = 0; i < 2; ++i) *(LAS u32x4*)(lds + kdst + nxt * KBUF + i * 64 * KP) = kreg[i];
                if (BIAS) { if (tid < 32) *(LAS f32x4*)(lds + OFF_B + nxt * 512 + 16 * tid) = breg; }
                const char* vt_ = (const char*)(Vtg + 128 * (t + 1));
#pragma unroll
                for (int i = 0; i < 2; ++i) kreg[i] = *(const u32x4*)(vt_ + (size_t)(32 * i) * vpitch * 2 + vofs); }
            { LAS unsigned char* Vs_ = lds + OFF_V + cur * VBUF;
#pragma unroll
              for (int kk = 0; kk < 4; ++kk)
#pragma unroll
                  for (int d0 = 0; d0 < 2; ++d0) { const LAS unsigned char* vp = Vs_ + (32 * d0 + r32) * VP + (16 * kk + 4 * hi) * 2;
                      const s16x4 lo = *(const LAS s16x4*)vp, hh = *(const LAS s16x4*)(vp + 16); kf[kk * 2 + d0] = (bf16x8){lo[0], lo[1], lo[2], lo[3], hh[0], hh[1], hh[2], hh[3]}; } }
            float mtb; ATT_HEAD(sb0, sb1, 128 * t + 64, mtb);
            const bool rescb = __builtin_amdgcn_ballot_w64(mtb > mrow + RESC_THR) != 0ull;
            const float mnewb = rescb ? fmaxf(mrow, mtb) : mrow, alphab = __builtin_amdgcn_exp2f(mrow - mnewb);
            float psb = 0.f;
            __builtin_amdgcn_sched_barrier(0);
#pragma unroll
            for (int kk = 0; kk < 4; ++kk)
#pragma unroll
                for (int d0 = 0; d0 < 2; ++d0) o[d0] = __builtin_amdgcn_mfma_f32_32x32x16_bf16(kf[kk * 2 + d0], pb[kk], o[d0], 0, 0, 0);
            exp_sum_pk(sb0, sb1, mnewb, psb);
            ATT_PACK(sb0, sb1, pc);
            ATT_MIX8();
            __builtin_amdgcn_sched_barrier(0);
            { LAS unsigned char* Vs_ = lds + OFF_V + cur * VBUF + 128;
#pragma unroll
              for (int kk = 0; kk < 4; ++kk)
#pragma unroll
                  for (int d0 = 0; d0 < 2; ++d0) { const LAS unsigned char* vp = Vs_ + (32 * d0 + r32) * VP + (16 * kk + 4 * hi) * 2;
                      const s16x4 lo = *(const LAS s16x4*)vp, hh = *(const LAS s16x4*)(vp + 16); kf[kk * 2 + d0] = (bf16x8){lo[0], lo[1], lo[2], lo[3], hh[0], hh[1], hh[2], hh[3]}; } }
            if (rescb) {
#pragma unroll
                for (int d0 = 0; d0 < DV / 32; ++d0)
#pragma unroll
                    for (int r = 0; r < 16; ++r) o[d0][r] *= alphab; }
            lrow = lrow * alphab + psb; mrow = mnewb;
            __builtin_amdgcn_sched_barrier(0);
#pragma unroll
            for (int kk = 0; kk < 4; ++kk)
#pragma unroll
                for (int d0 = 0; d0 < 2; ++d0) o[d0] = __builtin_amdgcn_mfma_f32_32x32x16_bf16(kf[kk * 2 + d0], pc[kk], o[d0], 0, 0, 0);
            __builtin_amdgcn_sched_barrier(0);
            if (more) {
#pragma unroll
                for (int i = 0; i < 2; ++i) { *(LAS u32x2*)(lds + vdst + nxt * VBUF + i * 32 * VP) = (u32x2){kreg[i].x, kreg[i].y}; *(LAS u32x2*)(lds + vdst + nxt * VBUF + i * 32 * VP + 8) = (u32x2){kreg[i].z, kreg[i].w}; } }
            __syncthreads();
            if (more) { ATT_KLOAD(sa0, sa1, nxt, 0); ATT_QKM(sa0, sa1); }
        }
#undef ATT_HEAD
#undef ATT_PACK
#undef ATT_MIX8
    } else if constexpr (DV == 128 && PIPE128) {
#define LOAD_A(t) do { _Pragma("unroll") for (int i = 0; i < 2; ++i) kreg[i] = *(const u32x4*)(ksrc + (size_t)(128 * (t) + 64 * i) * kpitch); \
        _Pragma("unroll") for (int i = 0; i < 2; ++i) vreg[i] = *(const u32x4*)(vsrc + (size_t)(32 * i) * vpitch + 128 * (t)); } while (0)
#define STORE_A(buf) do { _Pragma("unroll") for (int i = 0; i < 2; ++i) *(LAS u32x4*)(lds + kdst + (buf) * KBUF + i * 64 * KP) = kreg[i]; \
        _Pragma("unroll") for (int i = 0; i < 2; ++i) { *(LAS u32x2*)(lds + vdst + (buf) * VBUF + i * 32 * VP) = (u32x2){vreg[i].x, vreg[i].y}; *(LAS u32x2*)(lds + vdst + (buf) * VBUF + i * 32 * VP + 8) = (u32x2){vreg[i].z, vreg[i].w}; } } while (0)
#define LOAD_B(t) do { _Pragma("unroll") for (int i = 0; i < 2; ++i) vreg[i] = *(const u32x4*)(vsrc + (size_t)(32 * (i + 2)) * vpitch + 128 * (t)); } while (0)
#define STORE_B(buf) do { _Pragma("unroll") for (int i = 0; i < 2; ++i) { *(LAS u32x2*)(lds + vdst + (buf) * VBUF + (i + 2) * 32 * VP) = (u32x2){vreg[i].x, vreg[i].y}; *(LAS u32x2*)(lds + vdst + (buf) * VBUF + (i + 2) * 32 * VP + 8) = (u32x2){vreg[i].z, vreg[i].w}; } } while (0)
        f32x16 sa0, sa1, sb0, sb1;
        ATT_KLOAD(sa0, sa1, 0, 0); ATT_QKM(sa0, sa1);
        for (int t = 0; t < ntiles; ++t) {
            const int cur = t & 1, nxt = cur ^ 1; const bool more = (t + 1 < ntiles);
            if (more) LOAD_A(t + 1);
            ATT_KLOAD(sb0, sb1, cur, 1); ATT_QKM(sb0, sb1);
            ATT_VLOAD(cur, 0, 0, 1);
            ATT_SM(sa0, sa1, 128 * t);
            ATT_PVM(0, 1); ATT_VLOAD(cur, 0, 1, 1); ATT_PVM(1, 1); ATT_VLOAD(cur, 0, 2, 1); ATT_PVM(2, 1); ATT_VLOAD(cur, 0, 3, 1); ATT_PVM(3, 1);
            if (more) { STORE_A(nxt); LOAD_B(t + 1); }
            ATT_VLOAD(cur, 1, 0, 1);
            ATT_SM(sb0, sb1, 128 * t + 64);
            ATT_PVM(0, 1); ATT_VLOAD(cur, 1, 1, 1); ATT_PVM(1, 1); ATT_VLOAD(cur, 1, 2, 1); ATT_PVM(2, 1); ATT_VLOAD(cur, 1, 3, 1); ATT_PVM(3, 1);
            if (more) STORE_B(nxt);
            __syncthreads();
            if (more) { ATT_KLOAD(sa0, sa1, nxt, 0); ATT_QKM(sa0, sa1); }
        }
#undef LOAD_A
#undef STORE_A
#undef LOAD_B
#undef STORE_B
    } else {
        f32x16 sa0, sa1;
        for (int t = 0; t < ntiles; ++t) {
            const int cur = t & 1, nxt = cur ^ 1; const bool more = (t + 1 < ntiles);
            if (more) ATT_LOAD(t + 1);
#pragma unroll
            for (int sub = 0; sub < 2; ++sub) {
                if (!(CAUSAL && (128 * t + 64 * sub > qmin + 31))) {
                    ATT_KLOAD(sa0, sa1, cur, sub); ATT_QKM(sa0, sa1);
                    ATT_VLOAD(cur, sub, 0, 1);
                    ATT_SM(sa0, sa1, 128 * t + 64 * sub);
                    ATT_PVM(0, 1);
                    ATT_VLOAD(cur, sub, 1, 1); ATT_PVM(1, 1);
                    ATT_VLOAD(cur, sub, 2, 1); ATT_PVM(2, 1);
                    ATT_VLOAD(cur, sub, 3, 1); ATT_PVM(3, 1);
                }
            }
            if (more) ATT_STORE(nxt);
            __syncthreads();
        }
    }
#undef ATT_KLOAD
#undef ATT_QKM
#undef ATT_VLOAD
#undef ATT_SM
#undef ATT_PVM
#undef ATT_LOAD
#undef ATT_STORE
    const float inv = __builtin_amdgcn_rcpf(xhalf_sum(lrow));
#pragma unroll
    for (int d0 = 0; d0 < DV / 32; ++d0)
#pragma unroll
        for (int r = 0; r < 16; ++r) o[d0][r] *= inv;
}
constexpr int KP2 = 272, KBUF2 = 128 * KP2, OFF_K2 = 0, OFF_V2 = 2 * KBUF2;
template <int SEQ_>
__device__ __forceinline__ void attn_diff_unit(LAS unsigned char* lds, const bf16_t* Qg, const bf16_t* Kg, const bf16_t* Vtg, int q0, int ntiles, float lam, float post,
                                               const float* subln_g, bf16_t* mixbase, const int wv) {
    constexpr int DV = 128;
    int tid_ = wv * 64 + hw_lane(); asm volatile("" : "+v"(tid_));
    const int tid = tid_, lane = tid & 63, r32 = lane & 31, hi = lane >> 5, w = __builtin_amdgcn_readfirstlane(tid >> 6), wr = w & 3, strm = w >> 2;
    bf16x8 qf[4];
#pragma unroll
    for (int d0 = 0; d0 < 4; ++d0) qf[d0] = *(const bf16x8*)(Qg + (size_t)(q0 + 32 * wr + r32) * 768 + 64 * strm + 16 * d0 + 8 * hi);
    const int srow = tid >> 4, sch = tid & 15;
    const bf16_t* ksrc = Kg + (size_t)srow * 768 + sch * 8;
    const bf16_t* vsrc = Vtg + (size_t)srow * SEQ_ + sch * 8;
    const unsigned kdst = OFF_K2 + srow * KP2 + sch * 16, vdst = OFF_V2 + srow * VP + sch * 16;
    u32x4 sreg[4];
#define D_LOADK(t) do { _Pragma("unroll") for (int i = 0; i < 4; ++i) sreg[i] = *(const u32x4*)(ksrc + (size_t)(128 * (t) + 32 * i) * 768); } while (0)
#define D_STOREK(buf) do { _Pragma("unroll") for (int i = 0; i < 4; ++i) *(LAS u32x4*)(lds + kdst + (buf) * KBUF2 + i * 32 * KP2) = sreg[i]; } while (0)
#define D_LOADV(t) do { _Pragma("unroll") for (int i = 0; i < 4; ++i) sreg[i] = *(const u32x4*)(vsrc + (size_t)(32 * i) * SEQ_ + 128 * (t)); } while (0)
#define D_STOREV(buf) do { _Pragma("unroll") for (int i = 0; i < 4; ++i) { *(LAS u32x2*)(lds + vdst + (buf) * VBUF + i * 32 * VP) = (u32x2){sreg[i].x, sreg[i].y}; *(LAS u32x2*)(lds + vdst + (buf) * VBUF + i * 32 * VP + 8) = (u32x2){sreg[i].z, sreg[i].w}; } } while (0)
    D_LOADK(0); D_STOREK(0); D_LOADV(0); D_STOREV(0);
    __syncthreads();
    float mrow = -1e30f, lrow = 0.f;
    f32x16 o[4];
#pragma unroll
    for (int d0 = 0; d0 < 4; ++d0)
#pragma unroll
        for (int r = 0; r < 16; ++r) o[d0][r] = 0.f;
    const int qmin = q0 + 32 * wr;
    bf16x8 kf[8], vf[4], vg[4], pb[4];
    f32x16 p0, p1;
#define D_SUB(buf, sub, kv0) do { if (!((kv0) > qmin + 31)) { \
        LAS unsigned char* Ks_ = lds + OFF_K2 + (buf) * KBUF2 + (sub) * 64 * KP2 + strm * 128; \
        _Pragma("unroll") for (int d0 = 0; d0 < 4; ++d0) { kf[2 * d0] = *(LAS bf16x8*)(Ks_ + r32 * KP2 + (2 * d0 + hi) * 16); kf[2 * d0 + 1] = *(LAS bf16x8*)(Ks_ + (32 + r32) * KP2 + (2 * d0 + hi) * 16); } \
        _Pragma("unroll") for (int r = 0; r < 16; ++r) { p0[r] = 0.f; p1[r] = 0.f; } \
        __builtin_amdgcn_sched_barrier(0); \
        _Pragma("unroll") for (int d0 = 0; d0 < 4; ++d0) { \
            p0 = __builtin_amdgcn_mfma_f32_32x32x16_bf16(kf[2 * d0], qf[d0], p0, 0, 0, 0); \
            p1 = __builtin_amdgcn_mfma_f32_32x32x16_bf16(kf[2 * d0 + 1], qf[d0], p1, 0, 0, 0); } \
        __builtin_amdgcn_sched_barrier(0); \
        LAS unsigned char* Vs_ = lds + OFF_V2 + (buf) * VBUF + (sub) * 128; \
        D_VLOAD(0); \
        if ((kv0) + 63 > qmin) { const int qrel = qmin + r32 - (kv0); \
            _Pragma("unroll") for (int r = 0; r < 16; ++r) { const int kv = (r & 3) + 8 * (r >> 2) + 4 * hi; if (kv > qrel) p0[r] = -1e30f; if (kv + 32 > qrel) p1[r] = -1e30f; } } \
        float mt = max3f(p0[0], p1[0], p0[1]), mu = max3f(p1[1], p0[2], p1[2]); \
        _Pragma("unroll") for (int r = 3; r < 15; r += 2) { mt = max3f(mt, p0[r], p1[r]); mu = max3f(mu, p0[r + 1], p1[r + 1]); } \
        mt = max3f(mt, p0[15], p1[15]); mt = max3f(mt, mu, mu); \
        mt = xhalf_max(mt); \
        if (__builtin_amdgcn_ballot_w64(mt > mrow + RESC_THR) != 0ull) { \
            const float mnew = fmaxf(mrow, mt), alpha = __builtin_amdgcn_exp2f(mrow - mnew); mrow = mnew; lrow *= alpha; \
            _Pragma("unroll") for (int d0 = 0; d0 < 4; ++d0) _Pragma("unroll") for (int r = 0; r < 16; ++r) o[d0][r] *= alpha; } \
        exp_sum_pk(p0, p1, mrow, lrow); \
        { u32x4 x; x.x = cvtpk(p0[0], p0[1]); x.y = cvtpk(p0[2], p0[3]); x.z = cvtpk(p0[4], p0[5]); x.w = cvtpk(p0[6], p0[7]); pb[0] = __builtin_bit_cast(bf16x8, x); \
          x.x = cvtpk(p0[8], p0[9]); x.y = cvtpk(p0[10], p0[11]); x.z = cvtpk(p0[12], p0[13]); x.w = cvtpk(p0[14], p0[15]); pb[1] = __builtin_bit_cast(bf16x8, x); \
          x.x = cvtpk(p1[0], p1[1]); x.y = cvtpk(p1[2], p1[3]); x.z = cvtpk(p1[4], p1[5]); x.w = cvtpk(p1[6], p1[7]); pb[2] = __builtin_bit_cast(bf16x8, x); \
          x.x = cvtpk(p1[8], p1[9]); x.y = cvtpk(p1[10], p1[11]); x.z = cvtpk(p1[12], p1[13]); x.w = cvtpk(p1[14], p1[15]); pb[3] = __builtin_bit_cast(bf16x8, x); } \
        __builtin_amdgcn_sched_barrier(0); \
        D_VLOADB(1); D_PVM(0); D_VLOAD(2); D_PVMB(1); D_VLOADB(3); D_PVM(2); D_PVMB(3); } } while (0)
#define D_VLOAD(KK) do { _Pragma("unroll") for (int d0 = 0; d0 < 4; ++d0) { \
            const LAS unsigned char* vp = Vs_ + (32 * d0 + r32) * VP + (16 * (KK) + 4 * hi) * 2; \
            const s16x4 lo = *(const LAS s16x4*)vp, hh = *(const LAS s16x4*)(vp + 16); \
            vf[d0] = (bf16x8){lo[0], lo[1], lo[2], lo[3], hh[0], hh[1], hh[2], hh[3]}; } \
        __builtin_amdgcn_sched_barrier(0); } while (0)
#define D_VLOADB(KK) do { _Pragma("unroll") for (int d0 = 0; d0 < 4; ++d0) { \
            const LAS unsigned char* vp = Vs_ + (32 * d0 + r32) * VP + (16 * (KK) + 4 * hi) * 2; \
            const s16x4 lo = *(const LAS s16x4*)vp, hh = *(const LAS s16x4*)(vp + 16); \
            vg[d0] = (bf16x8){lo[0], lo[1], lo[2], lo[3], hh[0], hh[1], hh[2], hh[3]}; } \
        __builtin_amdgcn_sched_barrier(0); } while (0)
#define D_PVMB(KK) do { _Pragma("unroll") for (int d0 = 0; d0 < 4; ++d0) o[d0] = __builtin_amdgcn_mfma_f32_32x32x16_bf16(vg[d0], pb[KK], o[d0], 0, 0, 0); \
        __builtin_amdgcn_sched_barrier(0); } while (0)
#define D_PVM(KK) do { _Pragma("unroll") for (int d0 = 0; d0 < 4; ++d0) o[d0] = __builtin_amdgcn_mfma_f32_32x32x16_bf16(vf[d0], pb[KK], o[d0], 0, 0, 0); \
        __builtin_amdgcn_sched_barrier(0); } while (0)
    for (int t = 0; t < ntiles; ++t) {
        const int cur = t & 1, nxt = cur ^ 1; const bool more = (t + 1 < ntiles);
        if (more) D_LOADK(t + 1);
        D_SUB(cur, 0, 128 * t);
        if (more) { D_STOREK(nxt); D_LOADV(t + 1); }
        D_SUB(cur, 1, 128 * t + 64);
        if (more) D_STOREV(nxt);
        __syncthreads();
    }
#undef D_LOADK
#undef D_STOREK
#undef D_LOADV
#undef D_STOREV
#undef D_SUB
#undef D_VLOAD
#undef D_PVM
#undef D_VLOADB
#undef D_PVMB
    const float inv = __builtin_amdgcn_rcpf(xhalf_sum(lrow));
    const int lane_e = hw_lane(), r32e = lane_e & 31, hie = lane_e >> 5;
    if (strm == 1) {
#pragma unroll
        for (int d0 = 0; d0 < 4; ++d0)
#pragma unroll
            for (int g4 = 0; g4 < 4; ++g4) *(LAS f32x4*)(lds + (((d0 * 4 + g4) * 4 + wr) * 64 + lane_e) * 16) = (f32x4){o[d0][4 * g4] * inv, o[d0][4 * g4 + 1] * inv, o[d0][4 * g4 + 2] * inv, o[d0][4 * g4 + 3] * inv};
    }
    __syncthreads();
    if (strm == 0) {
        float sq = 0.f;
#pragma unroll
        for (int d0 = 0; d0 < 4; ++d0)
#pragma unroll
            for (int g4 = 0; g4 < 4; ++g4) { const f32x4 a = *(LAS f32x4*)(lds + (((d0 * 4 + g4) * 4 + wr) * 64 + lane_e) * 16);
#pragma unroll
                for (int e = 0; e < 4; ++e) { const float y = o[d0][4 * g4 + e] * inv - lam * a[e]; o[d0][4 * g4 + e] = y; sq += y * y; } }
        sq = xhalf_sum(sq);
        const float rn = __builtin_amdgcn_rsqf(sq * (1.0f / 128.0f) + 1e-6f) * post;
        bf16_t* dst = mixbase + (size_t)(q0 + 32 * wr + r32e) * 1024;
#pragma unroll
        for (int d0 = 0; d0 < 4; ++d0)
#pragma unroll
            for (int g4 = 0; g4 < 4; ++g4) { const f32x4 gv = *(const f32x4*)(subln_g + 32 * d0 + 8 * g4 + 4 * hie);
                u32x2 x; x.x = cvtpk(o[d0][4 * g4] * rn * gv[0], o[d0][4 * g4 + 1] * rn * gv[1]); x.y = cvtpk(o[d0][4 * g4 + 2] * rn * gv[2], o[d0][4 * g4 + 3] * rn * gv[3]);
                *(u32x2*)(dst + 32 * d0 + 8 * g4 + 4 * hie) = x; }
    }
}
template <int DV> __device__ __forceinline__ void store_o(bf16_t* dstrow, const f32x16 (&o)[DV / 32], int hi) {
#pragma unroll
    for (int d0 = 0; d0 < DV / 32; ++d0)
#pragma unroll
        for (int g = 0; g < 4; ++g) { u32x2 x; x.x = cvtpk(o[d0][4 * g], o[d0][4 * g + 1]); x.y = cvtpk(o[d0][4 * g + 2], o[d0][4 * g + 3]);
            *(u32x2*)(dstrow + 32 * d0 + 8 * g + 4 * hi) = x; }
}
}
__constant__ float INV_FREQ[32] = {1.000000000e+00f, 7.498942614e-01f, 5.623413324e-01f, 4.216965139e-01f, 3.162277639e-01f, 2.371373773e-01f, 1.778279394e-01f, 1.333521307e-01f, 1.000000015e-01f, 7.498941571e-02f, 5.623413250e-02f, 4.216965288e-02f, 3.162277490e-02f, 2.371373773e-02f, 1.778279431e-02f, 1.333521493e-02f, 9.999999776e-03f, 7.498941850e-03f, 5.623413250e-03f, 4.216964822e-03f, 3.162277630e-03f, 2.371373586e-03f, 1.778279431e-03f, 1.333521446e-03f, 1.000000047e-03f, 7.498942432e-04f, 5.623413017e-04f, 4.216965172e-04f, 3.162277571e-04f, 2.371373703e-04f, 1.778279402e-04f, 1.333521504e-04f};
namespace cg = cooperative_groups;
typedef unsigned short bf16;
typedef float f32x4 __attribute__((ext_vector_type(4)));
typedef unsigned v4u __attribute__((ext_vector_type(4)));
typedef unsigned v2u __attribute__((ext_vector_type(2)));
constexpr int NB = 4, SEQ = 4096, DM = 1024, M = NB * SEQ, NMEM = 256, MM = NB * NMEM, DFF = 2816, NPROJ = 2560, NPROJA = 2816;
constexpr float C2 = 0.125f * 1.4426950408889634f;
constexpr float LAMBDA_INIT = 0.35550906759096934f;
constexpr size_t MiB = 1u << 20;
constexpr size_t WS_CTL = 0;
constexpr size_t WS_SSQ = 1 * MiB;
constexpr size_t WS_SSQM = WS_SSQ + 5 * (size_t)M * 4;
constexpr size_t WS_LF = 2 * MiB;
constexpr size_t WS_COS = 3 * MiB, WS_SIN = 3 * MiB + 512 * 1024;
constexpr size_t WS_INVREV = 2 * MiB + 800 * 1024;
constexpr size_t WS_WA = 4 * MiB, WS_WB = 10 * MiB, WS_WO = 15 * MiB, WS_WM = 19 * MiB, WS_WGU = 21 * MiB, WS_WD = 43 * MiB;
constexpr size_t WS_MEMB = 54 * MiB, WS_MK = 56 * MiB, WS_MVT = 57 * MiB;
constexpr size_t WS_XB = 58 * MiB;
constexpr size_t WS_Q = 90 * MiB, WS_K = 114 * MiB, WS_VT = 138 * MiB, WS_MQ = 162 * MiB, WS_MIX = 170 * MiB, WS_H = 90 * MiB, WS_STASH = 202 * MiB, WS_END = 234 * MiB;
static_assert(WS_H + (size_t)M * DFF * 2 <= WS_END, "h overlay");
constexpr int LDS_BYTES = 147456, LDS_MISC = LDS_BYTES - 1024, LDS_ARGS = LDS_MISC + 256;

constexpr int CW_BAR = 4096;
struct Args {
    const float *x, *mem, *attn_g, *mem_g, *w_mem_kv, *w_out, *ffn_g, *w_gate_up, *w_down, *a_w_in, *a_b_f, *b_w_in, *lq1, *lk1, *lq2, *lk2, *subln_g, *kv_g, *w_kv, *final_g;
    float* out; unsigned char* ws;
};

__device__ __forceinline__ unsigned f2bf(float f) { unsigned u = __builtin_bit_cast(unsigned, f); return (u + 0x7fffu + ((u >> 16) & 1u)) >> 16; }
__device__ __forceinline__ unsigned pk2(float lo, float hi) { return att::cvtpk(lo, hi); }
__device__ __forceinline__ float wave_sum(float v) {
#pragma unroll
    for (int o = 1; o < 64; o <<= 1) v += __shfl_xor(v, o);
    return v;
}
__device__ __forceinline__ void wt_item(const float* W, int ldw, int K, const float* g, bf16* WT, int k0, int c0, int nvalid, int drowA, int drowB, LAS float* scr, int lane) {
    const int kq = lane >> 4, n4 = 4 * (lane & 15);
    f32x4 v[16]; float gk[16];
#pragma unroll
    for (int i = 0; i < 16; ++i) gk[i] = g ? g[k0 + 4 * i + kq] : 1.0f;
#pragma unroll
    for (int i = 0; i < 16; ++i) v[i] = *(const f32x4*)(W + (size_t)(k0 + 4 * i + kq) * ldw + c0 + n4);
    if (g) {
#pragma unroll
        for (int i = 0; i < 16; ++i) v[i] = v[i] * gk[i];
    }
    if (nvalid < 64) {
#pragma unroll
        for (int i = 0; i < 16; ++i)
#pragma unroll
            for (int e = 0; e < 4; ++e) if (n4 + e >= nvalid) v[i][e] = 0.f;
    }
#pragma unroll
    for (int i = 0; i < 16; ++i)
#pragma unroll
        for (int e = 0; e < 4; ++e) scr[(4 * i + kq) * 65 + n4 + e] = v[i][e];
    asm volatile("s_waitcnt lgkmcnt(0)" ::: "memory");
#pragma unroll
    for (int j = 0; j < 8; ++j) { const int q = lane + 64 * j, n = q >> 3, kc = q & 7; const LAS float* s = scr + (8 * kc) * 65 + n;
        v4u o; o.x = pk2(s[0 * 65], s[1 * 65]); o.y = pk2(s[2 * 65], s[3 * 65]); o.z = pk2(s[4 * 65], s[5 * 65]); o.w = pk2(s[6 * 65], s[7 * 65]);
        const int drow = (n < 32) ? drowA + n : drowB + n - 32;
        *(v4u*)(WT + (size_t)drow * K + k0 + 8 * kc) = o; }
    asm volatile("s_waitcnt lgkmcnt(0)" ::: "memory");
}
__device__ __forceinline__ int wt_drow(int l, int drow0, int kind) {
    if (kind == 0) return drow0 + l;
    if (kind == 1) return drow0 + (l / 256) * 256 + ((l >> 5) & 1) * 128 + ((l & 255) >> 6) * 32;
    const int up = l >= DFF ? 1 : 0, j = l - up * DFF; return drow0 + (j / 128) * 256 + up * 128 + (j & 127);
}
__device__ __forceinline__ void wt_job(int it, const float* W, int ldw, int K, int c_src, int ncols, int nvalid, const float* g, bf16* WT, int drow0, int kind, LAS float* scr, int lane) {
    const int nblk = ncols / 64, kb = it / nblk, nb = it % nblk; const int l = nb * 64;
    wt_item(W, ldw, K, g, WT, kb * 64, c_src + l, nvalid, wt_drow(l, drow0, kind), wt_drow(l + 32, drow0, kind), scr, lane);
}
#define XB_TMO      128
#define XB_XCNT(j)  (256  + 64 * (j))
#define XB_XSUB(j)  (1280 + 64 * (j))
#define XB_XGEN(j)  (2304 + 64 * (j))
#define XB_TOP      3328
#define XB_TOPGEN   3392
#define XCD_BAR_WORDS 3456
#define XB_SPIN_CAP (1u << 18)

__device__ __forceinline__ unsigned xb_ld(unsigned* p)              { return __hip_atomic_load(p, __ATOMIC_RELAXED, __HIP_MEMORY_SCOPE_AGENT); }
__device__ __forceinline__ unsigned xb_add(unsigned* p, unsigned v) { return __hip_atomic_fetch_add(p, v, __ATOMIC_RELAXED, __HIP_MEMORY_SCOPE_AGENT); }
__device__ __forceinline__ unsigned xb_xcc_id() { return (unsigned)__builtin_amdgcn_s_getreg((3 << 11) | 20) & 0xFu; }
#define XB_SPIN(cond, bar) do { unsigned _sp = 0; while (cond) { __builtin_amdgcn_s_sleep(1); \
    if ((++_sp & 255u) == 0u) { if (xb_ld(&(bar)[XB_TMO])) break; if (_sp > XB_SPIN_CAP) { atomicAdd(&(bar)[XB_TMO], 1u); break; } } } } while (0)

struct XcdBarrier {
    unsigned* bar; unsigned x; int wv;
    volatile LAS unsigned* st;
};

__device__ __forceinline__ XcdBarrier xcd_barrier_post(unsigned* bar, volatile LAS unsigned* st) {
    XcdBarrier b; b.bar = bar; b.x = xb_xcc_id(); b.st = st; b.wv = 0;
    if (threadIdx.x == 0) (void)xb_add(&bar[XB_XCNT(b.x)], 1u);
    return b;
}
__device__ __forceinline__ void xcd_barrier_complete(unsigned* bar, unsigned x, unsigned& nloc, unsigned& nx) {
    const unsigned G = gridDim.x * gridDim.y * gridDim.z;
    unsigned sum, cnt, mine, sp = 0u;
    for (;;) {
        sum = 0u; cnt = 0u; mine = 0u;
#pragma unroll
        for (unsigned j = 0; j < 16; ++j) { const unsigned c = xb_ld(&bar[XB_XCNT(j)]); sum += c; cnt += (c > 0u) ? 1u : 0u; mine = (j == x) ? c : mine; }
        if (sum == G) break;
        __builtin_amdgcn_s_sleep(1);
        if ((++sp & 255u) == 0u) { if (xb_ld(&bar[XB_TMO])) break; if (sp > XB_SPIN_CAP) { atomicAdd(&bar[XB_TMO], 1u); break; } }
    }
    nloc = mine > 0u ? mine : 1u; nx = cnt > 0u ? cnt : 1u;
}

__device__ __forceinline__ void xcd_barrier(const XcdBarrier& b) {
    asm volatile("s_waitcnt vmcnt(0)" ::: "memory");
    __syncthreads();
    if (b.wv * 64 + hw_lane() == 0) {
        unsigned* bar = b.bar;
        __builtin_amdgcn_s_waitcnt(0);
        unsigned nloc = b.st[0], nx = b.st[1];
        if (nloc == 0u) { xcd_barrier_complete(bar, b.x, nloc, nx); b.st[0] = nloc; b.st[1] = nx; }
        const unsigned old = xb_add(&bar[XB_XSUB(b.x)], 1u);
        const unsigned gen = old / nloc;
        if (old + 1u == (gen + 1u) * nloc) {
            __builtin_amdgcn_fence(__ATOMIC_RELEASE, "agent");
            asm volatile("s_waitcnt vmcnt(0)" ::: "memory");
            const unsigned og = xb_add(&bar[XB_TOP], 1u);
            const unsigned tg = og / nx;
            if (og + 1u == (tg + 1u) * nx) xb_add(&bar[XB_TOPGEN], 1u);
            else XB_SPIN(xb_ld(&bar[XB_TOPGEN]) == tg, bar);
            __builtin_amdgcn_fence(__ATOMIC_ACQUIRE, "agent");
            xb_add(&bar[XB_XGEN(b.x)], 1u);
            asm volatile("s_waitcnt vmcnt(0)" ::: "memory");
        } else {
            XB_SPIN(xb_ld(&bar[XB_XGEN(b.x)]) == gen, bar);
            __builtin_amdgcn_fence(__ATOMIC_ACQUIRE, "agent");
            asm volatile("s_waitcnt vmcnt(0)" ::: "memory");
        }
    }
    __syncthreads();
}
#ifndef NREP_SYNC
#define NREP_SYNC 0
#endif
#ifndef NREP2
#define NREP2 1
#endif
#ifndef NREP7
#define NREP7 1
#endif
#ifndef NREP4
#define NREP4 1
#endif
#ifndef NREP1
#define NREP1 1
#endif
#ifndef NREP0
#define NREP0 1
#endif
#ifndef NREP35
#define NREP35 1
#endif
#ifndef PREREAD
#define PREREAD 0
#endif
#ifndef NREPB
#define NREPB 1
#endif
#ifndef USE_XB
#define USE_XB 1
#endif
#ifndef PVAR
#define PVAR 0
#endif
#ifndef PH_MASK
#define PH_MASK 0xFFFF
#endif
__device__ __forceinline__ void scan_bh(float* lf, LAS float* sm, int tid) {
    const f32x4 a = *(const f32x4*)(lf + 8 * tid), b = *(const f32x4*)(lf + 8 * tid + 4);
    float v[8] = {a[0], a[1], a[2], a[3], b[0], b[1], b[2], b[3]};
#pragma unroll
    for (int i = 1; i < 8; ++i) v[i] += v[i - 1];
    float tot = v[7]; const int lane = tid & 63, w = tid >> 6;
    float inc = tot;
#pragma unroll
    for (int o = 1; o < 64; o <<= 1) { const float n = __shfl_up(inc, o); if (lane >= o) inc += n; }
    if (lane == 63) sm[w] = inc;
    __syncthreads();
    float base = inc - tot;
    for (int i = 0; i < w; ++i) base += sm[i];
    const float k = -1.4426950408889634f;
    f32x4 oa, ob;
#pragma unroll
    for (int i = 0; i < 4; ++i) { oa[i] = (v[i] + base) * k; ob[i] = (v[4 + i] + base) * k; }
    *(f32x4*)(lf + 8 * tid) = oa; *(f32x4*)(lf + 8 * tid + 4) = ob;
    __syncthreads();
}

enum { AX = 0, AMEM, AATTN_G, AMEM_G, AW_MEM_KV, AW_OUT, AFFN_G, AW_GATE_UP, AW_DOWN, AA_W_IN, AA_B_F, AB_W_IN, ALQ1, ALK1, ALQ2, ALK2, ASUBLN_G, AKV_G, AW_KV, AFINAL_G, AOUT, AWS };
__device__ __forceinline__ const float* argp(LAS unsigned char* lds, int i) {
    volatile LAS unsigned* p = (volatile LAS unsigned*)(lds + LDS_ARGS + 8 * i);
    const unsigned lo = __builtin_amdgcn_readfirstlane(p[0]), hi = __builtin_amdgcn_readfirstlane(p[1]);
    return (const float*)(__attribute__((address_space(1))) const float*)(((unsigned long long)hi << 32) | (unsigned long long)lo);
}
#define WSPTRS() \
    unsigned char* ws = (unsigned char*)argp(lds, AWS); \
    unsigned* ctl = (unsigned*)(ws + WS_CTL); float* ssq = (float*)(ws + WS_SSQ); float* ssqm = (float*)(ws + WS_SSQM); \
    float* LF = (float*)(ws + WS_LF); float* COS = (float*)(ws + WS_COS); float* SIN = (float*)(ws + WS_SIN); \
    bf16 *WA = (bf16*)(ws + WS_WA), *WB = (bf16*)(ws + WS_WB), *WO = (bf16*)(ws + WS_WO), *WM = (bf16*)(ws + WS_WM), *WGU = (bf16*)(ws + WS_WGU), *WD = (bf16*)(ws + WS_WD); \
    bf16 *MEMB = (bf16*)(ws + WS_MEMB), *MK = (bf16*)(ws + WS_MK), *MVT = (bf16*)(ws + WS_MVT), *XB = (bf16*)(ws + WS_XB); \
    bf16 *Qb = (bf16*)(ws + WS_Q), *Kb = (bf16*)(ws + WS_K), *VT = (bf16*)(ws + WS_VT), *MQ = (bf16*)(ws + WS_MQ), *MIX = (bf16*)(ws + WS_MIX), *H = (bf16*)(ws + WS_H); \
    (void)ctl; (void)ssq; (void)ssqm; (void)LF; (void)COS; (void)SIN; (void)WA; (void)WB; (void)WO; (void)WM; (void)WGU; (void)WD; (void)MEMB; (void)MK; (void)MVT; (void)XB; (void)Qb; (void)Kb; (void)VT; (void)MQ; (void)MIX; (void)H;

constexpr int I1 = 16 * 36, I2 = 16 * 4, IF_ = 16, I3 = 16 * 12, I4 = 16 * 12, I5 = 16 * 12, I6 = 16 * 4, I7 = 16 * 16, I9 = 16 * 8, I11 = 16 * 88, I13 = 44 * 16;
constexpr int WT_A = I11 + I13 + I1 + I2 + IF_ + I7 + 2 * I9, WT_B1 = I3 + I4 + I5 + I6, WT_B2 = I11, WT_B3 = I7 + I13;
#define WT_SRCS() const float *a_w_in = argp(lds, AA_W_IN), *attn_g = argp(lds, AATTN_G), *w_kv = argp(lds, AW_KV), *kv_g = argp(lds, AKV_G), *b_w_in = argp(lds, AB_W_IN), *w_out = argp(lds, AW_OUT); \
    const float *w_mem_kv = argp(lds, AW_MEM_KV), *mem_g = argp(lds, AMEM_G), *w_gate_up = argp(lds, AW_GATE_UP), *ffn_g = argp(lds, AFFN_G), *w_down = argp(lds, AW_DOWN);
#define WT_DISPATCH(it_) do { int r = (it_); \
    if (r < I11) { wt_job(r, w_gate_up, 5632, 1024, 0, 5632, 64, ffn_g, WGU, 0, 2, scr, lane); break; } r -= I11; \
    if (r < I13) { wt_job(r, w_down, 1024, 2816, 0, 1024, 64, nullptr, WD, 0, 0, scr, lane); break; } r -= I13; \
    if (r < I1) { wt_job(r, a_w_in, 2572, 1024, 0, 2304, 64, attn_g, WA, 0, 0, scr, lane); break; } r -= I1; \
    if (r < I2) { wt_job(r, a_w_in, 2572, 1024, 2316, 256, 64, attn_g, WA, 2304, 0, scr, lane); break; } r -= I2; \
    if (r < IF_) { wt_job(r, a_w_in, 2572, 1024, 2304, 64, 12, attn_g, WA, 2560, 0, scr, lane); break; } r -= IF_; \
    if (r < I7) { wt_job(r, w_out, 1024, 1024, 0, 1024, 64, nullptr, WO, 0, 0, scr, lane); break; } r -= I7; \
    if (r < 2 * I9) { const int l = r / I9; wt_job(r % I9, w_mem_kv + (size_t)l * 1024 * 512, 512, 1024, 0, 512, 64, mem_g + 1024 * l, WM, 512 * l, 0, scr, lane); break; } r -= 2 * I9; \
    if (r < I3) { wt_job(r, w_kv, 1536, 1024, 0, 768, 64, kv_g, WB, 0, 1, scr, lane); break; } r -= I3; \
    if (r < I4) { wt_job(r, w_kv, 1536, 1024, 768, 768, 64, kv_g, WB, 768, 0, scr, lane); break; } r -= I4; \
    if (r < I5) { wt_job(r, b_w_in, 1024, 1024, 0, 768, 64, attn_g + 1024, WB, 1536, 1, scr, lane); break; } r -= I5; \
    if (r < I6) { wt_job(r, b_w_in, 1024, 1024, 768, 256, 64, attn_g + 1024, WB, 2304, 0, scr, lane); break; } r -= I6; \
    if (r < I11) { wt_job(r, w_gate_up + (size_t)1024 * 5632, 5632, 1024, 0, 5632, 64, ffn_g + 1024, WGU + (size_t)5632 * 1024, 0, 2, scr, lane); break; } r -= I11; \
    if (r < I7) { wt_job(r, w_out + (size_t)1024 * 1024, 1024, 1024, 0, 1024, 64, nullptr, WO + (size_t)1024 * 1024, 0, 0, scr, lane); break; } r -= I7; \
    wt_job(r, w_down + (size_t)2816 * 1024, 1024, 2816, 0, 1024, 64, nullptr, WD + (size_t)1024 * 2816, 0, 0, scr, lane); } while (0)
#define WT_IDLE(first, lo, hi) do { const int f_ = (first) < G ? (first) : 0;        \
    if (bx >= f_) { WSPTRS(); PHASE_IDS(); WT_SRCS(); LAS float* scr = (LAS float*)(lds + wave * 16640); \
        for (int it = (lo) + (bx - f_) * 8 + wave; it < (hi); it += (G - f_) * 8) WT_DISPATCH(it); __syncthreads(); } } while (0)

__global__ void __launch_bounds__(512, 2) yoco_fwd(Args A) {
    extern __shared__ __attribute__((aligned(16))) unsigned char lds_raw[];
    LAS unsigned char* lds = (LAS unsigned char*)lds_raw;
#if USE_XB
    if (threadIdx.x < 2) ((volatile LAS unsigned*)(lds + LDS_MISC + 128))[threadIdx.x] = 0u;
    __syncthreads();
    XcdBarrier xbar = xcd_barrier_post((unsigned*)(A.ws + WS_CTL) + CW_BAR, (volatile LAS unsigned*)(lds + LDS_MISC + 128));
#define GRID_SYNC() xcd_barrier(xbar)
#else
    cg::grid_group grid = cg::this_grid();
#define GRID_SYNC() grid.sync()
#endif
    const int G = gridDim.x, bx = blockIdx.x;
    const int wave0 = __builtin_amdgcn_readfirstlane((int)threadIdx.x >> 6);
#define HW_TID() (wave0 * 64 + hw_lane())
#if USE_XB
    xbar.wv = wave0;
#endif
    if (threadIdx.x == 0) {
        LAS unsigned long long* P = (LAS unsigned long long*)(lds + LDS_ARGS);
        P[AX] = (unsigned long long)A.x; P[AMEM] = (unsigned long long)A.mem; P[AATTN_G] = (unsigned long long)A.attn_g; P[AMEM_G] = (unsigned long long)A.mem_g;
        P[AW_MEM_KV] = (unsigned long long)A.w_mem_kv; P[AW_OUT] = (unsigned long long)A.w_out; P[AFFN_G] = (unsigned long long)A.ffn_g; P[AW_GATE_UP] = (unsigned long long)A.w_gate_up;
        P[AW_DOWN] = (unsigned long long)A.w_down; P[AA_W_IN] = (unsigned long long)A.a_w_in; P[AA_B_F] = (unsigned long long)A.a_b_f; P[AB_W_IN] = (unsigned long long)A.b_w_in;
        P[ALQ1] = (unsigned long long)A.lq1; P[ALK1] = (unsigned long long)A.lk1; P[ALQ2] = (unsigned long long)A.lq2; P[ALK2] = (unsigned long long)A.lk2;
        P[ASUBLN_G] = (unsigned long long)A.subln_g; P[AKV_G] = (unsigned long long)A.kv_g; P[AW_KV] = (unsigned long long)A.w_kv; P[AFINAL_G] = (unsigned long long)A.final_g;
        P[AOUT] = (unsigned long long)A.out; P[AWS] = (unsigned long long)A.ws;
    }
    __syncthreads();
#define PHASE_IDS() int tid_ = HW_TID(); asm volatile("" : "+v"(tid_)); const int tid = tid_, lane = tid & 63, wave = __builtin_amdgcn_readfirstlane(tid >> 6); \
    const int gw = bx * 8 + wave, NGW = G * 8, gt = bx * 512 + tid, NGT = G * 512; (void)lane; (void)gw; (void)NGW; (void)gt; (void)NGT;

    for (int rep0_ = 0; rep0_ < NREP0; ++rep0_) {
        WSPTRS(); PHASE_IDS();
        const float *a_w_in = argp(lds, AA_W_IN), *attn_g = argp(lds, AATTN_G), *w_kv = argp(lds, AW_KV), *kv_g = argp(lds, AKV_G), *b_w_in = argp(lds, AB_W_IN), *w_out = argp(lds, AW_OUT);
        const float *w_mem_kv = argp(lds, AW_MEM_KV), *mem_g = argp(lds, AMEM_G), *w_gate_up = argp(lds, AW_GATE_UP), *ffn_g = argp(lds, AFFN_G), *w_down = argp(lds, AW_DOWN);
        const float *xin = argp(lds, AX), *memin = argp(lds, AMEM), *a_b_f = argp(lds, AA_B_F);
#if PREREAD
        {
            float acc_ = 0.f;
#define PRE_(ptr, n) for (int i = gt; i < (n) / 4; i += NGT) { const f32x4 v = ((const f32x4*)(ptr))[i]; acc_ += (v[0] + v[1]) + (v[2] + v[3]); }
            PRE_(w_gate_up, 2 * 1024 * 5632) PRE_(w_down, 2 * 2816 * 1024) PRE_(a_w_in, 1024 * 2572) PRE_(w_kv, 1024 * 1536) PRE_(b_w_in, 1024 * 1024) PRE_(w_out, 2 * 1024 * 1024) PRE_(w_mem_kv, 2 * 1024 * 512)
#undef PRE_
            if (acc_ == 1.2345e38f) ctl[63] = 1u;
        }
#endif
        LAS float* scr = (LAS float*)(lds + wave * 16640);
        {
            constexpr int o_WA = I11 + I13, o_WO0 = o_WA + I1 + I2 + IF_, o_WM = o_WO0 + I7, n0 = I11, n1 = o_WO0 - o_WA, n2 = 2 * I9;
            for (int j = gw; j < n0 + n1 + n2; j += NGW) { const int it = j < n0 ? j : (j < n0 + n1 ? o_WA + (j - n0) : o_WM + (j - n0 - n1)); WT_DISPATCH(it); }
        }
        for (int i = gt; i < 192 * 1024 / 8; i += NGT) ((v4u*)(WA + (size_t)2624 * 1024))[i] = (v4u){0u, 0u, 0u, 0u};
        for (int m = 2 * gw; m < M + MM; m += 2 * NGW) {
            const bool ism = m >= M; const float* src = ism ? memin + (size_t)(m - M) * DM : xin + (size_t)m * DM; bf16* dst = ism ? MEMB + (size_t)(m - M) * DM : XB + (size_t)m * DM; float* sdst = ism ? ssqm + (m - M) : ssq + m;
            const f32x4* xr = (const f32x4*)src + lane; f32x4 v[8]; float s0 = 0.f, s1 = 0.f;
#pragma unroll
            for (int j = 0; j < 8; ++j) v[j] = xr[64 * j];
#pragma unroll
            for (int j = 0; j < 4; ++j) { s0 += (v[j][0] * v[j][0] + v[j][1] * v[j][1]) + (v[j][2] * v[j][2] + v[j][3] * v[j][3]); s1 += (v[4 + j][0] * v[4 + j][0] + v[4 + j][1] * v[4 + j][1]) + (v[4 + j][2] * v[4 + j][2] + v[4 + j][3] * v[4 + j][3]); }
            s0 = wave_sum(s0); s1 = wave_sum(s1);
            if (lane == 0) { sdst[0] = s0; sdst[1] = s1; }
            unsigned long long* o8 = (unsigned long long*)dst + lane;
#pragma unroll
            for (int j = 0; j < 8; ++j) o8[64 * j] = (unsigned long long)pk2(v[j][0], v[j][1]) | ((unsigned long long)pk2(v[j][2], v[j][3]) << 32);
        }
        if (gt < 32) ((float*)(ws + WS_INVREV))[gt] = INV_FREQ[gt] * 0.15915494309189535f;
        for (int i = gt; i < 4 * M; i += NGT) ssq[M + i] = 0.f;
        if (gt < 64) ctl[gt] = 0u;
    }
    GRID_SYNC();

#if PH_MASK & (1 << 1)
    {
        WSPTRS(); PHASE_IDS();
        for (int rep_ = 0; rep_ < NREP1; ++rep_) {
        pg8::Gemm g{XB, WA, M, NPROJA, DM}; pg8::StaticOrder S; S.init(M, NPROJA, G, bx);
        pg8::EpiProj E{ssq, COS, SIN, argp(lds, AA_B_F), LF, SEQ, {Qb, 3, 0, 768, C2}, {Kb, 6, 0, 768, 1.f}, {VT, 9, 1, 768, 1.f}, {MQ, 10, 0, 256, C2}, {nullptr, 11, 3, 0, 1.f}};
        pg8::gemm_phase<pg8::EpiProj, pg8::StaticOrder, true, true>(lds, g, S, E, wave0);
        }
    }
    {
        WSPTRS();
        pg8::Gemm g{MEMB, WM, MM, 1024, DM}; pg8::StaticOrder S; S.init(MM, 1024, G, (bx + 64) & 255);
        pg8::EpiProj E{ssqm, COS, SIN, nullptr, nullptr, NMEM, {MK, 1, 0, 256, 1.f}, {MVT, 2, 1, 256, 1.f}, {MK + (size_t)MM * 256, 3, 0, 256, 1.f}, {MVT + (size_t)MM * 256, 4, 1, 256, 1.f}, {nullptr, 5, 0, 0, 1.f}};
        pg8::gemm_phase<pg8::EpiProj, pg8::StaticOrder, true, true>(lds, g, S, E, wave0);
    }
#endif
    WT_IDLE(208, WT_A, WT_A + WT_B1);
    WT_IDLE(208, I11 + I13 + I1 + I2 + IF_, I11 + I13 + I1 + I2 + IF_ + I7);
    GRID_SYNC();

    if (bx < 48) { WSPTRS(); PHASE_IDS(); scan_bh(LF + (size_t)bx * SEQ, (LAS float*)(lds + LDS_MISC + 64), tid); }
    GRID_SYNC();
#if PH_MASK & (1 << 2)
    for (int rep_ = 0; rep_ < NREP2; ++rep_) { WSPTRS(); PHASE_IDS();
    volatile LAS unsigned* qword = (volatile LAS unsigned*)(lds + LDS_MISC);
    bool first_ = true;
    for (;;) {
        if (HW_TID() == 0) qword[0] = first_ ? (unsigned)bx : (unsigned)G + atomicAdd(ctl + 0 + 2 * rep_, 1u);
        first_ = false;
        __syncthreads();
        const int u = (int)qword[0];
        __syncthreads();
        if (u >= 1024) break;
        att::f32x16 o[2];
        if (u < 768) {
            const int qb = 15 - u / 48, bh = u % 48, b = bh / 12, h = bh % 12;
            if (rep_ + 1 < NREP2) att::attn_stream<64, true, true, PVAR>(lds, Qb + (size_t)b * SEQ * 768 + 64 * h, 768, Kb + (size_t)b * SEQ * 768 + 64 * h, 768, VT + (size_t)(b * 768 + 64 * h) * SEQ, SEQ,
                                             LF + (size_t)bh * SEQ, 256 * qb, 2 * (qb + 1), o, wave0);
            else att::attn_stream<64, true, true>(lds, Qb + (size_t)b * SEQ * 768 + 64 * h, 768, Kb + (size_t)b * SEQ * 768 + 64 * h, 768, VT + (size_t)(b * 768 + 64 * h) * SEQ, SEQ,
                                             LF + (size_t)bh * SEQ, 256 * qb, 2 * (qb + 1), o, wave0);
            { const int l2_ = hw_lane(); att::store_o<64>(MIX + (size_t)(b * SEQ + 256 * qb + 32 * wave + (l2_ & 31)) * DM + 64 * h, o, l2_ >> 5); }
        } else {
            const int j = u - 768, b = j >> 6, hm = (j >> 4) & 3, qb = j & 15;
            att::attn_stream<64, false, false>(lds, MQ + (size_t)b * SEQ * 256 + 64 * hm, 256, MK + (size_t)b * NMEM * 256 + 64 * hm, 256, MVT + (size_t)(b * 256 + 64 * hm) * NMEM, NMEM,
                                               nullptr, 256 * qb, 2, o, wave0);
            { const int l2_ = hw_lane(); att::store_o<64>(MIX + (size_t)(b * SEQ + 256 * qb + 32 * wave + (l2_ & 31)) * DM + 768 + 64 * hm, o, l2_ >> 5); }
        }
    } }
#endif
    GRID_SYNC();

#if PH_MASK & (1 << 3)
    for (int rep_ = 0; rep_ < NREP35; ++rep_) {
        WSPTRS(); const float* xin = argp(lds, AX); float* outp = (float*)argp(lds, AOUT);
        pg8::Gemm g{MIX, WO, M, DM, DM}; pg8::StaticOrder S; S.init(M, DM, G, bx);
        pg8::EpiRes E{XB, ssq + M};
        pg8::gemm_phase<pg8::EpiRes, pg8::StaticOrder, true, true>(lds, g, S, E, wave0);
    }
#endif
    GRID_SYNC();
#if PH_MASK & (1 << 4)
    for (int rep_ = 0; rep_ < NREP4; ++rep_) {
        WSPTRS();
        pg8::Gemm g{XB, WGU, M, 2 * DFF, DM}; pg8::StaticOrder S; S.init(M, 2 * DFF, G, bx);
        pg8::EpiGU E{ssq + M, H};
        pg8::gemm_phase<pg8::EpiGU, pg8::StaticOrder, true, true>(lds, g, S, E, wave0);
    }
#endif
    WT_IDLE(128, WT_A + WT_B1, WT_A + WT_B1 + WT_B2);
    WT_IDLE(128, I11, I11 + I13);
    GRID_SYNC();
#if PH_MASK & (1 << 5)
    for (int rep_ = 0; rep_ < NREP35; ++rep_) {
        WSPTRS(); float* outp = (float*)argp(lds, AOUT);
        pg8::Gemm g{H, WD, M, DM, DFF}; pg8::StaticOrder S; S.init(M, DM, G, bx);
        pg8::EpiRes E{XB, ssq + 2 * M};
        pg8::gemm_phase<pg8::EpiRes, pg8::StaticOrder, true, true>(lds, g, S, E, wave0);
    }
#endif
    GRID_SYNC();
#if PH_MASK & (1 << 6)
    for (int rep_ = 0; rep_ < NREPB; ++rep_) {
        WSPTRS();
        pg8::Gemm g{XB, WB, M, NPROJ, DM}; pg8::StaticOrder S; S.init(M, NPROJ, G, bx);
        pg8::EpiProj E{ssq + 2 * M, (const float*)(ws + WS_INVREV), SIN, nullptr, nullptr, SEQ, {Kb, 3, 2, 768, 1.f}, {VT, 6, 1, 768, 1.f}, {Qb, 9, 2, 768, C2}, {MQ, 10, 0, 256, C2}, {nullptr, 11, 0, 0, 1.f}};
        pg8::gemm_phase<pg8::EpiProj, pg8::StaticOrder, true, true>(lds, g, S, E, wave0);
    }
#endif
    WT_IDLE(128, WT_A + WT_B1 + WT_B2, WT_A + WT_B1 + WT_B2 + WT_B3);
    GRID_SYNC();
#if PH_MASK & (1 << 7)
    {
        WSPTRS(); PHASE_IDS(); const float* subln_g = argp(lds, ASUBLN_G);
        volatile LAS unsigned* qword = (volatile LAS unsigned*)(lds + LDS_MISC);
        float d1 = argp(lds, ALQ1)[lane] * argp(lds, ALK1)[lane], d2 = argp(lds, ALQ2)[lane] * argp(lds, ALK2)[lane];
        d1 = wave_sum(d1); d2 = wave_sum(d2);
        const float lam = __builtin_bit_cast(float, __builtin_amdgcn_readfirstlane(__builtin_bit_cast(int, expf(d1) - expf(d2) + LAMBDA_INIT)));
        bool first_ = true;
        for (int rep_ = 0; rep_ < NREP7; ++rep_)
        for (;;) {
            if (HW_TID() == 0) qword[0] = first_ ? (unsigned)bx : (unsigned)G + atomicAdd(ctl + 1 + 2 * rep_, 1u);
            first_ = false;
            __syncthreads();
            const int u = (int)qword[0];
            __syncthreads();
            if (u >= 1024) break;
            if (u < 768) {
                const int qb = 31 - u / 24, bh = u % 24, b = bh / 6, hd = bh % 6;
                att::attn_diff_unit<SEQ>(lds, Qb + (size_t)b * SEQ * 768 + 128 * hd, Kb + (size_t)b * SEQ * 768 + 128 * hd, VT + (size_t)(b * 768 + 128 * hd) * SEQ, 128 * qb, qb + 1, lam, 1.0f - LAMBDA_INIT,
                                         subln_g, MIX + (size_t)b * SEQ * DM + 128 * hd, wave0);
            } else {
                att::f32x16 o[2];
                const int j = u - 768, b = j >> 6, hm = (j >> 4) & 3, qb = j & 15;
                att::attn_stream<64, false, false>(lds, MQ + (size_t)b * SEQ * 256 + 64 * hm, 256, MK + (size_t)(MM + b * NMEM) * 256 + 64 * hm, 256, MVT + (size_t)(MM + b * 256 + 64 * hm) * NMEM, NMEM,
                                                   nullptr, 256 * qb, 2, o, wave0);
                { const int l2_ = hw_lane(); att::store_o<64>(MIX + (size_t)(b * SEQ + 256 * qb + 32 * wave + (l2_ & 31)) * DM + 768 + 64 * hm, o, l2_ >> 5); }
            }
        }
    }
#endif
    GRID_SYNC();
#if PH_MASK & (1 << 8)
    for (int rep_ = 0; rep_ < NREPB; ++rep_) {
        WSPTRS(); float* outp = (float*)argp(lds, AOUT);
        pg8::Gemm g{MIX, WO + (size_t)1024 * 1024, M, DM, DM}; pg8::StaticOrder S; S.init(M, DM, G, bx);
        pg8::EpiRes E{XB, ssq + 3 * M};
        pg8::gemm_phase<pg8::EpiRes, pg8::StaticOrder, true, true>(lds, g, S, E, wave0);
    }
#endif
    GRID_SYNC();
#if PH_MASK & (1 << 9)
    for (int rep_ = 0; rep_ < NREPB; ++rep_) {
        WSPTRS();
        pg8::Gemm g{XB, WGU + (size_t)5632 * 1024, M, 2 * DFF, DM}; pg8::StaticOrder S; S.init(M, 2 * DFF, G, bx);
        pg8::EpiGU E{ssq + 3 * M, H};
        pg8::gemm_phase<pg8::EpiGU, pg8::StaticOrder, true, true>(lds, g, S, E, wave0);
    }
#endif
    GRID_SYNC();
#if PH_MASK & (1 << 10)
    {
        WSPTRS(); float* outp = (float*)argp(lds, AOUT);
        pg8::Gemm g{H, WD + (size_t)1024 * 2816, M, DM, DFF}; pg8::StaticOrder S; S.init(M, DM, G, bx);
        pg8::EpiResFinal E{XB, outp, ssq + 4 * M, ctl + 8192, argp(lds, AFINAL_G)};
        pg8::gemm_phase<pg8::EpiResFinal, pg8::StaticOrder, true, true>(lds, g, S, E, wave0);
    }
#endif
}

extern "C" void kernel_launch(void* const* d_in, const int* in_sizes, int n_in, void* d_out, int out_size, void* d_ws, size_t ws_size, hipStream_t stream) {
    static int grid = 0;
    if (grid == 0) {
        if (n_in != 20 || out_size != M * DM || ws_size < WS_END) { fprintf(stderr, "kernel_launch: unexpected sizes n_in %d out %d ws %zu\n", n_in, out_size, ws_size); grid = -1; return; }
        int dev = 0, cus = 0, per_cu = 0;
        (void)hipGetDevice(&dev); (void)hipDeviceGetAttribute(&cus, hipDeviceAttributeMultiprocessorCount, dev);
        (void)hipFuncSetAttribute((const void*)yoco_fwd, hipFuncAttributeMaxDynamicSharedMemorySize, LDS_BYTES);
        (void)hipOccupancyMaxActiveBlocksPerMultiprocessor(&per_cu, (const void*)yoco_fwd, 512, LDS_BYTES);
        if (per_cu < 1) { fprintf(stderr, "kernel_launch: occupancy query says %d blocks per CU; the grid barrier needs every workgroup resident: nothing launched\n", per_cu); grid = -1; return; }
        grid = cus;
        if (grid != 256) fprintf(stderr, "kernel_launch: %d CUs (expected 256)\n", grid);
    }
    if (grid < 0) return;
    Args a{};
    const float** p = (const float**)&a;
    for (int i = 0; i < 20; ++i) p[i] = (const float*)d_in[i];
    a.out = (float*)d_out; a.ws = (unsigned char*)d_ws;
    void* args[] = {&a};
#if USE_XB
    (void)hipMemsetAsync((char*)d_ws + WS_CTL, 0, 65536, stream);
    hipLaunchKernelGGL(yoco_fwd, dim3(grid), dim3(512), LDS_BYTES, stream, a);
    (void)args;
#else
    hipError_t e = hipLaunchCooperativeKernel((const void*)yoco_fwd, dim3(grid), dim3(512), args, LDS_BYTES, stream);
    if (e != hipSuccess) fprintf(stderr, "cooperative launch failed: %s (grid %d)\n", hipGetErrorString(e), grid);
#endif
}
```

```cpp
#include <hip/hip_runtime.h>
#include <hip/hip_cooperative_groups.h>
#include <cstdio>
#include <cstdint>
__device__ __forceinline__ int hw_lane() { unsigned z = 0u; asm volatile("" : "+v"(z)); return (int)__builtin_amdgcn_mbcnt_hi(~0u, __builtin_amdgcn_mbcnt_lo(~0u, z)); }
namespace pg8 {
#define PG8_LAS __attribute__((address_space(3)))
typedef unsigned short bf16_t;
typedef short bf16x8 __attribute__((ext_vector_type(8)));
typedef float f32x4 __attribute__((ext_vector_type(4)));
typedef unsigned u32x4 __attribute__((ext_vector_type(4)));
constexpr int BM = 256, BK = 64, HALF = 128, HTB = HALF * BK * 2  , STAGE_BYTES = 8 * HTB, NXCD = 8, WGM = 8;

__host__ __device__ __forceinline__ int lds_byte(int r, int c) { const int st = (r >> 4) * 2 + (c >> 5), rr = r & 15, cc = c & 31, ob = rr * 64 + cc * 2; return st * 1024 + (ob ^ (((ob >> 9) & 1) << 5)); }
__host__ __device__ __forceinline__ void stage_rc(int b, int& R, int& C) { const int st = b / 1024, sb = b % 1024, swz = sb ^ (((sb >> 9) & 1) << 5); R = (st >> 1) * 16 + swz / 64; C = (st & 1) * 32 + (swz % 64) / 2; }
__host__ __device__ __forceinline__ int perm32(int rho) { const int n = rho >> 4, i = rho & 15; return 8 * (i >> 2) + 4 * n + (i & 3); }

struct Unit { int pm, pn; };
struct Gemm { const bf16_t* A; const bf16_t* Bt; int M, N, K; };

struct StaticOrder {
    int nM, nN, nwg, G, c;
    __host__ __device__ void init(int M, int N, int G_, int c_) { nM = M / BM; nN = N / BM; nwg = nM * nN; G = G_; c = c_; }
    __host__ __device__ bool next(int i, Unit& u) const {
        const long L = (long)i * G + c; if (L >= nwg) return false;
        int wgid = (int)L; { const int q = nwg / NXCD, r = nwg % NXCD, xcd = wgid % NXCD, off = wgid / NXCD; wgid = (xcd < r ? xcd * (q + 1) : r * (q + 1) + (xcd - r) * q) + off; }
        const int nig = WGM * nN, gid = wgid / nig, fm = gid * WGM, gsz = (nM - fm) < WGM ? (nM - fm) : WGM;
        u.pm = fm + ((wgid % nig) % gsz); u.pn = (wgid % nig) / gsz; return true;
    }
    __device__ __forceinline__ void a_ready(const Unit&) const {}
    __device__ __forceinline__ void done(const Unit&) const {}
};

__device__ __forceinline__ unsigned cvt_pk_bf16(float lo, float hi) { typedef float f2_ __attribute__((ext_vector_type(2))); typedef __bf16 b2_ __attribute__((ext_vector_type(2))); const f2_ v = {lo, hi}; const b2_ b = __builtin_convertvector(v, b2_); return __builtin_bit_cast(unsigned, b); }
typedef float f32x2 __attribute__((ext_vector_type(2)));
typedef unsigned u32x2 __attribute__((ext_vector_type(2)));
struct Seg { bf16_t* dst; int pn_end; int kind; int pitch; float scale; };
struct EpiProj {
    static constexpr bool PERM = true, AFTER_DRAIN = false;
    const float* ssq; const float* cs; const float* sn; const float* bf; float* lf; int S; Seg s0, s1, s2, s3, s4;
    __device__ __forceinline__ void operator()(const f32x4 (&acc)[2][2][4][2], const Unit& u, int wr, int wc, int fr, int fq) const {
        Seg g = s4; int pn0 = s3.pn_end;
        if (u.pn < s0.pn_end) { g = s0; pn0 = 0; } else if (u.pn < s1.pn_end) { g = s1; pn0 = s0.pn_end; } else if (u.pn < s2.pn_end) { g = s2; pn0 = s1.pn_end; } else if (u.pn < s3.pn_end) { g = s3; pn0 = s2.pn_end; }
        const int ct = (u.pn - pn0) * BM;
        const int lane = fq * 16 + fr; const int ssh = 31 - __builtin_clz(S);
        float sq8[8];
#pragma unroll
        for (int i = 0; i < 8; ++i) sq8[i] = ssq[u.pm * BM + (i >> 2) * HALF + wr * 64 + (i & 3) * 16 + fr];
        f32x4 w0 = {0.f, 0.f, 0.f, 0.f}, w1 = {0.f, 0.f, 0.f, 0.f};
        if (g.kind == 2) { w0 = *(const f32x4*)(cs + 8 * fq); w1 = *(const f32x4*)(cs + 8 * fq + 4); }
#pragma unroll
        for (int am = 0; am < 4; ++am) {
            const int ai = am >> 1;
#pragma unroll
            for (int mm = 0; mm < 2; ++mm) {
                const int m = (am & 1) * 2 + mm;
                const int row = u.pm * BM + ai * HALF + wr * 64 + m * 16 + fr;
                const float rs = __builtin_amdgcn_rsqf(sq8[ai * 4 + m] * (1.0f / 1024.0f) + 1e-6f) * g.scale;
                if (g.kind == 0) {
#pragma unroll
                    for (int bj = 0; bj < 2; ++bj) { const f32x4 v0 = acc[ai][bj][m][0] * rs, v1 = acc[ai][bj][m][1] * rs;
                        u32x4 w; w.x = cvt_pk_bf16(v0[0], v0[1]); w.y = cvt_pk_bf16(v0[2], v0[3]); w.z = cvt_pk_bf16(v1[0], v1[1]); w.w = cvt_pk_bf16(v1[2], v1[3]);
                        *(u32x4*)(g.dst + (size_t)row * g.pitch + ct + bj * HALF + wc * 32 + 8 * fq) = w; }
                } else if (g.kind == 1) {
                    const int b = row >> ssh, s = row & (S - 1); const bool odd = (fr & 1) != 0;
#pragma unroll
                    for (int bj = 0; bj < 2; ++bj) { const f32x4 v0 = acc[ai][bj][m][0] * rs, v1 = acc[ai][bj][m][1] * rs;
                        const int cb = ct + bj * HALF + wc * 32 + 8 * fq + (odd ? 4 : 0);
#pragma unroll
                        for (int j = 0; j < 4; ++j) { const float snd = odd ? v0[j] : v1[j]; const float rcv = __builtin_bit_cast(float, __builtin_amdgcn_update_dpp(0, __builtin_bit_cast(int, snd), 0xB1  , 0xF, 0xF, true));
                            const float lo = odd ? rcv : v0[j], hi = odd ? v1[j] : rcv;
                            *(unsigned*)(g.dst + ((size_t)b * g.pitch + cb + j) * S + (s & ~1)) = cvt_pk_bf16(lo, hi); } }
                } else if (g.kind == 3) {
                    if (wc == 0 && fq < 2) { const int b = row >> ssh, s = row & (S - 1);
#pragma unroll
                        for (int n = 0; n < 2; ++n)
#pragma unroll
                            for (int e2 = 0; e2 < 4; ++e2) { const int c = 8 * fq + 4 * n + e2;
                                if (c < 12) { const float z = acc[ai][0][m][n][e2] * rs + bf[c]; lf[((size_t)b * 12 + c) * S + s] = fminf(z, 0.f) - 0.6931471805599453f * __builtin_amdgcn_logf(1.0f + __builtin_amdgcn_exp2f(-1.4426950408889634f * fabsf(z))); } } }
                } else {
                    const float pf = (float)(row & (S - 1)); f32x4 c0, c1, n0, n1;
#pragma unroll
                    for (int e = 0; e < 4; ++e) { const float r0 = __builtin_amdgcn_fractf(pf * w0[e]), r1 = __builtin_amdgcn_fractf(pf * w1[e]);
                        c0[e] = __builtin_amdgcn_cosf(r0); n0[e] = __builtin_amdgcn_sinf(r0); c1[e] = __builtin_amdgcn_cosf(r1); n1[e] = __builtin_amdgcn_sinf(r1); }
                    const f32x4 a0 = acc[ai][0][m][0] * rs, a1 = acc[ai][0][m][1] * rs, b0 = acc[ai][1][m][0] * rs, b1 = acc[ai][1][m][1] * rs;
                    const f32x4 x0 = a0 * c0 - b0 * n0, x1 = a1 * c1 - b1 * n1, y0 = a0 * n0 + b0 * c0, y1 = a1 * n1 + b1 * c1;
                    bf16_t* p = g.dst + (size_t)row * g.pitch + ct + wc * 64 + 8 * fq;
                    u32x4 w; w.x = cvt_pk_bf16(x0[0], x0[1]); w.y = cvt_pk_bf16(x0[2], x0[3]); w.z = cvt_pk_bf16(x1[0], x1[1]); w.w = cvt_pk_bf16(x1[2], x1[3]);
                    *(u32x4*)p = w;
                    w.x = cvt_pk_bf16(y0[0], y0[1]); w.y = cvt_pk_bf16(y0[2], y0[3]); w.z = cvt_pk_bf16(y1[0], y1[1]); w.w = cvt_pk_bf16(y1[2], y1[3]);
                    *(u32x4*)(p + 32) = w;
                }
            }
        }
        (void)lane;
    }
};
struct EpiRes {
    static constexpr bool PERM = true, AFTER_DRAIN = false;
    bf16_t* xb; float* ssq_out;
    __device__ __forceinline__ void operator()(const f32x4 (&acc)[2][2][4][2], const Unit& u, int wr, int wc, int fr, int fq) const {
#pragma unroll
        for (int ai = 0; ai < 2; ++ai) {
            u32x4 xr[4][2];
#pragma unroll
            for (int m = 0; m < 4; ++m)
#pragma unroll
                for (int bj = 0; bj < 2; ++bj) xr[m][bj] = *(const u32x4*)(xb + (size_t)(u.pm * BM + ai * HALF + wr * 64 + m * 16 + fr) * 1024 + u.pn * BM + bj * HALF + wc * 32 + 8 * fq);
            asm volatile("" ::: "memory");
#pragma unroll
            for (int m = 0; m < 4; ++m) {
                const int row = u.pm * BM + ai * HALF + wr * 64 + m * 16 + fr; float sq = 0.f;
#pragma unroll
                for (int bj = 0; bj < 2; ++bj) { const size_t off = (size_t)row * 1024 + u.pn * BM + bj * HALF + wc * 32 + 8 * fq; const u32x4 x = xr[m][bj];
                    const f32x4 v0 = (f32x4){__uint_as_float(x.x << 16), __uint_as_float(x.x & 0xffff0000u), __uint_as_float(x.y << 16), __uint_as_float(x.y & 0xffff0000u)} + acc[ai][bj][m][0];
                    const f32x4 v1 = (f32x4){__uint_as_float(x.z << 16), __uint_as_float(x.z & 0xffff0000u), __uint_as_float(x.w << 16), __uint_as_float(x.w & 0xffff0000u)} + acc[ai][bj][m][1];
                    u32x4 w; w.x = cvt_pk_bf16(v0[0], v0[1]); w.y = cvt_pk_bf16(v0[2], v0[3]); w.z = cvt_pk_bf16(v1[0], v1[1]); w.w = cvt_pk_bf16(v1[2], v1[3]);
                    *(u32x4*)(xb + off) = w;
                    sq += (v0[0] * v0[0] + v0[1] * v0[1]) + (v0[2] * v0[2] + v0[3] * v0[3]) + (v1[0] * v1[0] + v1[1] * v1[1]) + (v1[2] * v1[2] + v1[3] * v1[3]); }
                sq += __shfl_xor(sq, 16); sq += __shfl_xor(sq, 32);
                if (fq == 0) atomicAdd(ssq_out + row, sq);
            }
            asm volatile("" ::: "memory");
        }
    }
};
struct EpiResFinal {
    static constexpr bool PERM = true, AFTER_DRAIN = false;
    const bf16_t* xb; float* out; float* ssq; unsigned* cnt; const float* g;
    __device__ __forceinline__ void operator()(f32x4 (&acc)[2][2][4][2], const Unit& u, int wr, int wc, int fr, int fq) const {
        const int col0 = u.pn * BM + wc * 32 + 8 * fq;
#pragma unroll
        for (int ai = 0; ai < 2; ++ai) {
            u32x4 xr[4][2];
#pragma unroll
            for (int m = 0; m < 4; ++m)
#pragma unroll
                for (int bj = 0; bj < 2; ++bj) xr[m][bj] = *(const u32x4*)(xb + (size_t)(u.pm * BM + ai * HALF + wr * 64 + m * 16 + fr) * 1024 + col0 + bj * HALF);
            asm volatile("" ::: "memory");
#pragma unroll
            for (int m = 0; m < 4; ++m) {
                const int row = u.pm * BM + ai * HALF + wr * 64 + m * 16 + fr; float sq = 0.f;
#pragma unroll
                for (int bj = 0; bj < 2; ++bj) { const u32x4 x = xr[m][bj];
                    const f32x4 v0 = (f32x4){__uint_as_float(x.x << 16), __uint_as_float(x.x & 0xffff0000u), __uint_as_float(x.y << 16), __uint_as_float(x.y & 0xffff0000u)} + acc[ai][bj][m][0];
                    const f32x4 v1 = (f32x4){__uint_as_float(x.z << 16), __uint_as_float(x.z & 0xffff0000u), __uint_as_float(x.w << 16), __uint_as_float(x.w & 0xffff0000u)} + acc[ai][bj][m][1];
                    acc[ai][bj][m][0] = v0; acc[ai][bj][m][1] = v1;
                    sq += (v0[0] * v0[0] + v0[1] * v0[1]) + (v0[2] * v0[2] + v0[3] * v0[3]) + (v1[0] * v1[0] + v1[1] * v1[1]) + (v1[2] * v1[2] + v1[3] * v1[3]); }
                sq += __shfl_xor(sq, 16); sq += __shfl_xor(sq, 32);
                if (fq == 0) (void)__hip_atomic_fetch_add(ssq + row, sq, __ATOMIC_RELAXED, __HIP_MEMORY_SCOPE_AGENT);
            }
        }
        asm volatile("s_waitcnt vmcnt(0)" ::: "memory");
        unsigned* pc = cnt + 64 * u.pm;
        if (fr == 0 && fq == 0) (void)__hip_atomic_fetch_add(pc, 1u, __ATOMIC_RELAXED, __HIP_MEMORY_SCOPE_AGENT);
        for (unsigned it = 0; it < (1u << 22); ++it) {
            if ((unsigned)__builtin_amdgcn_readfirstlane((int)__hip_atomic_load(pc, __ATOMIC_RELAXED, __HIP_MEMORY_SCOPE_AGENT)) >= 32u) break;
            __builtin_amdgcn_s_sleep(2);
        }
        __builtin_amdgcn_fence(__ATOMIC_ACQUIRE, "agent");
        f32x4 gv[2][2];
#pragma unroll
        for (int bj = 0; bj < 2; ++bj) { gv[bj][0] = *(const f32x4*)(g + col0 + bj * HALF); gv[bj][1] = *(const f32x4*)(g + col0 + bj * HALF + 4); }
        float rs8[8];
#pragma unroll
        for (int i = 0; i < 8; ++i) { const unsigned sb = __hip_atomic_load((const unsigned*)(ssq + u.pm * BM + (i >> 2) * HALF + wr * 64 + (i & 3) * 16 + fr), __ATOMIC_RELAXED, __HIP_MEMORY_SCOPE_AGENT);
            rs8[i] = __builtin_amdgcn_rsqf(__uint_as_float(sb) * (1.0f / 1024.0f) + 1e-6f); }
#pragma unroll
        for (int ai = 0; ai < 2; ++ai)
#pragma unroll
            for (int m = 0; m < 4; ++m) { const float rs = rs8[ai * 4 + m];
#pragma unroll
                for (int bj = 0; bj < 2; ++bj) { const size_t off = (size_t)(u.pm * BM + ai * HALF + wr * 64 + m * 16 + fr) * 1024 + col0 + bj * HALF;
                    *(f32x4*)(out + off) = acc[ai][bj][m][0] * rs * gv[bj][0]; *(f32x4*)(out + off + 4) = acc[ai][bj][m][1] * rs * gv[bj][1]; } }
    }
};
struct EpiGU {
    static constexpr bool PERM = true, AFTER_DRAIN = false;
    const float* ssq; bf16_t* H;
    __device__ __forceinline__ void operator()(const f32x4 (&acc)[2][2][4][2], const Unit& u, int wr, int wc, int fr, int fq) const {
        float sq8[8];
#pragma unroll
        for (int i = 0; i < 8; ++i) sq8[i] = ssq[u.pm * BM + (i >> 2) * HALF + wr * 64 + (i & 3) * 16 + fr];
#pragma unroll
        for (int ai = 0; ai < 2; ++ai)
#pragma unroll
            for (int m = 0; m < 4; ++m) {
                const int row = u.pm * BM + ai * HALF + wr * 64 + m * 16 + fr;
                const float rs = __builtin_amdgcn_rsqf(sq8[ai * 4 + m] * (1.0f / 1024.0f) + 1e-6f), rs2 = rs * rs, nrs = -1.4426950408889634f * rs;
                float hv[8];
#pragma unroll
                for (int n = 0; n < 2; ++n)
#pragma unroll
                    for (int e = 0; e < 4; ++e) { const float g_ = acc[ai][0][m][n][e], u_ = acc[ai][1][m][n][e];
                        hv[n * 4 + e] = (g_ * u_) * (rs2 * __builtin_amdgcn_rcpf(1.0f + __builtin_amdgcn_exp2f(nrs * g_))); }
                u32x4 w; w.x = cvt_pk_bf16(hv[0], hv[1]); w.y = cvt_pk_bf16(hv[2], hv[3]); w.z = cvt_pk_bf16(hv[4], hv[5]); w.w = cvt_pk_bf16(hv[6], hv[7]);
                *(u32x4*)(H + (size_t)row * 2816 + u.pn * HALF + wc * 32 + 8 * fq) = w;
            }
    }
};
template <class Epi, class Sched, bool ALIGN_EPI = false, bool SP2 = false>
__device__ __forceinline__ void gemm_phase(PG8_LAS unsigned char* lds, const Gemm g, const Sched& S, const Epi& E, const int wv) {
    int tid_ = wv * 64 + hw_lane(); asm volatile("" : "+v"(tid_));
    const int tid = tid_, wid = __builtin_amdgcn_readfirstlane(tid >> 6), lane = tid & 63, wr = wid >> 2, wc = wid & 3, fr = lane & 15, fq = lane >> 4;
    const int K = g.K, nt = K / BK;
    unsigned voffA[2], voffB[2];
#pragma unroll
    for (int i = 0; i < 2; ++i) { int R, C; stage_rc(tid * 16 + i * 8192, R, C); const int Rb = Epi::PERM ? ((R & ~31) + perm32(R & 31)) : R;
        voffA[i] = (unsigned)(R * K + C) * 2u; voffB[i] = (unsigned)(Rb * K + C) * 2u; }
    const size_t kstep = (size_t)(BK * 2);
    const size_t hstep = (size_t)HALF * K * 2;
    const size_t tstep = 2 * hstep;
    const unsigned ldsw = (unsigned)wid * 1024u;
    const int aoff = lds_byte(wr * 64 + fr, fq * 8), boff = lds_byte(wc * 32 + fr, fq * 8);
#define PG8_SA(b, h) (((b) * 2 + (h)) * HTB)
#define PG8_SB(b, h) ((4 + (b) * 2 + (h)) * HTB)
#define PG8_STAGE(bufoff, gbase, voff) do { _Pragma("unroll") for (int _i = 0; _i < 2; ++_i) \
        __builtin_amdgcn_global_load_lds((const unsigned*)((const char*)(gbase) + (voff)[_i]), (PG8_LAS unsigned*)(lds + (bufoff) + ldsw + _i * 8192), 16, 0, 0); } while (0)
#define PG8_LDA(dst, b, h) do { _Pragma("unroll") for (int m = 0; m < 4; ++m) _Pragma("unroll") for (int k = 0; k < 2; ++k) dst[m][k] = *(const PG8_LAS bf16x8*)(lds + PG8_SA(b, h) + aoff + m * 2048 + k * 1024); } while (0)
#define PG8_LDB(dst, b, h) do { _Pragma("unroll") for (int n = 0; n < 2; ++n) _Pragma("unroll") for (int k = 0; k < 2; ++k) dst[n][k] = *(const PG8_LAS bf16x8*)(lds + PG8_SB(b, h) + boff + n * 2048 + k * 1024); } while (0)
#define PG8_MMA(ai, bj, At, Bt) do { __builtin_amdgcn_s_setprio(1); _Pragma("unroll") for (int m = 0; m < 4; ++m) _Pragma("unroll") for (int n = 0; n < 2; ++n) _Pragma("unroll") for (int k = 0; k < 2; ++k) \
        acc[ai][bj][m][n] = __builtin_amdgcn_mfma_f32_16x16x32_bf16(Bt[n][k], At[m][k], acc[ai][bj][m][n], 0, 0, 0); __builtin_amdgcn_s_setprio(0); } while (0)
#define PG8_WAIT_V(n) asm volatile("s_waitcnt vmcnt(" #n ")" ::: "memory")
#define PG8_WAIT_L(n) asm volatile("s_waitcnt lgkmcnt(" #n ")" ::: "memory")
#define PG8_BAR __builtin_amdgcn_s_barrier()
#define PG8_SCHED __builtin_amdgcn_sched_barrier(0)
    Unit cur, nxt; int ui = 0;
    if (!S.next(0, cur)) return;
    f32x4 acc[2][2][4][2];
#pragma unroll
    for (int a = 0; a < 2; ++a)
#pragma unroll
        for (int b = 0; b < 2; ++b)
#pragma unroll
            for (int m = 0; m < 4; ++m)
#pragma unroll
                for (int n = 0; n < 2; ++n) acc[a][b][m][n] = (f32x4){0.f, 0.f, 0.f, 0.f};
    bf16x8 At[4][2], B0[2][2], B1[2][2];
    const char* cA = (const char*)g.A + (size_t)cur.pm * tstep; const char* cB = (const char*)g.Bt + (size_t)cur.pn * tstep;
    S.a_ready(cur);
    if constexpr (SP2) {
        PG8_STAGE(PG8_SB(0, 0), cB, voffB); PG8_STAGE(PG8_SB(0, 1), cB + hstep, voffB); PG8_STAGE(PG8_SA(0, 0), cA, voffA); PG8_STAGE(PG8_SA(0, 1), cA + hstep, voffA);
        if (wr == 1) PG8_BAR;
        PG8_WAIT_V(2); PG8_BAR;
        PG8_STAGE(PG8_SB(1, 0), cB + kstep, voffB); PG8_STAGE(PG8_SA(1, 0), cA + kstep, voffA); PG8_STAGE(PG8_SB(1, 1), cB + hstep + kstep, voffB);
        PG8_WAIT_V(6); PG8_BAR;
    } else {
        PG8_STAGE(PG8_SB(0, 0), cB, voffB); PG8_STAGE(PG8_SA(0, 0), cA, voffA); PG8_STAGE(PG8_SB(0, 1), cB + hstep, voffB); PG8_STAGE(PG8_SA(0, 1), cA + hstep, voffA);
        if (wr == 1) PG8_BAR;
        PG8_WAIT_V(4); PG8_BAR;
        PG8_STAGE(PG8_SB(1, 0), cB + kstep, voffB); PG8_STAGE(PG8_SA(1, 0), cA + kstep, voffA); PG8_STAGE(PG8_SB(1, 1), cB + hstep + kstep, voffB);
        PG8_WAIT_V(6); PG8_BAR;
    }
    for (;;) {
        const bool has_next = S.next(ui + 1, nxt);
        const char* nA = has_next ? (const char*)g.A + (size_t)nxt.pm * tstep : cA; const char* nB = has_next ? (const char*)g.Bt + (size_t)nxt.pn * tstep : cB;
        for (int t = 0; t < nt; t += 2) {
            const bool last = (t == nt - 2);
            const char* a1 = cA + (size_t)(t + 1) * kstep;
            const char* a2 = last ? nA : cA + (size_t)(t + 2) * kstep; const char* b2 = last ? nB : cB + (size_t)(t + 2) * kstep;
            const char* a3 = a2 + kstep; const char* b3 = b2 + kstep;
            if (last && has_next) S.a_ready(nxt);
            if constexpr (SP2) {
            PG8_LDB(B0, 0, 0); PG8_LDB(B1, 0, 1); PG8_SCHED; PG8_LDA(At, 0, 0); PG8_STAGE(PG8_SA(1, 1), a1 + hstep, voffA);
            PG8_WAIT_V(8); PG8_WAIT_L(0); PG8_BAR; PG8_MMA(0, 0, At, B0); PG8_MMA(0, 1, At, B1); PG8_BAR; PG8_SCHED;
            PG8_LDA(At, 0, 1); PG8_STAGE(PG8_SB(0, 0), b2, voffB); PG8_STAGE(PG8_SB(0, 1), b2 + hstep, voffB); PG8_STAGE(PG8_SA(0, 0), a2, voffA);
            PG8_WAIT_V(8); PG8_WAIT_L(0); PG8_BAR; PG8_MMA(1, 0, At, B0); PG8_MMA(1, 1, At, B1); PG8_BAR; PG8_SCHED;
            PG8_LDB(B0, 1, 0); PG8_LDB(B1, 1, 1); PG8_SCHED; PG8_LDA(At, 1, 0); PG8_STAGE(PG8_SA(0, 1), a2 + hstep, voffA);
            PG8_WAIT_V(8); PG8_WAIT_L(0); PG8_BAR; PG8_MMA(0, 0, At, B0); PG8_MMA(0, 1, At, B1); PG8_BAR; PG8_SCHED;
            PG8_LDA(At, 1, 1); PG8_STAGE(PG8_SB(1, 0), b3, voffB); PG8_STAGE(PG8_SB(1, 1), b3 + hstep, voffB); PG8_STAGE(PG8_SA(1, 0), a3, voffA);
            PG8_WAIT_V(8); PG8_WAIT_L(0); PG8_BAR; PG8_MMA(1, 0, At, B0); PG8_MMA(1, 1, At, B1); PG8_BAR; PG8_SCHED;
            } else {
            PG8_LDB(B0, 0, 0); PG8_SCHED; PG8_LDA(At, 0, 0); PG8_STAGE(PG8_SA(1, 1), a1 + hstep, voffA);
            PG8_WAIT_L(8); PG8_BAR; PG8_WAIT_L(0); PG8_MMA(0, 0, At, B0); PG8_BAR; PG8_SCHED;
            PG8_LDB(B1, 0, 1); PG8_STAGE(PG8_SB(0, 0), b2, voffB);
            PG8_BAR; PG8_WAIT_L(0); PG8_MMA(0, 1, At, B1); PG8_BAR;
            PG8_LDA(At, 0, 1); PG8_STAGE(PG8_SA(0, 0), a2, voffA);
            PG8_BAR; PG8_WAIT_L(0); PG8_MMA(1, 0, At, B0); PG8_BAR; PG8_SCHED;
            PG8_STAGE(PG8_SB(0, 1), b2 + hstep, voffB);
            PG8_WAIT_V(6); PG8_BAR; PG8_MMA(1, 1, At, B1); PG8_BAR;
            PG8_LDB(B0, 1, 0); PG8_SCHED; PG8_LDA(At, 1, 0); PG8_STAGE(PG8_SA(0, 1), a2 + hstep, voffA);
            PG8_WAIT_L(8); PG8_BAR; PG8_WAIT_L(0); PG8_MMA(0, 0, At, B0); PG8_BAR; PG8_SCHED;
            PG8_LDB(B1, 1, 1); PG8_STAGE(PG8_SB(1, 0), b3, voffB);
            PG8_BAR; PG8_WAIT_L(0); PG8_MMA(0, 1, At, B1); PG8_BAR;
            PG8_LDA(At, 1, 1); PG8_STAGE(PG8_SA(1, 0), a3, voffA);
            PG8_BAR; PG8_WAIT_L(0); PG8_MMA(1, 0, At, B0); PG8_BAR; PG8_SCHED;
            PG8_STAGE(PG8_SB(1, 1), b3 + hstep, voffB);
            PG8_WAIT_V(6); PG8_BAR; PG8_MMA(1, 1, At, B1); PG8_BAR;
            }
        }
        if constexpr (ALIGN_EPI) { if (wr == 0) PG8_BAR; }
        if constexpr (!Epi::AFTER_DRAIN) { E(acc, cur, wr, wc, fr, fq); S.done(cur); }
        if (!has_next) break;
#pragma unroll
        for (int a = 0; a < 2; ++a)
#pragma unroll
            for (int b = 0; b < 2; ++b)
#pragma unroll
                for (int m = 0; m < 4; ++m)
#pragma unroll
                    for (int n = 0; n < 2; ++n) acc[a][b][m][n] = (f32x4){0.f, 0.f, 0.f, 0.f};
        cur = nxt; cA = nA; cB = nB; ++ui;
        if constexpr (ALIGN_EPI) { if (wr == 1) PG8_BAR; }
    }
    PG8_WAIT_V(0);
    if constexpr (!ALIGN_EPI) { if (wr == 0) PG8_BAR; }
    PG8_BAR;
    if constexpr (Epi::AFTER_DRAIN) { E.fused(acc, cur, wr, wc, fr, fq, lds, wid, lane); S.done(cur); }
#undef PG8_SA
#undef PG8_SB
#undef PG8_STAGE
#undef PG8_LDA
#undef PG8_LDB
#undef PG8_MMA
#undef PG8_WAIT_V
#undef PG8_WAIT_L
#undef PG8_BAR
#undef PG8_SCHED
}
}
namespace att {
#define LAS __attribute__((address_space(3)))
typedef unsigned short bf16_t;
typedef short bf16x8 __attribute__((ext_vector_type(8)));
typedef short s16x4 __attribute__((ext_vector_type(4)));
typedef float f32x16 __attribute__((ext_vector_type(16)));
typedef float f32x4 __attribute__((ext_vector_type(4)));
typedef unsigned u32x4 __attribute__((ext_vector_type(4)));
typedef unsigned u32x2 __attribute__((ext_vector_type(2)));
constexpr int KP = 144, VP = 264;
constexpr int KBUF = 128 * KP, VBUF = 128 * VP;
constexpr int OFF_K = 0, OFF_V = 2 * KBUF, OFF_B = OFF_V + 2 * VBUF, ATT_LDS = OFF_B + 1024;
#ifndef PIPE128
#define PIPE128 0
#endif
constexpr float RESC_THR = 60.f;
typedef float f32x2_t __attribute__((ext_vector_type(2))); typedef __bf16 bf16x2_t __attribute__((ext_vector_type(2)));
__device__ __forceinline__ unsigned cvtpk(float lo, float hi) { f32x2_t v = {lo, hi}; bf16x2_t b = __builtin_convertvector(v, bf16x2_t); return __builtin_bit_cast(unsigned, b); }
__device__ __forceinline__ float max3f(float a, float b, float c) { float r; asm("v_max3_f32 %0, %1, %2, %3" : "=v"(r) : "v"(a), "v"(b), "v"(c)); return r; }
__device__ __forceinline__ float xhalf_max(float m) { auto rr = __builtin_amdgcn_permlane32_swap(__float_as_uint(m), __float_as_uint(m), false, false); return fmaxf(__uint_as_float(rr[0]), __uint_as_float(rr[1])); }
__device__ __forceinline__ float xhalf_sum(float m) { auto rr = __builtin_amdgcn_permlane32_swap(__float_as_uint(m), __float_as_uint(m), false, false); return __uint_as_float(rr[0]) + __uint_as_float(rr[1]); }

typedef float f32x2v __attribute__((ext_vector_type(2)));
__device__ __forceinline__ void exp_sum_pk(f32x16& P0, f32x16& P1, float m, float& lrow) {
    const f32x2v mv = {m, m}; f32x2v s0 = {0.f, 0.f}, s1 = {0.f, 0.f};
#pragma unroll
    for (int r = 0; r < 16; r += 2) {
        f32x2v a = (f32x2v){P0[r], P0[r + 1]} - mv, b = (f32x2v){P1[r], P1[r + 1]} - mv;
        a.x = __builtin_amdgcn_exp2f(a.x); a.y = __builtin_amdgcn_exp2f(a.y); b.x = __builtin_amdgcn_exp2f(b.x); b.y = __builtin_amdgcn_exp2f(b.y);
        P0[r] = a.x; P0[r + 1] = a.y; P1[r] = b.x; P1[r + 1] = b.y; s0 += a; s1 += b;
    }
    s0 += s1; lrow += s0.x + s0.y;
}
template <int DV, bool CAUSAL, bool BIAS, int VAR = 0>
__device__ __forceinline__ void attn_stream(LAS unsigned char* lds, const bf16_t* Qg, int qpitch, const bf16_t* Kg, int kpitch, const bf16_t* Vtg, int vpitch,
                                            const float* bias, int q0, int ntiles, f32x16 (&o)[DV / 32], const int wv) {
    int tid_ = wv * 64 + hw_lane(); asm volatile("" : "+v"(tid_));
    const int tid = tid_, lane = tid & 63, r32 = lane & 31, hi = lane >> 5, w = __builtin_amdgcn_readfirstlane(tid >> 6);
    constexpr int NV = DV / 32;
    bf16x8 qf[4];
#pragma unroll
    for (int d0 = 0; d0 < 4; ++d0) qf[d0] = *(const bf16x8*)(Qg + (size_t)(q0 + 32 * w + r32) * qpitch + 16 * d0 + 8 * hi);
    const int krow = tid >> 3, kch = tid & 7, vrow = tid >> 4, vch = tid & 15;
    const bf16_t* ksrc = Kg + (size_t)krow * kpitch + kch * 8;
    const bf16_t* vsrc = Vtg + (size_t)vrow * vpitch + vch * 8;
    const unsigned kdst = OFF_K + krow * KP + kch * 16, vdst = OFF_V + vrow * VP + vch * 16;
    u32x4 kreg[2], vreg[NV]; f32x4 breg = {0.f, 0.f, 0.f, 0.f};
#define ATT_LOAD(t) do { \
        _Pragma("unroll") for (int i = 0; i < 2; ++i) kreg[i] = *(const u32x4*)(ksrc + (size_t)(128 * (t) + 64 * i) * kpitch); \
        _Pragma("unroll") for (int i = 0; i < NV; ++i) vreg[i] = *(const u32x4*)(vsrc + (size_t)(32 * i) * vpitch + 128 * (t)); \
        if (BIAS) { if (tid < 32) breg = *(const f32x4*)(bias + 128 * (t) + 4 * tid); } } while (0)
#define ATT_STORE(buf) do { \
        _Pragma("unroll") for (int i = 0; i < 2; ++i) *(LAS u32x4*)(lds + kdst + (buf) * KBUF + i * 64 * KP) = kreg[i]; \
        _Pragma("unroll") for (int i = 0; i < NV; ++i) { *(LAS u32x2*)(lds + vdst + (buf) * VBUF + i * 32 * VP) = (u32x2){vreg[i].x, vreg[i].y}; *(LAS u32x2*)(lds + vdst + (buf) * VBUF + i * 32 * VP + 8) = (u32x2){vreg[i].z, vreg[i].w}; } \
        if (BIAS) { if (tid < 32) *(LAS f32x4*)(lds + OFF_B + (buf) * 512 + 16 * tid) = breg; } } while (0)
    ATT_LOAD(0);
    ATT_STORE(0);
    __syncthreads();
    float mrow = -1e30f, lrow = 0.f;
#pragma unroll
    for (int d0 = 0; d0 < DV / 32; ++d0)
#pragma unroll
        for (int r = 0; r < 16; ++r) o[d0][r] = 0.f;
    const int qmin = q0 + 32 * w;
#define ATT_KLOAD(P0, P1, buf, sub) do { \
        LAS unsigned char* Ks_ = lds + OFF_K + (buf) * KBUF + (sub) * 64 * KP; \
        _Pragma("unroll") for (int d0 = 0; d0 < 4; ++d0) { kf[2 * d0] = *(LAS bf16x8*)(Ks_ + r32 * KP + (2 * d0 + hi) * 16); kf[2 * d0 + 1] = *(LAS bf16x8*)(Ks_ + (32 + r32) * KP + (2 * d0 + hi) * 16); } \
        if (BIAS) { LAS unsigned char* Bs_ = lds + OFF_B + (buf) * 512 + (sub) * 256; \
            _Pragma("unroll") for (int g = 0; g < 4; ++g) { const f32x4 b0 = *(LAS f32x4*)(Bs_ + (8 * g + 4 * hi) * 4), b1 = *(LAS f32x4*)(Bs_ + (32 + 8 * g + 4 * hi) * 4); \
                _Pragma("unroll") for (int e = 0; e < 4; ++e) { P0[4 * g + e] = b0[e]; P1[4 * g + e] = b1[e]; } } \
        } else { _Pragma("unroll") for (int r = 0; r < 16; ++r) { P0[r] = 0.f; P1[r] = 0.f; } } \
        __builtin_amdgcn_sched_barrier(0); } while (0)
#define ATT_QKM(P0, P1) do { \
        _Pragma("unroll") for (int d0 = 0; d0 < 4; ++d0) { \
            P0 = __builtin_amdgcn_mfma_f32_32x32x16_bf16(kf[2 * d0], qf[d0], P0, 0, 0, 0); \
            P1 = __builtin_amdgcn_mfma_f32_32x32x16_bf16(kf[2 * d0 + 1], qf[d0], P1, 0, 0, 0); } \
        __builtin_amdgcn_sched_barrier(0); } while (0)
#define ATT_VLOAD(buf, sub, KK0, NKK) do { \
        LAS unsigned char* Vs_ = lds + OFF_V + (buf) * VBUF + (sub) * 128; \
        _Pragma("unroll") for (int kk = 0; kk < (NKK); ++kk) _Pragma("unroll") for (int d0 = 0; d0 < DV / 32; ++d0) { \
            const LAS unsigned char* vp = Vs_ + (32 * d0 + r32) * VP + (16 * ((KK0) + kk) + 4 * hi) * 2; \
            const s16x4 lo = *(const LAS s16x4*)vp, hh = *(const LAS s16x4*)(vp + 16); \
            vf[kk * (DV / 32) + d0] = (bf16x8){lo[0], lo[1], lo[2], lo[3], hh[0], hh[1], hh[2], hh[3]}; } \
        __builtin_amdgcn_sched_barrier(0); } while (0)
#define ATT_SM(P0, P1, kv0) do { \
        if (CAUSAL && ((kv0) + 63 > qmin)) { const int qrel = qmin + r32 - (kv0); \
            _Pragma("unroll") for (int r = 0; r < 16; ++r) { const int kv = (r & 3) + 8 * (r >> 2) + 4 * hi; if (kv > qrel) P0[r] = -1e30f; if (kv + 32 > qrel) P1[r] = -1e30f; } } \
        float mt = max3f(P0[0], P1[0], P0[1]), mu = max3f(P1[1], P0[2], P1[2]); \
        _Pragma("unroll") for (int r = 3; r < 15; r += 2) { mt = max3f(mt, P0[r], P1[r]); mu = max3f(mu, P0[r + 1], P1[r + 1]); } \
        mt = max3f(mt, P0[15], P1[15]); mt = max3f(mt, mu, mu); \
        mt = xhalf_max(mt); \
        if (__builtin_amdgcn_ballot_w64(mt > mrow + RESC_THR) != 0ull) { \
            const float mnew = fmaxf(mrow, mt), alpha = __builtin_amdgcn_exp2f(mrow - mnew); mrow = mnew; lrow *= alpha; \
            _Pragma("unroll") for (int d0 = 0; d0 < DV / 32; ++d0) _Pragma("unroll") for (int r = 0; r < 16; ++r) o[d0][r] *= alpha; } \
        exp_sum_pk(P0, P1, mrow, lrow); \
        { u32x4 x; x.x = cvtpk(P0[0], P0[1]); x.y = cvtpk(P0[2], P0[3]); x.z = cvtpk(P0[4], P0[5]); x.w = cvtpk(P0[6], P0[7]); pb[0] = __builtin_bit_cast(bf16x8, x); \
          x.x = cvtpk(P0[8], P0[9]); x.y = cvtpk(P0[10], P0[11]); x.z = cvtpk(P0[12], P0[13]); x.w = cvtpk(P0[14], P0[15]); pb[1] = __builtin_bit_cast(bf16x8, x); \
          x.x = cvtpk(P1[0], P1[1]); x.y = cvtpk(P1[2], P1[3]); x.z = cvtpk(P1[4], P1[5]); x.w = cvtpk(P1[6], P1[7]); pb[2] = __builtin_bit_cast(bf16x8, x); \
          x.x = cvtpk(P1[8], P1[9]); x.y = cvtpk(P1[10], P1[11]); x.z = cvtpk(P1[12], P1[13]); x.w = cvtpk(P1[14], P1[15]); pb[3] = __builtin_bit_cast(bf16x8, x); } \
        __builtin_amdgcn_sched_barrier(0); } while (0)
#define ATT_PVM(KK0, NKK) do { \
        _Pragma("unroll") for (int kk = 0; kk < (NKK); ++kk) _Pragma("unroll") for (int d0 = 0; d0 < DV / 32; ++d0) \
            o[d0] = __builtin_amdgcn_mfma_f32_32x32x16_bf16(vf[kk * (DV / 32) + d0], pb[(KK0) + kk], o[d0], 0, 0, 0); \
        __builtin_amdgcn_sched_barrier(0); } while (0)
    bf16x8 kf[8], vf[8], pb[4];
    if constexpr (DV == 64) {
        f32x16 sa0, sa1, sb0, sb1; bf16x8 pc[4];
        const unsigned kofs = (unsigned)(krow * kpitch + kch * 8) * 2u, vofs = (unsigned)(vrow * vpitch + vch * 8) * 2u, bofs = (unsigned)tid * 16u;
#define ATT_HEAD(P0, P1, kv0, MT) do { \
        if (CAUSAL && ((kv0) + 63 > qmin)) { const int qrel = qmin + r32 - (kv0); \
            _Pragma("unroll") for (int r = 0; r < 16; ++r) { const int kv = (r & 3) + 8 * (r >> 2) + 4 * hi; if (kv > qrel) P0[r] = -1e30f; if (kv + 32 > qrel) P1[r] = -1e30f; } } \
        float mt_ = max3f(P0[0], P1[0], P0[1]), mu_ = max3f(P1[1], P0[2], P1[2]); \
        _Pragma("unroll") for (int r = 3; r < 15; r += 2) { mt_ = max3f(mt_, P0[r], P1[r]); mu_ = max3f(mu_, P0[r + 1], P1[r + 1]); } \
        mt_ = max3f(mt_, P0[15], P1[15]); mt_ = max3f(mt_, mu_, mu_); MT = xhalf_max(mt_); } while (0)
#define ATT_PACK(P0, P1, PB) do { u32x4 x; x.x = cvtpk(P0[0], P0[1]); x.y = cvtpk(P0[2], P0[3]); x.z = cvtpk(P0[4], P0[5]); x.w = cvtpk(P0[6], P0[7]); PB[0] = __builtin_bit_cast(bf16x8, x); \
          x.x = cvtpk(P0[8], P0[9]); x.y = cvtpk(P0[10], P0[11]); x.z = cvtpk(P0[12], P0[13]); x.w = cvtpk(P0[14], P0[15]); PB[1] = __builtin_bit_cast(bf16x8, x); \
          x.x = cvtpk(P1[0], P1[1]); x.y = cvtpk(P1[2], P1[3]); x.z = cvtpk(P1[4], P1[5]); x.w = cvtpk(P1[6], P1[7]); PB[2] = __builtin_bit_cast(bf16x8, x); \
          x.x = cvtpk(P1[8], P1[9]); x.y = cvtpk(P1[10], P1[11]); x.z = cvtpk(P1[12], P1[13]); x.w = cvtpk(P1[14], P1[15]); PB[3] = __builtin_bit_cast(bf16x8, x); } while (0)
#ifndef MIXN
#define MIXN 10
#endif
#define ATT_MIX8() do { if (MIXN > 0) { _Pragma("unroll") for (int i_ = 0; i_ < 8; ++i_) { __builtin_amdgcn_sched_group_barrier(0x008, 1, 0); __builtin_amdgcn_sched_group_barrier(0x402, MIXN, 0); } } } while (0)
        ATT_KLOAD(sa0, sa1, 0, 0); ATT_QKM(sa0, sa1);
        for (int t = 0; t < ntiles; ++t) {
            const int cur = t & 1, nxt = cur ^ 1; const bool more = (t + 1 < ntiles);
            if (more) {
                const char* kt_ = (const char*)(Kg + (size_t)(128 * (t + 1)) * kpitch);
#pragma unroll
                for (int i = 0; i < 2; ++i) kreg[i] = *(const u32x4*)(kt_ + (size_t)(64 * i) * kpitch * 2 + kofs);
                if (BIAS) { if (tid < 32) breg = *(const f32x4*)((const char*)(bias + 128 * (t + 1)) + bofs); } }
            ATT_KLOAD(sb0, sb1, cur, 1);
            { float mt; ATT_HEAD(sa0, sa1, 128 * t, mt);
              if (__builtin_amdgcn_ballot_w64(mt > mrow + RESC_THR) != 0ull) {
                  const float mnew = fmaxf(mrow, mt), alpha = __builtin_amdgcn_exp2f(mrow - mnew); mrow = mnew; lrow *= alpha;
#pragma unroll
                  for (int d0 = 0; d0 < DV / 32; ++d0)
#pragma unroll
                      for (int r = 0; r < 16; ++r) o[d0][r] *= alpha; } }
            __builtin_amdgcn_sched_barrier(0);
#pragma unroll
            for (int d0 = 0; d0 < 4; ++d0) { sb0 = __builtin_amdgcn_mfma_f32_32x32x16_bf16(kf[2 * d0], qf[d0], sb0, 0, 0, 0); sb1 = __builtin_amdgcn_mfma_f32_32x32x16_bf16(kf[2 * d0 + 1], qf[d0], sb1, 0, 0, 0); }
            exp_sum_pk(sa0, sa1, mrow, lrow);
            ATT_PACK(sa0, sa1, pb);
            ATT_MIX8();
            __builtin_amdgcn_sched_barrier(0);
            if (more) {
#pragma unroll
                for (int i = 0; i < 2; ++i) *(LAS u32x4*)(lds + kdst + nxt * KBUF + i * 64 * KP) = kreg[i];
                if (BIAS) { if (tid < 32) *(LAS f32x4*)(lds + OFF_B + nxt * 512 + 16 * tid) = breg; }
                const char* vt_ = (const char*)(Vtg + 128 * (t + 1));
#pragma unroll
                for (int i = 0; i < 2; ++i) kreg[i] = *(const u32x4*)(vt_ + (size_t)(32 * i) * vpitch * 2 + vofs); }
            { LAS unsigned char* Vs_ = lds + OFF_V + cur * VBUF;
#pragma unroll
              for (int kk = 0; kk < 4; ++kk)
#pragma unroll
                  for (int d0 = 0; d0 < 2; ++d0) { const LAS unsigned char* vp = Vs_ + (32 * d0 + r32) * VP + (16 * kk + 4 * hi) * 2;
                      const s16x4 lo = *(const LAS s16x4*)vp, hh = *(const LAS s16x4*)(vp + 16); kf[kk * 2 + d0] = (bf16x8){lo[0], lo[1], lo[2], lo[3], hh[0], hh[1], hh[2], hh[3]}; } }
            float mtb; ATT_HEAD(sb0, sb1, 128 * t + 64, mtb);
            const bool rescb = __builtin_amdgcn_ballot_w64(mtb > mrow + RESC_THR) != 0ull;
            const float mnewb = rescb ? fmaxf(mrow, mtb) : mrow, alphab = __builtin_amdgcn_exp2f(mrow - mnewb);
            float psb = 0.f;
            __builtin_amdgcn_sched_barrier(0);
#pragma unroll
            for (int kk = 0; kk < 4; ++kk)
#pragma unroll
                for (int d0 = 0; d0 < 2; ++d0) o[d0] = __builtin_amdgcn_mfma_f32_32x32x16_bf16(kf[kk * 2 + d0], pb[kk], o[d0], 0, 0, 0);
            exp_sum_pk(sb0, sb1, mnewb, psb);
            ATT_PACK(sb0, sb1, pc);
            ATT_MIX8();
            __builtin_amdgcn_sched_barrier(0);
            { LAS unsigned char* Vs_ = lds + OFF_V + cur * VBUF + 128;
#pragma unroll
              for (int kk = 0; kk < 4; ++kk)
#pragma unroll
                  for (int d0 = 0; d0 < 2; ++d0) { const LAS unsigned char* vp = Vs_ + (32 * d0 + r32) * VP + (16 * kk + 4 * hi) * 2;
                      const s16x4 lo = *(const LAS s16x4*)vp, hh = *(const LAS s16x4*)(vp + 16); kf[kk * 2 + d0] = (bf16x8){lo[0], lo[1], lo[2], lo[3], hh[0], hh[1], hh[2], hh[3]}; } }
            if (rescb) {
#pragma unroll
                for (int d0 = 0; d0 < DV / 32; ++d0)
#pragma unroll
                    for (int r = 0; r < 16; ++r) o[d0][r] *= alphab; }
            lrow = lrow * alphab + psb; mrow = mnewb;
            __builtin_amdgcn_sched_barrier(0);
#pragma unroll
            for (int kk = 0; kk < 4; ++kk)
#pragma unroll
                for (int d0 = 0; d0 < 2; ++d0) o[d0] = __builtin_amdgcn_mfma_f32_32x32x16_bf16(kf[kk * 2 + d0], pc[kk], o[d0], 0, 0, 0);
            __builtin_amdgcn_sched_barrier(0);
            if (more) {
#pragma unroll
                for (int i = 0; i < 2; ++i) { *(LAS u32x2*)(lds + vdst + nxt * VBUF + i * 32 * VP) = (u32x2){kreg[i].x, kreg[i].y}; *(LAS u32x2*)(lds + vdst + nxt * VBUF + i * 32 * VP + 8) = (u32x2){kreg[i].z, kreg[i].w}; } }
            __syncthreads();
            if (more) { ATT_KLOAD(sa0, sa1, nxt, 0); ATT_QKM(sa0, sa1); }
        }
#undef ATT_HEAD
#undef ATT_PACK
#undef ATT_MIX8
    } else if constexpr (DV == 128 && PIPE128) {
#define LOAD_A(t) do { _Pragma("unroll") for (int i = 0; i < 2; ++i) kreg[i] = *(const u32x4*)(ksrc + (size_t)(128 * (t) + 64 * i) * kpitch); \
        _Pragma("unroll") for (int i = 0; i < 2; ++i) vreg[i] = *(const u32x4*)(vsrc + (size_t)(32 * i) * vpitch + 128 * (t)); } while (0)
#define STORE_A(buf) do { _Pragma("unroll") for (int i = 0; i < 2; ++i) *(LAS u32x4*)(lds + kdst + (buf) * KBUF + i * 64 * KP) = kreg[i]; \
        _Pragma("unroll") for (int i = 0; i < 2; ++i) { *(LAS u32x2*)(lds + vdst + (buf) * VBUF + i * 32 * VP) = (u32x2){vreg[i].x, vreg[i].y}; *(LAS u32x2*)(lds + vdst + (buf) * VBUF + i * 32 * VP + 8) = (u32x2){vreg[i].z, vreg[i].w}; } } while (0)
#define LOAD_B(t) do { _Pragma("unroll") for (int i = 0; i < 2; ++i) vreg[i] = *(const u32x4*)(vsrc + (size_t)(32 * (i + 2)) * vpitch + 128 * (t)); } while (0)
#define STORE_B(buf) do { _Pragma("unroll") for (int i = 0; i < 2; ++i) { *(LAS u32x2*)(lds + vdst + (buf) * VBUF + (i + 2) * 32 * VP) = (u32x2){vreg[i].x, vreg[i].y}; *(LAS u32x2*)(lds + vdst + (buf) * VBUF + (i + 2) * 32 * VP + 8) = (u32x2){vreg[i].z, vreg[i].w}; } } while (0)
        f32x16 sa0, sa1, sb0, sb1;
        ATT_KLOAD(sa0, sa1, 0, 0); ATT_QKM(sa0, sa1);
        for (int t = 0; t < ntiles; ++t) {
            const int cur = t & 1, nxt = cur ^ 1; const bool more = (t + 1 < ntiles);
            if (more) LOAD_A(t + 1);
            ATT_KLOAD(sb0, sb1, cur, 1); ATT_QKM(sb0, sb1);
            ATT_VLOAD(cur, 0, 0, 1);
            ATT_SM(sa0, sa1, 128 * t);
            ATT_PVM(0, 1); ATT_VLOAD(cur, 0, 1, 1); ATT_PVM(1, 1); ATT_VLOAD(cur, 0, 2, 1); ATT_PVM(2, 1); ATT_VLOAD(cur, 0, 3, 1); ATT_PVM(3, 1);
            if (more) { STORE_A(nxt); LOAD_B(t + 1); }
            ATT_VLOAD(cur, 1, 0, 1);
            ATT_SM(sb0, sb1, 128 * t + 64);
            ATT_PVM(0, 1); ATT_VLOAD(cur, 1, 1, 1); ATT_PVM(1, 1); ATT_VLOAD(cur, 1, 2, 1); ATT_PVM(2, 1); ATT_VLOAD(cur, 1, 3, 1); ATT_PVM(3, 1);
            if (more) STORE_B(nxt);
            __syncthreads();
            if (more) { ATT_KLOAD(sa0, sa1, nxt, 0); ATT_QKM(sa0, sa1); }
        }
#undef LOAD_A
#undef STORE_A
#undef LOAD_B
#undef STORE_B
    } else {
        f32x16 sa0, sa1;
        for (int t = 0; t < ntiles; ++t) {
            const int cur = t & 1, nxt = cur ^ 1; const bool more = (t + 1 < ntiles);
            if (more) ATT_LOAD(t + 1);
#pragma unroll
            for (int sub = 0; sub < 2; ++sub) {
                if (!(CAUSAL && (128 * t + 64 * sub > qmin + 31))) {
                    ATT_KLOAD(sa0, sa1, cur, sub); ATT_QKM(sa0, sa1);
                    ATT_VLOAD(cur, sub, 0, 1);
                    ATT_SM(sa0, sa1, 128 * t + 64 * sub);
                    ATT_PVM(0, 1);
                    ATT_VLOAD(cur, sub, 1, 1); ATT_PVM(1, 1);
                    ATT_VLOAD(cur, sub, 2, 1); ATT_PVM(2, 1);
                    ATT_VLOAD(cur, sub, 3, 1); ATT_PVM(3, 1);
                }
            }
            if (more) ATT_STORE(nxt);
            __syncthreads();
        }
    }
#undef ATT_KLOAD
#undef ATT_QKM
#undef ATT_VLOAD
#undef ATT_SM
#undef ATT_PVM
#undef ATT_LOAD
#undef ATT_STORE
    const float inv = __builtin_amdgcn_rcpf(xhalf_sum(lrow));
#pragma unroll
    for (int d0 = 0; d0 < DV / 32; ++d0)
#pragma unroll
        for (int r = 0; r < 16; ++r) o[d0][r] *= inv;
}
constexpr int KP2 = 272, KBUF2 = 128 * KP2, OFF_K2 = 0, OFF_V2 = 2 * KBUF2;
template <int SEQ_>
__device__ __forceinline__ void attn_diff_unit(LAS unsigned char* lds, const bf16_t* Qg, const bf16_t* Kg, const bf16_t* Vtg, int q0, int ntiles, float lam, float post,
                                               const float* subln_g, bf16_t* mixbase, const int wv) {
    constexpr int DV = 128;
    int tid_ = wv * 64 + hw_lane(); asm volatile("" : "+v"(tid_));
    const int tid = tid_, lane = tid & 63, r32 = lane & 31, hi = lane >> 5, w = __builtin_amdgcn_readfirstlane(tid >> 6), wr = w & 3, strm = w >> 2;
    bf16x8 qf[4];
#pragma unroll
    for (int d0 = 0; d0 < 4; ++d0) qf[d0] = *(const bf16x8*)(Qg + (size_t)(q0 + 32 * wr + r32) * 768 + 64 * strm + 16 * d0 + 8 * hi);
    const int srow = tid >> 4, sch = tid & 15;
    const bf16_t* ksrc = Kg + (size_t)srow * 768 + sch * 8;
    const bf16_t* vsrc = Vtg + (size_t)srow * SEQ_ + sch * 8;
    const unsigned kdst = OFF_K2 + srow * KP2 + sch * 16, vdst = OFF_V2 + srow * VP + sch * 16;
    u32x4 sreg[4];
#define D_LOADK(t) do { _Pragma("unroll") for (int i = 0; i < 4; ++i) sreg[i] = *(const u32x4*)(ksrc + (size_t)(128 * (t) + 32 * i) * 768); } while (0)
#define D_STOREK(buf) do { _Pragma("unroll") for (int i = 0; i < 4; ++i) *(LAS u32x4*)(lds + kdst + (buf) * KBUF2 + i * 32 * KP2) = sreg[i]; } while (0)
#define D_LOADV(t) do { _Pragma("unroll") for (int i = 0; i < 4; ++i) sreg[i] = *(const u32x4*)(vsrc + (size_t)(32 * i) * SEQ_ + 128 * (t)); } while (0)
#define D_STOREV(buf) do { _Pragma("unroll") for (int i = 0; i < 4; ++i) { *(LAS u32x2*)(lds + vdst + (buf) * VBUF + i * 32 * VP) = (u32x2){sreg[i].x, sreg[i].y}; *(LAS u32x2*)(lds + vdst + (buf) * VBUF + i * 32 * VP + 8) = (u32x2){sreg[i].z, sreg[i].w}; } } while (0)
    D_LOADK(0); D_STOREK(0); D_LOADV(0); D_STOREV(0);
    __syncthreads();
    float mrow = -1e30f, lrow = 0.f;
    f32x16 o[4];
#pragma unroll
    for (int d0 = 0; d0 < 4; ++d0)
#pragma unroll
        for (int r = 0; r < 16; ++r) o[d0][r] = 0.f;
    const int qmin = q0 + 32 * wr;
    bf16x8 kf[8], vf[4], vg[4], pb[4];
    f32x16 p0, p1;
#define D_SUB(buf, sub, kv0) do { if (!((kv0) > qmin + 31)) { \
        LAS unsigned char* Ks_ = lds + OFF_K2 + (buf) * KBUF2 + (sub) * 64 * KP2 + strm * 128; \
        _Pragma("unroll") for (int d0 = 0; d0 < 4; ++d0) { kf[2 * d0] = *(LAS bf16x8*)(Ks_ + r32 * KP2 + (2 * d0 + hi) * 16); kf[2 * d0 + 1] = *(LAS bf16x8*)(Ks_ + (32 + r32) * KP2 + (2 * d0 + hi) * 16); } \
        _Pragma("unroll") for (int r = 0; r < 16; ++r) { p0[r] = 0.f; p1[r] = 0.f; } \
        __builtin_amdgcn_sched_barrier(0); \
        _Pragma("unroll") for (int d0 = 0; d0 < 4; ++d0) { \
            p0 = __builtin_amdgcn_mfma_f32_32x32x16_bf16(kf[2 * d0], qf[d0], p0, 0, 0, 0); \
            p1 = __builtin_amdgcn_mfma_f32_32x32x16_bf16(kf[2 * d0 + 1], qf[d0], p1, 0, 0, 0); } \
        __builtin_amdgcn_sched_barrier(0); \
        LAS unsigned char* Vs_ = lds + OFF_V2 + (buf) * VBUF + (sub) * 128; \
        D_VLOAD(0); \
        if ((kv0) + 63 > qmin) { const int qrel = qmin + r32 - (kv0); \
            _Pragma("unroll") for (int r = 0; r < 16; ++r) { const int kv = (r & 3) + 8 * (r >> 2) + 4 * hi; if (kv > qrel) p0[r] = -1e30f; if (kv + 32 > qrel) p1[r] = -1e30f; } } \
        float mt = max3f(p0[0], p1[0], p0[1]), mu = max3f(p1[1], p0[2], p1[2]); \
        _Pragma("unroll") for (int r = 3; r < 15; r += 2) { mt = max3f(mt, p0[r], p1[r]); mu = max3f(mu, p0[r + 1], p1[r + 1]); } \
        mt = max3f(mt, p0[15], p1[15]); mt = max3f(mt, mu, mu); \
        mt = xhalf_max(mt); \
        if (__builtin_amdgcn_ballot_w64(mt > mrow + RESC_THR) != 0ull) { \
            const float mnew = fmaxf(mrow, mt), alpha = __builtin_amdgcn_exp2f(mrow - mnew); mrow = mnew; lrow *= alpha; \
            _Pragma("unroll") for (int d0 = 0; d0 < 4; ++d0) _Pragma("unroll") for (int r = 0; r < 16; ++r) o[d0][r] *= alpha; } \
        exp_sum_pk(p0, p1, mrow, lrow); \
        { u32x4 x; x.x = cvtpk(p0[0], p0[1]); x.y = cvtpk(p0[2], p0[3]); x.z = cvtpk(p0[4], p0[5]); x.w = cvtpk(p0[6], p0[7]); pb[0] = __builtin_bit_cast(bf16x8, x); \
          x.x = cvtpk(p0[8], p0[9]); x.y = cvtpk(p0[10], p0[11]); x.z = cvtpk(p0[12], p0[13]); x.w = cvtpk(p0[14], p0[15]); pb[1] = __builtin_bit_cast(bf16x8, x); \
          x.x = cvtpk(p1[0], p1[1]); x.y = cvtpk(p1[2], p1[3]); x.z = cvtpk(p1[4], p1[5]); x.w = cvtpk(p1[6], p1[7]); pb[2] = __builtin_bit_cast(bf16x8, x); \
          x.x = cvtpk(p1[8], p1[9]); x.y = cvtpk(p1[10], p1[11]); x.z = cvtpk(p1[12], p1[13]); x.w = cvtpk(p1[14], p1[15]); pb[3] = __builtin_bit_cast(bf16x8, x); } \
        __builtin_amdgcn_sched_barrier(0); \
        D_VLOADB(1); D_PVM(0); D_VLOAD(2); D_PVMB(1); D_VLOADB(3); D_PVM(2); D_PVMB(3); } } while (0)
#define D_VLOAD(KK) do { _Pragma("unroll") for (int d0 = 0; d0 < 4; ++d0) { \
            const LAS unsigned char* vp = Vs_ + (32 * d0 + r32) * VP + (16 * (KK) + 4 * hi) * 2; \
            const s16x4 lo = *(const LAS s16x4*)vp, hh = *(const LAS s16x4*)(vp + 16); \
            vf[d0] = (bf16x8){lo[0], lo[1], lo[2], lo[3], hh[0], hh[1], hh[2], hh[3]}; } \
        __builtin_amdgcn_sched_barrier(0); } while (0)
#define D_VLOADB(KK) do { _Pragma("unroll") for (int d0 = 0; d0 < 4; ++d0) { \
            const LAS unsigned char* vp = Vs_ + (32 * d0 + r32) * VP + (16 * (KK) + 4 * hi) * 2; \
            const s16x4 lo = *(const LAS s16x4*)vp, hh = *(const LAS s16x4*)(vp + 16); \
            vg[d0] = (bf16x8){lo[0], lo[1], lo[2], lo[3], hh[0], hh[1], hh[2], hh[3]}; } \
        __builtin_amdgcn_sched_barrier(0); } while (0)
#define D_PVMB(KK) do { _Pragma("unroll") for (int d0 = 0; d0 < 4; ++d0) o[d0] = __builtin_amdgcn_mfma_f32_32x32x16_bf16(vg[d0], pb[KK], o[d0], 0, 0, 0); \
        __builtin_amdgcn_sched_barrier(0); } while (0)
#define D_PVM(KK) do { _Pragma("unroll") for (int d0 = 0; d0 < 4; ++d0) o[d0] = __builtin_amdgcn_mfma_f32_32x32x16_bf16(vf[d0], pb[KK], o[d0], 0, 0, 0); \
        __builtin_amdgcn_sched_barrier(0); } while (0)
    for (int t = 0; t < ntiles; ++t) {
        const int cur = t & 1, nxt = cur ^ 1; const bool more = (t + 1 < ntiles);
        if (more) D_LOADK(t + 1);
        D_SUB(cur, 0, 128 * t);
        if (more) { D_STOREK(nxt); D_LOADV(t + 1); }
        D_SUB(cur, 1, 128 * t + 64);
        if (more) D_STOREV(nxt);
        __syncthreads();
    }
#undef D_LOADK
#undef D_STOREK
#undef D_LOADV
#undef D_STOREV
#undef D_SUB
#undef D_VLOAD
#undef D_PVM
#undef D_VLOADB
#undef D_PVMB
    const float inv = __builtin_amdgcn_rcpf(xhalf_sum(lrow));
    const int lane_e = hw_lane(), r32e = lane_e & 31, hie = lane_e >> 5;
    if (strm == 1) {
#pragma unroll
        for (int d0 = 0; d0 < 4; ++d0)
#pragma unroll
            for (int g4 = 0; g4 < 4; ++g4) *(LAS f32x4*)(lds + (((d0 * 4 + g4) * 4 + wr) * 64 + lane_e) * 16) = (f32x4){o[d0][4 * g4] * inv, o[d0][4 * g4 + 1] * inv, o[d0][4 * g4 + 2] * inv, o[d0][4 * g4 + 3] * inv};
    }
    __syncthreads();
    if (strm == 0) {
        float sq = 0.f;
#pragma unroll
        for (int d0 = 0; d0 < 4; ++d0)
#pragma unroll
            for (int g4 = 0; g4 < 4; ++g4) { const f32x4 a = *(LAS f32x4*)(lds + (((d0 * 4 + g4) * 4 + wr) * 64 + lane_e) * 16);
#pragma unroll
                for (int e = 0; e < 4; ++e) { const float y = o[d0][4 * g4 + e] * inv - lam * a[e]; o[d0][4 * g4 + e] = y; sq += y * y; } }
        sq = xhalf_sum(sq);
        const float rn = __builtin_amdgcn_rsqf(sq * (1.0f / 128.0f) + 1e-6f) * post;
        bf16_t* dst = mixbase + (size_t)(q0 + 32 * wr + r32e) * 1024;
#pragma unroll
        for (int d0 = 0; d0 < 4; ++d0)
#pragma unroll
            for (int g4 = 0; g4 < 4; ++g4) { const f32x4 gv = *(const f32x4*)(subln_g + 32 * d0 + 8 * g4 + 4 * hie);
                u32x2 x; x.x = cvtpk(o[d0][4 * g4] * rn * gv[0], o[d0][4 * g4 + 1] * rn * gv[1]); x.y = cvtpk(o[d0][4 * g4 + 2] * rn * gv[2], o[d0][4 * g4 + 3] * rn * gv[3]);
                *(u32x2*)(dst + 32 * d0 + 8 * g4 + 4 * hie) = x; }
    }
}
template <int DV> __device__ __forceinline__ void store_o(bf16_t* dstrow, const f32x16 (&o)[DV / 32], int hi) {
#pragma unroll
    for (int d0 = 0; d0 < DV / 32; ++d0)
#pragma unroll
        for (int g = 0; g < 4; ++g) { u32x2 x; x.x = cvtpk(o[d0][4 * g], o[d0][4 * g + 1]); x.y = cvtpk(o[d0][4 * g + 2], o[d0][4 * g + 3]);
            *(u32x2*)(dstrow + 32 * d0 + 8 * g + 4 * hi) = x; }
}
}
__constant__ float INV_FREQ[32] = {1.000000000e+00f, 7.498942614e-01f, 5.623413324e-01f, 4.216965139e-01f, 3.162277639e-01f, 2.371373773e-01f, 1.778279394e-01f, 1.333521307e-01f, 1.000000015e-01f, 7.498941571e-02f, 5.623413250e-02f, 4.216965288e-02f, 3.162277490e-02f, 2.371373773e-02f, 1.778279431e-02f, 1.333521493e-02f, 9.999999776e-03f, 7.498941850e-03f, 5.623413250e-03f, 4.216964822e-03f, 3.162277630e-03f, 2.371373586e-03f, 1.778279431e-03f, 1.333521446e-03f, 1.000000047e-03f, 7.498942432e-04f, 5.623413017e-04f, 4.216965172e-04f, 3.162277571e-04f, 2.371373703e-04f, 1.778279402e-04f, 1.333521504e-04f};
namespace cg = cooperative_groups;
typedef unsigned short bf16;
typedef float f32x4 __attribute__((ext_vector_type(4)));
typedef unsigned v4u __attribute__((ext_vector_type(4)));
typedef unsigned v2u __attribute__((ext_vector_type(2)));
constexpr int NB = 4, SEQ = 4096, DM = 1024, M = NB * SEQ, NMEM = 256, MM = NB * NMEM, DFF = 2816, NPROJ = 2560, NPROJA = 2816;
constexpr float C2 = 0.125f * 1.4426950408889634f;
constexpr float LAMBDA_INIT = 0.35550906759096934f;
constexpr size_t MiB = 1u << 20;
constexpr size_t WS_CTL = 0;
constexpr size_t WS_SSQ = 1 * MiB;
constexpr size_t WS_SSQM = WS_SSQ + 5 * (size_t)M * 4;
constexpr size_t WS_LF = 2 * MiB;
constexpr size_t WS_COS = 3 * MiB, WS_SIN = 3 * MiB + 512 * 1024;
constexpr size_t WS_INVREV = 2 * MiB + 800 * 1024;
constexpr size_t WS_WA = 4 * MiB, WS_WB = 10 * MiB, WS_WO = 15 * MiB, WS_WM = 19 * MiB, WS_WGU = 21 * MiB, WS_WD = 43 * MiB;
constexpr size_t WS_MEMB = 54 * MiB, WS_MK = 56 * MiB, WS_MVT = 57 * MiB;
constexpr size_t WS_XB = 58 * MiB;
constexpr size_t WS_Q = 90 * MiB, WS_K = 114 * MiB, WS_VT = 138 * MiB, WS_MQ = 162 * MiB, WS_MIX = 170 * MiB, WS_H = 90 * MiB, WS_STASH = 202 * MiB, WS_END = 234 * MiB;
static_assert(WS_H + (size_t)M * DFF * 2 <= WS_END, "h overlay");
constexpr int LDS_BYTES = 147456, LDS_MISC = LDS_BYTES - 1024, LDS_ARGS = LDS_MISC + 256;

constexpr int CW_BAR = 4096;
struct Args {
    const float *x, *mem, *attn_g, *mem_g, *w_mem_kv, *w_out, *ffn_g, *w_gate_up, *w_down, *a_w_in, *a_b_f, *b_w_in, *lq1, *lk1, *lq2, *lk2, *subln_g, *kv_g, *w_kv, *final_g;
    float* out; unsigned char* ws;
};

__device__ __forceinline__ unsigned f2bf(float f) { unsigned u = __builtin_bit_cast(unsigned, f); return (u + 0x7fffu + ((u >> 16) & 1u)) >> 16; }
__device__ __forceinline__ unsigned pk2(float lo, float hi) { return att::cvtpk(lo, hi); }
__device__ __forceinline__ float wave_sum(float v) {
#pragma unroll
    for (int o = 1; o < 64; o <<= 1) v += __shfl_xor(v, o);
    return v;
}
__device__ __forceinline__ void wt_item(const float* W, int ldw, int K, const float* g, bf16* WT, int k0, int c0, int nvalid, int drowA, int drowB, LAS float* scr, int lane) {
    const int kq = lane >> 4, n4 = 4 * (lane & 15);
    f32x4 v[16]; float gk[16];
#pragma unroll
    for (int i = 0; i < 16; ++i) gk[i] = g ? g[k0 + 4 * i + kq] : 1.0f;
#pragma unroll
    for (int i = 0; i < 16; ++i) v[i] = *(const f32x4*)(W + (size_t)(k0 + 4 * i + kq) * ldw + c0 + n4);
    if (g) {
#pragma unroll
        for (int i = 0; i < 16; ++i) v[i] = v[i] * gk[i];
    }
    if (nvalid < 64) {
#pragma unroll
        for (int i = 0; i < 16; ++i)
#pragma unroll
            for (int e = 0; e < 4; ++e) if (n4 + e >= nvalid) v[i][e] = 0.f;
    }
#pragma unroll
    for (int i = 0; i < 16; ++i)
#pragma unroll
        for (int e = 0; e < 4; ++e) scr[(4 * i + kq) * 65 + n4 + e] = v[i][e];
    asm volatile("s_waitcnt lgkmcnt(0)" ::: "memory");
#pragma unroll
    for (int j = 0; j < 8; ++j) { const int q = lane + 64 * j, n = q >> 3, kc = q & 7; const LAS float* s = scr + (8 * kc) * 65 + n;
        v4u o; o.x = pk2(s[0 * 65], s[1 * 65]); o.y = pk2(s[2 * 65], s[3 * 65]); o.z = pk2(s[4 * 65], s[5 * 65]); o.w = pk2(s[6 * 65], s[7 * 65]);
        const int drow = (n < 32) ? drowA + n : drowB + n - 32;
        *(v4u*)(WT + (size_t)drow * K + k0 + 8 * kc) = o; }
    asm volatile("s_waitcnt lgkmcnt(0)" ::: "memory");
}
__device__ __forceinline__ int wt_drow(int l, int drow0, int kind) {
    if (kind == 0) return drow0 + l;
    if (kind == 1) return drow0 + (l / 256) * 256 + ((l >> 5) & 1) * 128 + ((l & 255) >> 6) * 32;
    const int up = l >= DFF ? 1 : 0, j = l - up * DFF; return drow0 + (j / 128) * 256 + up * 128 + (j & 127);
}
__device__ __forceinline__ void wt_job(int it, const float* W, int ldw, int K, int c_src, int ncols, int nvalid, const float* g, bf16* WT, int drow0, int kind, LAS float* scr, int lane) {
    const int nblk = ncols / 64, kb = it / nblk, nb = it % nblk; const int l = nb * 64;
    wt_item(W, ldw, K, g, WT, kb * 64, c_src + l, nvalid, wt_drow(l, drow0, kind), wt_drow(l + 32, drow0, kind), scr, lane);
}
#define XB_TMO      128
#define XB_XCNT(j)  (256  + 64 * (j))
#define XB_XSUB(j)  (1280 + 64 * (j))
#define XB_XGEN(j)  (2304 + 64 * (j))
#define XB_TOP      3328
#define XB_TOPGEN   3392
#define XCD_BAR_WORDS 3456
#define XB_SPIN_CAP (1u << 18)

__device__ __forceinline__ unsigned xb_ld(unsigned* p)              { return __hip_atomic_load(p, __ATOMIC_RELAXED, __HIP_MEMORY_SCOPE_AGENT); }
__device__ __forceinline__ unsigned xb_add(unsigned* p, unsigned v) { return __hip_atomic_fetch_add(p, v, __ATOMIC_RELAXED, __HIP_MEMORY_SCOPE_AGENT); }
__device__ __forceinline__ unsigned xb_xcc_id() { return (unsigned)__builtin_amdgcn_s_getreg((3 << 11) | 20) & 0xFu; }
#define XB_SPIN(cond, bar) do { unsigned _sp = 0; while (cond) { __builtin_amdgcn_s_sleep(1); \
    if ((++_sp & 255u) == 0u) { if (xb_ld(&(bar)[XB_TMO])) break; if (_sp > XB_SPIN_CAP) { atomicAdd(&(bar)[XB_TMO], 1u); break; } } } } while (0)

struct XcdBarrier {
    unsigned* bar; unsigned x; int wv;
    volatile LAS unsigned* st;
};

__device__ __forceinline__ XcdBarrier xcd_barrier_post(unsigned* bar, volatile LAS unsigned* st) {
    XcdBarrier b; b.bar = bar; b.x = xb_xcc_id(); b.st = st; b.wv = 0;
    if (threadIdx.x == 0) (void)xb_add(&bar[XB_XCNT(b.x)], 1u);
    return b;
}
__device__ __forceinline__ void xcd_barrier_complete(unsigned* bar, unsigned x, unsigned& nloc, unsigned& nx) {
    const unsigned G = gridDim.x * gridDim.y * gridDim.z;
    unsigned sum, cnt, mine, sp = 0u;
    for (;;) {
        sum = 0u; cnt = 0u; mine = 0u;
#pragma unroll
        for (unsigned j = 0; j < 16; ++j) { const unsigned c = xb_ld(&bar[XB_XCNT(j)]); sum += c; cnt += (c > 0u) ? 1u : 0u; mine = (j == x) ? c : mine; }
        if (sum == G) break;
        __builtin_amdgcn_s_sleep(1);
        if ((++sp & 255u) == 0u) { if (xb_ld(&bar[XB_TMO])) break; if (sp > XB_SPIN_CAP) { atomicAdd(&bar[XB_TMO], 1u); break; } }
    }
    nloc = mine > 0u ? mine : 1u; nx = cnt > 0u ? cnt : 1u;
}

__device__ __forceinline__ void xcd_barrier(const XcdBarrier& b) {
    asm volatile("s_waitcnt vmcnt(0)" ::: "memory");
    __syncthreads();
    if (b.wv * 64 + hw_lane() == 0) {
        unsigned* bar = b.bar;
        __builtin_amdgcn_s_waitcnt(0);
        unsigned nloc = b.st[0], nx = b.st[1];
        if (nloc == 0u) { xcd_barrier_complete(bar, b.x, nloc, nx); b.st[0] = nloc; b.st[1] = nx; }
        const unsigned old = xb_add(&bar[XB_XSUB(b.x)], 1u);
        const unsigned gen = old / nloc;
        if (old + 1u == (gen + 1u) * nloc) {
            __builtin_amdgcn_fence(__ATOMIC_RELEASE, "agent");
            asm volatile("s_waitcnt vmcnt(0)" ::: "memory");
            const unsigned og = xb_add(&bar[XB_TOP], 1u);
            const unsigned tg = og / nx;
            if (og + 1u == (tg + 1u) * nx) xb_add(&bar[XB_TOPGEN], 1u);
            else XB_SPIN(xb_ld(&bar[XB_TOPGEN]) == tg, bar);
            __builtin_amdgcn_fence(__ATOMIC_ACQUIRE, "agent");
            xb_add(&bar[XB_XGEN(b.x)], 1u);
            asm volatile("s_waitcnt vmcnt(0)" ::: "memory");
        } else {
            XB_SPIN(xb_ld(&bar[XB_XGEN(b.x)]) == gen, bar);
            __builtin_amdgcn_fence(__ATOMIC_ACQUIRE, "agent");
            asm volatile("s_waitcnt vmcnt(0)" ::: "memory");
        }
    }
    __syncthreads();
}
#ifndef NREP_SYNC
#define NREP_SYNC 0
#endif
#ifndef NREP2
#define NREP2 1
#endif
#ifndef NREP7
#define NREP7 1
#endif
#ifndef NREP4
#define NREP4 1
#endif
#ifndef NREP1
#define NREP1 1
#endif
#ifndef NREP0
#define NREP0 1
#endif
#ifndef NREP35
#define NREP35 1
#endif
#ifndef PREREAD
#define PREREAD 0
#endif
#ifndef NREPB
#define NREPB 1
#endif
#ifndef USE_XB
#define USE_XB 1
#endif
#ifndef PVAR
#define PVAR 0
#endif
#ifndef PH_MASK
#define PH_MASK 0xFFFF
#endif
__device__ __forceinline__ void scan_bh(float* lf, LAS float* sm, int tid) {
    const f32x4 a = *(const f32x4*)(lf + 8 * tid), b = *(const f32x4*)(lf + 8 * tid + 4);
    float v[8] = {a[0], a[1], a[2], a[3], b[0], b[1], b[2], b[3]};
#pragma unroll
    for (int i = 1; i < 8; ++i) v[i] += v[i - 1];
    float tot = v[7]; const int lane = tid & 63, w = tid >> 6;
    float inc = tot;
#pragma unroll
    for (int o = 1; o < 64; o <<= 1) { const float n = __shfl_up(inc, o); if (lane >= o) inc += n; }
    if (lane == 63) sm[w] = inc;
    __syncthreads();
    float base = inc - tot;
    for (int i = 0; i < w; ++i) base += sm[i];
    const float k = -1.4426950408889634f;
    f32x4 oa, ob;
#pragma unroll
    for (int i = 0; i < 4; ++i) { oa[i] = (v[i] + base) * k; ob[i] = (v[4 + i] + base) * k; }
    *(f32x4*)(lf + 8 * tid) = oa; *(f32x4*)(lf + 8 * tid + 4) = ob;
    __syncthreads();
}

enum { AX = 0, AMEM, AATTN_G, AMEM_G, AW_MEM_KV, AW_OUT, AFFN_G, AW_GATE_UP, AW_DOWN, AA_W_IN, AA_B_F, AB_W_IN, ALQ1, ALK1, ALQ2, ALK2, ASUBLN_G, AKV_G, AW_KV, AFINAL_G, AOUT, AWS };
__device__ __forceinline__ const float* argp(LAS unsigned char* lds, int i) {
    volatile LAS unsigned* p = (volatile LAS unsigned*)(lds + LDS_ARGS + 8 * i);
    const unsigned lo = __builtin_amdgcn_readfirstlane(p[0]), hi = __builtin_amdgcn_readfirstlane(p[1]);
    return (const float*)(__attribute__((address_space(1))) const float*)(((unsigned long long)hi << 32) | (unsigned long long)lo);
}
#define WSPTRS() \
    unsigned char* ws = (unsigned char*)argp(lds, AWS); \
    unsigned* ctl = (unsigned*)(ws + WS_CTL); float* ssq = (float*)(ws + WS_SSQ); float* ssqm = (float*)(ws + WS_SSQM); \
    float* LF = (float*)(ws + WS_LF); float* COS = (float*)(ws + WS_COS); float* SIN = (float*)(ws + WS_SIN); \
    bf16 *WA = (bf16*)(ws + WS_WA), *WB = (bf16*)(ws + WS_WB), *WO = (bf16*)(ws + WS_WO), *WM = (bf16*)(ws + WS_WM), *WGU = (bf16*)(ws + WS_WGU), *WD = (bf16*)(ws + WS_WD); \
    bf16 *MEMB = (bf16*)(ws + WS_MEMB), *MK = (bf16*)(ws + WS_MK), *MVT = (bf16*)(ws + WS_MVT), *XB = (bf16*)(ws + WS_XB); \
    bf16 *Qb = (bf16*)(ws + WS_Q), *Kb = (bf16*)(ws + WS_K), *VT = (bf16*)(ws + WS_VT), *MQ = (bf16*)(ws + WS_MQ), *MIX = (bf16*)(ws + WS_MIX), *H = (bf16*)(ws + WS_H); \
    (void)ctl; (void)ssq; (void)ssqm; (void)LF; (void)COS; (void)SIN; (void)WA; (void)WB; (void)WO; (void)WM; (void)WGU; (void)WD; (void)MEMB; (void)MK; (void)MVT; (void)XB; (void)Qb; (void)Kb; (void)VT; (void)MQ; (void)MIX; (void)H;

constexpr int I1 = 16 * 36, I2 = 16 * 4, IF_ = 16, I3 = 16 * 12, I4 = 16 * 12, I5 = 16 * 12, I6 = 16 * 4, I7 = 16 * 16, I9 = 16 * 8, I11 = 16 * 88, I13 = 44 * 16;
constexpr int WT_A = I11 + I13 + I1 + I2 + IF_ + I7 + 2 * I9, WT_B1 = I3 + I4 + I5 + I6, WT_B2 = I11, WT_B3 = I7 + I13;
#define WT_SRCS() const float *a_w_in = argp(lds, AA_W_IN), *attn_g = argp(lds, AATTN_G), *w_kv = argp(lds, AW_KV), *kv_g = argp(lds, AKV_G), *b_w_in = argp(lds, AB_W_IN), *w_out = argp(lds, AW_OUT); \
    const float *w_mem_kv = argp(lds, AW_MEM_KV), *mem_g = argp(lds, AMEM_G), *w_gate_up = argp(lds, AW_GATE_UP), *ffn_g = argp(lds, AFFN_G), *w_down = argp(lds, AW_DOWN);
#define WT_DISPATCH(it_) do { int r = (it_); \
    if (r < I11) { wt_job(r, w_gate_up, 5632, 1024, 0, 5632, 64, ffn_g, WGU, 0, 2, scr, lane); break; } r -= I11; \
    if (r < I13) { wt_job(r, w_down, 1024, 2816, 0, 1024, 64, nullptr, WD, 0, 0, scr, lane); break; } r -= I13; \
    if (r < I1) { wt_job(r, a_w_in, 2572, 1024, 0, 2304, 64, attn_g, WA, 0, 0, scr, lane); break; } r -= I1; \
    if (r < I2) { wt_job(r, a_w_in, 2572, 1024, 2316, 256, 64, attn_g, WA, 2304, 0, scr, lane); break; } r -= I2; \
    if (r < IF_) { wt_job(r, a_w_in, 2572, 1024, 2304, 64, 12, attn_g, WA, 2560, 0, scr, lane); break; } r -= IF_; \
    if (r < I7) { wt_job(r, w_out, 1024, 1024, 0, 1024, 64, nullptr, WO, 0, 0, scr, lane); break; } r -= I7; \
    if (r < 2 * I9) { const int l = r / I9; wt_job(r % I9, w_mem_kv + (size_t)l * 1024 * 512, 512, 1024, 0, 512, 64, mem_g + 1024 * l, WM, 512 * l, 0, scr, lane); break; } r -= 2 * I9; \
    if (r < I3) { wt_job(r, w_kv, 1536, 1024, 0, 768, 64, kv_g, WB, 0, 1, scr, lane); break; } r -= I3; \
    if (r < I4) { wt_job(r, w_kv, 1536, 1024, 768, 768, 64, kv_g, WB, 768, 0, scr, lane); break; } r -= I4; \
    if (r < I5) { wt_job(r, b_w_in, 1024, 1024, 0, 768, 64, attn_g + 1024, WB, 1536, 1, scr, lane); break; } r -= I5; \
    if (r < I6) { wt_job(r, b_w_in, 1024, 1024, 768, 256, 64, attn_g + 1024, WB, 2304, 0, scr, lane); break; } r -= I6; \
    if (r < I11) { wt_job(r, w_gate_up + (size_t)1024 * 5632, 5632, 1024, 0, 5632, 64, ffn_g + 1024, WGU + (size_t)5632 * 1024, 0, 2, scr, lane); break; } r -= I11; \
    if (r < I7) { wt_job(r, w_out + (size_t)1024 * 1024, 1024, 1024, 0, 1024, 64, nullptr, WO + (size_t)1024 * 1024, 0, 0, scr, lane); break; } r -= I7; \
    wt_job(r, w_down + (size_t)2816 * 1024, 1024, 2816, 0, 1024, 64, nullptr, WD + (size_t)1024 * 2816, 0, 0, scr, lane); } while (0)
#define WT_IDLE(first, lo, hi) do { const int f_ = (first) < G ? (first) : 0;        \
    if (bx >= f_) { WSPTRS(); PHASE_IDS(); WT_SRCS(); LAS float* scr = (LAS float*)(lds + wave * 16640); \
        for (int it = (lo) + (bx - f_) * 8 + wave; it < (hi); it += (G - f_) * 8) WT_DISPATCH(it); __syncthreads(); } } while (0)

__global__ void __launch_bounds__(512, 2) yoco_fwd(Args A) {
    extern __shared__ __attribute__((aligned(16))) unsigned char lds_raw[];
    LAS unsigned char* lds = (LAS unsigned char*)lds_raw;
#if USE_XB
    if (threadIdx.x < 2) ((volatile LAS unsigned*)(lds + LDS_MISC + 128))[threadIdx.x] = 0u;
    __syncthreads();
    XcdBarrier xbar = xcd_barrier_post((unsigned*)(A.ws + WS_CTL) + CW_BAR, (volatile LAS unsigned*)(lds + LDS_MISC + 128));
#define GRID_SYNC() xcd_barrier(xbar)
#else
    cg::grid_group grid = cg::this_grid();
#define GRID_SYNC() grid.sync()
#endif
    const int G = gridDim.x, bx = blockIdx.x;
    const int wave0 = __builtin_amdgcn_readfirstlane((int)threadIdx.x >> 6);
#define HW_TID() (wave0 * 64 + hw_lane())
#if USE_XB
    xbar.wv = wave0;
#endif
    if (threadIdx.x == 0) {
        LAS unsigned long long* P = (LAS unsigned long long*)(lds + LDS_ARGS);
        P[AX] = (unsigned long long)A.x; P[AMEM] = (unsigned long long)A.mem; P[AATTN_G] = (unsigned long long)A.attn_g; P[AMEM_G] = (unsigned long long)A.mem_g;
        P[AW_MEM_KV] = (unsigned long long)A.w_mem_kv; P[AW_OUT] = (unsigned long long)A.w_out; P[AFFN_G] = (unsigned long long)A.ffn_g; P[AW_GATE_UP] = (unsigned long long)A.w_gate_up;
        P[AW_DOWN] = (unsigned long long)A.w_down; P[AA_W_IN] = (unsigned long long)A.a_w_in; P[AA_B_F] = (unsigned long long)A.a_b_f; P[AB_W_IN] = (unsigned long long)A.b_w_in;
        P[ALQ1] = (unsigned long long)A.lq1; P[ALK1] = (unsigned long long)A.lk1; P[ALQ2] = (unsigned long long)A.lq2; P[ALK2] = (unsigned long long)A.lk2;
        P[ASUBLN_G] = (unsigned long long)A.subln_g; P[AKV_G] = (unsigned long long)A.kv_g; P[AW_KV] = (unsigned long long)A.w_kv; P[AFINAL_G] = (unsigned long long)A.final_g;
        P[AOUT] = (unsigned long long)A.out; P[AWS] = (unsigned long long)A.ws;
    }
    __syncthreads();
#define PHASE_IDS() int tid_ = HW_TID(); asm volatile("" : "+v"(tid_)); const int tid = tid_, lane = tid & 63, wave = __builtin_amdgcn_readfirstlane(tid >> 6); \
    const int gw = bx * 8 + wave, NGW = G * 8, gt = bx * 512 + tid, NGT = G * 512; (void)lane; (void)gw; (void)NGW; (void)gt; (void)NGT;

    for (int rep0_ = 0; rep0_ < NREP0; ++rep0_) {
        WSPTRS(); PHASE_IDS();
        const float *a_w_in = argp(lds, AA_W_IN), *attn_g = argp(lds, AATTN_G), *w_kv = argp(lds, AW_KV), *kv_g = argp(lds, AKV_G), *b_w_in = argp(lds, AB_W_IN), *w_out = argp(lds, AW_OUT);
        const float *w_mem_kv = argp(lds, AW_MEM_KV), *mem_g = argp(lds, AMEM_G), *w_gate_up = argp(lds, AW_GATE_UP), *ffn_g = argp(lds, AFFN_G), *w_down = argp(lds, AW_DOWN);
        const float *xin = argp(lds, AX), *memin = argp(lds, AMEM), *a_b_f = argp(lds, AA_B_F);
#if PREREAD
        {
            float acc_ = 0.f;
#define PRE_(ptr, n) for (int i = gt; i < (n) / 4; i += NGT) { const f32x4 v = ((const f32x4*)(ptr))[i]; acc_ += (v[0] + v[1]) + (v[2] + v[3]); }
            PRE_(w_gate_up, 2 * 1024 * 5632) PRE_(w_down, 2 * 2816 * 1024) PRE_(a_w_in, 1024 * 2572) PRE_(w_kv, 1024 * 1536) PRE_(b_w_in, 1024 * 1024) PRE_(w_out, 2 * 1024 * 1024) PRE_(w_mem_kv, 2 * 1024 * 512)
#undef PRE_
            if (acc_ == 1.2345e38f) ctl[63] = 1u;
        }
#endif
        LAS float* scr = (LAS float*)(lds + wave * 16640);
        {
            constexpr int o_WA = I11 + I13, o_WO0 = o_WA + I1 + I2 + IF_, o_WM = o_WO0 + I7, n0 = I11, n1 = o_WO0 - o_WA, n2 = 2 * I9;
            for (int j = gw; j < n0 + n1 + n2; j += NGW) { const int it = j < n0 ? j : (j < n0 + n1 ? o_WA + (j - n0) : o_WM + (j - n0 - n1)); WT_DISPATCH(it); }
        }
        for (int i = gt; i < 192 * 1024 / 8; i += NGT) ((v4u*)(WA + (size_t)2624 * 1024))[i] = (v4u){0u, 0u, 0u, 0u};
        for (int m = 2 * gw; m < M + MM; m += 2 * NGW) {
            const bool ism = m >= M; const float* src = ism ? memin + (size_t)(m - M) * DM : xin + (size_t)m * DM; bf16* dst = ism ? MEMB + (size_t)(m - M) * DM : XB + (size_t)m * DM; float* sdst = ism ? ssqm + (m - M) : ssq + m;
            const f32x4* xr = (const f32x4*)src + lane; f32x4 v[8]; float s0 = 0.f, s1 = 0.f;
#pragma unroll
            for (int j = 0; j < 8; ++j) v[j] = xr[64 * j];
#pragma unroll
            for (int j = 0; j < 4; ++j) { s0 += (v[j][0] * v[j][0] + v[j][1] * v[j][1]) + (v[j][2] * v[j][2] + v[j][3] * v[j][3]); s1 += (v[4 + j][0] * v[4 + j][0] + v[4 + j][1] * v[4 + j][1]) + (v[4 + j][2] * v[4 + j][2] + v[4 + j][3] * v[4 + j][3]); }
            s0 = wave_sum(s0); s1 = wave_sum(s1);
            if (lane == 0) { sdst[0] = s0; sdst[1] = s1; }
            unsigned long long* o8 = (unsigned long long*)dst + lane;
#pragma unroll
            for (int j = 0; j < 8; ++j) o8[64 * j] = (unsigned long long)pk2(v[j][0], v[j][1]) | ((unsigned long long)pk2(v[j][2], v[j][3]) << 32);
        }
        if (gt < 32) ((float*)(ws + WS_INVREV))[gt] = INV_FREQ[gt] * 0.15915494309189535f;
        for (int i = gt; i < 4 * M; i += NGT) ssq[M + i] = 0.f;
        if (gt < 64) ctl[gt] = 0u;
    }
    GRID_SYNC();

#if PH_MASK & (1 << 1)
    {
        WSPTRS(); PHASE_IDS();
        for (int rep_ = 0; rep_ < NREP1; ++rep_) {
        pg8::Gemm g{XB, WA, M, NPROJA, DM}; pg8::StaticOrder S; S.init(M, NPROJA, G, bx);
        pg8::EpiProj E{ssq, COS, SIN, argp(lds, AA_B_F), LF, SEQ, {Qb, 3, 0, 768, C2}, {Kb, 6, 0, 768, 1.f}, {VT, 9, 1, 768, 1.f}, {MQ, 10, 0, 256, C2}, {nullptr, 11, 3, 0, 1.f}};
        pg8::gemm_phase<pg8::EpiProj, pg8::StaticOrder, true, true>(lds, g, S, E, wave0);
        }
    }
    {
        WSPTRS();
        pg8::Gemm g{MEMB, WM, MM, 1024, DM}; pg8::StaticOrder S; S.init(MM, 1024, G, (bx + 64) & 255);
        pg8::EpiProj E{ssqm, COS, SIN, nullptr, nullptr, NMEM, {MK, 1, 0, 256, 1.f}, {MVT, 2, 1, 256, 1.f}, {MK + (size_t)MM * 256, 3, 0, 256, 1.f}, {MVT + (size_t)MM * 256, 4, 1, 256, 1.f}, {nullptr, 5, 0, 0, 1.f}};
        pg8::gemm_phase<pg8::EpiProj, pg8::StaticOrder, true, true>(lds, g, S, E, wave0);
    }
#endif
    WT_IDLE(208, WT_A, WT_A + WT_B1);
    WT_IDLE(208, I11 + I13 + I1 + I2 + IF_, I11 + I13 + I1 + I2 + IF_ + I7);
    GRID_SYNC();

    if (bx < 48) { WSPTRS(); PHASE_IDS(); scan_bh(LF + (size_t)bx * SEQ, (LAS float*)(lds + LDS_MISC + 64), tid); }
    GRID_SYNC();
#if PH_MASK & (1 << 2)
    for (int rep_ = 0; rep_ < NREP2; ++rep_) { WSPTRS(); PHASE_IDS();
    volatile LAS unsigned* qword = (volatile LAS unsigned*)(lds + LDS_MISC);
    bool first_ = true;
    for (;;) {
        if (HW_TID() == 0) qword[0] = first_ ? (unsigned)bx : (unsigned)G + atomicAdd(ctl + 0 + 2 * rep_, 1u);
        first_ = false;
        __syncthreads();
        const int u = (int)qword[0];
        __syncthreads();
        if (u >= 1024) break;
        att::f32x16 o[2];
        if (u < 768) {
            const int qb = 15 - u / 48, bh = u % 48, b = bh / 12, h = bh % 12;
            if (rep_ + 1 < NREP2) att::attn_stream<64, true, true, PVAR>(lds, Qb + (size_t)b * SEQ * 768 + 64 * h, 768, Kb + (size_t)b * SEQ * 768 + 64 * h, 768, VT + (size_t)(b * 768 + 64 * h) * SEQ, SEQ,
                                             LF + (size_t)bh * SEQ, 256 * qb, 2 * (qb + 1), o, wave0);
            else att::attn_stream<64, true, true>(lds, Qb + (size_t)b * SEQ * 768 + 64 * h, 768, Kb + (size_t)b * SEQ * 768 + 64 * h, 768, VT + (size_t)(b * 768 + 64 * h) * SEQ, SEQ,
                                             LF + (size_t)bh * SEQ, 256 * qb, 2 * (qb + 1), o, wave0);
            { const int l2_ = hw_lane(); att::store_o<64>(MIX + (size_t)(b * SEQ + 256 * qb + 32 * wave + (l2_ & 31)) * DM + 64 * h, o, l2_ >> 5); }
        } else {
            const int j = u - 768, b = j >> 6, hm = (j >> 4) & 3, qb = j & 15;
            att::attn_stream<64, false, false>(lds, MQ + (size_t)b * SEQ * 256 + 64 * hm, 256, MK + (size_t)b * NMEM * 256 + 64 * hm, 256, MVT + (size_t)(b * 256 + 64 * hm) * NMEM, NMEM,
                                               nullptr, 256 * qb, 2, o, wave0);
            { const int l2_ = hw_lane(); att::store_o<64>(MIX + (size_t)(b * SEQ + 256 * qb + 32 * wave + (l2_ & 31)) * DM + 768 + 64 * hm, o, l2_ >> 5); }
        }
    } }
#endif
    GRID_SYNC();

#if PH_MASK & (1 << 3)
    for (int rep_ = 0; rep_ < NREP35; ++rep_) {
        WSPTRS(); const float* xin = argp(lds, AX); float* outp = (float*)argp(lds, AOUT);
        pg8::Gemm g{MIX, WO, M, DM, DM}; pg8::StaticOrder S; S.init(M, DM, G, bx);
        pg8::EpiRes E{XB, ssq + M};
        pg8::gemm_phase<pg8::EpiRes, pg8::StaticOrder, true, true>(lds, g, S, E, wave0);
    }
#endif
    GRID_SYNC();
#if PH_MASK & (1 << 4)
    for (int rep_ = 0; rep_ < NREP4; ++rep_) {
        WSPTRS();
        pg8::Gemm g{XB, WGU, M, 2 * DFF, DM}; pg8::StaticOrder S; S.init(M, 2 * DFF, G, bx);
        pg8::EpiGU E{ssq + M, H};
        pg8::gemm_phase<pg8::EpiGU, pg8::StaticOrder, true, true>(lds, g, S, E, wave0);
    }
#endif
    WT_IDLE(128, WT_A + WT_B1, WT_A + WT_B1 + WT_B2);
    WT_IDLE(128, I11, I11 + I13);
    GRID_SYNC();
#if PH_MASK & (1 << 5)
    for (int rep_ = 0; rep_ < NREP35; ++rep_) {
        WSPTRS(); float* outp = (float*)argp(lds, AOUT);
        pg8::Gemm g{H, WD, M, DM, DFF}; pg8::StaticOrder S; S.init(M, DM, G, bx);
        pg8::EpiRes E{XB, ssq + 2 * M};
        pg8::gemm_phase<pg8::EpiRes, pg8::StaticOrder, true, true>(lds, g, S, E, wave0);
    }
#endif
    GRID_SYNC();
#if PH_MASK & (1 << 6)
    for (int rep_ = 0; rep_ < NREPB; ++rep_) {
        WSPTRS();
        pg8::Gemm g{XB, WB, M, NPROJ, DM}; pg8::StaticOrder S; S.init(M, NPROJ, G, bx);
        pg8::EpiProj E{ssq + 2 * M, (const float*)(ws + WS_INVREV), SIN, nullptr, nullptr, SEQ, {Kb, 3, 2, 768, 1.f}, {VT, 6, 1, 768, 1.f}, {Qb, 9, 2, 768, C2}, {MQ, 10, 0, 256, C2}, {nullptr, 11, 0, 0, 1.f}};
        pg8::gemm_phase<pg8::EpiProj, pg8::StaticOrder, true, true>(lds, g, S, E, wave0);
    }
#endif
    WT_IDLE(128, WT_A + WT_B1 + WT_B2, WT_A + WT_B1 + WT_B2 + WT_B3);
    GRID_SYNC();
#if PH_MASK & (1 << 7)
    {
        WSPTRS(); PHASE_IDS(); const float* subln_g = argp(lds, ASUBLN_G);
        volatile LAS unsigned* qword = (volatile LAS unsigned*)(lds + LDS_MISC);
        float d1 = argp(lds, ALQ1)[lane] * argp(lds, ALK1)[lane], d2 = argp(lds, ALQ2)[lane] * argp(lds, ALK2)[lane];
        d1 = wave_sum(d1); d2 = wave_sum(d2);
        const float lam = __builtin_bit_cast(float, __builtin_amdgcn_readfirstlane(__builtin_bit_cast(int, expf(d1) - expf(d2) + LAMBDA_INIT)));
        bool first_ = true;
        for (int rep_ = 0; rep_ < NREP7; ++rep_)
        for (;;) {
            if (HW_TID() == 0) qword[0] = first_ ? (unsigned)bx : (unsigned)G + atomicAdd(ctl + 1 + 2 * rep_, 1u);
            first_ = false;
            __syncthreads();
            const int u = (int)qword[0];
            __syncthreads();
            if (u >= 1024) break;
            if (u < 768) {
                const int qb = 31 - u / 24, bh = u % 24, b = bh / 6, hd = bh % 6;
                att::attn_diff_unit<SEQ>(lds, Qb + (size_t)b * SEQ * 768 + 128 * hd, Kb + (size_t)b * SEQ * 768 + 128 * hd, VT + (size_t)(b * 768 + 128 * hd) * SEQ, 128 * qb, qb + 1, lam, 1.0f - LAMBDA_INIT,
                                         subln_g, MIX + (size_t)b * SEQ * DM + 128 * hd, wave0);
            } else {
                att::f32x16 o[2];
                const int j = u - 768, b = j >> 6, hm = (j >> 4) & 3, qb = j & 15;
                att::attn_stream<64, false, false>(lds, MQ + (size_t)b * SEQ * 256 + 64 * hm, 256, MK + (size_t)(MM + b * NMEM) * 256 + 64 * hm, 256, MVT + (size_t)(MM + b * 256 + 64 * hm) * NMEM, NMEM,
                                                   nullptr, 256 * qb, 2, o, wave0);
                { const int l2_ = hw_lane(); att::store_o<64>(MIX + (size_t)(b * SEQ + 256 * qb + 32 * wave + (l2_ & 31)) * DM + 768 + 64 * hm, o, l2_ >> 5); }
            }
        }
    }
#endif
    GRID_SYNC();
#if PH_MASK & (1 << 8)
    for (int rep_ = 0; rep_ < NREPB; ++rep_) {
        WSPTRS(); float* outp = (float*)argp(lds, AOUT);
        pg8::Gemm g{MIX, WO + (size_t)1024 * 1024, M, DM, DM}; pg8::StaticOrder S; S.init(M, DM, G, bx);
        pg8::EpiRes E{XB, ssq + 3 * M};
        pg8::gemm_phase<pg8::EpiRes, pg8::StaticOrder, true, true>(lds, g, S, E, wave0);
    }
#endif
    GRID_SYNC();
#if PH_MASK & (1 << 9)
    for (int rep_ = 0; rep_ < NREPB; ++rep_) {
        WSPTRS();
        pg8::Gemm g{XB, WGU + (size_t)5632 * 1024, M, 2 * DFF, DM}; pg8::StaticOrder S; S.init(M, 2 * DFF, G, bx);
        pg8::EpiGU E{ssq + 3 * M, H};
        pg8::gemm_phase<pg8::EpiGU, pg8::StaticOrder, true, true>(lds, g, S, E, wave0);
    }
#endif
    GRID_SYNC();
#if PH_MASK & (1 << 10)
    {
        WSPTRS(); float* outp = (float*)argp(lds, AOUT);
        pg8::Gemm g{H, WD + (size_t)1024 * 2816, M, DM, DFF}; pg8::StaticOrder S; S.init(M, DM, G, bx);
        pg8::EpiResFinal E{XB, outp, ssq + 4 * M, ctl + 8192, argp(lds, AFINAL_G)};
        pg8::gemm_phase<pg8::EpiResFinal, pg8::StaticOrder, true, true>(lds, g, S, E, wave0);
    }
#endif
}

extern "C" void kernel_launch(void* const* d_in, const int* in_sizes, int n_in, void* d_out, int out_size, void* d_ws, size_t ws_size, hipStream_t stream) {
    static int grid = 0;
    if (grid == 0) {
        if (n_in != 20 || out_size != M * DM || ws_size < WS_END) { fprintf(stderr, "kernel_launch: unexpected sizes n_in %d out %d ws %zu\n", n_in, out_size, ws_size); grid = -1; return; }
        int dev = 0, cus = 0, per_cu = 0;
        (void)hipGetDevice(&dev); (void)hipDeviceGetAttribute(&cus, hipDeviceAttributeMultiprocessorCount, dev);
        (void)hipFuncSetAttribute((const void*)yoco_fwd, hipFuncAttributeMaxDynamicSharedMemorySize, LDS_BYTES);
        (void)hipOccupancyMaxActiveBlocksPerMultiprocessor(&per_cu, (const void*)yoco_fwd, 512, LDS_BYTES);
        if (per_cu < 1) { fprintf(stderr, "kernel_launch: occupancy query says %d blocks per CU; the grid barrier needs every workgroup resident: nothing launched\n", per_cu); grid = -1; return; }
        grid = cus;
        if (grid != 256) fprintf(stderr, "kernel_launch: %d CUs (expected 256)\n", grid);
    }
    if (grid < 0) return;
    Args a{};
    const float** p = (const float**)&a;
    for (int i = 0; i < 20; ++i) p[i] = (const float*)d_in[i];
    a.out = (float*)d_out; a.ws = (unsigned char*)d_ws;
    void* args[] = {&a};
#if USE_XB
    (void)hipMemsetAsync((char*)d_ws + WS_CTL, 0, 65536, stream);
    hipLaunchKernelGGL(yoco_fwd, dim3(grid), dim3(512), LDS_BYTES, stream, a);
    (void)args;
#else
    hipError_t e = hipLaunchCooperativeKernel((const void*)yoco_fwd, dim3(grid), dim3(512), args, LDS_BYTES, stream);
    if (e != hipSuccess) fprintf(stderr, "cooperative launch failed: %s (grid %d)\n", hipGetErrorString(e), grid);
#endif
}
```

```cpp
#include <hip/hip_runtime.h>
#include <hip/hip_cooperative_groups.h>
#include <cstdio>
#include <cstdint>
__device__ __forceinline__ int hw_lane() { unsigned z = 0u; asm volatile("" : "+v"(z)); return (int)__builtin_amdgcn_mbcnt_hi(~0u, __builtin_amdgcn_mbcnt_lo(~0u, z)); }
namespace pg8 {
#define PG8_LAS __attribute__((address_space(3)))
typedef unsigned short bf16_t;
typedef short bf16x8 __attribute__((ext_vector_type(8)));
typedef float f32x4 __attribute__((ext_vector_type(4)));
typedef unsigned u32x4 __attribute__((ext_vector_type(4)));
constexpr int BM = 256, BK = 64, HALF = 128, HTB = HALF * BK * 2  , STAGE_BYTES = 8 * HTB, NXCD = 8, WGM = 8;

__host__ __device__ __forceinline__ int lds_byte(int r, int c) { const int st = (r >> 4) * 2 + (c >> 5), rr = r & 15, cc = c & 31, ob = rr * 64 + cc * 2; return st * 1024 + (ob ^ (((ob >> 9) & 1) << 5)); }
__host__ __device__ __forceinline__ void stage_rc(int b, int& R, int& C) { const int st = b / 1024, sb = b % 1024, swz = sb ^ (((sb >> 9) & 1) << 5); R = (st >> 1) * 16 + swz / 64; C = (st & 1) * 32 + (swz % 64) / 2; }
__host__ __device__ __forceinline__ int perm32(int rho) { const int n = rho >> 4, i = rho & 15; return 8 * (i >> 2) + 4 * n + (i & 3); }

struct Unit { int pm, pn; };
struct Gemm { const bf16_t* A; const bf16_t* Bt; int M, N, K; };

struct StaticOrder {
    int nM, nN, nwg, G, c;
    __host__ __device__ void init(int M, int N, int G_, int c_) { nM = M / BM; nN = N / BM; nwg = nM * nN; G = G_; c = c_; }
    __host__ __device__ bool next(int i, Unit& u) const {
        const long L = (long)i * G + c; if (L >= nwg) return false;
        int wgid = (int)L; { const int q = nwg / NXCD, r = nwg % NXCD, xcd = wgid % NXCD, off = wgid / NXCD; wgid = (xcd < r ? xcd * (q + 1) : r * (q + 1) + (xcd - r) * q) + off; }
        const int nig = WGM * nN, gid = wgid / nig, fm = gid * WGM, gsz = (nM - fm) < WGM ? (nM - fm) : WGM;
        u.pm = fm + ((wgid % nig) % gsz); u.pn = (wgid % nig) / gsz; return true;
    }
    __device__ __forceinline__ void a_ready(const Unit&) const {}
    __device__ __forceinline__ void done(const Unit&) const {}
};

__device__ __forceinline__ unsigned cvt_pk_bf16(float lo, float hi) { typedef float f2_ __attribute__((ext_vector_type(2))); typedef __bf16 b2_ __attribute__((ext_vector_type(2))); const f2_ v = {lo, hi}; const b2_ b = __builtin_convertvector(v, b2_); return __builtin_bit_cast(unsigned, b); }
typedef float f32x2 __attribute__((ext_vector_type(2)));
typedef unsigned u32x2 __attribute__((ext_vector_type(2)));
struct Seg { bf16_t* dst; int pn_end; int kind; int pitch; float scale; };
struct EpiProj {
    static constexpr bool PERM = true, AFTER_DRAIN = false;
    const float* ssq; const float* cs; const float* sn; const float* bf; float* lf; int S; Seg s0, s1, s2, s3, s4;
    __device__ __forceinline__ void operator()(const f32x4 (&acc)[2][2][4][2], const Unit& u, int wr, int wc, int fr, int fq) const {
        Seg g = s4; int pn0 = s3.pn_end;
        if (u.pn < s0.pn_end) { g = s0; pn0 = 0; } else if (u.pn < s1.pn_end) { g = s1; pn0 = s0.pn_end; } else if (u.pn < s2.pn_end) { g = s2; pn0 = s1.pn_end; } else if (u.pn < s3.pn_end) { g = s3; pn0 = s2.pn_end; }
        const int ct = (u.pn - pn0) * BM;
        const int lane = fq * 16 + fr; const int ssh = 31 - __builtin_clz(S);
        float sq8[8];
#pragma unroll
        for (int i = 0; i < 8; ++i) sq8[i] = ssq[u.pm * BM + (i >> 2) * HALF + wr * 64 + (i & 3) * 16 + fr];
        f32x4 w0 = {0.f, 0.f, 0.f, 0.f}, w1 = {0.f, 0.f, 0.f, 0.f};
        if (g.kind == 2) { w0 = *(const f32x4*)(cs + 8 * fq); w1 = *(const f32x4*)(cs + 8 * fq + 4); }
#pragma unroll
        for (int am = 0; am < 4; ++am) {
            const int ai = am >> 1;
#pragma unroll
            for (int mm = 0; mm < 2; ++mm) {
                const int m = (am & 1) * 2 + mm;
                const int row = u.pm * BM + ai * HALF + wr * 64 + m * 16 + fr;
                const float rs = __builtin_amdgcn_rsqf(sq8[ai * 4 + m] * (1.0f / 1024.0f) + 1e-6f) * g.scale;
                if (g.kind == 0) {
#pragma unroll
                    for (int bj = 0; bj < 2; ++bj) { const f32x4 v0 = acc[ai][bj][m][0] * rs, v1 = acc[ai][bj][m][1] * rs;
                        u32x4 w; w.x = cvt_pk_bf16(v0[0], v0[1]); w.y = cvt_pk_bf16(v0[2], v0[3]); w.z = cvt_pk_bf16(v1[0], v1[1]); w.w = cvt_pk_bf16(v1[2], v1[3]);
                        *(u32x4*)(g.dst + (size_t)row * g.pitch + ct + bj * HALF + wc * 32 + 8 * fq) = w; }
                } else if (g.kind == 1) {
                    const int b = row >> ssh, s = row & (S - 1); const bool odd = (fr & 1) != 0;
#pragma unroll
                    for (int bj = 0; bj < 2; ++bj) { const f32x4 v0 = acc[ai][bj][m][0] * rs, v1 = acc[ai][bj][m][1] * rs;
                        const int cb = ct + bj * HALF + wc * 32 + 8 * fq + (odd ? 4 : 0);
#pragma unroll
                        for (int j = 0; j < 4; ++j) { const float snd = odd ? v0[j] : v1[j]; const float rcv = __builtin_bit_cast(float, __builtin_amdgcn_update_dpp(0, __builtin_bit_cast(int, snd), 0xB1  , 0xF, 0xF, true));
                            const float lo = odd ? rcv : v0[j], hi = odd ? v1[j] : rcv;
                            *(unsigned*)(g.dst + ((size_t)b * g.pitch + cb + j) * S + (s & ~1)) = cvt_pk_bf16(lo, hi); } }
                } else if (g.kind == 3) {
                    if (wc == 0 && fq < 2) { const int b = row >> ssh, s = row & (S - 1);
#pragma unroll
                        for (int n = 0; n < 2; ++n)
#pragma unroll
                            for (int e2 = 0; e2 < 4; ++e2) { const int c = 8 * fq + 4 * n + e2;
                                if (c < 12) { const float z = acc[ai][0][m][n][e2] * rs + bf[c]; lf[((size_t)b * 12 + c) * S + s] = fminf(z, 0.f) - 0.6931471805599453f * __builtin_amdgcn_logf(1.0f + __builtin_amdgcn_exp2f(-1.4426950408889634f * fabsf(z))); } } }
                } else {
                    const float pf = (float)(row & (S - 1)); f32x4 c0, c1, n0, n1;
#pragma unroll
                    for (int e = 0; e < 4; ++e) { const float r0 = __builtin_amdgcn_fractf(pf * w0[e]), r1 = __builtin_amdgcn_fractf(pf * w1[e]);
                        c0[e] = __builtin_amdgcn_cosf(r0); n0[e] = __builtin_amdgcn_sinf(r0); c1[e] = __builtin_amdgcn_cosf(r1); n1[e] = __builtin_amdgcn_sinf(r1); }
                    const f32x4 a0 = acc[ai][0][m][0] * rs, a1 = acc[ai][0][m][1] * rs, b0 = acc[ai][1][m][0] * rs, b1 = acc[ai][1][m][1] * rs;
                    const f32x4 x0 = a0 * c0 - b0 * n0, x1 = a1 * c1 - b1 * n1, y0 = a0 * n0 + b0 * c0, y1 = a1 * n1 + b1 * c1;
                    bf16_t* p = g.dst + (size_t)row * g.pitch + ct + wc * 64 + 8 * fq;
                    u32x4 w; w.x = cvt_pk_bf16(x0[0], x0[1]); w.y = cvt_pk_bf16(x0[2], x0[3]); w.z = cvt_pk_bf16(x1[0], x1[1]); w.w = cvt_pk_bf16(x1[2], x1[3]);
                    *(u32x4*)p = w;
                    w.x = cvt_pk_bf16(y0[0], y0[1]); w.y = cvt_pk_bf16(y0[2], y0[3]); w.z = cvt_pk_bf16(y1[0], y1[1]); w.w = cvt_pk_bf16(y1[2], y1[3]);
                    *(u32x4*)(p + 32) = w;
                }
            }
        }
        (void)lane;
    }
};
struct EpiRes {
    static constexpr bool PERM = true, AFTER_DRAIN = false;
    bf16_t* xb; float* ssq_out;
    __device__ __forceinline__ void operator()(const f32x4 (&acc)[2][2][4][2], const Unit& u, int wr, int wc, int fr, int fq) const {
#pragma unroll
        for (int ai = 0; ai < 2; ++ai) {
            u32x4 xr[4][2];
#pragma unroll
            for (int m = 0; m < 4; ++m)
#pragma unroll
                for (int bj = 0; bj < 2; ++bj) xr[m][bj] = *(const u32x4*)(xb + (size_t)(u.pm * BM + ai * HALF + wr * 64 + m * 16 + fr) * 1024 + u.pn * BM + bj * HALF + wc * 32 + 8 * fq);
            asm volatile("" ::: "memory");
#pragma unroll
            for (int m = 0; m < 4; ++m) {
                const int row = u.pm * BM + ai * HALF + wr * 64 + m * 16 + fr; float sq = 0.f;
#pragma unroll
                for (int bj = 0; bj < 2; ++bj) { const size_t off = (size_t)row * 1024 + u.pn * BM + bj * HALF + wc * 32 + 8 * fq; const u32x4 x = xr[m][bj];
                    const f32x4 v0 = (f32x4){__uint_as_float(x.x << 16), __uint_as_float(x.x & 0xffff0000u), __uint_as_float(x.y << 16), __uint_as_float(x.y & 0xffff0000u)} + acc[ai][bj][m][0];
                    const f32x4 v1 = (f32x4){__uint_as_float(x.z << 16), __uint_as_float(x.z & 0xffff0000u), __uint_as_float(x.w << 16), __uint_as_float(x.w & 0xffff0000u)} + acc[ai][bj][m][1];
                    u32x4 w; w.x = cvt_pk_bf16(v0[0], v0[1]); w.y = cvt_pk_bf16(v0[2], v0[3]); w.z = cvt_pk_bf16(v1[0], v1[1]); w.w = cvt_pk_bf16(v1[2], v1[3]);
                    *(u32x4*)(xb + off) = w;
                    sq += (v0[0] * v0[0] + v0[1] * v0[1]) + (v0[2] * v0[2] + v0[3] * v0[3]) + (v1[0] * v1[0] + v1[1] * v1[1]) + (v1[2] * v1[2] + v1[3] * v1[3]); }
                { auto r16_ = __builtin_amdgcn_permlane16_swap(__float_as_uint(sq), __float_as_uint(sq), false, false); sq = __uint_as_float(r16_[0]) + __uint_as_float(r16_[1]); auto r32_ = __builtin_amdgcn_permlane32_swap(__float_as_uint(sq), __float_as_uint(sq), false, false); sq = __uint_as_float(r32_[0]) + __uint_as_float(r32_[1]); }
                if (fq == 0) atomicAdd(ssq_out + row, sq);
            }
            asm volatile("" ::: "memory");
        }
    }
};
struct EpiResFinal {
    static constexpr bool PERM = true, AFTER_DRAIN = false;
    const bf16_t* xb; float* out; float* ssq; unsigned* cnt; const float* g;
    __device__ __forceinline__ void operator()(f32x4 (&acc)[2][2][4][2], const Unit& u, int wr, int wc, int fr, int fq) const {
        const int col0 = u.pn * BM + wc * 32 + 8 * fq;
#pragma unroll
        for (int ai = 0; ai < 2; ++ai) {
            u32x4 xr[4][2];
#pragma unroll
            for (int m = 0; m < 4; ++m)
#pragma unroll
                for (int bj = 0; bj < 2; ++bj) xr[m][bj] = *(const u32x4*)(xb + (size_t)(u.pm * BM + ai * HALF + wr * 64 + m * 16 + fr) * 1024 + col0 + bj * HALF);
            asm volatile("" ::: "memory");
#pragma unroll
            for (int m = 0; m < 4; ++m) {
                const int row = u.pm * BM + ai * HALF + wr * 64 + m * 16 + fr; float sq = 0.f;
#pragma unroll
                for (int bj = 0; bj < 2; ++bj) { const u32x4 x = xr[m][bj];
                    const f32x4 v0 = (f32x4){__uint_as_float(x.x << 16), __uint_as_float(x.x & 0xffff0000u), __uint_as_float(x.y << 16), __uint_as_float(x.y & 0xffff0000u)} + acc[ai][bj][m][0];
                    const f32x4 v1 = (f32x4){__uint_as_float(x.z << 16), __uint_as_float(x.z & 0xffff0000u), __uint_as_float(x.w << 16), __uint_as_float(x.w & 0xffff0000u)} + acc[ai][bj][m][1];
                    acc[ai][bj][m][0] = v0; acc[ai][bj][m][1] = v1;
                    sq += (v0[0] * v0[0] + v0[1] * v0[1]) + (v0[2] * v0[2] + v0[3] * v0[3]) + (v1[0] * v1[0] + v1[1] * v1[1]) + (v1[2] * v1[2] + v1[3] * v1[3]); }
                { auto r16_ = __builtin_amdgcn_permlane16_swap(__float_as_uint(sq), __float_as_uint(sq), false, false); sq = __uint_as_float(r16_[0]) + __uint_as_float(r16_[1]); auto r32_ = __builtin_amdgcn_permlane32_swap(__float_as_uint(sq), __float_as_uint(sq), false, false); sq = __uint_as_float(r32_[0]) + __uint_as_float(r32_[1]); }
                if (fq == 0) (void)__hip_atomic_fetch_add(ssq + row, sq, __ATOMIC_RELAXED, __HIP_MEMORY_SCOPE_AGENT);
            }
        }
        asm volatile("s_waitcnt vmcnt(0)" ::: "memory");
        unsigned* pc = cnt + 64 * u.pm;
        if (fr == 0 && fq == 0) (void)__hip_atomic_fetch_add(pc, 1u, __ATOMIC_RELAXED, __HIP_MEMORY_SCOPE_AGENT);
        for (unsigned it = 0; it < (1u << 22); ++it) {
            if ((unsigned)__builtin_amdgcn_readfirstlane((int)__hip_atomic_load(pc, __ATOMIC_RELAXED, __HIP_MEMORY_SCOPE_AGENT)) >= 32u) break;
            __builtin_amdgcn_s_sleep(2);
        }
        __builtin_amdgcn_fence(__ATOMIC_ACQUIRE, "agent");
        f32x4 gv[2][2];
#pragma unroll
        for (int bj = 0; bj < 2; ++bj) { gv[bj][0] = *(const f32x4*)(g + col0 + bj * HALF); gv[bj][1] = *(const f32x4*)(g + col0 + bj * HALF + 4); }
        float rs8[8];
#pragma unroll
        for (int i = 0; i < 8; ++i) { const unsigned sb = __hip_atomic_load((const unsigned*)(ssq + u.pm * BM + (i >> 2) * HALF + wr * 64 + (i & 3) * 16 + fr), __ATOMIC_RELAXED, __HIP_MEMORY_SCOPE_AGENT);
            rs8[i] = __builtin_amdgcn_rsqf(__uint_as_float(sb) * (1.0f / 1024.0f) + 1e-6f); }
#pragma unroll
        for (int ai = 0; ai < 2; ++ai)
#pragma unroll
            for (int m = 0; m < 4; ++m) { const float rs = rs8[ai * 4 + m];
#pragma unroll
                for (int bj = 0; bj < 2; ++bj) { const size_t off = (size_t)(u.pm * BM + ai * HALF + wr * 64 + m * 16 + fr) * 1024 + col0 + bj * HALF;
                    *(f32x4*)(out + off) = acc[ai][bj][m][0] * rs * gv[bj][0]; *(f32x4*)(out + off + 4) = acc[ai][bj][m][1] * rs * gv[bj][1]; } }
    }
};
struct EpiGU {
    static constexpr bool PERM = true, AFTER_DRAIN = false;
    const float* ssq; bf16_t* H;
    __device__ __forceinline__ void operator()(const f32x4 (&acc)[2][2][4][2], const Unit& u, int wr, int wc, int fr, int fq) const {
        float sq8[8];
#pragma unroll
        for (int i = 0; i < 8; ++i) sq8[i] = ssq[u.pm * BM + (i >> 2) * HALF + wr * 64 + (i & 3) * 16 + fr];
#pragma unroll
        for (int ai = 0; ai < 2; ++ai)
#pragma unroll
            for (int m = 0; m < 4; ++m) {
                const int row = u.pm * BM + ai * HALF + wr * 64 + m * 16 + fr;
                const float rs = __builtin_amdgcn_rsqf(sq8[ai * 4 + m] * (1.0f / 1024.0f) + 1e-6f), rs2 = rs * rs, nrs = -1.4426950408889634f * rs;
                float hv[8];
#pragma unroll
                for (int n = 0; n < 2; ++n)
#pragma unroll
                    for (int e = 0; e < 4; ++e) { const float g_ = acc[ai][0][m][n][e], u_ = acc[ai][1][m][n][e];
                        hv[n * 4 + e] = (g_ * u_) * (rs2 * __builtin_amdgcn_rcpf(1.0f + __builtin_amdgcn_exp2f(nrs * g_))); }
                u32x4 w; w.x = cvt_pk_bf16(hv[0], hv[1]); w.y = cvt_pk_bf16(hv[2], hv[3]); w.z = cvt_pk_bf16(hv[4], hv[5]); w.w = cvt_pk_bf16(hv[6], hv[7]);
                *(u32x4*)(H + (size_t)row * 2816 + u.pn * HALF + wc * 32 + 8 * fq) = w;
            }
    }
};
template <class Epi, class Sched, bool ALIGN_EPI = false, bool SP2 = false>
__device__ __forceinline__ void gemm_phase(PG8_LAS unsigned char* lds, const Gemm g, const Sched& S, const Epi& E, const int wv) {
    int tid_ = wv * 64 + hw_lane(); asm volatile("" : "+v"(tid_));
    const int tid = tid_, wid = __builtin_amdgcn_readfirstlane(tid >> 6), lane = tid & 63, wr = wid >> 2, wc = wid & 3, fr = lane & 15, fq = lane >> 4;
    const int K = g.K, nt = K / BK;
    unsigned voffA[2], voffB[2];
#pragma unroll
    for (int i = 0; i < 2; ++i) { int R, C; stage_rc(tid * 16 + i * 8192, R, C); const int Rb = Epi::PERM ? ((R & ~31) + perm32(R & 31)) : R;
        voffA[i] = (unsigned)(R * K + C) * 2u; voffB[i] = (unsigned)(Rb * K + C) * 2u; }
    const size_t kstep = (size_t)(BK * 2);
    const size_t hstep = (size_t)HALF * K * 2;
    const size_t tstep = 2 * hstep;
    const unsigned ldsw = (unsigned)wid * 1024u;
    const int aoff = lds_byte(wr * 64 + fr, fq * 8), boff = lds_byte(wc * 32 + fr, fq * 8);
#define PG8_SA(b, h) (((b) * 2 + (h)) * HTB)
#define PG8_SB(b, h) ((4 + (b) * 2 + (h)) * HTB)
#define PG8_STAGE(bufoff, gbase, voff) do { _Pragma("unroll") for (int _i = 0; _i < 2; ++_i) \
        __builtin_amdgcn_global_load_lds((const unsigned*)((const char*)(gbase) + (voff)[_i]), (PG8_LAS unsigned*)(lds + (bufoff) + ldsw + _i * 8192), 16, 0, 0); } while (0)
#define PG8_LDA(dst, b, h) do { _Pragma("unroll") for (int m = 0; m < 4; ++m) _Pragma("unroll") for (int k = 0; k < 2; ++k) dst[m][k] = *(const PG8_LAS bf16x8*)(lds + PG8_SA(b, h) + aoff + m * 2048 + k * 1024); } while (0)
#define PG8_LDB(dst, b, h) do { _Pragma("unroll") for (int n = 0; n < 2; ++n) _Pragma("unroll") for (int k = 0; k < 2; ++k) dst[n][k] = *(const PG8_LAS bf16x8*)(lds + PG8_SB(b, h) + boff + n * 2048 + k * 1024); } while (0)
#define PG8_MMA(ai, bj, At, Bt) do { __builtin_amdgcn_s_setprio(1); _Pragma("unroll") for (int m = 0; m < 4; ++m) _Pragma("unroll") for (int n = 0; n < 2; ++n) _Pragma("unroll") for (int k = 0; k < 2; ++k) \
        acc[ai][bj][m][n] = __builtin_amdgcn_mfma_f32_16x16x32_bf16(Bt[n][k], At[m][k], acc[ai][bj][m][n], 0, 0, 0); __builtin_amdgcn_s_setprio(0); } while (0)
#define PG8_WAIT_V(n) asm volatile("s_waitcnt vmcnt(" #n ")" ::: "memory")
#define PG8_WAIT_L(n) asm volatile("s_waitcnt lgkmcnt(" #n ")" ::: "memory")
#define PG8_BAR __builtin_amdgcn_s_barrier()
#define PG8_SCHED __builtin_amdgcn_sched_barrier(0)
    Unit cur, nxt; int ui = 0;
    if (!S.next(0, cur)) return;
    f32x4 acc[2][2][4][2];
#pragma unroll
    for (int a = 0; a < 2; ++a)
#pragma unroll
        for (int b = 0; b < 2; ++b)
#pragma unroll
            for (int m = 0; m < 4; ++m)
#pragma unroll
                for (int n = 0; n < 2; ++n) acc[a][b][m][n] = (f32x4){0.f, 0.f, 0.f, 0.f};
    bf16x8 At[4][2], B0[2][2], B1[2][2];
    const char* cA = (const char*)g.A + (size_t)cur.pm * tstep; const char* cB = (const char*)g.Bt + (size_t)cur.pn * tstep;
    S.a_ready(cur);
    if constexpr (SP2) {
        PG8_STAGE(PG8_SB(0, 0), cB, voffB); PG8_STAGE(PG8_SB(0, 1), cB + hstep, voffB); PG8_STAGE(PG8_SA(0, 0), cA, voffA); PG8_STAGE(PG8_SA(0, 1), cA + hstep, voffA);
        if (wr == 1) PG8_BAR;
        PG8_WAIT_V(2); PG8_BAR;
        PG8_STAGE(PG8_SB(1, 0), cB + kstep, voffB); PG8_STAGE(PG8_SA(1, 0), cA + kstep, voffA); PG8_STAGE(PG8_SB(1, 1), cB + hstep + kstep, voffB);
        PG8_WAIT_V(6); PG8_BAR;
    } else {
        PG8_STAGE(PG8_SB(0, 0), cB, voffB); PG8_STAGE(PG8_SA(0, 0), cA, voffA); PG8_STAGE(PG8_SB(0, 1), cB + hstep, voffB); PG8_STAGE(PG8_SA(0, 1), cA + hstep, voffA);
        if (wr == 1) PG8_BAR;
        PG8_WAIT_V(4); PG8_BAR;
        PG8_STAGE(PG8_SB(1, 0), cB + kstep, voffB); PG8_STAGE(PG8_SA(1, 0), cA + kstep, voffA); PG8_STAGE(PG8_SB(1, 1), cB + hstep + kstep, voffB);
        PG8_WAIT_V(6); PG8_BAR;
    }
    for (;;) {
        const bool has_next = S.next(ui + 1, nxt);
        const char* nA = has_next ? (const char*)g.A + (size_t)nxt.pm * tstep : cA; const char* nB = has_next ? (const char*)g.Bt + (size_t)nxt.pn * tstep : cB;
        for (int t = 0; t < nt; t += 2) {
            const bool last = (t == nt - 2);
            const char* a1 = cA + (size_t)(t + 1) * kstep;
            const char* a2 = last ? nA : cA + (size_t)(t + 2) * kstep; const char* b2 = last ? nB : cB + (size_t)(t + 2) * kstep;
            const char* a3 = a2 + kstep; const char* b3 = b2 + kstep;
            if (last && has_next) S.a_ready(nxt);
            if constexpr (SP2) {
            PG8_LDB(B0, 0, 0); PG8_LDB(B1, 0, 1); PG8_SCHED; PG8_LDA(At, 0, 0); PG8_STAGE(PG8_SA(1, 1), a1 + hstep, voffA);
            PG8_WAIT_V(8); PG8_WAIT_L(0); PG8_BAR; PG8_MMA(0, 0, At, B0); PG8_MMA(0, 1, At, B1); PG8_BAR; PG8_SCHED;
            PG8_LDA(At, 0, 1); PG8_STAGE(PG8_SB(0, 0), b2, voffB); PG8_STAGE(PG8_SB(0, 1), b2 + hstep, voffB); PG8_STAGE(PG8_SA(0, 0), a2, voffA);
            PG8_WAIT_V(8); PG8_WAIT_L(0); PG8_BAR; PG8_MMA(1, 0, At, B0); PG8_MMA(1, 1, At, B1); PG8_BAR; PG8_SCHED;
            PG8_LDB(B0, 1, 0); PG8_LDB(B1, 1, 1); PG8_SCHED; PG8_LDA(At, 1, 0); PG8_STAGE(PG8_SA(0, 1), a2 + hstep, voffA);
            PG8_WAIT_V(8); PG8_WAIT_L(0); PG8_BAR; PG8_MMA(0, 0, At, B0); PG8_MMA(0, 1, At, B1); PG8_BAR; PG8_SCHED;
            PG8_LDA(At, 1, 1); PG8_STAGE(PG8_SB(1, 0), b3, voffB); PG8_STAGE(PG8_SB(1, 1), b3 + hstep, voffB); PG8_STAGE(PG8_SA(1, 0), a3, voffA);
            PG8_WAIT_V(8); PG8_WAIT_L(0); PG8_BAR; PG8_MMA(1, 0, At, B0); PG8_MMA(1, 1, At, B1); PG8_BAR; PG8_SCHED;
            } else {
            PG8_LDB(B0, 0, 0); PG8_SCHED; PG8_LDA(At, 0, 0); PG8_STAGE(PG8_SA(1, 1), a1 + hstep, voffA);
            PG8_WAIT_L(8); PG8_BAR; PG8_WAIT_L(0); PG8_MMA(0, 0, At, B0); PG8_BAR; PG8_SCHED;
            PG8_LDB(B1, 0, 1); PG8_STAGE(PG8_SB(0, 0), b2, voffB);
            PG8_BAR; PG8_WAIT_L(0); PG8_MMA(0, 1, At, B1); PG8_BAR;
            PG8_LDA(At, 0, 1); PG8_STAGE(PG8_SA(0, 0), a2, voffA);
            PG8_BAR; PG8_WAIT_L(0); PG8_MMA(1, 0, At, B0); PG8_BAR; PG8_SCHED;
            PG8_STAGE(PG8_SB(0, 1), b2 + hstep, voffB);
            PG8_WAIT_V(6); PG8_BAR; PG8_MMA(1, 1, At, B1); PG8_BAR;
            PG8_LDB(B0, 1, 0); PG8_SCHED; PG8_LDA(At, 1, 0); PG8_STAGE(PG8_SA(0, 1), a2 + hstep, voffA);
            PG8_WAIT_L(8); PG8_BAR; PG8_WAIT_L(0); PG8_MMA(0, 0, At, B0); PG8_BAR; PG8_SCHED;
            PG8_LDB(B1, 1, 1); PG8_STAGE(PG8_SB(1, 0), b3, voffB);
            PG8_BAR; PG8_WAIT_L(0); PG8_MMA(0, 1, At, B1); PG8_BAR;
            PG8_LDA(At, 1, 1); PG8_STAGE(PG8_SA(1, 0), a3, voffA);
            PG8_BAR; PG8_WAIT_L(0); PG8_MMA(1, 0, At, B0); PG8_BAR; PG8_SCHED;
            PG8_STAGE(PG8_SB(1, 1), b3 + hstep, voffB);
            PG8_WAIT_V(6); PG8_BAR; PG8_MMA(1, 1, At, B1); PG8_BAR;
            }
        }
        if constexpr (ALIGN_EPI) { if (wr == 0) PG8_BAR; }
        if constexpr (!Epi::AFTER_DRAIN) { E(acc, cur, wr, wc, fr, fq); S.done(cur); }
        if (!has_next) break;
#pragma unroll
        for (int a = 0; a < 2; ++a)
#pragma unroll
            for (int b = 0; b < 2; ++b)
#pragma unroll
                for (int m = 0; m < 4; ++m)
#pragma unroll
                    for (int n = 0; n < 2; ++n) acc[a][b][m][n] = (f32x4){0.f, 0.f, 0.f, 0.f};
        cur = nxt; cA = nA; cB = nB; ++ui;
        if constexpr (ALIGN_EPI) { if (wr == 1) PG8_BAR; }
    }
    PG8_WAIT_V(0);
    if constexpr (!ALIGN_EPI) { if (wr == 0) PG8_BAR; }
    PG8_BAR;
    if constexpr (Epi::AFTER_DRAIN) { E.fused(acc, cur, wr, wc, fr, fq, lds, wid, lane); S.done(cur); }
#undef PG8_SA
#undef PG8_SB
#undef PG8_STAGE
#undef PG8_LDA
#undef PG8_LDB
#undef PG8_MMA
#undef PG8_WAIT_V
#undef PG8_WAIT_L
#undef PG8_BAR
#undef PG8_SCHED
}
}
namespace att {
#define LAS __attribute__((address_space(3)))
typedef unsigned short bf16_t;
typedef short bf16x8 __attribute__((ext_vector_type(8)));
typedef short s16x4 __attribute__((ext_vector_type(4)));
typedef float f32x16 __attribute__((ext_vector_type(16)));
typedef float f32x4 __attribute__((ext_vector_type(4)));
typedef unsigned u32x4 __attribute__((ext_vector_type(4)));
typedef unsigned u32x2 __attribute__((ext_vector_type(2)));
constexpr int KP = 144, VP = 264;
constexpr int KBUF = 128 * KP, VBUF = 128 * VP;
constexpr int OFF_K = 0, OFF_V = 2 * KBUF, OFF_B = OFF_V + 2 * VBUF, ATT_LDS = OFF_B + 1024;
#ifndef PIPE128
#define PIPE128 0
#endif
constexpr float RESC_THR = 60.f;
typedef float f32x2_t __attribute__((ext_vector_type(2))); typedef __bf16 bf16x2_t __attribute__((ext_vector_type(2)));
__device__ __forceinline__ unsigned cvtpk(float lo, float hi) { f32x2_t v = {lo, hi}; bf16x2_t b = __builtin_convertvector(v, bf16x2_t); return __builtin_bit_cast(unsigned, b); }
__device__ __forceinline__ float max3f(float a, float b, float c) { float r; asm("v_max3_f32 %0, %1, %2, %3" : "=v"(r) : "v"(a), "v"(b), "v"(c)); return r; }
__device__ __forceinline__ float xhalf_max(float m) { auto rr = __builtin_amdgcn_permlane32_swap(__float_as_uint(m), __float_as_uint(m), false, false); return fmaxf(__uint_as_float(rr[0]), __uint_as_float(rr[1])); }
__device__ __forceinline__ float xhalf_sum(float m) { auto rr = __builtin_amdgcn_permlane32_swap(__float_as_uint(m), __float_as_uint(m), false, false); return __uint_as_float(rr[0]) + __uint_as_float(rr[1]); }

typedef float f32x2v __attribute__((ext_vector_type(2)));
__device__ __forceinline__ void exp_sum_pk(f32x16& P0, f32x16& P1, float m, float& lrow) {
    const f32x2v mv = {m, m}; f32x2v s0 = {0.f, 0.f}, s1 = {0.f, 0.f};
#pragma unroll
    for (int r = 0; r < 16; r += 2) {
        f32x2v a = (f32x2v){P0[r], P0[r + 1]} - mv, b = (f32x2v){P1[r], P1[r + 1]} - mv;
        a.x = __builtin_amdgcn_exp2f(a.x); a.y = __builtin_amdgcn_exp2f(a.y); b.x = __builtin_amdgcn_exp2f(b.x); b.y = __builtin_amdgcn_exp2f(b.y);
        P0[r] = a.x; P0[r + 1] = a.y; P1[r] = b.x; P1[r + 1] = b.y; s0 += a; s1 += b;
    }
    s0 += s1; lrow += s0.x + s0.y;
}
template <int DV, bool CAUSAL, bool BIAS, int VAR = 0>
__device__ __forceinline__ void attn_stream(LAS unsigned char* lds, const bf16_t* Qg, int qpitch, const bf16_t* Kg, int kpitch, const bf16_t* Vtg, int vpitch,
                                            const float* bias, int q0, int ntiles, f32x16 (&o)[DV / 32], const int wv) {
    int tid_ = wv * 64 + hw_lane(); asm volatile("" : "+v"(tid_));
    const int tid = tid_, lane = tid & 63, r32 = lane & 31, hi = lane >> 5, w = __builtin_amdgcn_readfirstlane(tid >> 6);
    constexpr int NV = DV / 32;
    bf16x8 qf[4];
#pragma unroll
    for (int d0 = 0; d0 < 4; ++d0) qf[d0] = *(const bf16x8*)(Qg + (size_t)(q0 + 32 * w + r32) * qpitch + 16 * d0 + 8 * hi);
    const int krow = tid >> 3, kch = tid & 7, vrow = tid >> 4, vch = tid & 15;
    const bf16_t* ksrc = Kg + (size_t)krow * kpitch + kch * 8;
    const bf16_t* vsrc = Vtg + (size_t)vrow * vpitch + vch * 8;
    const unsigned kdst = OFF_K + krow * KP + kch * 16, vdst = OFF_V + vrow * VP + vch * 16;
    u32x4 kreg[2], vreg[NV]; f32x4 breg = {0.f, 0.f, 0.f, 0.f};
#define ATT_LOAD(t) do { \
        _Pragma("unroll") for (int i = 0; i < 2; ++i) kreg[i] = *(const u32x4*)(ksrc + (size_t)(128 * (t) + 64 * i) * kpitch); \
        _Pragma("unroll") for (int i = 0; i < NV; ++i) vreg[i] = *(const u32x4*)(vsrc + (size_t)(32 * i) * vpitch + 128 * (t)); \
        if (BIAS) { if (tid < 32) breg = *(const f32x4*)(bias + 128 * (t) + 4 * tid); } } while (0)
#define ATT_STORE(buf) do { \
        _Pragma("unroll") for (int i = 0; i < 2; ++i) *(LAS u32x4*)(lds + kdst + (buf) * KBUF + i * 64 * KP) = kreg[i]; \
        _Pragma("unroll") for (int i = 0; i < NV; ++i) { *(LAS u32x2*)(lds + vdst + (buf) * VBUF + i * 32 * VP) = (u32x2){vreg[i].x, vreg[i].y}; *(LAS u32x2*)(lds + vdst + (buf) * VBUF + i * 32 * VP + 8) = (u32x2){vreg[i].z, vreg[i].w}; } \
        if (BIAS) { if (tid < 32) *(LAS f32x4*)(lds + OFF_B + (buf) * 512 + 16 * tid) = breg; } } while (0)
    ATT_LOAD(0);
    ATT_STORE(0);
    __syncthreads();
    float mrow = -1e30f, lrow = 0.f;
#pragma unroll
    for (int d0 = 0; d0 < DV / 32; ++d0)
#pragma unroll
        for (int r = 0; r < 16; ++r) o[d0][r] = 0.f;
    const int qmin = q0 + 32 * w;
#define ATT_KLOAD(P0, P1, buf, sub) do { \
        LAS unsigned char* Ks_ = lds + OFF_K + (buf) * KBUF + (sub) * 64 * KP; \
        _Pragma("unroll") for (int d0 = 0; d0 < 4; ++d0) { kf[2 * d0] = *(LAS bf16x8*)(Ks_ + r32 * KP + (2 * d0 + hi) * 16); kf[2 * d0 + 1] = *(LAS bf16x8*)(Ks_ + (32 + r32) * KP + (2 * d0 + hi) * 16); } \
        if (BIAS) { LAS unsigned char* Bs_ = lds + OFF_B + (buf) * 512 + (sub) * 256; \
            _Pragma("unroll") for (int g = 0; g < 4; ++g) { const f32x4 b0 = *(LAS f32x4*)(Bs_ + (8 * g + 4 * hi) * 4), b1 = *(LAS f32x4*)(Bs_ + (32 + 8 * g + 4 * hi) * 4); \
                _Pragma("unroll") for (int e = 0; e < 4; ++e) { P0[4 * g + e] = b0[e]; P1[4 * g + e] = b1[e]; } } \
        } else { _Pragma("unroll") for (int r = 0; r < 16; ++r) { P0[r] = 0.f; P1[r] = 0.f; } } \
        __builtin_amdgcn_sched_barrier(0); } while (0)
#define ATT_QKM(P0, P1) do { \
        _Pragma("unroll") for (int d0 = 0; d0 < 4; ++d0) { \
            P0 = __builtin_amdgcn_mfma_f32_32x32x16_bf16(kf[2 * d0], qf[d0], P0, 0, 0, 0); \
            P1 = __builtin_amdgcn_mfma_f32_32x32x16_bf16(kf[2 * d0 + 1], qf[d0], P1, 0, 0, 0); } \
        __builtin_amdgcn_sched_barrier(0); } while (0)
#define ATT_VLOAD(buf, sub, KK0, NKK) do { \
        LAS unsigned char* Vs_ = lds + OFF_V + (buf) * VBUF + (sub) * 128; \
        _Pragma("unroll") for (int kk = 0; kk < (NKK); ++kk) _Pragma("unroll") for (int d0 = 0; d0 < DV / 32; ++d0) { \
            const LAS unsigned char* vp = Vs_ + (32 * d0 + r32) * VP + (16 * ((KK0) + kk) + 4 * hi) * 2; \
            const s16x4 lo = *(const LAS s16x4*)vp, hh = *(const LAS s16x4*)(vp + 16); \
            vf[kk * (DV / 32) + d0] = (bf16x8){lo[0], lo[1], lo[2], lo[3], hh[0], hh[1], hh[2], hh[3]}; } \
        __builtin_amdgcn_sched_barrier(0); } while (0)
#define ATT_SM(P0, P1, kv0) do { \
        if (CAUSAL && ((kv0) + 63 > qmin)) { const int qrel = qmin + r32 - (kv0); \
            _Pragma("unroll") for (int r = 0; r < 16; ++r) { const int kv = (r & 3) + 8 * (r >> 2) + 4 * hi; if (kv > qrel) P0[r] = -1e30f; if (kv + 32 > qrel) P1[r] = -1e30f; } } \
        float mt = max3f(P0[0], P1[0], P0[1]), mu = max3f(P1[1], P0[2], P1[2]); \
        _Pragma("unroll") for (int r = 3; r < 15; r += 2) { mt = max3f(mt, P0[r], P1[r]); mu = max3f(mu, P0[r + 1], P1[r + 1]); } \
        mt = max3f(mt, P0[15], P1[15]); mt = max3f(mt, mu, mu); \
        mt = xhalf_max(mt); \
        if (__builtin_amdgcn_ballot_w64(mt > mrow + RESC_THR) != 0ull) { \
            const float mnew = fmaxf(mrow, mt), alpha = __builtin_amdgcn_exp2f(mrow - mnew); mrow = mnew; lrow *= alpha; \
            _Pragma("unroll") for (int d0 = 0; d0 < DV / 32; ++d0) _Pragma("unroll") for (int r = 0; r < 16; ++r) o[d0][r] *= alpha; } \
        exp_sum_pk(P0, P1, mrow, lrow); \
        { u32x4 x; x.x = cvtpk(P0[0], P0[1]); x.y = cvtpk(P0[2], P0[3]); x.z = cvtpk(P0[4], P0[5]); x.w = cvtpk(P0[6], P0[7]); pb[0] = __builtin_bit_cast(bf16x8, x); \
          x.x = cvtpk(P0[8], P0[9]); x.y = cvtpk(P0[10], P0[11]); x.z = cvtpk(P0[12], P0[13]); x.w = cvtpk(P0[14], P0[15]); pb[1] = __builtin_bit_cast(bf16x8, x); \
          x.x = cvtpk(P1[0], P1[1]); x.y = cvtpk(P1[2], P1[3]); x.z = cvtpk(P1[4], P1[5]); x.w = cvtpk(P1[6], P1[7]); pb[2] = __builtin_bit_cast(bf16x8, x); \
          x.x = cvtpk(P1[8], P1[9]); x.y = cvtpk(P1[10], P1[11]); x.z = cvtpk(P1[12], P1[13]); x.w = cvtpk(P1[14], P1[15]); pb[3] = __builtin_bit_cast(bf16x8, x); } \
        __builtin_amdgcn_sched_barrier(0); } while (0)
#define ATT_PVM(KK0, NKK) do { \
        _Pragma("unroll") for (int kk = 0; kk < (NKK); ++kk) _Pragma("unroll") for (int d0 = 0; d0 < DV / 32; ++d0) \
            o[d0] = __builtin_amdgcn_mfma_f32_32x32x16_bf16(vf[kk * (DV / 32) + d0], pb[(KK0) + kk], o[d0], 0, 0, 0); \
        __builtin_amdgcn_sched_barrier(0); } while (0)
    bf16x8 kf[8], vf[8], pb[4];
    if constexpr (DV == 64) {
        f32x16 sa0, sa1, sb0, sb1; bf16x8 pc[4];
        const unsigned kofs = (unsigned)(krow * kpitch + kch * 8) * 2u, vofs = (unsigned)(vrow * vpitch + vch * 8) * 2u, bofs = (unsigned)tid * 16u;
#define ATT_HEAD(P0, P1, kv0, MT) do { \
        if (CAUSAL && ((kv0) + 63 > qmin)) { const int qrel = qmin + r32 - (kv0); \
            _Pragma("unroll") for (int r = 0; r < 16; ++r) { const int kv = (r & 3) + 8 * (r >> 2) + 4 * hi; if (kv > qrel) P0[r] = -1e30f; if (kv + 32 > qrel) P1[r] = -1e30f; } } \
        float mt_ = max3f(P0[0], P1[0], P0[1]), mu_ = max3f(P1[1], P0[2], P1[2]); \
        _Pragma("unroll") for (int r = 3; r < 15; r += 2) { mt_ = max3f(mt_, P0[r], P1[r]); mu_ = max3f(mu_, P0[r + 1], P1[r + 1]); } \
        mt_ = max3f(mt_, P0[15], P1[15]); mt_ = max3f(mt_, mu_, mu_); MT = xhalf_max(mt_); } while (0)
#define ATT_PACK(P0, P1, PB) do { u32x4 x; x.x = cvtpk(P0[0], P0[1]); x.y = cvtpk(P0[2], P0[3]); x.z = cvtpk(P0[4], P0[5]); x.w = cvtpk(P0[6], P0[7]); PB[0] = __builtin_bit_cast(bf16x8, x); \
          x.x = cvtpk(P0[8], P0[9]); x.y = cvtpk(P0[10], P0[11]); x.z = cvtpk(P0[12], P0[13]); x.w = cvtpk(P0[14], P0[15]); PB[1] = __builtin_bit_cast(bf16x8, x); \
          x.x = cvtpk(P1[0], P1[1]); x.y = cvtpk(P1[2], P1[3]); x.z = cvtpk(P1[4], P1[5]); x.w = cvtpk(P1[6], P1[7]); PB[2] = __builtin_bit_cast(bf16x8, x); \
          x.x = cvtpk(P1[8], P1[9]); x.y = cvtpk(P1[10], P1[11]); x.z = cvtpk(P1[12], P1[13]); x.w = cvtpk(P1[14], P1[15]); PB[3] = __builtin_bit_cast(bf16x8, x); } while (0)
#ifndef MIXN
#define MIXN 10
#endif
#define ATT_MIX8() do { if (MIXN > 0) { _Pragma("unroll") for (int i_ = 0; i_ < 8; ++i_) { __builtin_amdgcn_sched_group_barrier(0x008, 1, 0); __builtin_amdgcn_sched_group_barrier(0x402, MIXN, 0); } } } while (0)
        ATT_KLOAD(sa0, sa1, 0, 0); ATT_QKM(sa0, sa1);
        for (int t = 0; t < ntiles; ++t) {
            const int cur = t & 1, nxt = cur ^ 1; const bool more = (t + 1 < ntiles);
            if (more) {
                const char* kt_ = (const char*)(Kg + (size_t)(128 * (t + 1)) * kpitch);
#pragma unroll
                for (int i = 0; i < 2; ++i) kreg[i] = *(const u32x4*)(kt_ + (size_t)(64 * i) * kpitch * 2 + kofs);
                if (BIAS) { if (tid < 32) breg = *(const f32x4*)((const char*)(bias + 128 * (t + 1)) + bofs); } }
            ATT_KLOAD(sb0, sb1, cur, 1);
            { float mt; ATT_HEAD(sa0, sa1, 128 * t, mt);
              if (__builtin_amdgcn_ballot_w64(mt > mrow + RESC_THR) != 0ull) {
                  const float mnew = fmaxf(mrow, mt), alpha = __builtin_amdgcn_exp2f(mrow - mnew); mrow = mnew; lrow *= alpha;
#pragma unroll
                  for (int d0 = 0; d0 < DV / 32; ++d0)
#pragma unroll
                      for (int r = 0; r < 16; ++r) o[d0][r] *= alpha; } }
            __builtin_amdgcn_sched_barrier(0);
#pragma unroll
            for (int d0 = 0; d0 < 4; ++d0) { sb0 = __builtin_amdgcn_mfma_f32_32x32x16_bf16(kf[2 * d0], qf[d0], sb0, 0, 0, 0); sb1 = __builtin_amdgcn_mfma_f32_32x32x16_bf16(kf[2 * d0 + 1], qf[d0], sb1, 0, 0, 0); }
            exp_sum_pk(sa0, sa1, mrow, lrow);
            ATT_PACK(sa0, sa1, pb);
            ATT_MIX8();
            __builtin_amdgcn_sched_barrier(0);
            if (more) {
#pragma unroll
                for (int i = 0; i < 2; ++i) *(LAS u32x4*)(lds + kdst + nxt * KBUF + i * 64 * KP) = kreg[i];
                if (BIAS) { if (tid < 32) *(LAS f32x4*)(lds + OFF_B + nxt * 512 + 16 * tid) = breg; }
                const char* vt_ = (const char*)(Vtg + 128 * (t + 1));
#pragma unroll
                for (int i = 0; i < 2; ++i) kreg[i] = *(const u32x4*)(vt_ + (size_t)(32 * i) * vpitch * 2 + vofs); }
            { LAS unsigned char* Vs_ = lds + OFF_V + cur * VBUF;
#pragma unroll
              for (int kk = 0; kk < 4; ++kk)
#pragma unroll
                  for (int d0 = 0; d0 < 2; ++d0) { const LAS unsigned char* vp = Vs_ + (32 * d0 + r32) * VP + (16 * kk + 4 * hi) * 2;
                      const s16x4 lo = *(const LAS s16x4*)vp, hh = *(const LAS s16x4*)(vp + 16); kf[kk * 2 + d0] = (bf16x8){lo[0], lo[1], lo[2], lo[3], hh[0], hh[1], hh[2], hh[3]}; } }
            float mtb; ATT_HEAD(sb0, sb1, 128 * t + 64, mtb);
            const bool rescb = __builtin_amdgcn_ballot_w64(mtb > mrow + RESC_THR) != 0ull;
            const float mnewb = rescb ? fmaxf(mrow, mtb) : mrow, alphab = __builtin_amdgcn_exp2f(mrow - mnewb);
            float psb = 0.f;
            __builtin_amdgcn_sched_barrier(0);
#pragma unroll
            for (int kk = 0; kk < 4; ++kk)
#pragma unroll
                for (int d0 = 0; d0 < 2; ++d0) o[d0] = __builtin_amdgcn_mfma_f32_32x32x16_bf16(kf[kk * 2 + d0], pb[kk], o[d0], 0, 0, 0);
            exp_sum_pk(sb0, sb1, mnewb, psb);
            ATT_PACK(sb0, sb1, pc);
            ATT_MIX8();
            __builtin_amdgcn_sched_barrier(0);
            { LAS unsigned char* Vs_ = lds + OFF_V + cur * VBUF + 128;
#pragma unroll
              for (int kk = 0; kk < 4; ++kk)
#pragma unroll
                  for (int d0 = 0; d0 < 2; ++d0) { const LAS unsigned char* vp = Vs_ + (32 * d0 + r32) * VP + (16 * kk + 4 * hi) * 2;
                      const s16x4 lo = *(const LAS s16x4*)vp, hh = *(const LAS s16x4*)(vp + 16); kf[kk * 2 + d0] = (bf16x8){lo[0], lo[1], lo[2], lo[3], hh[0], hh[1], hh[2], hh[3]}; } }
            if (rescb) {
#pragma unroll
                for (int d0 = 0; d0 < DV / 32; ++d0)
#pragma unroll
                    for (int r = 0; r < 16; ++r) o[d0][r] *= alphab; }
            lrow = lrow * alphab + psb; mrow = mnewb;
            __builtin_amdgcn_sched_barrier(0);
#pragma unroll
            for (int kk = 0; kk < 4; ++kk)
#pragma unroll
                for (int d0 = 0; d0 < 2; ++d0) o[d0] = __builtin_amdgcn_mfma_f32_32x32x16_bf16(kf[kk * 2 + d0], pc[kk], o[d0], 0, 0, 0);
            __builtin_amdgcn_sched_barrier(0);
            if (more) {
#pragma unroll
                for (int i = 0; i < 2; ++i) { *(LAS u32x2*)(lds + vdst + nxt * VBUF + i * 32 * VP) = (u32x2){kreg[i].x, kreg[i].y}; *(LAS u32x2*)(lds + vdst + nxt * VBUF + i * 32 * VP + 8) = (u32x2){kreg[i].z, kreg[i].w}; } }
            __syncthreads();
            if (more) { ATT_KLOAD(sa0, sa1, nxt, 0); ATT_QKM(sa0, sa1); }
        }
#undef ATT_HEAD
#undef ATT_PACK
#undef ATT_MIX8
    } else if constexpr (DV == 128 && PIPE128) {
#define LOAD_A(t) do { _Pragma("unroll") for (int i = 0; i < 2; ++i) kreg[i] = *(const u32x4*)(ksrc + (size_t)(128 * (t) + 64 * i) * kpitch); \
        _Pragma("unroll") for (int i = 0; i < 2; ++i) vreg[i] = *(const u32x4*)(vsrc + (size_t)(32 * i) * vpitch + 128 * (t)); } while (0)
#define STORE_A(buf) do { _Pragma("unroll") for (int i = 0; i < 2; ++i) *(LAS u32x4*)(lds + kdst + (buf) * KBUF + i * 64 * KP) = kreg[i]; \
        _Pragma("unroll") for (int i = 0; i < 2; ++i) { *(LAS u32x2*)(lds + vdst + (buf) * VBUF + i * 32 * VP) = (u32x2){vreg[i].x, vreg[i].y}; *(LAS u32x2*)(lds + vdst + (buf) * VBUF + i * 32 * VP + 8) = (u32x2){vreg[i].z, vreg[i].w}; } } while (0)
#define LOAD_B(t) do { _Pragma("unroll") for (int i = 0; i < 2; ++i) vreg[i] = *(const u32x4*)(vsrc + (size_t)(32 * (i + 2)) * vpitch + 128 * (t)); } while (0)
#define STORE_B(buf) do { _Pragma("unroll") for (int i = 0; i < 2; ++i) { *(LAS u32x2*)(lds + vdst + (buf) * VBUF + (i + 2) * 32 * VP) = (u32x2){vreg[i].x, vreg[i].y}; *(LAS u32x2*)(lds + vdst + (buf) * VBUF + (i + 2) * 32 * VP + 8) = (u32x2){vreg[i].z, vreg[i].w}; } } while (0)
        f32x16 sa0, sa1, sb0, sb1;
        ATT_KLOAD(sa0, sa1, 0, 0); ATT_QKM(sa0, sa1);
        for (int t = 0; t < ntiles; ++t) {
            const int cur = t & 1, nxt = cur ^ 1; const bool more = (t + 1 < ntiles);
            if (more) LOAD_A(t + 1);
            ATT_KLOAD(sb0, sb1, cur, 1); ATT_QKM(sb0, sb1);
            ATT_VLOAD(cur, 0, 0, 1);
            ATT_SM(sa0, sa1, 128 * t);
            ATT_PVM(0, 1); ATT_VLOAD(cur, 0, 1, 1); ATT_PVM(1, 1); ATT_VLOAD(cur, 0, 2, 1); ATT_PVM(2, 1); ATT_VLOAD(cur, 0, 3, 1); ATT_PVM(3, 1);
            if (more) { STORE_A(nxt); LOAD_B(t + 1); }
            ATT_VLOAD(cur, 1, 0, 1);
            ATT_SM(sb0, sb1, 128 * t + 64);
            ATT_PVM(0, 1); ATT_VLOAD(cur, 1, 1, 1); ATT_PVM(1, 1); ATT_VLOAD(cur, 1, 2, 1); ATT_PVM(2, 1); ATT_VLOAD(cur, 1, 3, 1); ATT_PVM(3, 1);
            if (more) STORE_B(nxt);
            __syncthreads();
            if (more) { ATT_KLOAD(sa0, sa1, nxt, 0); ATT_QKM(sa0, sa1); }
        }
#undef LOAD_A
#undef STORE_A
#undef LOAD_B
#undef STORE_B
    } else {
        f32x16 sa0, sa1;
        for (int t = 0; t < ntiles; ++t) {
            const int cur = t & 1, nxt = cur ^ 1; const bool more = (t + 1 < ntiles);
            if (more) ATT_LOAD(t + 1);
#pragma unroll
            for (int sub = 0; sub < 2; ++sub) {
                if (!(CAUSAL && (128 * t + 64 * sub > qmin + 31))) {
                    ATT_KLOAD(sa0, sa1, cur, sub); ATT_QKM(sa0, sa1);
                    ATT_VLOAD(cur, sub, 0, 1);
                    ATT_SM(sa0, sa1, 128 * t + 64 * sub);
                    ATT_PVM(0, 1);
                    ATT_VLOAD(cur, sub, 1, 1); ATT_PVM(1, 1);
                    ATT_VLOAD(cur, sub, 2, 1); ATT_PVM(2, 1);
                    ATT_VLOAD(cur, sub, 3, 1); ATT_PVM(3, 1);
                }
            }
            if (more) ATT_STORE(nxt);
            __syncthreads();
        }
    }
#undef ATT_KLOAD
#undef ATT_QKM
#undef ATT_VLOAD
#undef ATT_SM
#undef ATT_PVM
#undef ATT_LOAD
#undef ATT_STORE
    const float inv = __builtin_amdgcn_rcpf(xhalf_sum(lrow));
#pragma unroll
    for (int d0 = 0; d0 < DV / 32; ++d0)
#pragma unroll
        for (int r = 0; r < 16; ++r) o[d0][r] *= inv;
}
constexpr int KP2 = 272, KBUF2 = 128 * KP2, OFF_K2 = 0, OFF_V2 = 2 * KBUF2;
template <int SEQ_>
__device__ __forceinline__ void attn_diff_unit(LAS unsigned char* lds, const bf16_t* Qg, const bf16_t* Kg, const bf16_t* Vtg, int q0, int ntiles, float lam, float post,
                                               const float* subln_g, bf16_t* mixbase, const int wv) {
    constexpr int DV = 128;
    int tid_ = wv * 64 + hw_lane(); asm volatile("" : "+v"(tid_));
    const int tid = tid_, lane = tid & 63, r32 = lane & 31, hi = lane >> 5, w = __builtin_amdgcn_readfirstlane(tid >> 6), wr = w & 3, strm = w >> 2;
    bf16x8 qf[4];
#pragma unroll
    for (int d0 = 0; d0 < 4; ++d0) qf[d0] = *(const bf16x8*)(Qg + (size_t)(q0 + 32 * wr + r32) * 768 + 64 * strm + 16 * d0 + 8 * hi);
    const int srow = tid >> 4, sch = tid & 15;
    const bf16_t* ksrc = Kg + (size_t)srow * 768 + sch * 8;
    const bf16_t* vsrc = Vtg + (size_t)srow * SEQ_ + sch * 8;
    const unsigned kdst = OFF_K2 + srow * KP2 + sch * 16, vdst = OFF_V2 + srow * VP + sch * 16;
    u32x4 sreg[4];
#define D_LOADK(t) do { _Pragma("unroll") for (int i = 0; i < 4; ++i) sreg[i] = *(const u32x4*)(ksrc + (size_t)(128 * (t) + 32 * i) * 768); } while (0)
#define D_STOREK(buf) do { _Pragma("unroll") for (int i = 0; i < 4; ++i) *(LAS u32x4*)(lds + kdst + (buf) * KBUF2 + i * 32 * KP2) = sreg[i]; } while (0)
#define D_LOADV(t) do { _Pragma("unroll") for (int i = 0; i < 4; ++i) sreg[i] = *(const u32x4*)(vsrc + (size_t)(32 * i) * SEQ_ + 128 * (t)); } while (0)
#define D_STOREV(buf) do { _Pragma("unroll") for (int i = 0; i < 4; ++i) { *(LAS u32x2*)(lds + vdst + (buf) * VBUF + i * 32 * VP) = (u32x2){sreg[i].x, sreg[i].y}; *(LAS u32x2*)(lds + vdst + (buf) * VBUF + i * 32 * VP + 8) = (u32x2){sreg[i].z, sreg[i].w}; } } while (0)
    D_LOADK(0); D_STOREK(0); D_LOADV(0); D_STOREV(0);
    __syncthreads();
    float mrow = -1e30f, lrow = 0.f;
    f32x16 o[4];
#pragma unroll
    for (int d0 = 0; d0 < 4; ++d0)
#pragma unroll
        for (int r = 0; r < 16; ++r) o[d0][r] = 0.f;
    const int qmin = q0 + 32 * wr;
    bf16x8 kf[8], vf[4], vg[4], pb[4];
    f32x16 p0, p1;
#define D_SUB(buf, sub, kv0) do { if (!((kv0) > qmin + 31)) { \
        LAS unsigned char* Ks_ = lds + OFF_K2 + (buf) * KBUF2 + (sub) * 64 * KP2 + strm * 128; \
        _Pragma("unroll") for (int d0 = 0; d0 < 4; ++d0) { kf[2 * d0] = *(LAS bf16x8*)(Ks_ + r32 * KP2 + (2 * d0 + hi) * 16); kf[2 * d0 + 1] = *(LAS bf16x8*)(Ks_ + (32 + r32) * KP2 + (2 * d0 + hi) * 16); } \
        _Pragma("unroll") for (int r = 0; r < 16; ++r) { p0[r] = 0.f; p1[r] = 0.f; } \
        __builtin_amdgcn_sched_barrier(0); \
        _Pragma("unroll") for (int d0 = 0; d0 < 4; ++d0) { \
            p0 = __builtin_amdgcn_mfma_f32_32x32x16_bf16(kf[2 * d0], qf[d0], p0, 0, 0, 0); \
            p1 = __builtin_amdgcn_mfma_f32_32x32x16_bf16(kf[2 * d0 + 1], qf[d0], p1, 0, 0, 0); } \
        __builtin_amdgcn_sched_barrier(0); \
        LAS unsigned char* Vs_ = lds + OFF_V2 + (buf) * VBUF + (sub) * 128; \
        D_VLOAD(0); \
        if ((kv0) + 63 > qmin) { const int qrel = qmin + r32 - (kv0); \
            _Pragma("unroll") for (int r = 0; r < 16; ++r) { const int kv = (r & 3) + 8 * (r >> 2) + 4 * hi; if (kv > qrel) p0[r] = -1e30f; if (kv + 32 > qrel) p1[r] = -1e30f; } } \
        float mt = max3f(p0[0], p1[0], p0[1]), mu = max3f(p1[1], p0[2], p1[2]); \
        _Pragma("unroll") for (int r = 3; r < 15; r += 2) { mt = max3f(mt, p0[r], p1[r]); mu = max3f(mu, p0[r + 1], p1[r + 1]); } \
        mt = max3f(mt, p0[15], p1[15]); mt = max3f(mt, mu, mu); \
        mt = xhalf_max(mt); \
        if (__builtin_amdgcn_ballot_w64(mt > mrow + RESC_THR) != 0ull) { \
            const float mnew = fmaxf(mrow, mt), alpha = __builtin_amdgcn_exp2f(mrow - mnew); mrow = mnew; lrow *= alpha; \
            _Pragma("unroll") for (int d0 = 0; d0 < 4; ++d0) _Pragma("unroll") for (int r = 0; r < 16; ++r) o[d0][r] *= alpha; } \
        exp_sum_pk(p0, p1, mrow, lrow); \
        { u32x4 x; x.x = cvtpk(p0[0], p0[1]); x.y = cvtpk(p0[2], p0[3]); x.z = cvtpk(p0[4], p0[5]); x.w = cvtpk(p0[6], p0[7]); pb[0] = __builtin_bit_cast(bf16x8, x); \
          x.x = cvtpk(p0[8], p0[9]); x.y = cvtpk(p0[10], p0[11]); x.z = cvtpk(p0[12], p0[13]); x.w = cvtpk(p0[14], p0[15]); pb[1] = __builtin_bit_cast(bf16x8, x); \
          x.x = cvtpk(p1[0], p1[1]); x.y = cvtpk(p1[2], p1[3]); x.z = cvtpk(p1[4], p1[5]); x.w = cvtpk(p1[6], p1[7]); pb[2] = __builtin_bit_cast(bf16x8, x); \
          x.x = cvtpk(p1[8], p1[9]); x.y = cvtpk(p1[10], p1[11]); x.z = cvtpk(p1[12], p1[13]); x.w = cvtpk(p1[14], p1[15]); pb[3] = __builtin_bit_cast(bf16x8, x); } \
        __builtin_amdgcn_sched_barrier(0); \
        D_VLOADB(1); D_PVM(0); D_VLOAD(2); D_PVMB(1); D_VLOADB(3); D_PVM(2); D_PVMB(3); } } while (0)
#define D_VLOAD(KK) do { _Pragma("unroll") for (int d0 = 0; d0 < 4; ++d0) { \
            const LAS unsigned char* vp = Vs_ + (32 * d0 + r32) * VP + (16 * (KK) + 4 * hi) * 2; \
            const s16x4 lo = *(const LAS s16x4*)vp, hh = *(const LAS s16x4*)(vp + 16); \
            vf[d0] = (bf16x8){lo[0], lo[1], lo[2], lo[3], hh[0], hh[1], hh[2], hh[3]}; } \
        __builtin_amdgcn_sched_barrier(0); } while (0)
#define D_VLOADB(KK) do { _Pragma("unroll") for (int d0 = 0; d0 < 4; ++d0) { \
            const LAS unsigned char* vp = Vs_ + (32 * d0 + r32) * VP + (16 * (KK) + 4 * hi) * 2; \
            const s16x4 lo = *(const LAS s16x4*)vp, hh = *(const LAS s16x4*)(vp + 16); \
            vg[d0] = (bf16x8){lo[0], lo[1], lo[2], lo[3], hh[0], hh[1], hh[2], hh[3]}; } \
        __builtin_amdgcn_sched_barrier(0); } while (0)
#define D_PVMB(KK) do { _Pragma("unroll") for (int d0 = 0; d0 < 4; ++d0) o[d0] = __builtin_amdgcn_mfma_f32_32x32x16_bf16(vg[d0], pb[KK], o[d0], 0, 0, 0); \
        __builtin_amdgcn_sched_barrier(0); } while (0)
#define D_PVM(KK) do { _Pragma("unroll") for (int d0 = 0; d0 < 4; ++d0) o[d0] = __builtin_amdgcn_mfma_f32_32x32x16_bf16(vf[d0], pb[KK], o[d0], 0, 0, 0); \
        __builtin_amdgcn_sched_barrier(0); } while (0)
    for (int t = 0; t < ntiles; ++t) {
        const int cur = t & 1, nxt = cur ^ 1; const bool more = (t + 1 < ntiles);
        if (more) D_LOADK(t + 1);
        D_SUB(cur, 0, 128 * t);
        if (more) { D_STOREK(nxt); D_LOADV(t + 1); }
        D_SUB(cur, 1, 128 * t + 64);
        if (more) D_STOREV(nxt);
        __syncthreads();
    }
#undef D_LOADK
#undef D_STOREK
#undef D_LOADV
#undef D_STOREV
#undef D_SUB
#undef D_VLOAD
#undef D_PVM
#undef D_VLOADB
#undef D_PVMB
    const float inv = __builtin_amdgcn_rcpf(xhalf_sum(lrow));
    const int lane_e = hw_lane(), r32e = lane_e & 31, hie = lane_e >> 5;
    if (strm == 1) {
#pragma unroll
        for (int d0 = 0; d0 < 4; ++d0)
#pragma unroll
            for (int g4 = 0; g4 < 4; ++g4) *(LAS f32x4*)(lds + (((d0 * 4 + g4) * 4 + wr) * 64 + lane_e) * 16) = (f32x4){o[d0][4 * g4] * inv, o[d0][4 * g4 + 1] * inv, o[d0][4 * g4 + 2] * inv, o[d0][4 * g4 + 3] * inv};
    }
    __syncthreads();
    if (strm == 0) {
        float sq = 0.f;
#pragma unroll
        for (int d0 = 0; d0 < 4; ++d0)
#pragma unroll
            for (int g4 = 0; g4 < 4; ++g4) { const f32x4 a = *(LAS f32x4*)(lds + (((d0 * 4 + g4) * 4 + wr) * 64 + lane_e) * 16);
#pragma unroll
                for (int e = 0; e < 4; ++e) { const float y = o[d0][4 * g4 + e] * inv - lam * a[e]; o[d0][4 * g4 + e] = y; sq += y * y; } }
        sq = xhalf_sum(sq);
        const float rn = __builtin_amdgcn_rsqf(sq * (1.0f / 128.0f) + 1e-6f) * post;
        bf16_t* dst = mixbase + (size_t)(q0 + 32 * wr + r32e) * 1024;
#pragma unroll
        for (int d0 = 0; d0 < 4; ++d0)
#pragma unroll
            for (int g4 = 0; g4 < 4; ++g4) { const f32x4 gv = *(const f32x4*)(subln_g + 32 * d0 + 8 * g4 + 4 * hie);
                u32x2 x; x.x = cvtpk(o[d0][4 * g4] * rn * gv[0], o[d0][4 * g4 + 1] * rn * gv[1]); x.y = cvtpk(o[d0][4 * g4 + 2] * rn * gv[2], o[d0][4 * g4 + 3] * rn * gv[3]);
                *(u32x2*)(dst + 32 * d0 + 8 * g4 + 4 * hie) = x; }
    }
}
template <int DV> __device__ __forceinline__ void store_o(bf16_t* dstrow, const f32x16 (&o)[DV / 32], int hi) {
#pragma unroll
    for (int d0 = 0; d0 < DV / 32; ++d0)
#pragma unroll
        for (int g = 0; g < 4; ++g) { u32x2 x; x.x = cvtpk(o[d0][4 * g], o[d0][4 * g + 1]); x.y = cvtpk(o[d0][4 * g + 2], o[d0][4 * g + 3]);
            *(u32x2*)(dstrow + 32 * d0 + 8 * g + 4 * hi) = x; }
}
}
__constant__ float INV_FREQ[32] = {1.000000000e+00f, 7.498942614e-01f, 5.623413324e-01f, 4.216965139e-01f, 3.162277639e-01f, 2.371373773e-01f, 1.778279394e-01f, 1.333521307e-01f, 1.000000015e-01f, 7.498941571e-02f, 5.623413250e-02f, 4.216965288e-02f, 3.162277490e-02f, 2.371373773e-02f, 1.778279431e-02f, 1.333521493e-02f, 9.999999776e-03f, 7.498941850e-03f, 5.623413250e-03f, 4.216964822e-03f, 3.162277630e-03f, 2.371373586e-03f, 1.778279431e-03f, 1.333521446e-03f, 1.000000047e-03f, 7.498942432e-04f, 5.623413017e-04f, 4.216965172e-04f, 3.162277571e-04f, 2.371373703e-04f, 1.778279402e-04f, 1.333521504e-04f};
namespace cg = cooperative_groups;
typedef unsigned short bf16;
typedef float f32x4 __attribute__((ext_vector_type(4)));
typedef unsigned v4u __attribute__((ext_vector_type(4)));
typedef unsigned v2u __attribute__((ext_vector_type(2)));
constexpr int NB = 4, SEQ = 4096, DM = 1024, M = NB * SEQ, NMEM = 256, MM = NB * NMEM, DFF = 2816, NPROJ = 2560, NPROJA = 2816;
constexpr float C2 = 0.125f * 1.4426950408889634f;
constexpr float LAMBDA_INIT = 0.35550906759096934f;
constexpr size_t MiB = 1u << 20;
constexpr size_t WS_CTL = 0;
constexpr size_t WS_SSQ = 1 * MiB;
constexpr size_t WS_SSQM = WS_SSQ + 5 * (size_t)M * 4;
constexpr size_t WS_LF = 2 * MiB;
constexpr size_t WS_COS = 3 * MiB, WS_SIN = 3 * MiB + 512 * 1024;
constexpr size_t WS_INVREV = 2 * MiB + 800 * 1024;
constexpr size_t WS_WA = 4 * MiB, WS_WB = 10 * MiB, WS_WO = 15 * MiB, WS_WM = 19 * MiB, WS_WGU = 21 * MiB, WS_WD = 43 * MiB;
constexpr size_t WS_MEMB = 54 * MiB, WS_MK = 56 * MiB, WS_MVT = 57 * MiB;
constexpr size_t WS_XB = 58 * MiB;
constexpr size_t WS_Q = 90 * MiB, WS_K = 114 * MiB, WS_VT = 138 * MiB, WS_MQ = 162 * MiB, WS_MIX = 170 * MiB, WS_H = 90 * MiB, WS_STASH = 202 * MiB, WS_END = 234 * MiB;
static_assert(WS_H + (size_t)M * DFF * 2 <= WS_END, "h overlay");
constexpr int LDS_BYTES = 147456, LDS_MISC = LDS_BYTES - 1024, LDS_ARGS = LDS_MISC + 256;

constexpr int CW_BAR = 4096;
struct Args {
    const float *x, *mem, *attn_g, *mem_g, *w_mem_kv, *w_out, *ffn_g, *w_gate_up, *w_down, *a_w_in, *a_b_f, *b_w_in, *lq1, *lk1, *lq2, *lk2, *subln_g, *kv_g, *w_kv, *final_g;
    float* out; unsigned char* ws;
};

__device__ __forceinline__ unsigned f2bf(float f) { unsigned u = __builtin_bit_cast(unsigned, f); return (u + 0x7fffu + ((u >> 16) & 1u)) >> 16; }
__device__ __forceinline__ unsigned pk2(float lo, float hi) { return att::cvtpk(lo, hi); }
__device__ __forceinline__ float wave_sum(float v) {
#pragma unroll
    for (int o = 1; o < 64; o <<= 1) v += __shfl_xor(v, o);
    return v;
}
__device__ __forceinline__ void wt_item(const float* W, int ldw, int K, const float* g, bf16* WT, int k0, int c0, int nvalid, int drowA, int drowB, LAS float* scr, int lane) {
    const int kq = lane >> 4, n4 = 4 * (lane & 15);
    f32x4 v[16]; float gk[16];
#pragma unroll
    for (int i = 0; i < 16; ++i) gk[i] = g ? g[k0 + 4 * i + kq] : 1.0f;
#pragma unroll
    for (int i = 0; i < 16; ++i) v[i] = *(const f32x4*)(W + (size_t)(k0 + 4 * i + kq) * ldw + c0 + n4);
    if (g) {
#pragma unroll
        for (int i = 0; i < 16; ++i) v[i] = v[i] * gk[i];
    }
    if (nvalid < 64) {
#pragma unroll
        for (int i = 0; i < 16; ++i)
#pragma unroll
            for (int e = 0; e < 4; ++e) if (n4 + e >= nvalid) v[i][e] = 0.f;
    }
#pragma unroll
    for (int i = 0; i < 16; ++i)
#pragma unroll
        for (int e = 0; e < 4; ++e) scr[(4 * i + kq) * 65 + n4 + e] = v[i][e];
    asm volatile("s_waitcnt lgkmcnt(0)" ::: "memory");
#pragma unroll
    for (int j = 0; j < 8; ++j) { const int q = lane + 64 * j, n = q >> 3, kc = q & 7; const LAS float* s = scr + (8 * kc) * 65 + n;
        v4u o; o.x = pk2(s[0 * 65], s[1 * 65]); o.y = pk2(s[2 * 65], s[3 * 65]); o.z = pk2(s[4 * 65], s[5 * 65]); o.w = pk2(s[6 * 65], s[7 * 65]);
        const int drow = (n < 32) ? drowA + n : drowB + n - 32;
        *(v4u*)(WT + (size_t)drow * K + k0 + 8 * kc) = o; }
    asm volatile("s_waitcnt lgkmcnt(0)" ::: "memory");
}
__device__ __forceinline__ int wt_drow(int l, int drow0, int kind) {
    if (kind == 0) return drow0 + l;
    if (kind == 1) return drow0 + (l / 256) * 256 + ((l >> 5) & 1) * 128 + ((l & 255) >> 6) * 32;
    const int up = l >= DFF ? 1 : 0, j = l - up * DFF; return drow0 + (j / 128) * 256 + up * 128 + (j & 127);
}
__device__ __forceinline__ void wt_job(int it, const float* W, int ldw, int K, int c_src, int ncols, int nvalid, const float* g, bf16* WT, int drow0, int kind, LAS float* scr, int lane) {
    const int nblk = ncols / 64, kb = it / nblk, nb = it % nblk; const int l = nb * 64;
    wt_item(W, ldw, K, g, WT, kb * 64, c_src + l, nvalid, wt_drow(l, drow0, kind), wt_drow(l + 32, drow0, kind), scr, lane);
}
#define XB_TMO      128
#define XB_XCNT(j)  (256  + 64 * (j))
#define XB_XSUB(j)  (1280 + 64 * (j))
#define XB_XGEN(j)  (2304 + 64 * (j))
#define XB_TOP      3328
#define XB_TOPGEN   3392
#define XCD_BAR_WORDS 3456
#define XB_SPIN_CAP (1u << 18)

__device__ __forceinline__ unsigned xb_ld(unsigned* p)              { return __hip_atomic_load(p, __ATOMIC_RELAXED, __HIP_MEMORY_SCOPE_AGENT); }
__device__ __forceinline__ unsigned xb_add(unsigned* p, unsigned v) { return __hip_atomic_fetch_add(p, v, __ATOMIC_RELAXED, __HIP_MEMORY_SCOPE_AGENT); }
__device__ __forceinline__ unsigned xb_xcc_id() { return (unsigned)__builtin_amdgcn_s_getreg((3 << 11) | 20) & 0xFu; }
#define XB_SPIN(cond, bar) do { unsigned _sp = 0; while (cond) { __builtin_amdgcn_s_sleep(1); \
    if ((++_sp & 255u) == 0u) { if (xb_ld(&(bar)[XB_TMO])) break; if (_sp > XB_SPIN_CAP) { atomicAdd(&(bar)[XB_TMO], 1u); break; } } } } while (0)

struct XcdBarrier {
    unsigned* bar; unsigned x; int wv;
    volatile LAS unsigned* st;
};

__device__ __forceinline__ XcdBarrier xcd_barrier_post(unsigned* bar, volatile LAS unsigned* st) {
    XcdBarrier b; b.bar = bar; b.x = xb_xcc_id(); b.st = st; b.wv = 0;
    if (threadIdx.x == 0) (void)xb_add(&bar[XB_XCNT(b.x)], 1u);
    return b;
}
__device__ __forceinline__ void xcd_barrier_complete(unsigned* bar, unsigned x, unsigned& nloc, unsigned& nx) {
    const unsigned G = gridDim.x * gridDim.y * gridDim.z;
    unsigned sum, cnt, mine, sp = 0u;
    for (;;) {
        sum = 0u; cnt = 0u; mine = 0u;
#pragma unroll
        for (unsigned j = 0; j < 16; ++j) { const unsigned c = xb_ld(&bar[XB_XCNT(j)]); sum += c; cnt += (c > 0u) ? 1u : 0u; mine = (j == x) ? c : mine; }
        if (sum == G) break;
        __builtin_amdgcn_s_sleep(1);
        if ((++sp & 255u) == 0u) { if (xb_ld(&bar[XB_TMO])) break; if (sp > XB_SPIN_CAP) { atomicAdd(&bar[XB_TMO], 1u); break; } }
    }
    nloc = mine > 0u ? mine : 1u; nx = cnt > 0u ? cnt : 1u;
}

__device__ __forceinline__ void xcd_barrier(const XcdBarrier& b) {
    asm volatile("s_waitcnt vmcnt(0)" ::: "memory");
    __syncthreads();
    if (b.wv * 64 + hw_lane() == 0) {
        unsigned* bar = b.bar;
        __builtin_amdgcn_s_waitcnt(0);
        unsigned nloc = b.st[0], nx = b.st[1];
        if (nloc == 0u) { xcd_barrier_complete(bar, b.x, nloc, nx); b.st[0] = nloc; b.st[1] = nx; }
        const unsigned old = xb_add(&bar[XB_XSUB(b.x)], 1u);
        const unsigned gen = old / nloc;
        if (old + 1u == (gen + 1u) * nloc) {
            __builtin_amdgcn_fence(__ATOMIC_RELEASE, "agent");
            asm volatile("s_waitcnt vmcnt(0)" ::: "memory");
            const unsigned og = xb_add(&bar[XB_TOP], 1u);
            const unsigned tg = og / nx;
            if (og + 1u == (tg + 1u) * nx) xb_add(&bar[XB_TOPGEN], 1u);
            else XB_SPIN(xb_ld(&bar[XB_TOPGEN]) == tg, bar);
            __builtin_amdgcn_fence(__ATOMIC_ACQUIRE, "agent");
            xb_add(&bar[XB_XGEN(b.x)], 1u);
            asm volatile("s_waitcnt vmcnt(0)" ::: "memory");
        } else {
            XB_SPIN(xb_ld(&bar[XB_XGEN(b.x)]) == gen, bar);
            __builtin_amdgcn_fence(__ATOMIC_ACQUIRE, "agent");
            asm volatile("s_waitcnt vmcnt(0)" ::: "memory");
        }
    }
    __syncthreads();
}
#ifndef NREP_SYNC
#define NREP_SYNC 0
#endif
#ifndef NREP2
#define NREP2 1
#endif
#ifndef NREP7
#define NREP7 1
#endif
#ifndef NREP4
#define NREP4 1
#endif
#ifndef NREP1
#define NREP1 1
#endif
#ifndef NREP0
#define NREP0 1
#endif
#ifndef NREP35
#define NREP35 1
#endif
#ifndef PREREAD
#define PREREAD 0
#endif
#ifndef NREPB
#define NREPB 1
#endif
#ifndef USE_XB
#define USE_XB 1
#endif
#ifndef PVAR
#define PVAR 0
#endif
#ifndef PH_MASK
#define PH_MASK 0xFFFF
#endif
__device__ __forceinline__ void scan_bh(float* lf, LAS float* sm, int tid) {
    const f32x4 a = *(const f32x4*)(lf + 8 * tid), b = *(const f32x4*)(lf + 8 * tid + 4);
    float v[8] = {a[0], a[1], a[2], a[3], b[0], b[1], b[2], b[3]};
#pragma unroll
    for (int i = 1; i < 8; ++i) v[i] += v[i - 1];
    float tot = v[7]; const int lane = tid & 63, w = tid >> 6;
    float inc = tot;
#pragma unroll
    for (int o = 1; o < 64; o <<= 1) { const float n = __shfl_up(inc, o); if (lane >= o) inc += n; }
    if (lane == 63) sm[w] = inc;
    __syncthreads();
    float base = inc - tot;
    for (int i = 0; i < w; ++i) base += sm[i];
    const float k = -1.4426950408889634f;
    f32x4 oa, ob;
#pragma unroll
    for (int i = 0; i < 4; ++i) { oa[i] = (v[i] + base) * k; ob[i] = (v[4 + i] + base) * k; }
    *(f32x4*)(lf + 8 * tid) = oa; *(f32x4*)(lf + 8 * tid + 4) = ob;
    __syncthreads();
}

enum { AX = 0, AMEM, AATTN_G, AMEM_G, AW_MEM_KV, AW_OUT, AFFN_G, AW_GATE_UP, AW_DOWN, AA_W_IN, AA_B_F, AB_W_IN, ALQ1, ALK1, ALQ2, ALK2, ASUBLN_G, AKV_G, AW_KV, AFINAL_G, AOUT, AWS };
__device__ __forceinline__ const float* argp(LAS unsigned char* lds, int i) {
    volatile LAS unsigned* p = (volatile LAS unsigned*)(lds + LDS_ARGS + 8 * i);
    const unsigned lo = __builtin_amdgcn_readfirstlane(p[0]), hi = __builtin_amdgcn_readfirstlane(p[1]);
    return (const float*)(__attribute__((address_space(1))) const float*)(((unsigned long long)hi << 32) | (unsigned long long)lo);
}
#define WSPTRS() \
    unsigned char* ws = (unsigned char*)argp(lds, AWS); \
    unsigned* ctl = (unsigned*)(ws + WS_CTL); float* ssq = (float*)(ws + WS_SSQ); float* ssqm = (float*)(ws + WS_SSQM); \
    float* LF = (float*)(ws + WS_LF); float* COS = (float*)(ws + WS_COS); float* SIN = (float*)(ws + WS_SIN); \
    bf16 *WA = (bf16*)(ws + WS_WA), *WB = (bf16*)(ws + WS_WB), *WO = (bf16*)(ws + WS_WO), *WM = (bf16*)(ws + WS_WM), *WGU = (bf16*)(ws + WS_WGU), *WD = (bf16*)(ws + WS_WD); \
    bf16 *MEMB = (bf16*)(ws + WS_MEMB), *MK = (bf16*)(ws + WS_MK), *MVT = (bf16*)(ws + WS_MVT), *XB = (bf16*)(ws + WS_XB); \
    bf16 *Qb = (bf16*)(ws + WS_Q), *Kb = (bf16*)(ws + WS_K), *VT = (bf16*)(ws + WS_VT), *MQ = (bf16*)(ws + WS_MQ), *MIX = (bf16*)(ws + WS_MIX), *H = (bf16*)(ws + WS_H); \
    (void)ctl; (void)ssq; (void)ssqm; (void)LF; (void)COS; (void)SIN; (void)WA; (void)WB; (void)WO; (void)WM; (void)WGU; (void)WD; (void)MEMB; (void)MK; (void)MVT; (void)XB; (void)Qb; (void)Kb; (void)VT; (void)MQ; (void)MIX; (void)H;

constexpr int I1 = 16 * 36, I2 = 16 * 4, IF_ = 16, I3 = 16 * 12, I4 = 16 * 12, I5 = 16 * 12, I6 = 16 * 4, I7 = 16 * 16, I9 = 16 * 8, I11 = 16 * 88, I13 = 44 * 16;
constexpr int WT_A = I11 + I13 + I1 + I2 + IF_ + I7 + 2 * I9, WT_B1 = I3 + I4 + I5 + I6, WT_B2 = I11, WT_B3 = I7 + I13;
#define WT_SRCS() const float *a_w_in = argp(lds, AA_W_IN), *attn_g = argp(lds, AATTN_G), *w_kv = argp(lds, AW_KV), *kv_g = argp(lds, AKV_G), *b_w_in = argp(lds, AB_W_IN), *w_out = argp(lds, AW_OUT); \
    const float *w_mem_kv = argp(lds, AW_MEM_KV), *mem_g = argp(lds, AMEM_G), *w_gate_up = argp(lds, AW_GATE_UP), *ffn_g = argp(lds, AFFN_G), *w_down = argp(lds, AW_DOWN);
#define WT_DISPATCH(it_) do { int r = (it_); \
    if (r < I11) { wt_job(r, w_gate_up, 5632, 1024, 0, 5632, 64, ffn_g, WGU, 0, 2, scr, lane); break; } r -= I11; \
    if (r < I13) { wt_job(r, w_down, 1024, 2816, 0, 1024, 64, nullptr, WD, 0, 0, scr, lane); break; } r -= I13; \
    if (r < I1) { wt_job(r, a_w_in, 2572, 1024, 0, 2304, 64, attn_g, WA, 0, 0, scr, lane); break; } r -= I1; \
    if (r < I2) { wt_job(r, a_w_in, 2572, 1024, 2316, 256, 64, attn_g, WA, 2304, 0, scr, lane); break; } r -= I2; \
    if (r < IF_) { wt_job(r, a_w_in, 2572, 1024, 2304, 64, 12, attn_g, WA, 2560, 0, scr, lane); break; } r -= IF_; \
    if (r < I7) { wt_job(r, w_out, 1024, 1024, 0, 1024, 64, nullptr, WO, 0, 0, scr, lane); break; } r -= I7; \
    if (r < 2 * I9) { const int l = r / I9; wt_job(r % I9, w_mem_kv + (size_t)l * 1024 * 512, 512, 1024, 0, 512, 64, mem_g + 1024 * l, WM, 512 * l, 0, scr, lane); break; } r -= 2 * I9; \
    if (r < I3) { wt_job(r, w_kv, 1536, 1024, 0, 768, 64, kv_g, WB, 0, 1, scr, lane); break; } r -= I3; \
    if (r < I4) { wt_job(r, w_kv, 1536, 1024, 768, 768, 64, kv_g, WB, 768, 0, scr, lane); break; } r -= I4; \
    if (r < I5) { wt_job(r, b_w_in, 1024, 1024, 0, 768, 64, attn_g + 1024, WB, 1536, 1, scr, lane); break; } r -= I5; \
    if (r < I6) { wt_job(r, b_w_in, 1024, 1024, 768, 256, 64, attn_g + 1024, WB, 2304, 0, scr, lane); break; } r -= I6; \
    if (r < I11) { wt_job(r, w_gate_up + (size_t)1024 * 5632, 5632, 1024, 0, 5632, 64, ffn_g + 1024, WGU + (size_t)5632 * 1024, 0, 2, scr, lane); break; } r -= I11; \
    if (r < I7) { wt_job(r, w_out + (size_t)1024 * 1024, 1024, 1024, 0, 1024, 64, nullptr, WO + (size_t)1024 * 1024, 0, 0, scr, lane); break; } r -= I7; \
    wt_job(r, w_down + (size_t)2816 * 1024, 1024, 2816, 0, 1024, 64, nullptr, WD + (size_t)1024 * 2816, 0, 0, scr, lane); } while (0)
#define WT_IDLE(first, lo, hi) do { const int f_ = (first) < G ? (first) : 0;        \
    if (bx >= f_) { WSPTRS(); PHASE_IDS(); WT_SRCS(); LAS float* scr = (LAS float*)(lds + wave * 16640); \
        for (int it = (lo) + (bx - f_) * 8 + wave; it < (hi); it += (G - f_) * 8) WT_DISPATCH(it); __syncthreads(); } } while (0)

__global__ void __launch_bounds__(512, 2) yoco_fwd(Args A) {
    extern __shared__ __attribute__((aligned(16))) unsigned char lds_raw[];
    LAS unsigned char* lds = (LAS unsigned char*)lds_raw;
#if USE_XB
    if (threadIdx.x < 2) ((volatile LAS unsigned*)(lds + LDS_MISC + 128))[threadIdx.x] = 0u;
    __syncthreads();
    XcdBarrier xbar = xcd_barrier_post((unsigned*)(A.ws + WS_CTL) + CW_BAR, (volatile LAS unsigned*)(lds + LDS_MISC + 128));
#define GRID_SYNC() xcd_barrier(xbar)
#else
    cg::grid_group grid = cg::this_grid();
#define GRID_SYNC() grid.sync()
#endif
    const int G = gridDim.x, bx = blockIdx.x;
    const int wave0 = __builtin_amdgcn_readfirstlane((int)threadIdx.x >> 6);
#define HW_TID() (wave0 * 64 + hw_lane())
#if USE_XB
    xbar.wv = wave0;
#endif
    if (threadIdx.x == 0) {
        LAS unsigned long long* P = (LAS unsigned long long*)(lds + LDS_ARGS);
        P[AX] = (unsigned long long)A.x; P[AMEM] = (unsigned long long)A.mem; P[AATTN_G] = (unsigned long long)A.attn_g; P[AMEM_G] = (unsigned long long)A.mem_g;
        P[AW_MEM_KV] = (unsigned long long)A.w_mem_kv; P[AW_OUT] = (unsigned long long)A.w_out; P[AFFN_G] = (unsigned long long)A.ffn_g; P[AW_GATE_UP] = (unsigned long long)A.w_gate_up;
        P[AW_DOWN] = (unsigned long long)A.w_down; P[AA_W_IN] = (unsigned long long)A.a_w_in; P[AA_B_F] = (unsigned long long)A.a_b_f; P[AB_W_IN] = (unsigned long long)A.b_w_in;
        P[ALQ1] = (unsigned long long)A.lq1; P[ALK1] = (unsigned long long)A.lk1; P[ALQ2] = (unsigned long long)A.lq2; P[ALK2] = (unsigned long long)A.lk2;
        P[ASUBLN_G] = (unsigned long long)A.subln_g; P[AKV_G] = (unsigned long long)A.kv_g; P[AW_KV] = (unsigned long long)A.w_kv; P[AFINAL_G] = (unsigned long long)A.final_g;
        P[AOUT] = (unsigned long long)A.out; P[AWS] = (unsigned long long)A.ws;
    }
    __syncthreads();
#define PHASE_IDS() int tid_ = HW_TID(); asm volatile("" : "+v"(tid_)); const int tid = tid_, lane = tid & 63, wave = __builtin_amdgcn_readfirstlane(tid >> 6); \
    const int gw = bx * 8 + wave, NGW = G * 8, gt = bx * 512 + tid, NGT = G * 512; (void)lane; (void)gw; (void)NGW; (void)gt; (void)NGT;

    for (int rep0_ = 0; rep0_ < NREP0; ++rep0_) {
        WSPTRS(); PHASE_IDS();
        const float *a_w_in = argp(lds, AA_W_IN), *attn_g = argp(lds, AATTN_G), *w_kv = argp(lds, AW_KV), *kv_g = argp(lds, AKV_G), *b_w_in = argp(lds, AB_W_IN), *w_out = argp(lds, AW_OUT);
        const float *w_mem_kv = argp(lds, AW_MEM_KV), *mem_g = argp(lds, AMEM_G), *w_gate_up = argp(lds, AW_GATE_UP), *ffn_g = argp(lds, AFFN_G), *w_down = argp(lds, AW_DOWN);
        const float *xin = argp(lds, AX), *memin = argp(lds, AMEM), *a_b_f = argp(lds, AA_B_F);
#if PREREAD
        {
            float acc_ = 0.f;
#define PRE_(ptr, n) for (int i = gt; i < (n) / 4; i += NGT) { const f32x4 v = ((const f32x4*)(ptr))[i]; acc_ += (v[0] + v[1]) + (v[2] + v[3]); }
            PRE_(w_gate_up, 2 * 1024 * 5632) PRE_(w_down, 2 * 2816 * 1024) PRE_(a_w_in, 1024 * 2572) PRE_(w_kv, 1024 * 1536) PRE_(b_w_in, 1024 * 1024) PRE_(w_out, 2 * 1024 * 1024) PRE_(w_mem_kv, 2 * 1024 * 512)
#undef PRE_
            if (acc_ == 1.2345e38f) ctl[63] = 1u;
        }
#endif
        LAS float* scr = (LAS float*)(lds + wave * 16640);
        {
            constexpr int o_WA = I11 + I13, o_WO0 = o_WA + I1 + I2 + IF_, o_WM = o_WO0 + I7, n0 = I11, n1 = o_WO0 - o_WA, n2 = 2 * I9;
            for (int j = gw; j < n0 + n1 + n2; j += NGW) { const int it = j < n0 ? j : (j < n0 + n1 ? o_WA + (j - n0) : o_WM + (j - n0 - n1)); WT_DISPATCH(it); }
        }
        for (int i = gt; i < 192 * 1024 / 8; i += NGT) ((v4u*)(WA + (size_t)2624 * 1024))[i] = (v4u){0u, 0u, 0u, 0u};
        for (int m = 2 * gw; m < M + MM; m += 2 * NGW) {
            const bool ism = m >= M; const float* src = ism ? memin + (size_t)(m - M) * DM : xin + (size_t)m * DM; bf16* dst = ism ? MEMB + (size_t)(m - M) * DM : XB + (size_t)m * DM; float* sdst = ism ? ssqm + (m - M) : ssq + m;
            const f32x4* xr = (const f32x4*)src + lane; f32x4 v[8]; float s0 = 0.f, s1 = 0.f;
#pragma unroll
            for (int j = 0; j < 8; ++j) v[j] = xr[64 * j];
#pragma unroll
            for (int j = 0; j < 4; ++j) { s0 += (v[j][0] * v[j][0] + v[j][1] * v[j][1]) + (v[j][2] * v[j][2] + v[j][3] * v[j][3]); s1 += (v[4 + j][0] * v[4 + j][0] + v[4 + j][1] * v[4 + j][1]) + (v[4 + j][2] * v[4 + j][2] + v[4 + j][3] * v[4 + j][3]); }
            s0 = wave_sum(s0); s1 = wave_sum(s1);
            if (lane == 0) { sdst[0] = s0; sdst[1] = s1; }
            unsigned long long* o8 = (unsigned long long*)dst + lane;
#pragma unroll
            for (int j = 0; j < 8; ++j) o8[64 * j] = (unsigned long long)pk2(v[j][0], v[j][1]) | ((unsigned long long)pk2(v[j][2], v[j][3]) << 32);
        }
        if (gt < 32) ((float*)(ws + WS_INVREV))[gt] = INV_FREQ[gt] * 0.15915494309189535f;
        for (int i = gt; i < 4 * M; i += NGT) ssq[M + i] = 0.f;
        if (gt < 64) ctl[gt] = 0u;
    }
    GRID_SYNC();

#if PH_MASK & (1 << 1)
    {
        WSPTRS(); PHASE_IDS();
        for (int rep_ = 0; rep_ < NREP1; ++rep_) {
        pg8::Gemm g{XB, WA, M, NPROJA, DM}; pg8::StaticOrder S; S.init(M, NPROJA, G, bx);
        pg8::EpiProj E{ssq, COS, SIN, argp(lds, AA_B_F), LF, SEQ, {Qb, 3, 0, 768, C2}, {Kb, 6, 0, 768, 1.f}, {VT, 9, 1, 768, 1.f}, {MQ, 10, 0, 256, C2}, {nullptr, 11, 3, 0, 1.f}};
        pg8::gemm_phase<pg8::EpiProj, pg8::StaticOrder, true, true>(lds, g, S, E, wave0);
        }
    }
    {
        WSPTRS();
        pg8::Gemm g{MEMB, WM, MM, 1024, DM}; pg8::StaticOrder S; S.init(MM, 1024, G, (bx + 64) & 255);
        pg8::EpiProj E{ssqm, COS, SIN, nullptr, nullptr, NMEM, {MK, 1, 0, 256, 1.f}, {MVT, 2, 1, 256, 1.f}, {MK + (size_t)MM * 256, 3, 0, 256, 1.f}, {MVT + (size_t)MM * 256, 4, 1, 256, 1.f}, {nullptr, 5, 0, 0, 1.f}};
        pg8::gemm_phase<pg8::EpiProj, pg8::StaticOrder, true, true>(lds, g, S, E, wave0);
    }
#endif
    WT_IDLE(208, WT_A, WT_A + WT_B1);
    WT_IDLE(208, I11 + I13 + I1 + I2 + IF_, I11 + I13 + I1 + I2 + IF_ + I7);
    GRID_SYNC();

    if (bx < 48) { WSPTRS(); PHASE_IDS(); scan_bh(LF + (size_t)bx * SEQ, (LAS float*)(lds + LDS_MISC + 64), tid); }
    GRID_SYNC();
#if PH_MASK & (1 << 2)
    for (int rep_ = 0; rep_ < NREP2; ++rep_) { WSPTRS(); PHASE_IDS();
    volatile LAS unsigned* qword = (volatile LAS unsigned*)(lds + LDS_MISC);
    bool first_ = true;
    for (;;) {
        if (HW_TID() == 0) qword[0] = first_ ? (unsigned)bx : (unsigned)G + atomicAdd(ctl + 0 + 2 * rep_, 1u);
        first_ = false;
        __syncthreads();
        const int u = (int)qword[0];
        __syncthreads();
        if (u >= 1024) break;
        att::f32x16 o[2];
        if (u < 768) {
            const int qb = 15 - u / 48, bh = u % 48, b = bh / 12, h = bh % 12;
            if (rep_ + 1 < NREP2) att::attn_stream<64, true, true, PVAR>(lds, Qb + (size_t)b * SEQ * 768 + 64 * h, 768, Kb + (size_t)b * SEQ * 768 + 64 * h, 768, VT + (size_t)(b * 768 + 64 * h) * SEQ, SEQ,
                                             LF + (size_t)bh * SEQ, 256 * qb, 2 * (qb + 1), o, wave0);
            else att::attn_stream<64, true, true>(lds, Qb + (size_t)b * SEQ * 768 + 64 * h, 768, Kb + (size_t)b * SEQ * 768 + 64 * h, 768, VT + (size_t)(b * 768 + 64 * h) * SEQ, SEQ,
                                             LF + (size_t)bh * SEQ, 256 * qb, 2 * (qb + 1), o, wave0);
            { const int l2_ = hw_lane(); att::store_o<64>(MIX + (size_t)(b * SEQ + 256 * qb + 32 * wave + (l2_ & 31)) * DM + 64 * h, o, l2_ >> 5); }
        } else {
            const int j = u - 768, b = j >> 6, hm = (j >> 4) & 3, qb = j & 15;
            att::attn_stream<64, false, false>(lds, MQ + (size_t)b * SEQ * 256 + 64 * hm, 256, MK + (size_t)b * NMEM * 256 + 64 * hm, 256, MVT + (size_t)(b * 256 + 64 * hm) * NMEM, NMEM,
                                               nullptr, 256 * qb, 2, o, wave0);
            { const int l2_ = hw_lane(); att::store_o<64>(MIX + (size_t)(b * SEQ + 256 * qb + 32 * wave + (l2_ & 31)) * DM + 768 + 64 * hm, o, l2_ >> 5); }
        }
    } }
#endif
    GRID_SYNC();

#if PH_MASK & (1 << 3)
    for (int rep_ = 0; rep_ < NREP35; ++rep_) {
        WSPTRS(); const float* xin = argp(lds, AX); float* outp = (float*)argp(lds, AOUT);
        pg8::Gemm g{MIX, WO, M, DM, DM}; pg8::StaticOrder S; S.init(M, DM, G, bx);
        pg8::EpiRes E{XB, ssq + M};
        pg8::gemm_phase<pg8::EpiRes, pg8::StaticOrder, true, true>(lds, g, S, E, wave0);
    }
#endif
    GRID_SYNC();
#if PH_MASK & (1 << 4)
    for (int rep_ = 0; rep_ < NREP4; ++rep_) {
        WSPTRS();
        pg8::Gemm g{XB, WGU, M, 2 * DFF, DM}; pg8::StaticOrder S; S.init(M, 2 * DFF, G, bx);
        pg8::EpiGU E{ssq + M, H};
        pg8::gemm_phase<pg8::EpiGU, pg8::StaticOrder, true, true>(lds, g, S, E, wave0);
    }
#endif
    WT_IDLE(128, WT_A + WT_B1, WT_A + WT_B1 + WT_B2);
    WT_IDLE(128, I11, I11 + I13);
    GRID_SYNC();
#if PH_MASK & (1 << 5)
    for (int rep_ = 0; rep_ < NREP35; ++rep_) {
        WSPTRS(); float* outp = (float*)argp(lds, AOUT);
        pg8::Gemm g{H, WD, M, DM, DFF}; pg8::StaticOrder S; S.init(M, DM, G, bx);
        pg8::EpiRes E{XB, ssq + 2 * M};
        pg8::gemm_phase<pg8::EpiRes, pg8::StaticOrder, true, true>(lds, g, S, E, wave0);
    }
#endif
    GRID_SYNC();
#if PH_MASK & (1 << 6)
    for (int rep_ = 0; rep_ < NREPB; ++rep_) {
        WSPTRS();
        pg8::Gemm g{XB, WB, M, NPROJ, DM}; pg8::StaticOrder S; S.init(M, NPROJ, G, bx);
        pg8::EpiProj E{ssq + 2 * M, (const float*)(ws + WS_INVREV), SIN, nullptr, nullptr, SEQ, {Kb, 3, 2, 768, 1.f}, {VT, 6, 1, 768, 1.f}, {Qb, 9, 2, 768, C2}, {MQ, 10, 0, 256, C2}, {nullptr, 11, 0, 0, 1.f}};
        pg8::gemm_phase<pg8::EpiProj, pg8::StaticOrder, true, true>(lds, g, S, E, wave0);
    }
#endif
    WT_IDLE(128, WT_A + WT_B1 + WT_B2, WT_A + WT_B1 + WT_B2 + WT_B3);
    GRID_SYNC();
#if PH_MASK & (1 << 7)
    {
        WSPTRS(); PHASE_IDS(); const float* subln_g = argp(lds, ASUBLN_G);
        volatile LAS unsigned* qword = (volatile LAS unsigned*)(lds + LDS_MISC);
        float d1 = argp(lds, ALQ1)[lane] * argp(lds, ALK1)[lane], d2 = argp(lds, ALQ2)[lane] * argp(lds, ALK2)[lane];
        d1 = wave_sum(d1); d2 = wave_sum(d2);
        const float lam = __builtin_bit_cast(float, __builtin_amdgcn_readfirstlane(__builtin_bit_cast(int, expf(d1) - expf(d2) + LAMBDA_INIT)));
        bool first_ = true;
        for (int rep_ = 0; rep_ < NREP7; ++rep_)
        for (;;) {
            if (HW_TID() == 0) qword[0] = first_ ? (unsigned)bx : (unsigned)G + atomicAdd(ctl + 1 + 2 * rep_, 1u);
            first_ = false;
            __syncthreads();
            const int u = (int)qword[0];
            __syncthreads();
            if (u >= 1024) break;
            if (u < 768) {
                const int qb = 31 - u / 24, bh = u % 24, b = bh / 6, hd = bh % 6;
                att::attn_diff_unit<SEQ>(lds, Qb + (size_t)b * SEQ * 768 + 128 * hd, Kb + (size_t)b * SEQ * 768 + 128 * hd, VT + (size_t)(b * 768 + 128 * hd) * SEQ, 128 * qb, qb + 1, lam, 1.0f - LAMBDA_INIT,
                                         subln_g, MIX + (size_t)b * SEQ * DM + 128 * hd, wave0);
            } else {
                att::f32x16 o[2];
                const int j = u - 768, b = j >> 6, hm = (j >> 4) & 3, qb = j & 15;
                att::attn_stream<64, false, false>(lds, MQ + (size_t)b * SEQ * 256 + 64 * hm, 256, MK + (size_t)(MM + b * NMEM) * 256 + 64 * hm, 256, MVT + (size_t)(MM + b * 256 + 64 * hm) * NMEM, NMEM,
                                                   nullptr, 256 * qb, 2, o, wave0);
                { const int l2_ = hw_lane(); att::store_o<64>(MIX + (size_t)(b * SEQ + 256 * qb + 32 * wave + (l2_ & 31)) * DM + 768 + 64 * hm, o, l2_ >> 5); }
            }
        }
    }
#endif
    GRID_SYNC();
#if PH_MASK & (1 << 8)
    for (int rep_ = 0; rep_ < NREPB; ++rep_) {
        WSPTRS(); float* outp = (float*)argp(lds, AOUT);
        pg8::Gemm g{MIX, WO + (size_t)1024 * 1024, M, DM, DM}; pg8::StaticOrder S; S.init(M, DM, G, bx);
        pg8::EpiRes E{XB, ssq + 3 * M};
        pg8::gemm_phase<pg8::EpiRes, pg8::StaticOrder, true, true>(lds, g, S, E, wave0);
    }
#endif
    GRID_SYNC();
#if PH_MASK & (1 << 9)
    for (int rep_ = 0; rep_ < NREPB; ++rep_) {
        WSPTRS();
        pg8::Gemm g{XB, WGU + (size_t)5632 * 1024, M, 2 * DFF, DM}; pg8::StaticOrder S; S.init(M, 2 * DFF, G, bx);
        pg8::EpiGU E{ssq + 3 * M, H};
        pg8::gemm_phase<pg8::EpiGU, pg8::StaticOrder, true, true>(lds, g, S, E, wave0);
    }
#endif
    GRID_SYNC();
#if PH_MASK & (1 << 10)
    {
        WSPTRS(); float* outp = (float*)argp(lds, AOUT);
        pg8::Gemm g{H, WD + (size_t)1024 * 2816, M, DM, DFF}; pg8::StaticOrder S; S.init(M, DM, G, bx);
        pg8::EpiResFinal E{XB, outp, ssq + 4 * M, ctl + 8192, argp(lds, AFINAL_G)};
        pg8::gemm_phase<pg8::EpiResFinal, pg8::StaticOrder, true, true>(lds, g, S, E, wave0);
    }
#endif
}

extern "C" void kernel_launch(void* const* d_in, const int* in_sizes, int n_in, void* d_out, int out_size, void* d_ws, size_t ws_size, hipStream_t stream) {
    static int grid = 0;
    if (grid == 0) {
        if (n_in != 20 || out_size != M * DM || ws_size < WS_END) { fprintf(stderr, "kernel_launch: unexpected sizes n_in %d out %d ws %zu\n", n_in, out_size, ws_size); grid = -1; return; }
        int dev = 0, cus = 0, per_cu = 0;
        (void)hipGetDevice(&dev); (void)hipDeviceGetAttribute(&cus, hipDeviceAttributeMultiprocessorCount, dev);
        (void)hipFuncSetAttribute((const void*)yoco_fwd, hipFuncAttributeMaxDynamicSharedMemorySize, LDS_BYTES);
        (void)hipOccupancyMaxActiveBlocksPerMultiprocessor(&per_cu, (const void*)yoco_fwd, 512, LDS_BYTES);
        if (per_cu < 1) { fprintf(stderr, "kernel_launch: occupancy query says %d blocks per CU; the grid barrier needs every workgroup resident: nothing launched\n", per_cu); grid = -1; return; }
        grid = cus;
        if (grid != 256) fprintf(stderr, "kernel_launch: %d CUs (expected 256)\n", grid);
    }
    if (grid < 0) return;
    Args a{};
    const float** p = (const float**)&a;
    for (int i = 0; i < 20; ++i) p[i] = (const float*)d_in[i];
    a.out = (float*)d_out; a.ws = (unsigned char*)d_ws;
    void* args[] = {&a};
#if USE_XB
    (void)hipMemsetAsync((char*)d_ws + WS_CTL, 0, 65536, stream);
    hipLaunchKernelGGL(yoco_fwd, dim3(grid), dim3(512), LDS_BYTES, stream, a);
    (void)args;
#else
    hipError_t e = hipLaunchCooperativeKernel((const void*)yoco_fwd, dim3(grid), dim3(512), args, LDS_BYTES, stream);
    if (e != hipSuccess) fprintf(stderr, "cooperative launch failed: %s (grid %d)\n", hipGetErrorString(e), grid);
#endif
}
```
